# Optimizing an MI355X kernel written in HIP

```python
import math
import jax, jax.numpy as jnp
from jax import lax
import numpy as np

D_MODEL = 1024
BATCH = 32
SEQ = 2048
DEPTH = 2
DEC_BATCH = 32
DEC_SEQ = 64
PAST_LEN = 4096

CHUNK = 64
Q_BLOCK = 128
ROPE_THETA = 10000.0
EPS = 1e-6
NEG_INF = -1e30
HEAD_DIM = D_MODEL // 16
D_FF = 11 * D_MODEL // 4
H_A = 4
Q_LORA = 4 * HEAD_DIM
KV_LORA = 2 * HEAD_DIM
NOPE_A = HEAD_DIM
ROPE_A = HEAD_DIM // 2
V_A = HEAD_DIM
H_B = 4
DH_B = HEAD_DIM
H_IDX = 8
D_IDX = HEAD_DIM
TOPK_MAX = 256
H_C = 4
DH_C = HEAD_DIM
H_D = 4
DQK_D = HEAD_DIM // 2
DV_D = HEAD_DIM
MIX_WIDTH = H_A * V_A + H_B * DH_B + H_C * DH_C + H_D * DV_D
COL_SIZES = (Q_LORA, KV_LORA, ROPE_A,
             H_B * DH_B, DH_B, DH_B, H_IDX * D_IDX, D_IDX, H_IDX,
             H_C * DH_C, H_C * DH_C, H_C * DH_C,
             H_D * 2 * DQK_D, H_D * 2 * DQK_D, H_D * DV_D)
IN_COLS = sum(COL_SIZES)

kernel_name = 'hybrid_streaming_encoder_step'


def _rmsnorm(x, g):
    xf = x.astype(jnp.float32)
    y = xf * lax.rsqrt(jnp.mean(xf * xf, axis=-1, keepdims=True) + EPS)
    return (y * g.astype(jnp.float32)).astype(x.dtype)


def _rope(x, pos):
    d = x.shape[-1]
    half = d // 2
    freqs = ROPE_THETA ** (-jnp.arange(half, dtype=jnp.float32) * 2.0 / d)
    ang = pos.astype(jnp.float32)[:, None] * freqs[None, :]
    shp = (1, pos.shape[0]) + (1,) * (x.ndim - 3) + (half,)
    cos = jnp.cos(ang).reshape(shp)
    sin = jnp.sin(ang).reshape(shp)
    xf = x.astype(jnp.float32)
    x1, x2 = xf[..., :half], xf[..., half:]
    return jnp.concatenate([x1 * cos - x2 * sin, x2 * cos + x1 * sin], axis=-1).astype(x.dtype)


def _swiglu(x, wg, wu, wd):
    return (jax.nn.silu(x @ wg) * (x @ wu)) @ wd


def _chunk_mask(q_pos, k_pos):
    return (k_pos[None, :] // CHUNK) <= (q_pos[:, None] // CHUNK)


def _with_past(past, new):
    return new if past is None else jnp.concatenate([past.astype(new.dtype), new], axis=1)


def _over_query_blocks(fn, q_pos, *q_arrays):
    T = q_pos.shape[0]
    if T <= Q_BLOCK:
        return fn(q_pos, *q_arrays)
    nb = T // Q_BLOCK
    split = lambda a: jnp.moveaxis(a.reshape((a.shape[0], nb, Q_BLOCK) + a.shape[2:]), 1, 0)
    xs = (q_pos.reshape(nb, Q_BLOCK),) + tuple(split(a) for a in q_arrays)
    out = lax.map(lambda args: fn(*args), xs)
    out = jnp.moveaxis(out, 0, 1)
    return out.reshape((out.shape[0], T) + out.shape[3:])


def _softmax_attend(q, k, v, mask):
    s = jnp.einsum('bqhd,bkhd->bhqk', q, k).astype(jnp.float32) * (q.shape[-1] ** -0.5)
    p = jax.nn.softmax(jnp.where(mask[None, None], s, NEG_INF), axis=-1).astype(v.dtype)
    return jnp.einsum('bhqk,bkhd->bqhd', p, v)


def _mla(cq, ckv, kr_raw, past, q_pos, k_pos, q_norm, w_qb, kv_norm, w_kvb):
    B, T = cq.shape[:2]
    q = (_rmsnorm(cq, q_norm) @ w_qb).reshape(B, T, H_A, NOPE_A + ROPE_A)
    q = jnp.concatenate([q[..., :NOPE_A], _rope(q[..., NOPE_A:], q_pos)], axis=-1)
    new_rows = jnp.concatenate([_rmsnorm(ckv, kv_norm), _rope(kr_raw, q_pos)], axis=-1)
    rows = _with_past(past, new_rows)
    L = rows.shape[1]
    kv = (rows[..., :KV_LORA] @ w_kvb).reshape(B, L, H_A, NOPE_A + V_A)
    k = jnp.concatenate([kv[..., :NOPE_A],
                         jnp.broadcast_to(rows[..., None, KV_LORA:], (B, L, H_A, ROPE_A))], axis=-1)
    v = kv[..., NOPE_A:]
    out = _over_query_blocks(lambda qp, qb: _softmax_attend(qb, k, v, _chunk_mask(qp, k_pos)), q_pos, q)
    return out.reshape(B, T, H_A * V_A), new_rows


def _dsa(q, k, v, qi, ki, wi, past, q_pos, k_pos):
    B, T = q.shape[:2]
    q = _rope(q.reshape(B, T, H_B, DH_B), q_pos)
    qi = _rope(qi.reshape(B, T, H_IDX, D_IDX), q_pos)
    wi = wi * (H_IDX ** -0.5)
    new_rows = jnp.concatenate([_rope(k, q_pos), v, _rope(ki, q_pos)], axis=-1)
    rows = _with_past(past, new_rows)
    L = rows.shape[1]
    k_all = rows[..., :DH_B]
    v_all = rows[..., DH_B:2 * DH_B]
    ki_all = rows[..., 2 * DH_B:]
    n_sel = min(TOPK_MAX, L // 4)
    gather = jax.vmap(lambda r, i: r[i])

    def block(qp, qb, qib, wib):
        mask = _chunk_mask(qp, k_pos)
        score = jax.nn.relu(jnp.einsum('bqhd,bkd->bqhk', qib, ki_all).astype(jnp.float32))
        score = jnp.einsum('bqhk,bqh->bqk', score, wib.astype(jnp.float32))
        score = jnp.where(mask[None], score, -jnp.inf)
        _, idx = lax.top_k(score, n_sel)
        valid = (k_pos[idx] // CHUNK) <= (qp[None, :, None] // CHUNK)
        ks = gather(k_all, idx)
        vs = gather(v_all, idx)
        s = jnp.einsum('bqhd,bqkd->bhqk', qb, ks).astype(jnp.float32) * (DH_B ** -0.5)
        p = jax.nn.softmax(jnp.where(valid[:, None], s, NEG_INF), axis=-1).astype(vs.dtype)
        return jnp.einsum('bhqk,bqkd->bqhd', p, vs)

    out = _over_query_blocks(block, q_pos, q, qi, wi)
    return out.reshape(B, T, H_B * DH_B), new_rows


def _stick_breaking(q, k, v, past, q_pos, k_pos):
    B, T = q.shape[:2]
    q = q.reshape(B, T, H_C, DH_C)
    new_rows = jnp.concatenate([k.reshape(B, T, H_C, DH_C), v.reshape(B, T, H_C, DH_C)], axis=-1)
    rows = _with_past(past, new_rows)
    k_all = rows[..., :DH_C]
    v_all = rows[..., DH_C:]

    def block(qp, qb):
        z = jnp.einsum('bqhd,bkhd->bhqk', qb, k_all).astype(jnp.float32) * (DH_C ** -0.5)
        mask = (k_pos[None, :] < qp[:, None])[None, None]
        log_keep = jnp.where(mask, jax.nn.log_sigmoid(-z), 0.0)
        log_after = lax.cumsum(log_keep, axis=3, reverse=True) - log_keep
        a = jnp.where(mask, jnp.exp(jax.nn.log_sigmoid(z) + log_after), 0.0)
        return jnp.einsum('bhqk,bkhd->bqhd', a.astype(v_all.dtype), v_all)

    out = _over_query_blocks(block, q_pos, q)
    return out.reshape(B, T, H_C * DH_C), new_rows


def _diff_attn(q, k, v, past, q_pos, k_pos, lam, sub_norm, lam_init):
    B, T = q.shape[:2]
    q = _rope(q.reshape(B, T, H_D, 2, DQK_D), q_pos)
    k = _rope(k.reshape(B, T, H_D, 2, DQK_D), q_pos).reshape(B, T, H_D, 2 * DQK_D)
    new_rows = jnp.concatenate([k, v.reshape(B, T, H_D, DV_D)], axis=-1)
    rows = _with_past(past, new_rows)
    L = rows.shape[1]
    k_all = rows[..., :2 * DQK_D].reshape(B, L, H_D, 2, DQK_D)
    v_all = rows[..., 2 * DQK_D:]
    lf = lam.astype(jnp.float32)
    lam_full = jnp.exp(jnp.sum(lf[0] * lf[1])) - jnp.exp(jnp.sum(lf[2] * lf[3])) + lam_init

    def block(qp, qb):
        s = jnp.einsum('bqhmd,bkhmd->bhmqk', qb, k_all).astype(jnp.float32) * (DQK_D ** -0.5)
        p = jax.nn.softmax(jnp.where(_chunk_mask(qp, k_pos)[None, None, None], s, NEG_INF), axis=-1)
        w = p[:, :, 0] - lam_full * p[:, :, 1]
        return jnp.einsum('bhqk,bkhd->bqhd', w.astype(v_all.dtype), v_all)

    out = _over_query_blocks(block, q_pos, q)
    out = _rmsnorm(out, sub_norm) * (1.0 - lam_init)
    return out.reshape(B, T, H_D * DV_D), new_rows


def _trunk(x, caches, q_pos, k_pos, params):
    (n1, g1, u1, d1, nm, w_in, qn, wqb, kvn, wkvb, lam, dn, wo, n2, g2, u2, d2, fnorm) = params
    split_at = np.cumsum(COL_SIZES)[:-1].tolist()
    rows_a, rows_b, rows_c, rows_d = [], [], [], []
    for l in range(DEPTH):
        if caches is None:
            pa = pb = pc = pd = None
        else:
            pa, pb, pc, pd = caches[0][l], caches[1][l], caches[2][l], caches[3][l]
        lam_init = 0.8 - 0.6 * math.exp(-0.3 * l)
        x = x + 0.5 * _swiglu(_rmsnorm(x, n1[l]), g1[l], u1[l], d1[l])
        (cq, ckv, kr, qb, kb, vb, qib, kib, wib, qc, kc, vc, qd, kd, vd) = jnp.split(
            _rmsnorm(x, nm[l]) @ w_in[l], split_at, axis=-1)
        oa, ra = _mla(cq, ckv, kr, pa, q_pos, k_pos, qn[l], wqb[l], kvn[l], wkvb[l])
        ob, rb = _dsa(qb, kb, vb, qib, kib, wib, pb, q_pos, k_pos)
        oc, rc = _stick_breaking(qc, kc, vc, pc, q_pos, k_pos)
        od, rd = _diff_attn(qd, kd, vd, pd, q_pos, k_pos, lam[l], dn[l], lam_init)
        x = x + jnp.concatenate([oa, ob, oc, od], axis=-1) @ wo[l]
        x = x + 0.5 * _swiglu(_rmsnorm(x, n2[l]), g2[l], u2[l], d2[l])
        rows_a.append(ra)
        rows_b.append(rb)
        rows_c.append(rc)
        rows_d.append(rd)
    return (_rmsnorm(x, fnorm), jnp.stack(rows_a), jnp.stack(rows_b), jnp.stack(rows_c), jnp.stack(rows_d))


def setup_inputs(seed: int = 0) -> dict:
    key = jax.random.key(seed)
    ks = iter(jax.random.split(key, 32))
    nrm = lambda shape, scale=1.0: scale * jax.random.normal(next(ks), shape, jnp.float32)
    gain = lambda shape: 1.0 + 0.01 * jax.random.normal(next(ks), shape, jnp.float32)
    return {
        'x_prompt': nrm((BATCH, SEQ, D_MODEL)),
        'x_sample': nrm((DEC_BATCH, DEC_SEQ, D_MODEL)),
        'cache_mla': nrm((DEPTH, DEC_BATCH, PAST_LEN, KV_LORA + ROPE_A)),
        'cache_dsa': nrm((DEPTH, DEC_BATCH, PAST_LEN, 2 * DH_B + D_IDX)),
        'cache_sb': nrm((DEPTH, DEC_BATCH, PAST_LEN, H_C, 2 * DH_C)),
        'cache_diff': nrm((DEPTH, DEC_BATCH, PAST_LEN, H_D, 2 * DQK_D + DV_D)),
        'norm_ff1': gain((DEPTH, D_MODEL)),
        'w_ff1_gate': nrm((DEPTH, D_MODEL, D_FF), D_MODEL ** -0.5),
        'w_ff1_up': nrm((DEPTH, D_MODEL, D_FF), D_MODEL ** -0.5),
        'w_ff1_down': nrm((DEPTH, D_FF, D_MODEL), D_FF ** -0.5),
        'norm_mix': gain((DEPTH, D_MODEL)),
        'w_in': nrm((DEPTH, D_MODEL, IN_COLS), D_MODEL ** -0.5),
        'mla_q_norm': gain((DEPTH, Q_LORA)),
        'mla_w_qb': nrm((DEPTH, Q_LORA, H_A * (NOPE_A + ROPE_A)), Q_LORA ** -0.5),
        'mla_kv_norm': gain((DEPTH, KV_LORA)),
        'mla_w_kvb': nrm((DEPTH, KV_LORA, H_A * (NOPE_A + V_A)), KV_LORA ** -0.5),
        'diff_lambda': nrm((DEPTH, 4, DQK_D), 0.1),
        'diff_norm': gain((DEPTH, DV_D)),
        'w_out': nrm((DEPTH, MIX_WIDTH, D_MODEL), MIX_WIDTH ** -0.5),
        'norm_ff2': gain((DEPTH, D_MODEL)),
        'w_ff2_gate': nrm((DEPTH, D_MODEL, D_FF), D_MODEL ** -0.5),
        'w_ff2_up': nrm((DEPTH, D_MODEL, D_FF), D_MODEL ** -0.5),
        'w_ff2_down': nrm((DEPTH, D_FF, D_MODEL), D_FF ** -0.5),
        'final_norm': gain((D_MODEL,)),
    }


def reference(x_prompt, x_sample, cache_mla, cache_dsa, cache_sb, cache_diff,
              norm_ff1, w_ff1_gate, w_ff1_up, w_ff1_down, norm_mix, w_in,
              mla_q_norm, mla_w_qb, mla_kv_norm, mla_w_kvb, diff_lambda, diff_norm, w_out,
              norm_ff2, w_ff2_gate, w_ff2_up, w_ff2_down, final_norm):
    params = (norm_ff1, w_ff1_gate, w_ff1_up, w_ff1_down, norm_mix, w_in,
              mla_q_norm, mla_w_qb, mla_kv_norm, mla_w_kvb, diff_lambda, diff_norm, w_out,
              norm_ff2, w_ff2_gate, w_ff2_up, w_ff2_down, final_norm)
    p_pos = jnp.arange(x_prompt.shape[1], dtype=jnp.int32)
    y_prompt, mla_p, dsa_p, sb_p, diff_p = _trunk(x_prompt, None, p_pos, p_pos, params)
    past_len = cache_mla.shape[2]
    t_new = x_sample.shape[1]
    s_qpos = past_len + jnp.arange(t_new, dtype=jnp.int32)
    s_kpos = jnp.arange(past_len + t_new, dtype=jnp.int32)
    y_sample, mla_s, dsa_s, sb_s, diff_s = _trunk(
        x_sample, (cache_mla, cache_dsa, cache_sb, cache_diff), s_qpos, s_kpos, params)
    return (y_prompt, y_sample, mla_p, dsa_p, sb_p, diff_p, mla_s, dsa_s, sb_s, diff_s)
```

```cpp
#include <hip/hip_runtime.h>
#include <cstdio>
#include <cstdint>
#include <cmath>

#ifndef DBG_VARIANTS
#define DBG_VARIANTS 0
#endif
#ifndef ATTN_REPS
#define ATTN_REPS 1
#endif
#ifndef POST_REPS
#define POST_REPS 1
#endif
#ifndef GU_REPS
#define GU_REPS 1
#endif
#ifndef P0_REPS
#define P0_REPS 1
#endif
#ifndef REP_MASK
#define REP_MASK 15
#endif
#ifndef SELFCHECK
#define SELFCHECK 0
#endif
#ifndef CHK_FILTER
#define CHK_FILTER 0
#endif
#ifndef FUSE_POST
#define FUSE_POST 1
#endif
#ifndef MK_N_LAUNCHES
#define MK_N_LAUNCHES 1
#endif

#ifndef PHMASK
#define PHMASK 0x3ff
#endif
#define EN_PH(c) (((PHMASK) >> (c)) & 1)
#ifndef EN_MLA
#define EN_MLA 1
#endif
#ifndef EN_DSA
#define EN_DSA 1
#endif
#ifndef EN_SB
#define EN_SB 1
#endif
#ifndef EN_DIFF
#define EN_DIFF 1
#endif
#define LAS __attribute__((address_space(3)))
#define GAS __attribute__((address_space(1)))

constexpr int DM = 1024, NB = 32, SEQ = 2048, DEPTH = 2, DSEQ = 64, PAST = 4096;
constexpr int MP = NB * SEQ, MS = NB * DSEQ, M = MP + MS;
constexpr int DFF = 2816, NGU = 2 * DFF, NIN = 2920, NINP = 3072, NQ = 640, NQP = 768, KOUT = 1280;
constexpr float EPS = 1e-6f;
constexpr float LOG2E = 1.4426950408889634f;
constexpr int H_CQ = 0, H_CKV = 256, H_KR = 384, H_QB = 416, H_KB = 672, H_VB = 736, H_QI = 800, H_KI = 1312,
              H_QC = 1376, H_KC = 1632, H_VC = 1888, H_QD = 2144, H_KD = 2400, H_VD = 2656, H_WI = 2912;
constexpr size_t O_Y = 0;
constexpr size_t O_MLA_P = (size_t)M * DM;
constexpr size_t O_DSA_P = O_MLA_P + (size_t)DEPTH * MP * 160;
constexpr size_t O_SB_P = O_DSA_P + (size_t)DEPTH * MP * 192;
constexpr size_t O_DIFF_P = O_SB_P + (size_t)DEPTH * MP * 512;
constexpr size_t O_MLA_S = O_DIFF_P + (size_t)DEPTH * MP * 512;
constexpr size_t O_DSA_S = O_MLA_S + (size_t)DEPTH * MS * 160;
constexpr size_t O_SB_S = O_DSA_S + (size_t)DEPTH * MS * 192;
constexpr size_t O_DIFF_S = O_SB_S + (size_t)DEPTH * MS * 512;
constexpr size_t O_END = O_DIFF_S + (size_t)DEPTH * MS * 512;

constexpr size_t MiB = 1u << 20;
constexpr size_t WS_CTL = 0, CTL_ZERO_BYTES = SELFCHECK ? 4 * MiB : 128 * 1024;
constexpr size_t WS_SSQ = 1 * MiB;
constexpr size_t WS_MISC = 4 * MiB;
constexpr size_t MISC_ROPE64 = 4096, MISC_ROPE32 = MISC_ROPE64 + (size_t)2112 * 32 * 8;
constexpr size_t WS_W = 5 * MiB;
constexpr size_t W_GU1 = 0, W_D1 = W_GU1 + (size_t)NGU * DM * 2, W_IN = W_D1 + (size_t)DM * DFF * 2, W_Q = W_IN + (size_t)NINP * DM * 2,
                 W_OUT = W_Q + (size_t)NQP * 256 * 2, W_GU2 = W_OUT + (size_t)DM * KOUT * 2, W_D2 = W_GU2 + (size_t)NGU * DM * 2, W_LAYER = W_D2 + (size_t)DM * DFF * 2;
constexpr size_t WS_XB = 90 * MiB;
constexpr size_t WS_REGA = 222 * MiB;
constexpr size_t REGA_BYTES = (size_t)M * NINP * 2;
constexpr size_t WS_QA = 618 * MiB, WS_QB = 717 * MiB, WS_QI = 750 * MiB, WS_QC = 816 * MiB, WS_QD = 849 * MiB, WS_WI = 882 * MiB;
constexpr size_t WS_RA = 885 * MiB, WS_RB = 906 * MiB, WS_RC = 931 * MiB, WS_RD = 997 * MiB, WS_CC = 1063 * MiB, WS_SSQP = 1228 * MiB, WS_END = 1264 * MiB;
static_assert(WS_W + 2 * W_LAYER <= WS_XB && WS_XB + (size_t)M * DM * 2 <= WS_REGA && WS_REGA + REGA_BYTES <= WS_QA, "ws map");
static_assert(WS_QA + (size_t)M * NQP * 2 <= WS_QB && WS_QI + (size_t)M * 512 * 2 <= WS_QC && WS_WI + (size_t)M * 32 <= WS_RA, "ws map");
static_assert(WS_RA + (size_t)M * 160 * 2 <= WS_RB && WS_RB + (size_t)M * 192 * 2 <= WS_RC && WS_RC + (size_t)M * 1024 <= WS_RD && WS_RD + (size_t)M * 1024 <= WS_CC && WS_CC + (size_t)M * KOUT * 2 <= WS_SSQP && WS_SSQP + (size_t)M * 16 * 4 * 7 + (size_t)M * 4 * 4 * 4 <= WS_END, "ws map");
constexpr int CW_BAR = 4096, CW_Q = 8192;
constexpr int SC_LS = 4160;
constexpr int MK_LS = 72;
constexpr size_t DSA_SCR = 1105920;
constexpr size_t DSA_MASK_OFF = (size_t)64 * SC_LS * 4;
static_assert(DSA_MASK_OFF + 64 * MK_LS * 8 <= DSA_SCR && 256 * DSA_SCR <= REGA_BYTES, "dsa scratch");

constexpr int RING_BYTES = 135168, LDSCTL_OFF = RING_BYTES, MISC_OFF = LDSCTL_OFF + 320, LDS_BYTES = 147456;
constexpr int NWAVES = 8;

typedef unsigned short bf16;
typedef unsigned v4u __attribute__((ext_vector_type(4)));
typedef unsigned v2u __attribute__((ext_vector_type(2)));
typedef float f32x4 __attribute__((ext_vector_type(4)));
typedef float f32x16 __attribute__((ext_vector_type(16)));
typedef short bf16x8 __attribute__((ext_vector_type(8)));
typedef short s16x4 __attribute__((ext_vector_type(4)));
typedef GAS unsigned gu32;
#define RLX_AGENT __ATOMIC_RELAXED, __HIP_MEMORY_SCOPE_AGENT
#define LDS_WAIT() asm volatile("s_waitcnt lgkmcnt(0)" ::: "memory")
#define VM_WAIT() asm volatile("s_waitcnt vmcnt(0)" ::: "memory")

__device__ __forceinline__ unsigned f2bf(float f) { unsigned u = __builtin_bit_cast(unsigned, f); return (u + 0x7fffu + ((u >> 16) & 1u)) >> 16; }
__device__ __forceinline__ unsigned pk2(float lo, float hi) { return f2bf(lo) | (f2bf(hi) << 16); }
__device__ __forceinline__ float bf2f(bf16 b) { return __builtin_bit_cast(float, ((unsigned)b) << 16); }
typedef float f32x2_t __attribute__((ext_vector_type(2))); typedef __bf16 bf16x2_t __attribute__((ext_vector_type(2)));
__device__ __forceinline__ unsigned cvtpk(float lo, float hi) { f32x2_t v = {lo, hi}; bf16x2_t b = __builtin_convertvector(v, bf16x2_t); return __builtin_bit_cast(unsigned, b); }
__device__ __forceinline__ int opaque_s(int x) { asm volatile("" : "+s"(x)); return x; }
__device__ __forceinline__ float opaque_vf(float x) { asm volatile("" : "+v"(x)); return x; }
__device__ __forceinline__ float wave_sum(float v) {
#pragma unroll
    for (int o = 1; o < 64; o <<= 1) v += __shfl_xor(v, o);
    return v;
}

__device__ __forceinline__ float ssq_sum16(const float* p, int row) { const f32x4* q = (const f32x4*)(p + (size_t)row * 16); const f32x4 a = q[0], b = q[1], c = q[2], d = q[3];
    return (((a[0] + a[1]) + (a[2] + a[3])) + ((b[0] + b[1]) + (b[2] + b[3]))) + (((c[0] + c[1]) + (c[2] + c[3])) + ((d[0] + d[1]) + (d[2] + d[3]))); }
__device__ __forceinline__ float ssq_sum4(const float* p, int row) { const f32x4 a = *(const f32x4*)(p + (size_t)row * 4); return (a[0] + a[1]) + (a[2] + a[3]); }
namespace pg8 {
#define PG8_LAS __attribute__((address_space(3)))
typedef unsigned short bf16_t;
typedef unsigned u32x4 __attribute__((ext_vector_type(4)));
constexpr int BM = 256, BK = 64, HALF = 128, HTB = HALF * BK * 2, STAGE_BYTES = 8 * HTB, NXCD = 8, WGM = 8;
__host__ __device__ __forceinline__ int lds_byte(int r, int c) { const int st = (r >> 4) * 2 + (c >> 5), rr = r & 15, cc = c & 31, ob = rr * 64 + cc * 2; return st * 1024 + (ob ^ (((ob >> 9) & 1) << 5)); }
__host__ __device__ __forceinline__ void stage_rc(int b, int& R, int& C) { const int st = b / 1024, sb = b % 1024, swz = sb ^ (((sb >> 9) & 1) << 5); R = (st >> 1) * 16 + swz / 64; C = (st & 1) * 32 + (swz % 64) / 2; }
__host__ __device__ __forceinline__ int perm32(int rho) { const int n = rho >> 4, i = rho & 15; return 8 * (i >> 2) + 4 * n + (i & 3); }
struct Unit { int pm, pn; };
struct Gemm { const bf16_t* A; const bf16_t* Bt; int M, N, K, lda; };
struct StaticOrder {
    int nM, nN, nwg, G, c;
    __host__ __device__ void init(int M_, int N_, int G_, int c_) { nM = M_ / BM; nN = N_ / BM; nwg = nM * nN; G = G_; c = c_; }
    __host__ __device__ bool next(int i, Unit& u) const {
        const long L = (long)i * G + c; if (L >= nwg) return false;
        int wgid = (int)L; { const int q = nwg / NXCD, r = nwg % NXCD, xcd = wgid % NXCD, off = wgid / NXCD; wgid = (xcd < r ? xcd * (q + 1) : r * (q + 1) + (xcd - r) * q) + off; }
        const int nig = WGM * nN, gid = wgid / nig, fm = gid * WGM, gsz = (nM - fm) < WGM ? (nM - fm) : WGM;
        u.pm = fm + ((wgid % nig) % gsz); u.pn = (wgid % nig) / gsz; return true;
    }
    __device__ __forceinline__ void a_ready(const Unit&) const {}
    __device__ __forceinline__ void done(const Unit&) const {}
};

struct EpiSwiGLU {
    static constexpr bool PERM = true, AFTER_DRAIN = false;
    bf16_t* act; const float* ssq;
    __device__ __forceinline__ void operator()(const f32x4 (&acc)[2][2][4][2], const Unit& u, int wr, int wc, int fr, int fq) const {
        const int row0 = u.pm * BM + wr * 64 + fr, col0 = u.pn * 128 + wc * 32 + 8 * fq;
#pragma unroll
        for (int ai = 0; ai < 2; ++ai)
#pragma unroll
            for (int m = 0; m < 4; ++m) {
                const int row = row0 + ai * HALF + m * 16;
                const float rs = 1.0f / sqrtf(ssq_sum16(ssq, row) * (1.0f / 1024.0f) + EPS);
                float o[8];
#pragma unroll
                for (int n = 0; n < 2; ++n)
#pragma unroll
                    for (int j = 0; j < 4; ++j) {
                        const float g = acc[ai][0][m][n][j] * rs, up = acc[ai][1][m][n][j] * rs;
                        const float sg = g * __builtin_amdgcn_rcpf(1.0f + __builtin_amdgcn_exp2f(-g * LOG2E));
                        o[n * 4 + j] = sg * up;
                    }
                u32x4 w; w.x = cvtpk(o[0], o[1]); w.y = cvtpk(o[2], o[3]); w.z = cvtpk(o[4], o[5]); w.w = cvtpk(o[6], o[7]);
                *(u32x4*)(act + (size_t)row * DFF + col0) = w;
            }
    }
};
template <bool BASE_F32> struct EpiResid {
    static constexpr bool PERM = true, AFTER_DRAIN = false;
    const float* baseP; const float* baseS; bf16_t* xb; float* ssq_out; float alpha;
    __device__ __forceinline__ void operator()(const f32x4 (&acc)[2][2][4][2], const Unit& u, int wr, int wc, int fr, int fq) const {
        const int row0 = u.pm * BM + wr * 64 + fr, col0 = u.pn * BM + wc * 32 + 8 * fq;
        const float* base = (u.pm < MP / BM) ? baseP : baseS;
#pragma unroll
        for (int ai = 0; ai < 2; ++ai)
#pragma unroll
            for (int m = 0; m < 4; ++m) {
                const int row = row0 + ai * HALF + m * 16; const size_t off = (size_t)row * DM + col0; float ss = 0.f;
#pragma unroll
                for (int bj = 0; bj < 2; ++bj) {
                    f32x4 b0, b1;
                    if (BASE_F32) { b0 = *(const f32x4*)(base + off + bj * HALF); b1 = *(const f32x4*)(base + off + bj * HALF + 4); }
                    else { const u32x4 w = *(const u32x4*)(xb + off + bj * HALF);
                        b0 = (f32x4){__uint_as_float(w.x << 16), __uint_as_float(w.x & 0xffff0000u), __uint_as_float(w.y << 16), __uint_as_float(w.y & 0xffff0000u)};
                        b1 = (f32x4){__uint_as_float(w.z << 16), __uint_as_float(w.z & 0xffff0000u), __uint_as_float(w.w << 16), __uint_as_float(w.w & 0xffff0000u)}; }
                    const f32x4 o0 = b0 + acc[ai][bj][m][0] * alpha, o1 = b1 + acc[ai][bj][m][1] * alpha;
                    u32x4 w2; w2.x = cvtpk(o0[0], o0[1]); w2.y = cvtpk(o0[2], o0[3]); w2.z = cvtpk(o1[0], o1[1]); w2.w = cvtpk(o1[2], o1[3]);
                    *(u32x4*)(xb + off + bj * HALF) = w2;
                    ss += (o0[0] * o0[0] + o0[1] * o0[1]) + (o0[2] * o0[2] + o0[3] * o0[3]) + (o1[0] * o1[0] + o1[1] * o1[1]) + (o1[2] * o1[2] + o1[3] * o1[3]);
                }
                ss += __shfl_xor(ss, 16); ss += __shfl_xor(ss, 32);
                if (fq == 0) ssq_out[(size_t)row * 16 + u.pn * 4 + wc] = ss;
                asm volatile("" ::: "memory");
            }
    }
};
struct EpiScaleBf16 {
    static constexpr bool PERM = true, AFTER_DRAIN = false;
    bf16_t* O; int ldc; const float* ssq_in; int np_in; float inv_dim; float* ssq_out;
    __device__ __forceinline__ void operator()(const f32x4 (&acc)[2][2][4][2], const Unit& u, int wr, int wc, int fr, int fq) const {
        const int row0 = u.pm * BM + wr * 64 + fr, col0 = u.pn * BM + wc * 32 + 8 * fq;
        const bool do_ssq = (ssq_out != nullptr) && (u.pn == 0);
#pragma unroll
        for (int ai = 0; ai < 2; ++ai)
#pragma unroll
            for (int m = 0; m < 4; ++m) {
                const int row = row0 + ai * HALF + m * 16;
                const float rs = 1.0f / sqrtf((np_in == 16 ? ssq_sum16(ssq_in, row) : ssq_sum4(ssq_in, row)) * inv_dim + EPS); float ss = 0.f;
                bf16_t* rowp = O + (size_t)row * ldc + col0;
#pragma unroll
                for (int bj = 0; bj < 2; ++bj) {
                    const f32x4 v0 = acc[ai][bj][m][0] * rs, v1 = acc[ai][bj][m][1] * rs;
                    u32x4 w; w.x = cvtpk(v0[0], v0[1]); w.y = cvtpk(v0[2], v0[3]); w.z = cvtpk(v1[0], v1[1]); w.w = cvtpk(v1[2], v1[3]);
                    *(u32x4*)(rowp + bj * HALF) = w;
                    ss += (v0[0] * v0[0] + v0[1] * v0[1]) + (v0[2] * v0[2] + v0[3] * v0[3]) + (v1[0] * v1[0] + v1[1] * v1[1]) + (v1[2] * v1[2] + v1[3] * v1[3]);
                }
                if (do_ssq) { ss += __shfl_xor(ss, 16); ss += __shfl_xor(ss, 32); if (fq == 0) ssq_out[(size_t)row * 4 + wc] = ss; }
            }
    }
};


struct EpiInFused {
    static constexpr bool PERM = true, AFTER_DRAIN = false;
    unsigned char* ws; float* out; int layer;
    __device__ __forceinline__ void operator()(const f32x4 (&acc)[2][2][4][2], const Unit& u, int wr, int wc, int fr_, int fq_) const {
        int fr = fr_, fq = fq_; asm volatile("" : "+v"(fr), "+v"(fq));
        const int row0 = u.pm * BM + wr * 64 + fr, c0 = wc * 32 + 8 * fq, pn = u.pn;
        float* const SSQP_ = (float*)(ws + WS_SSQP);
        const float* ssq_in = SSQP_ + (size_t)(3 + layer) * M * 16; float* ssq_cq = SSQP_ + (size_t)7 * M * 16 + (size_t)layer * M * 4; float* ssq_kv = SSQP_ + (size_t)7 * M * 16 + (size_t)(2 + layer) * M * 4;
        bf16_t* const CQ = (bf16_t*)(ws + WS_REGA + (size_t)300 * MiB); bf16_t* const CKV = (bf16_t*)(ws + WS_REGA + (size_t)340 * MiB);
        bf16_t* const QB = (bf16_t*)(ws + WS_QB); bf16_t* const QI = (bf16_t*)(ws + WS_QI); bf16_t* const QC = (bf16_t*)(ws + WS_QC); bf16_t* const QD = (bf16_t*)(ws + WS_QD);
        bf16_t* const RA = (bf16_t*)(ws + WS_RA); bf16_t* const RB = (bf16_t*)(ws + WS_RB); bf16_t* const RC = (bf16_t*)(ws + WS_RC); bf16_t* const RD = (bf16_t*)(ws + WS_RD);
        float* const WI = (float*)(ws + WS_WI); const float2* const R64 = (const float2*)(ws + WS_MISC + MISC_ROPE64); const float2* const R32 = (const float2*)(ws + WS_MISC + MISC_ROPE32);
        bf16_t* const HBdbg = SELFCHECK ? (bf16_t*)(ws + WS_REGA) : nullptr;
        const float scaleB = 0.125f * LOG2E, scaleD = 0.17677669529663687f * LOG2E, scaleC = 0.125f * LOG2E;
#define EPK8(f) ((u32x4){cvtpk(f[0], f[1]), cvtpk(f[2], f[3]), cvtpk(f[4], f[5]), cvtpk(f[6], f[7])})
#define EST8F(p, f) do { *(f32x4*)(p) = (f32x4){f[0], f[1], f[2], f[3]}; *(f32x4*)((p) + 4) = (f32x4){f[4], f[5], f[6], f[7]}; } while (0)
#pragma unroll
        for (int ai = 0; ai < 2; ++ai)
#pragma unroll
            for (int m = 0; m < 4; ++m) {
                const int row = row0 + ai * HALF + m * 16;
                const float rs = 1.0f / sqrtf(ssq_sum16(ssq_in, row) * (1.0f / 1024.0f) + EPS);
                float v0[8], v1[8];
#pragma unroll
                for (int e = 0; e < 4; ++e) { v0[e] = acc[ai][0][m][0][e] * rs; v0[4 + e] = acc[ai][0][m][1][e] * rs; v1[e] = acc[ai][1][m][0][e] * rs; v1[4 + e] = acc[ai][1][m][1][e] * rs; }
                if (HBdbg) { *(u32x4*)(HBdbg + (size_t)row * NINP + pn * 256 + c0) = EPK8(v0); *(u32x4*)(HBdbg + (size_t)row * NINP + pn * 256 + 128 + c0) = EPK8(v1); }
                const bool smp = row >= MP; const int rr = smp ? row - MP : row; const int pidx = smp ? 2048 + (rr & 63) : (rr & 2047);
                if (pn == 0) {
                    *(u32x4*)(CQ + (size_t)row * 256 + c0) = EPK8(v0); *(u32x4*)(CQ + (size_t)row * 256 + 128 + c0) = EPK8(v1);
                    float ss = 0.f;
#pragma unroll
                    for (int e = 0; e < 8; ++e) ss += v0[e] * v0[e] + v1[e] * v1[e];
                    ss += __shfl_xor(ss, 16); ss += __shfl_xor(ss, 32); if (fq == 0) ssq_cq[(size_t)row * 4 + wc] = ss;
                } else if (pn <= 6 && pn != 4) {
                    const bool d32 = pn >= 5; const int i0 = d32 ? 8 * (fq & 1) : 8 * fq;
                    const f32x4* cp = (const f32x4*)(d32 ? R32 + pidx * 16 + i0 : R64 + pidx * 32 + i0);
                    float a[8], b[8];
#pragma unroll
                    for (int e2 = 0; e2 < 4; ++e2) { const f32x4 cs = cp[e2];
                        a[2 * e2] = v0[2 * e2] * cs[0] - v1[2 * e2] * cs[1]; b[2 * e2] = v1[2 * e2] * cs[0] + v0[2 * e2] * cs[1];
                        a[2 * e2 + 1] = v0[2 * e2 + 1] * cs[2] - v1[2 * e2 + 1] * cs[3]; b[2 * e2 + 1] = v1[2 * e2 + 1] * cs[2] + v0[2 * e2 + 1] * cs[3]; }
                    if (pn == 1) {
#pragma unroll
                        for (int e = 0; e < 8; ++e) { a[e] *= scaleB; b[e] *= scaleB; }
                        bf16_t* d = QB + (size_t)row * 256 + wc * 64 + 8 * fq; *(u32x4*)d = EPK8(a); *(u32x4*)(d + 32) = EPK8(b);
                    } else if (pn <= 3) { bf16_t* d = QI + (size_t)row * 512 + (4 * (pn - 2) + wc) * 64 + 8 * fq; *(u32x4*)d = EPK8(a); *(u32x4*)(d + 32) = EPK8(b);
                    } else { const int blk = 2 * wc + (fq >> 1);
                        if (pn == 5) {
#pragma unroll
                            for (int e = 0; e < 8; ++e) { a[e] *= scaleD; b[e] *= scaleD; }
                            bf16_t* d = QD + (size_t)row * 256 + blk * 32 + i0; *(u32x4*)d = EPK8(a); *(u32x4*)(d + 16) = EPK8(b);
                        } else { const int oc = (blk >> 1) * 128 + (blk & 1) * 32 + i0;
                            float* od = out + (smp ? O_DIFF_S + ((size_t)layer * MS + rr) * 512 : O_DIFF_P + ((size_t)layer * MP + rr) * 512) + oc;
                            EST8F(od, a); EST8F(od + 16, b); bf16_t* d = RD + (size_t)row * 512 + oc; *(u32x4*)d = EPK8(a); *(u32x4*)(d + 16) = EPK8(b); } }
                } else if (pn == 4) {
                    if (wc < 2 || (wc == 2 && fq < 2)) {
                        const bool d32 = wc == 2; const f32x4* cp = (const f32x4*)(d32 ? R32 + pidx * 16 + 8 * fq : R64 + pidx * 32 + 8 * fq);
                        float a[8], b[8];
#pragma unroll
                        for (int e2 = 0; e2 < 4; ++e2) { const f32x4 cs = cp[e2];
                            a[2 * e2] = v0[2 * e2] * cs[0] - v1[2 * e2] * cs[1]; b[2 * e2] = v1[2 * e2] * cs[0] + v0[2 * e2] * cs[1];
                            a[2 * e2 + 1] = v0[2 * e2 + 1] * cs[2] - v1[2 * e2 + 1] * cs[3]; b[2 * e2 + 1] = v1[2 * e2 + 1] * cs[2] + v0[2 * e2 + 1] * cs[3]; }
                        if (!d32) { const int oc = (wc == 0 ? 0 : 128) + 8 * fq;
                            float* od = out + (smp ? O_DSA_S + ((size_t)layer * MS + rr) * 192 : O_DSA_P + ((size_t)layer * MP + rr) * 192) + oc;
                            EST8F(od, a); EST8F(od + 32, b); bf16_t* d = RB + (size_t)row * 192 + oc; *(u32x4*)d = EPK8(a); *(u32x4*)(d + 32) = EPK8(b);
                        } else { const int oc = 128 + 8 * fq;
                            float* od = out + (smp ? O_MLA_S + ((size_t)layer * MS + rr) * 160 : O_MLA_P + ((size_t)layer * MP + rr) * 160) + oc;
                            EST8F(od, a); EST8F(od + 16, b); bf16_t* d = RA + (size_t)row * 160 + oc; *(u32x4*)d = EPK8(a); *(u32x4*)(d + 16) = EPK8(b); } }
                } else if (pn == 7) {
                    *(u32x4*)(CKV + (size_t)row * 128 + c0) = EPK8(v0);
                    float ss = 0.f;
#pragma unroll
                    for (int e = 0; e < 8; ++e) ss += v0[e] * v0[e];
                    ss += __shfl_xor(ss, 16); ss += __shfl_xor(ss, 32); if (fq == 0) ssq_kv[(size_t)row * 4 + wc] = ss;
                    if (wc < 2) { const int oc = 64 + c0; float* od = out + (smp ? O_DSA_S + ((size_t)layer * MS + rr) * 192 : O_DSA_P + ((size_t)layer * MP + rr) * 192) + oc;
                        EST8F(od, v1); *(u32x4*)(RB + (size_t)row * 192 + oc) = EPK8(v1); }
                    else if (wc == 2 && fq == 0) { float w8[8];
#pragma unroll
                        for (int e = 0; e < 8; ++e) w8[e] = v1[e] * 0.35355339059327373f;
                        EST8F(WI + (size_t)row * 8, w8); }
                } else if (pn == 8) {
                    float a[8], b[8];
#pragma unroll
                    for (int e = 0; e < 8; ++e) { a[e] = v0[e] * scaleC; b[e] = v1[e] * scaleC; }
                    *(u32x4*)(QC + (size_t)row * 256 + c0) = EPK8(a); *(u32x4*)(QC + (size_t)row * 256 + 128 + c0) = EPK8(b);
                } else {
                    const int h0 = wc >> 1, d0 = 32 * (wc & 1) + 8 * fq;
                    const int voff = (pn == 9) ? 0 : 64;
                    if (pn == 11) { float* od = out + (smp ? O_DIFF_S + ((size_t)layer * MS + rr) * 512 : O_DIFF_P + ((size_t)layer * MP + rr) * 512);
                        EST8F(od + h0 * 128 + voff + d0, v0); EST8F(od + (h0 + 2) * 128 + voff + d0, v1);
                        *(u32x4*)(RD + (size_t)row * 512 + h0 * 128 + voff + d0) = EPK8(v0); *(u32x4*)(RD + (size_t)row * 512 + (h0 + 2) * 128 + voff + d0) = EPK8(v1);
                    } else { float* od = out + (smp ? O_SB_S + ((size_t)layer * MS + rr) * 512 : O_SB_P + ((size_t)layer * MP + rr) * 512);
                        EST8F(od + h0 * 128 + voff + d0, v0); EST8F(od + (h0 + 2) * 128 + voff + d0, v1);
                        *(u32x4*)(RC + (size_t)row * 512 + h0 * 128 + voff + d0) = EPK8(v0); *(u32x4*)(RC + (size_t)row * 512 + (h0 + 2) * 128 + voff + d0) = EPK8(v1); }
                }
                asm volatile("" ::: "memory");
            }
#undef EPK8
#undef EST8F
    }
};

template <class Epi, class Sched, bool ALIGN_EPI = false, bool SP2 = false>
__device__ __forceinline__ void gemm_phase(PG8_LAS unsigned char* lds, const Gemm g, const Sched& S, const Epi& E) {
    int tid_ = threadIdx.x; asm volatile("" : "+v"(tid_));
    const int tid = tid_, wid = __builtin_amdgcn_readfirstlane(tid >> 6), lane = tid & 63, wr = wid >> 2, wc = wid & 3, fr = lane & 15, fq = lane >> 4;
    const int K = g.K, nt = K / BK, lda = g.lda;
    unsigned voffA[2], voffB[2];
#pragma unroll
    for (int i = 0; i < 2; ++i) { int R, C; stage_rc(tid * 16 + i * 8192, R, C); const int Rb = Epi::PERM ? ((R & ~31) + perm32(R & 31)) : R;
        voffA[i] = (unsigned)(R * lda + C) * 2u; voffB[i] = (unsigned)(Rb * K + C) * 2u; }
    const size_t kstep = (size_t)(BK * 2);
    const size_t hstepA = (size_t)HALF * lda * 2, hstepB = (size_t)HALF * K * 2;
    const size_t tstepA = 2 * hstepA, tstepB = 2 * hstepB;
    const unsigned ldsw = (unsigned)wid * 1024u;
    const int aoff = lds_byte(wr * 64 + fr, fq * 8), boff = lds_byte(wc * 32 + fr, fq * 8);
#define PG8_SA(b, h) (((b) * 2 + (h)) * HTB)
#define PG8_SB(b, h) ((4 + (b) * 2 + (h)) * HTB)
#define PG8_STAGE(bufoff, gbase, voff) do { _Pragma("unroll") for (int _i = 0; _i < 2; ++_i) \
        __builtin_amdgcn_global_load_lds((const unsigned*)((const char*)(gbase) + (voff)[_i]), (PG8_LAS unsigned*)(lds + (bufoff) + ldsw + _i * 8192), 16, 0, 0); } while (0)
#define PG8_LDA(dst, b, h) do { _Pragma("unroll") for (int m = 0; m < 4; ++m) _Pragma("unroll") for (int k = 0; k < 2; ++k) dst[m][k] = *(const PG8_LAS bf16x8*)(lds + PG8_SA(b, h) + aoff + m * 2048 + k * 1024); } while (0)
#define PG8_LDB(dst, b, h) do { _Pragma("unroll") for (int n = 0; n < 2; ++n) _Pragma("unroll") for (int k = 0; k < 2; ++k) dst[n][k] = *(const PG8_LAS bf16x8*)(lds + PG8_SB(b, h) + boff + n * 2048 + k * 1024); } while (0)
#define PG8_MMA(ai, bj, At, Bt) do { __builtin_amdgcn_s_setprio(1); _Pragma("unroll") for (int m = 0; m < 4; ++m) _Pragma("unroll") for (int n = 0; n < 2; ++n) _Pragma("unroll") for (int k = 0; k < 2; ++k) \
        acc[ai][bj][m][n] = __builtin_amdgcn_mfma_f32_16x16x32_bf16(Bt[n][k], At[m][k], acc[ai][bj][m][n], 0, 0, 0); __builtin_amdgcn_s_setprio(0); } while (0)
#define PG8_WAIT_V(n) asm volatile("s_waitcnt vmcnt(" #n ")" ::: "memory")
#define PG8_WAIT_L(n) asm volatile("s_waitcnt lgkmcnt(" #n ")" ::: "memory")
#define PG8_BAR __builtin_amdgcn_s_barrier()
#define PG8_SCHED __builtin_amdgcn_sched_barrier(0)
    Unit cur, nxt; int ui = 0;
    if (!S.next(0, cur)) return;
    f32x4 acc[2][2][4][2];
#pragma unroll
    for (int a = 0; a < 2; ++a)
#pragma unroll
        for (int b = 0; b < 2; ++b)
#pragma unroll
            for (int m = 0; m < 4; ++m)
#pragma unroll
                for (int n = 0; n < 2; ++n) acc[a][b][m][n] = (f32x4){0.f, 0.f, 0.f, 0.f};
    bf16x8 At[4][2], B0[2][2], B1[2][2];
    const char* cA = (const char*)g.A + (size_t)cur.pm * tstepA; const char* cB = (const char*)g.Bt + (size_t)cur.pn * tstepB;
    S.a_ready(cur);
    if constexpr (SP2) {
        PG8_STAGE(PG8_SB(0, 0), cB, voffB); PG8_STAGE(PG8_SB(0, 1), cB + hstepB, voffB); PG8_STAGE(PG8_SA(0, 0), cA, voffA); PG8_STAGE(PG8_SA(0, 1), cA + hstepA, voffA);
        if (wr == 1) PG8_BAR;
        PG8_WAIT_V(2); PG8_BAR;
        PG8_STAGE(PG8_SB(1, 0), cB + kstep, voffB); PG8_STAGE(PG8_SA(1, 0), cA + kstep, voffA); PG8_STAGE(PG8_SB(1, 1), cB + hstepB + kstep, voffB);
        PG8_WAIT_V(6); PG8_BAR;
    } else {
        PG8_STAGE(PG8_SB(0, 0), cB, voffB); PG8_STAGE(PG8_SA(0, 0), cA, voffA); PG8_STAGE(PG8_SB(0, 1), cB + hstepB, voffB); PG8_STAGE(PG8_SA(0, 1), cA + hstepA, voffA);
        if (wr == 1) PG8_BAR;
        PG8_WAIT_V(4); PG8_BAR;
        PG8_STAGE(PG8_SB(1, 0), cB + kstep, voffB); PG8_STAGE(PG8_SA(1, 0), cA + kstep, voffA); PG8_STAGE(PG8_SB(1, 1), cB + hstepB + kstep, voffB);
        PG8_WAIT_V(6); PG8_BAR;
    }
    for (;;) {
        const bool has_next = S.next(ui + 1, nxt);
        const char* nA = has_next ? (const char*)g.A + (size_t)nxt.pm * tstepA : cA; const char* nB = has_next ? (const char*)g.Bt + (size_t)nxt.pn * tstepB : cB;
        for (int t = 0; t < nt; t += 2) {
            const bool last = (t == nt - 2);
            const char* a1 = cA + (size_t)(t + 1) * kstep;
            const char* a2 = last ? nA : cA + (size_t)(t + 2) * kstep; const char* b2 = last ? nB : cB + (size_t)(t + 2) * kstep;
            const char* a3 = a2 + kstep; const char* b3 = b2 + kstep;
            if (last && has_next) S.a_ready(nxt);
            if constexpr (SP2) {
            PG8_LDB(B0, 0, 0); PG8_LDB(B1, 0, 1); PG8_SCHED; PG8_LDA(At, 0, 0); PG8_STAGE(PG8_SA(1, 1), a1 + hstepA, voffA);
            PG8_WAIT_V(8); PG8_WAIT_L(0); PG8_BAR; PG8_MMA(0, 0, At, B0); PG8_MMA(0, 1, At, B1); PG8_BAR; PG8_SCHED;
            PG8_LDA(At, 0, 1); PG8_STAGE(PG8_SB(0, 0), b2, voffB); PG8_STAGE(PG8_SB(0, 1), b2 + hstepB, voffB); PG8_STAGE(PG8_SA(0, 0), a2, voffA);
            PG8_WAIT_V(8); PG8_WAIT_L(0); PG8_BAR; PG8_MMA(1, 0, At, B0); PG8_MMA(1, 1, At, B1); PG8_BAR; PG8_SCHED;
            PG8_LDB(B0, 1, 0); PG8_LDB(B1, 1, 1); PG8_SCHED; PG8_LDA(At, 1, 0); PG8_STAGE(PG8_SA(0, 1), a2 + hstepA, voffA);
            PG8_WAIT_V(8); PG8_WAIT_L(0); PG8_BAR; PG8_MMA(0, 0, At, B0); PG8_MMA(0, 1, At, B1); PG8_BAR; PG8_SCHED;
            PG8_LDA(At, 1, 1); PG8_STAGE(PG8_SB(1, 0), b3, voffB); PG8_STAGE(PG8_SB(1, 1), b3 + hstepB, voffB); PG8_STAGE(PG8_SA(1, 0), a3, voffA);
            PG8_WAIT_V(8); PG8_WAIT_L(0); PG8_BAR; PG8_MMA(1, 0, At, B0); PG8_MMA(1, 1, At, B1); PG8_BAR; PG8_SCHED;
            } else {
            PG8_LDB(B0, 0, 0); PG8_SCHED; PG8_LDA(At, 0, 0); PG8_STAGE(PG8_SA(1, 1), a1 + hstepA, voffA);
            PG8_WAIT_L(8); PG8_BAR; PG8_WAIT_L(0); PG8_MMA(0, 0, At, B0); PG8_BAR; PG8_SCHED;
            PG8_LDB(B1, 0, 1); PG8_STAGE(PG8_SB(0, 0), b2, voffB);
            PG8_BAR; PG8_WAIT_L(0); PG8_MMA(0, 1, At, B1); PG8_BAR;
            PG8_LDA(At, 0, 1); PG8_STAGE(PG8_SA(0, 0), a2, voffA);
            PG8_BAR; PG8_WAIT_L(0); PG8_MMA(1, 0, At, B0); PG8_BAR; PG8_SCHED;
            PG8_STAGE(PG8_SB(0, 1), b2 + hstepB, voffB);
            PG8_WAIT_V(6); PG8_BAR; PG8_MMA(1, 1, At, B1); PG8_BAR;
            PG8_LDB(B0, 1, 0); PG8_SCHED; PG8_LDA(At, 1, 0); PG8_STAGE(PG8_SA(0, 1), a2 + hstepA, voffA);
            PG8_WAIT_L(8); PG8_BAR; PG8_WAIT_L(0); PG8_MMA(0, 0, At, B0); PG8_BAR; PG8_SCHED;
            PG8_LDB(B1, 1, 1); PG8_STAGE(PG8_SB(1, 0), b3, voffB);
            PG8_BAR; PG8_WAIT_L(0); PG8_MMA(0, 1, At, B1); PG8_BAR;
            PG8_LDA(At, 1, 1); PG8_STAGE(PG8_SA(1, 0), a3, voffA);
            PG8_BAR; PG8_WAIT_L(0); PG8_MMA(1, 0, At, B0); PG8_BAR; PG8_SCHED;
            PG8_STAGE(PG8_SB(1, 1), b3 + hstepB, voffB);
            PG8_WAIT_V(6); PG8_BAR; PG8_MMA(1, 1, At, B1); PG8_BAR;
            }
        }
        if constexpr (ALIGN_EPI) { if (wr == 0) PG8_BAR; }
        if constexpr (!Epi::AFTER_DRAIN) { E(acc, cur, wr, wc, fr, fq); S.done(cur); }
        if (!has_next) break;
#pragma unroll
        for (int a = 0; a < 2; ++a)
#pragma unroll
            for (int b = 0; b < 2; ++b)
#pragma unroll
                for (int m = 0; m < 4; ++m)
#pragma unroll
                    for (int n = 0; n < 2; ++n) acc[a][b][m][n] = (f32x4){0.f, 0.f, 0.f, 0.f};
        cur = nxt; cA = nA; cB = nB; ++ui;
        if constexpr (ALIGN_EPI) { if (wr == 1) PG8_BAR; }
    }
    PG8_WAIT_V(0);
    if constexpr (!ALIGN_EPI) { if (wr == 0) PG8_BAR; }
    PG8_BAR;
#undef PG8_SA
#undef PG8_SB
#undef PG8_STAGE
#undef PG8_LDA
#undef PG8_LDB
#undef PG8_MMA
#undef PG8_WAIT_V
#undef PG8_WAIT_L
#undef PG8_BAR
#undef PG8_SCHED
}
}

#define XB_TMO      128
#define XB_XCNT(j)  (256  + 64 * (j))
#define XB_XSUB(j)  (1280 + 64 * (j))
#define XB_XGEN(j)  (2304 + 64 * (j))
#define XB_TOP      3328
#define XB_TOPGEN   3392
#define XCD_BAR_WORDS 3456
#define XB_SPIN_CAP (1u << 18)
__device__ __forceinline__ unsigned xb_ld(unsigned* p)              { return __hip_atomic_load(p, __ATOMIC_RELAXED, __HIP_MEMORY_SCOPE_AGENT); }
__device__ __forceinline__ unsigned xb_add(unsigned* p, unsigned v) { return __hip_atomic_fetch_add(p, v, __ATOMIC_RELAXED, __HIP_MEMORY_SCOPE_AGENT); }
__device__ __forceinline__ unsigned xb_xcc_id() { return (unsigned)__builtin_amdgcn_s_getreg((3 << 11) | 20) & 0xFu; }
#define XB_SPIN(cond, bar) do { unsigned _sp = 0; while (cond) { __builtin_amdgcn_s_sleep(1); \
    if ((++_sp & 255u) == 0u) { if (xb_ld(&(bar)[XB_TMO])) break; if (_sp > XB_SPIN_CAP) { atomicAdd(&(bar)[XB_TMO], 1u); break; } } } } while (0)
struct XcdBarrier { unsigned* bar; unsigned x; volatile LAS unsigned* st; };
__device__ __forceinline__ XcdBarrier xcd_barrier_post(unsigned* bar, volatile LAS unsigned* st) {
    XcdBarrier b; b.bar = bar; b.x = xb_xcc_id(); b.st = st;
    if (threadIdx.x == 0) (void)xb_add(&bar[XB_XCNT(b.x)], 1u);
    return b;
}
__device__ __forceinline__ void xcd_barrier_complete(unsigned* bar, unsigned x, unsigned& nloc, unsigned& nx) {
    const unsigned G = gridDim.x * gridDim.y * gridDim.z;
    unsigned sum, cnt, mine, sp = 0u;
    for (;;) {
        sum = 0u; cnt = 0u; mine = 0u;
#pragma unroll
        for (unsigned j = 0; j < 16; ++j) { const unsigned c = xb_ld(&bar[XB_XCNT(j)]); sum += c; cnt += (c > 0u) ? 1u : 0u; mine = (j == x) ? c : mine; }
        if (sum == G) break;
        __builtin_amdgcn_s_sleep(1);
        if ((++sp & 255u) == 0u) { if (xb_ld(&bar[XB_TMO])) break; if (sp > XB_SPIN_CAP) { atomicAdd(&bar[XB_TMO], 1u); break; } }
    }
    nloc = mine > 0u ? mine : 1u; nx = cnt > 0u ? cnt : 1u;
}
__device__ __forceinline__ void xcd_barrier(const XcdBarrier& b) {
    asm volatile("s_waitcnt vmcnt(0)" ::: "memory");
    __syncthreads();
    if (threadIdx.x == 0) {
        unsigned* bar = b.bar;
        __builtin_amdgcn_s_waitcnt(0);
        unsigned nloc = b.st[0], nx = b.st[1];
        if (nloc == 0u) { xcd_barrier_complete(bar, b.x, nloc, nx); b.st[0] = nloc; b.st[1] = nx; }
        const unsigned old = xb_add(&bar[XB_XSUB(b.x)], 1u);
        const unsigned gen = old / nloc;
        if (old + 1u == (gen + 1u) * nloc) {
            __builtin_amdgcn_fence(__ATOMIC_RELEASE, "agent");
            asm volatile("s_waitcnt vmcnt(0)" ::: "memory");
            const unsigned og = xb_add(&bar[XB_TOP], 1u);
            const unsigned tg = og / nx;
            if (og + 1u == (tg + 1u) * nx) xb_add(&bar[XB_TOPGEN], 1u);
            else XB_SPIN(xb_ld(&bar[XB_TOPGEN]) == tg, bar);
            __builtin_amdgcn_fence(__ATOMIC_ACQUIRE, "agent");
            xb_add(&bar[XB_XGEN(b.x)], 1u);
            asm volatile("s_waitcnt vmcnt(0)" ::: "memory");
        } else {
            XB_SPIN(xb_ld(&bar[XB_XGEN(b.x)]) == gen, bar);
            __builtin_amdgcn_fence(__ATOMIC_ACQUIRE, "agent");
            asm volatile("s_waitcnt vmcnt(0)" ::: "memory");
        }
    }
    __syncthreads();
}

struct Args { const float* in[24]; float* out; unsigned char* ws; float freq64[32]; float freq32[16]; int ph_lo, ph_hi; };
enum { I_XP = 0, I_XS, I_CMLA, I_CDSA, I_CSB, I_CDIFF, I_N1, I_G1, I_U1, I_D1, I_NM, I_WIN, I_QN, I_WQB, I_KVN, I_WKVB, I_LAM, I_DN, I_WO, I_N2, I_G2, I_U2, I_D2, I_FN };

__host__ __device__ __forceinline__ int mycol(int j) {
    if (j < 256) return j;
    if (j < 384) return 7 * 256 + (j - 256);
    if (j < 416) { const int t = j - 384; return 4 * 256 + (t >> 4) * 128 + 64 + (t & 15); }
    if (j < 672) { const int t = j - 416; return 1 * 256 + ((t >> 5) & 1) * 128 + (t >> 6) * 32 + (t & 31); }
    if (j < 736) { const int t = j - 672; return 4 * 256 + (t >> 5) * 128 + (t & 31); }
    if (j < 800) return 7 * 256 + 128 + (j - 736);
    if (j < 1312) { const int t = j - 800, h8 = t >> 6; return (2 + (h8 >> 2)) * 256 + ((t >> 5) & 1) * 128 + (h8 & 3) * 32 + (t & 31); }
    if (j < 1376) { const int t = j - 1312; return 4 * 256 + (t >> 5) * 128 + 32 + (t & 31); }
    if (j < 1384) return 7 * 256 + 128 + 64 + (j - 1376);
    if (j < 1640) return 8 * 256 + (j - 1384);
    if (j < 1896) return 9 * 256 + (j - 1640);
    if (j < 2152) return 10 * 256 + (j - 1896);
    if (j < 2408) { const int t = j - 2152; return 5 * 256 + ((t >> 4) & 1) * 128 + (t >> 5) * 16 + (t & 15); }
    if (j < 2664) { const int t = j - 2408; return 6 * 256 + ((t >> 4) & 1) * 128 + (t >> 5) * 16 + (t & 15); }
    return 11 * 256 + (j - 2664);
}
__host__ __device__ __forceinline__ bool mycol_is_pad(int np) { const int t = np >> 8, c = np & 127, hf = (np >> 7) & 1; return (t == 4 && c >= 80) || (t == 7 && hf == 1 && c >= 72); }
typedef __attribute__((address_space(4))) const char* kaptr_t;
__device__ __forceinline__ kaptr_t kargs() { kaptr_t p = (kaptr_t)__builtin_amdgcn_kernarg_segment_ptr(); asm volatile("" : "+s"(p)); return p; }
typedef const float* cfp_t; typedef float* fp_t; typedef unsigned char* ucp_t;
typedef __attribute__((address_space(4))) const cfp_t* ka_cfp_t; typedef __attribute__((address_space(4))) const fp_t* ka_fp_t; typedef __attribute__((address_space(4))) const ucp_t* ka_ucp_t;
typedef __attribute__((address_space(4))) const float* ka_f_t; typedef __attribute__((address_space(4))) const int* ka_i_t;
#define ARG_IN(i) (*(ka_cfp_t)(kargs() + 8 * (i)))
#define ARG_OUT (*(ka_fp_t)(kargs() + 192))
#define ARG_WS (*(ka_ucp_t)(kargs() + 200))
#define ARG_FREQ64(j) (((ka_f_t)(kargs() + 208))[j])
#define ARG_FREQ32(j) (((ka_f_t)(kargs() + 336))[j])
#define ARG_PH_LO (*(ka_i_t)(kargs() + 400))
#define ARG_PH_HI (*(ka_i_t)(kargs() + 404))
static_assert(sizeof(Args) == 408, "kernarg offsets above follow struct Args");
template <int MAP> __device__ __forceinline__ int rowmap(int n) {
    if (MAP == 1) return (n >> 7) * 256 + (n & 127);
    if (MAP == 2) return (n >> 7) * 256 + 128 + (n & 127);
    if (MAP == 3) return FUSE_POST ? mycol(n) : (n < 1376 ? n : (n < 1384 ? H_WI + (n - 1376) : n - 8));
    return n;
}
template <int MAP> __device__ __forceinline__ void transpose_item(const float* W, int K, int N, const float* g, bf16* dst, int ldd, int koff, LAS float* scr, int item, int lane) {
    const int nblk = (N + 31) / 32, kb = item / nblk, nb = item % nblk, k0 = 64 * kb, n0 = 32 * nb;
    const int nn = n0 + (lane & 31); const bool nok = nn < N;
    float tv[32];
#pragma unroll
    for (int i = 0; i < 32; ++i) { const int kk = 2 * i + (lane >> 5); tv[i] = nok ? W[(size_t)(k0 + kk) * N + nn] : 0.f; }
#pragma unroll
    for (int i = 0; i < 32; ++i) { const int kk = 2 * i + (lane >> 5); float v = tv[i]; if (g) v *= g[k0 + kk]; scr[kk * 33 + (lane & 31)] = v; }
    LDS_WAIT(); asm volatile("" ::: "memory");
    const int c = lane & 7;
#pragma unroll
    for (int j = 0; j < 4; ++j) { const int n = (lane >> 3) + 8 * j; const LAS float* s = scr + (8 * c) * 33 + n;
        v4u o; o.x = pk2(s[0 * 33], s[1 * 33]); o.y = pk2(s[2 * 33], s[3 * 33]); o.z = pk2(s[4 * 33], s[5 * 33]); o.w = pk2(s[6 * 33], s[7 * 33]);
        if (n0 + n < N) *(v4u*)(dst + (size_t)rowmap<MAP>(n0 + n) * ldd + koff + k0 + 8 * c) = o; }
    LDS_WAIT(); asm volatile("" ::: "memory");
}
__device__ __forceinline__ void sincos_acc(float ang, float& sn, float& cs) {
    const double a = (double)ang; const double k = rint(a * 0.15915494309189533577); const double x = fma(-k, 6.283185307179586476925, a); const double x2 = x * x;
    double s = 1.0, c = 1.0;
#pragma unroll
    for (int n = 14; n >= 1; --n) { s = 1.0 - x2 * (1.0 / (double)((2 * n) * (2 * n + 1))) * s; c = 1.0 - x2 * (1.0 / (double)((2 * n - 1) * (2 * n))) * c; }
    sn = (float)(x * s); cs = (float)c;
}

#define MFMA32(a, b, c) __builtin_amdgcn_mfma_f32_32x32x16_bf16((a), (b), (c), 0, 0, 0)
__device__ __forceinline__ f32x16 zero16() { f32x16 z;
#pragma unroll
    for (int i = 0; i < 16; ++i) z[i] = 0.f; return z; }
__device__ __forceinline__ s16x4 vtr(const LAS char* p) { return __builtin_bit_cast(s16x4, __builtin_amdgcn_ds_read_tr16_b64_v4i16((LAS s16x4*)p)); }
template <int BASE> __device__ __forceinline__ bf16x8 pack8(const f32x16& p) {
    v4u w; w.x = cvtpk(p[BASE], p[BASE + 1]); w.y = cvtpk(p[BASE + 2], p[BASE + 3]); w.z = cvtpk(p[BASE + 4], p[BASE + 5]); w.w = cvtpk(p[BASE + 6], p[BASE + 7]);
    return __builtin_bit_cast(bf16x8, w);
}
template <int NS> __device__ __forceinline__ void qk(f32x16& p0, f32x16& p1, const LAS char* kb, int strideB, const bf16x8 (&q)[NS]) {
    p0 = zero16(); p1 = zero16();
#pragma unroll
    for (int s = 0; s < NS; ++s) {
        const bf16x8 a0 = *(const LAS bf16x8*)(kb + s * 32);
        const bf16x8 a1 = *(const LAS bf16x8*)(kb + 32 * strideB + s * 32);
        p0 = MFMA32(a0, q[s], p0); p1 = MFMA32(a1, q[s], p1);
    }
}
template <int NDB> __device__ __forceinline__ void pv(f32x16 (&o)[NDB], const f32x16& p0, const f32x16& p1, const LAS char* vb, int strideB) {
    const bf16x8 pb0 = pack8<0>(p0), pb1 = pack8<8>(p0), pb2 = pack8<0>(p1), pb3 = pack8<8>(p1);
#pragma unroll
    for (int kk = 0; kk < 4; ++kk) {
        const bf16x8 pb = kk == 0 ? pb0 : (kk == 1 ? pb1 : (kk == 2 ? pb2 : pb3));
#pragma unroll
        for (int db = 0; db < NDB; ++db) {
            const s16x4 lo = vtr(vb + (16 * kk) * strideB + db * 64);
            const s16x4 hh = vtr(vb + (16 * kk + 8) * strideB + db * 64);
            const bf16x8 a = __builtin_shufflevector(lo, hh, 0, 1, 2, 3, 4, 5, 6, 7);
            o[db] = MFMA32(a, pb, o[db]);
        }
    }
}
template <int NDB> __device__ __forceinline__ void softmax_step(f32x16& p0, f32x16& p1, float& m, float& l, f32x16 (&o)[NDB]) {
    float mx = p0[0];
#pragma unroll
    for (int r = 1; r < 16; ++r) mx = fmaxf(mx, p0[r]);
#pragma unroll
    for (int r = 0; r < 16; ++r) mx = fmaxf(mx, p1[r]);
    mx = fmaxf(mx, __shfl_xor(mx, 32));
    const float mn = fmaxf(m, mx);
    if (__any(mn > m)) {
        const float alpha = __builtin_amdgcn_exp2f(m - mn);
        l *= alpha;
#pragma unroll
        for (int db = 0; db < NDB; ++db)
#pragma unroll
            for (int r = 0; r < 16; ++r) o[db][r] *= alpha;
    }
    m = mn;
    float s = 0.f;
#pragma unroll
    for (int r = 0; r < 16; ++r) { p0[r] = __builtin_amdgcn_exp2f(p0[r] - mn); s += p0[r]; }
#pragma unroll
    for (int r = 0; r < 16; ++r) { p1[r] = __builtin_amdgcn_exp2f(p1[r] - mn); s += p1[r]; }
    l += s;
}
__device__ __forceinline__ v4u cvt8f(const v4u a, const v4u b) {
    const unsigned a0 = a[0], a1 = a[1], a2 = a[2], a3 = a[3], b0 = b[0], b1 = b[1], b2 = b[2], b3 = b[3]; v4u v;
    v[0] = cvtpk(__uint_as_float(a0), __uint_as_float(a1)); v[1] = cvtpk(__uint_as_float(a2), __uint_as_float(a3));
    v[2] = cvtpk(__uint_as_float(b0), __uint_as_float(b1)); v[3] = cvtpk(__uint_as_float(b2), __uint_as_float(b3)); return v; }
template <int W, int STRIDE, bool F32PF = true, int ROWS = 64> struct TileLd {
    static constexpr int CH = W / 8, RPP = 512 / CH, PER = (ROWS + RPP - 1) / RPP, STRB = (W + 8) * 2;
    int nrows_ = ROWS;
    v4u raw[PER][F32PF ? 2 : 1];
    const char* src_;
    __device__ __forceinline__ void init() { src_ = nullptr;
#pragma unroll
        for (int i = 0; i < PER; ++i) { raw[i][0] = (v4u){0u, 0u, 0u, 0u}; raw[i][F32PF ? 1 : 0] = (v4u){0u, 0u, 0u, 0u}; } }
    __device__ __forceinline__ void issue(const void* src, bool f32, int tid) {
        src_ = (const char*)src;
        if (!F32PF && f32) return;
        const int row0 = tid / CH, cc = tid % CH; const bool act = tid < RPP * CH;
        const unsigned loff = (unsigned)(row0 * STRIDE + cc * 8);
#pragma unroll
        for (int i = 0; i < PER; ++i) {
            if (act && (row0 + i * RPP < nrows_)) {
                if (F32PF && f32) { const v4u* p = (const v4u*)(src_ + (size_t)i * RPP * STRIDE * 4 + (size_t)loff * 4); raw[i][0] = p[0]; raw[i][F32PF ? 1 : 0] = p[1]; }
                else { raw[i][0] = *(const v4u*)(src_ + (size_t)i * RPP * STRIDE * 2 + (size_t)loff * 2); } } }
    }
    __device__ __forceinline__ static v4u cvt8(const v4u a, const v4u b) { return cvt8f(a, b); }
    __device__ __forceinline__ void store(LAS char* tile, bool f32, int tid) {
        const int row0 = tid / CH, cc = tid % CH; const bool act = tid < RPP * CH;
        const unsigned loff = (unsigned)(row0 * STRIDE + cc * 8);
        LAS char* dst = tile + row0 * STRB + cc * 16;
#pragma unroll
        for (int i = 0; i < PER; ++i) {
            if (act && (row0 + i * RPP < nrows_)) { v4u v = raw[i][0];
                if (f32) {
                    if (F32PF) v = cvt8(raw[i][0], raw[i][F32PF ? 1 : 0]);
                    else { const v4u* p = (const v4u*)(src_ + (size_t)i * RPP * STRIDE * 4 + (size_t)loff * 4); v = cvt8(p[0], p[1]); } }
                *(LAS v4u*)(dst + i * RPP * STRB) = v; } }
    }
};
constexpr int T512_STRB = 1040, T512_BYTES = 64 * T512_STRB;
__device__ __forceinline__ void t512_dma(const void* src, LAS char* buf, int wave, int lane) {
#pragma unroll
    for (int j = 0; j < 8; ++j) { const int row = wave * 8 + j;
        __builtin_amdgcn_global_load_lds((const unsigned*)((const char*)src + (size_t)row * 1024 + lane * 16), (LAS unsigned*)(buf + row * T512_STRB), 16, 0, 0); }
}
__device__ __forceinline__ void t512_cvt(const void* src, LAS char* buf, int tid) {
    const int row0 = tid >> 6, cc = tid & 63; const char* p0 = (const char*)src + (size_t)row0 * 2048 + cc * 32; LAS char* d0 = buf + row0 * T512_STRB + cc * 16;
#pragma unroll
    for (int i = 0; i < 8; ++i) { const v4u* p = (const v4u*)(p0 + (size_t)i * 8 * 2048); const v4u a = p[0], b = p[1]; v4u v;
        v = cvt8f(a, b);
        *(LAS v4u*)(d0 + i * 8 * T512_STRB) = v; }
}
__device__ __forceinline__ int crow(int r, int hi) { return (r & 3) + 8 * (r >> 2) + 4 * hi; }

struct UnitId { int sample, b, c, nt, qrow0, krow0; };
constexpr int QLIST = 4 + 4 * 32;
__device__ __forceinline__ UnitId decode_unit(int x, int idx) {
    UnitId u;
    if (idx < 4) { u.sample = 1; u.b = x + 8 * idx; u.c = 0; u.nt = PAST / 64 + 1; u.qrow0 = MP + u.b * DSEQ; u.krow0 = MP + u.b * DSEQ; }
    else { const int j = idx - 4; u.sample = 0; u.c = 31 - (j & 31); u.b = x + 8 * (j >> 5); u.nt = u.c + 1; u.qrow0 = u.b * SEQ + u.c * 64; u.krow0 = u.b * SEQ; }
    return u;
}
constexpr int N_UNITS = NB + NB * (SEQ / 64);

__device__ __forceinline__ const void* tile_src(const UnitId& u, int t, const float* cache_lb  , const bf16* rows, int W, int coloff, bool& f32) {
    if (u.sample && t < PAST / 64) { f32 = true; return cache_lb + (size_t)t * 64 * W + coloff; }
    f32 = false; const int tt = u.sample ? 0 : t;
    return rows + (size_t)(u.krow0 + tt * 64) * W + coloff;
}

__device__ __forceinline__ void hist_pick(LAS unsigned* hist, int lane, int& kk, int& bin_out, unsigned& cnt_out) {
    unsigned sl = 0u;
#pragma unroll
    for (int j = 0; j < 8; ++j) { const v4u c4 = ((LAS v4u*)hist)[lane * 8 + j]; sl += (c4[0] + c4[1]) + (c4[2] + c4[3]); }
    unsigned incl = sl;
#pragma unroll
    for (int o = 1; o < 64; o <<= 1) { const unsigned t2 = (unsigned)__shfl_down((int)incl, o); incl += (lane + o < 64) ? t2 : 0u; }
    const unsigned above_l = incl - sl;
    const bool hit = (above_l < (unsigned)kk) && ((unsigned)kk <= incl);
    const unsigned long long hb = __ballot(hit); const int hl = hb ? (int)__builtin_ctzll(hb) : 0;
    const unsigned above_h = (unsigned)__builtin_amdgcn_readlane((int)above_l, hl);
    const unsigned v = (lane < 32) ? hist[hl * 32 + lane] : 0u;
    unsigned inc2 = v;
#pragma unroll
    for (int o = 1; o < 32; o <<= 1) { const unsigned t2 = (unsigned)__shfl_down((int)inc2, o); inc2 += (lane + o < 32) ? t2 : 0u; }
    const unsigned above2 = above_h + inc2 - v;
    const bool hit2 = (lane < 32) && (above2 < (unsigned)kk) && ((unsigned)kk <= above2 + v);
    const unsigned long long hb2 = __ballot(hit2); const int l2 = hb2 ? (int)__builtin_ctzll(hb2) : 0;
    bin_out = hl * 32 + l2; kk -= __builtin_amdgcn_readlane((int)above2, l2); cnt_out = (unsigned)__builtin_amdgcn_readlane((int)v, l2);
}
template <int NI, int NQ> __device__ __forceinline__ void dsa_select(const float* srow, int nt, LAS unsigned* hist, unsigned long long* mrow, int lane) {
    float xv[NQ][NI]; float lo[NQ], hi[NQ];
#pragma unroll
    for (int a = 0; a < NQ; ++a) { lo[a] = 3e38f; hi[a] = -3e38f; }
    { const int nt_ = opaque_s(nt);
#pragma unroll
    for (int i = 0; i < NI; ++i) {
#pragma unroll
        for (int a = 0; a < NQ; ++a) xv[a][i] = 0.f;
        if (i < nt_) {
#pragma unroll
            for (int a = 0; a < NQ; ++a) { xv[a][i] = srow[(size_t)a * SC_LS + i * 64 + lane]; lo[a] = fminf(lo[a], xv[a][i]); hi[a] = fmaxf(hi[a], xv[a][i]); } } } }
#pragma unroll
    for (int o = 1; o < 64; o <<= 1)
#pragma unroll
        for (int a = 0; a < NQ; ++a) { lo[a] = fminf(lo[a], __shfl_xor(lo[a], o)); hi[a] = fmaxf(hi[a], __shfl_xor(hi[a], o)); }
    float scale[NQ]; int kk[NQ], b0[NQ]; unsigned c0n[NQ];
#pragma unroll
    for (int a = 0; a < NQ; ++a) { const float range = hi[a] - lo[a]; scale[a] = (range > 1e-30f) ? 2047.0f / range : 0.f; kk[a] = 256; b0[a] = 0; c0n[a] = 0u; }
#pragma unroll
    for (int j = 0; j < 8 * NQ; ++j) ((LAS v4u*)hist)[lane + 64 * j] = (v4u){0u, 0u, 0u, 0u};
    LDS_WAIT();
    { const int nt_ = opaque_s(nt); float sc_[NQ];
#pragma unroll
    for (int a = 0; a < NQ; ++a) sc_[a] = opaque_vf(scale[a]);
#pragma unroll
    for (int i = 0; i < NI; ++i) if (i < nt_) {
#pragma unroll
        for (int a = 0; a < NQ; ++a) { const int b = min(2047, (int)((xv[a][i] - lo[a]) * sc_[a])); __hip_atomic_fetch_add(hist + a * 2048 + b, 1u, __ATOMIC_RELAXED, __HIP_MEMORY_SCOPE_WORKGROUP); } } }
    LDS_WAIT();
#pragma unroll
    for (int a = 0; a < NQ; ++a) hist_pick(hist + a * 2048, lane, kk[a], b0[a], c0n[a]);
    unsigned prefix[NQ], pmask[NQ]; bool whole[NQ], live[NQ]; bool any_live = false;
#pragma unroll
    for (int a = 0; a < NQ; ++a) { prefix[a] = 0u; pmask[a] = 0u; whole[a] = ((unsigned)kk[a] == c0n[a]); live[a] = !whole[a]; any_live = any_live || live[a]; }
    if (any_live) {
#pragma unroll
        for (int pass = 0; pass < 3; ++pass) {
            const int SH = pass == 0 ? 21 : (pass == 1 ? 10 : 0); const unsigned BM_ = pass == 2 ? 1023u : 2047u;
#pragma unroll
            for (int j = 0; j < 8 * NQ; ++j) ((LAS v4u*)hist)[lane + 64 * j] = (v4u){0u, 0u, 0u, 0u};
            LDS_WAIT();
            const int nt_ = opaque_s(nt); float sc_[NQ];
#pragma unroll
            for (int a = 0; a < NQ; ++a) sc_[a] = opaque_vf(scale[a]);
#pragma unroll
            for (int i = 0; i < NI; ++i) if (i < nt_) {
#pragma unroll
                for (int a = 0; a < NQ; ++a) { const int b = min(2047, (int)((xv[a][i] - lo[a]) * sc_[a])); const unsigned bts = __float_as_uint(xv[a][i]); const unsigned x = bts ^ ((bts >> 31) ? 0xFFFFFFFFu : 0x80000000u);
                    if (live[a] && b == b0[a] && (x & pmask[a]) == prefix[a]) __hip_atomic_fetch_add(hist + a * 2048 + ((x >> SH) & BM_), 1u, __ATOMIC_RELAXED, __HIP_MEMORY_SCOPE_WORKGROUP); } }
            LDS_WAIT();
            bool more = false;
#pragma unroll
            for (int a = 0; a < NQ; ++a) if (live[a]) { int bin; unsigned c_u; hist_pick(hist + a * 2048, lane, kk[a], bin, c_u);
                prefix[a] |= ((unsigned)bin & BM_) << SH; pmask[a] |= BM_ << SH;
                if ((unsigned)kk[a] == c_u) live[a] = false;
                more = more || live[a]; }
            if (!more) break;
        }
    }
    const int nt2_ = opaque_s(nt); float sc2_[NQ];
#pragma unroll
    for (int a = 0; a < NQ; ++a) sc2_[a] = opaque_vf(scale[a]);
#pragma unroll
    for (int i = 0; i < NI; ++i) if (i < nt2_) {
#pragma unroll
        for (int a = 0; a < NQ; ++a) { const int b = min(2047, (int)((xv[a][i] - lo[a]) * sc2_[a])); const unsigned bts = __float_as_uint(xv[a][i]); const unsigned x = bts ^ ((bts >> 31) ? 0xFFFFFFFFu : 0x80000000u);
            const bool selq = b > b0[a] || (b == b0[a] && (whole[a] || x >= prefix[a]));
            const unsigned long long mw = __ballot(selq); if (lane == 0) mrow[(size_t)a * MK_LS + i] = mw; } }
}
#define PHASE_PTRS() unsigned char* ws = ARG_WS; float* out = ARG_OUT; asm volatile("" : "+s"(ws), "+s"(out)); gu32* ctl = (gu32*)(ws + WS_CTL); (void)out; (void)ctl
#define FRESH_TID() int tid_o = threadIdx.x; asm volatile("" : "+v"(tid_o)); const int tid = tid_o, lane = tid & 63, wave = __builtin_amdgcn_readfirstlane(tid >> 6); (void)lane; (void)wave
__global__ void __launch_bounds__(NWAVES * 64, 2) fwd_kernel(Args args) {
    extern __shared__ __attribute__((aligned(16))) unsigned char lds_raw[];
    LAS unsigned char* lds = (LAS unsigned char*)lds_raw;
    volatile LAS unsigned* MISC = (volatile LAS unsigned*)(lds + MISC_OFF);
    const int tid = threadIdx.x, lane = tid & 63, wave = __builtin_amdgcn_readfirstlane(tid >> 6);
    const int G = gridDim.x;
    unsigned char* ws = ARG_WS;
    gu32* ctl = (gu32*)(ws + WS_CTL);
    float* const out = ARG_OUT;
#define X (out + O_Y)
#define XB ((bf16*)(ws + WS_XB))
#define HB ((bf16*)(ws + WS_REGA))
#define ACT ((bf16*)(ws + WS_REGA))
#define QA ((bf16*)(ws + WS_QA))
#define QB ((bf16*)(ws + WS_QB))
#define QI ((bf16*)(ws + WS_QI))
#define QC ((bf16*)(ws + WS_QC))
#define QD ((bf16*)(ws + WS_QD))
#define WI ((float*)(ws + WS_WI))
#define RA ((bf16*)(ws + WS_RA))
#define RB ((bf16*)(ws + WS_RB))
#define RC ((bf16*)(ws + WS_RC))
#define RD ((bf16*)(ws + WS_RD))
#define CC ((bf16*)(ws + WS_CC))
#define CQ ((bf16*)(ws + WS_REGA + (size_t)300 * MiB))
#define CKV ((bf16*)(ws + WS_REGA + (size_t)340 * MiB))
#define SSQP ((float*)(ws + WS_SSQP))
#define LAMF ((float*)(ws + WS_MISC))
#define ROPE64 ((float2*)(ws + WS_MISC + MISC_ROPE64))
#define ROPE32 ((float2*)(ws + WS_MISC + MISC_ROPE32))
    for (int u = tid; u < (LDS_BYTES - LDSCTL_OFF) / 4; u += NWAVES * 64) ((LAS unsigned*)(lds + LDSCTL_OFF))[u] = 0u;
    __syncthreads();
    XcdBarrier bar; bar.bar = (unsigned*)(ctl + CW_BAR); bar.x = 0; bar.st = nullptr;
    const int lo = ARG_PH_LO, hi_ph = ARG_PH_HI;
    if (hi_ph - lo > 1) bar = xcd_barrier_post((unsigned*)(ctl + CW_BAR), MISC + 8);
#define IN(k) (opaque_s(lo) <= (k) && (k) < opaque_s(hi_ph))
#define BOTH(k) (IN(k) && IN((k) + 1))
#define GRID_BAR() xcd_barrier(bar)

    if (EN_PH(0) && IN(0)) {
        PHASE_PTRS();
        FRESH_TID();
        for (int p0rep = 0; p0rep < P0_REPS; ++p0rep) {
        LAS float* scr = (LAS float*)(lds + wave * 16384);
        const int gw = blockIdx.x * NWAVES + wave, NGW = G * NWAVES;
        for (int l = 0; l < DEPTH; ++l) {
            unsigned char* wl = ws + WS_W + (size_t)l * W_LAYER;
            const int I_GU = (DM / 64) * (DFF / 32), I_D = (DFF / 64) * (DM / 32), I_INN = (DM / 64) * ((NIN + 31) / 32), I_O = (768 / 64) * (DM / 32);
            const int NIT = 4 * I_GU + 2 * I_D + I_INN + I_O;
            for (int it = gw; it < NIT; it += NGW) {
                int r = it;
                if (r < I_GU) { transpose_item<1>(ARG_IN(I_G1) + (size_t)l * DM * DFF, DM, DFF, ARG_IN(I_N1) + l * DM, (bf16*)(wl + W_GU1), DM, 0, scr, r, lane); continue; } r -= I_GU;
                if (r < I_GU) { transpose_item<2>(ARG_IN(I_U1) + (size_t)l * DM * DFF, DM, DFF, ARG_IN(I_N1) + l * DM, (bf16*)(wl + W_GU1), DM, 0, scr, r, lane); continue; } r -= I_GU;
                if (r < I_GU) { transpose_item<1>(ARG_IN(I_G2) + (size_t)l * DM * DFF, DM, DFF, ARG_IN(I_N2) + l * DM, (bf16*)(wl + W_GU2), DM, 0, scr, r, lane); continue; } r -= I_GU;
                if (r < I_GU) { transpose_item<2>(ARG_IN(I_U2) + (size_t)l * DM * DFF, DM, DFF, ARG_IN(I_N2) + l * DM, (bf16*)(wl + W_GU2), DM, 0, scr, r, lane); continue; } r -= I_GU;
                if (r < I_D) { transpose_item<0>(ARG_IN(I_D1) + (size_t)l * DFF * DM, DFF, DM, nullptr, (bf16*)(wl + W_D1), DFF, 0, scr, r, lane); continue; } r -= I_D;
                if (r < I_D) { transpose_item<0>(ARG_IN(I_D2) + (size_t)l * DFF * DM, DFF, DM, nullptr, (bf16*)(wl + W_D2), DFF, 0, scr, r, lane); continue; } r -= I_D;
                if (r < I_INN) { transpose_item<3>(ARG_IN(I_WIN) + (size_t)l * DM * NIN, DM, NIN, ARG_IN(I_NM) + l * DM, (bf16*)(wl + W_IN), DM, 0, scr, r, lane); continue; } r -= I_INN;
                transpose_item<0>(ARG_IN(I_WO) + (size_t)l * DM * DM + (size_t)256 * DM, 768, DM, nullptr, (bf16*)(wl + W_OUT), KOUT, 512, scr, r, lane);
            }
            const int gt = blockIdx.x * 512 + tid, NGT = G * 512;
            if (FUSE_POST) { for (int i = gt; i < NINP * (DM / 8); i += NGT) { const int np = i / (DM / 8); if (mycol_is_pad(np)) *(v4u*)((bf16*)(wl + W_IN) + (size_t)np * DM + 8 * (i % (DM / 8))) = (v4u){0u, 0u, 0u, 0u}; } }
            else for (int i = gt; i < (NINP - NIN) * DM; i += NGT) ((bf16*)(wl + W_IN))[(size_t)NIN * DM + i] = 0;
            for (int i = gt; i < (NQP - NQ) * 256; i += NGT) ((bf16*)(wl + W_Q))[(size_t)NQ * 256 + i] = 0;
            const float* wqb = ARG_IN(I_WQB) + (size_t)l * 256 * 384; const float* wkvb = ARG_IN(I_WKVB) + (size_t)l * 128 * 512; const float* qn = ARG_IN(I_QN) + l * 256;
            const float scaleA = 0.10206207261596575f * LOG2E;
            for (int i = gt; i < NQ * 256; i += NGT) {
                const int np = i >> 8, k = i & 255, hh = np / 160, c = np % 160; float v;
                if (c < 128) { float s = 0.f; for (int e = 0; e < 64; ++e) s += wqb[(size_t)k * 384 + hh * 96 + e] * wkvb[(size_t)c * 512 + hh * 128 + e]; v = s; }
                else v = wqb[(size_t)k * 384 + hh * 96 + 64 + (c - 128)];
                ((bf16*)(wl + W_Q))[(size_t)np * 256 + k] = (bf16)f2bf(v * qn[k] * scaleA);
            }
            const float* wo = ARG_IN(I_WO) + (size_t)l * DM * DM;
            for (int i = gt; i < 512 * DM; i += NGT) {
                const int n = i & 1023, kc = i >> 10, hh = kc >> 7, c = kc & 127; float s = 0.f;
                for (int e = 0; e < 64; ++e) s += wkvb[(size_t)c * 512 + hh * 128 + 64 + e] * wo[(size_t)(hh * 64 + e) * DM + n];
                ((bf16*)(wl + W_OUT))[(size_t)n * KOUT + kc] = (bf16)f2bf(s);
            }
            if (blockIdx.x == 0 && wave == 0) {
                const float* lf = ARG_IN(I_LAM) + l * 128;
                float a = lane < 32 ? lf[lane] * lf[32 + lane] : 0.f, b = lane < 32 ? lf[64 + lane] * lf[96 + lane] : 0.f;
                a = wave_sum(a); b = wave_sum(b);
                const float lam_init = 0.8f - 0.6f * expf(-0.3f * (float)l);
                if (lane == 0) LAMF[l] = expf(a) - expf(b) + lam_init;
            }
        }
        {
            const int gt = blockIdx.x * 512 + tid, NGT = G * 512;
            for (int i = gt; i < 2112 * 48; i += NGT) {
                const int pidx = i / 48, j = i % 48; const float pos = (float)(pidx < 2048 ? pidx : 4096 + (pidx - 2048));
                const float fr = j < 32 ? ARG_FREQ64(j) : ARG_FREQ32(j - 32);
                float sn, cs; sincos_acc(pos * fr, sn, cs);
                if (j < 32) ROPE64[pidx * 32 + j] = make_float2(cs, sn); else ROPE32[pidx * 16 + (j - 32)] = make_float2(cs, sn);
            }
        }
        for (int m = 2 * gw; m < M; m += 2 * NGW) {
            f32x4 v[2][4]; float sq[2];
#pragma unroll
            for (int r2 = 0; r2 < 2; ++r2) { const int mr = m + r2; const float* xr = (mr < MP) ? ARG_IN(I_XP) + (size_t)mr * DM : ARG_IN(I_XS) + (size_t)(mr - MP) * DM; const f32x4* x4 = (const f32x4*)xr + lane;
#pragma unroll
                for (int j = 0; j < 4; ++j) v[r2][j] = x4[64 * j]; }
#pragma unroll
            for (int r2 = 0; r2 < 2; ++r2) { const int mr = m + r2; float s2 = 0.f; unsigned long long* o8 = (unsigned long long*)(XB + (size_t)mr * DM) + lane;
#pragma unroll
                for (int j = 0; j < 4; ++j) { const f32x4 w = v[r2][j]; s2 += (w.x * w.x + w.y * w.y) + (w.z * w.z + w.w * w.w);
                    o8[64 * j] = (unsigned long long)cvtpk(w.x, w.y) | ((unsigned long long)cvtpk(w.z, w.w) << 32); }
                sq[r2] = wave_sum(s2); }
#pragma unroll
            for (int r2 = 0; r2 < 2; ++r2) if (lane < 16) SSQP[(size_t)(m + r2) * 16 + lane] = lane == 0 ? sq[r2] : 0.f;
        }
        }
        if (BOTH(0)) GRID_BAR();
    }

#pragma unroll 1
    for (int l = 0; l < DEPTH; ++l) {
        const int pb = 1 + 8 * l;
        unsigned char* wl = ws + WS_W + (size_t)l * W_LAYER;
        float* ssqA = SSQP + (size_t)l * M * 16; float* ssqAn = SSQP + (size_t)(l + 1) * M * 16; float* ssqB = SSQP + (size_t)(3 + l) * M * 16; float* ssqC = SSQP + (size_t)(5 + l) * M * 16; float* ssqQ = SSQP + (size_t)7 * M * 16 + (size_t)l * M * 4; float* ssqK = SSQP + (size_t)7 * M * 16 + (size_t)(2 + l) * M * 4; (void)ssqK;
        if (EN_PH(1) && IN(pb + 0)) {
            PHASE_PTRS();
            pg8::Gemm g{XB, (const bf16*)(wl + W_GU1), M, NGU, DM, DM}; pg8::StaticOrder S; S.init(M, NGU, G, (int)blockIdx.x);
            pg8::EpiSwiGLU E{ACT, ssqA};
            for (int grep = 0; grep < GU_REPS; ++grep)
            pg8::gemm_phase<pg8::EpiSwiGLU, pg8::StaticOrder, true, true>(lds, g, S, E);
            if (BOTH(pb + 0)) GRID_BAR();
        }
        if (EN_PH(2) && IN(pb + 1)) {
            PHASE_PTRS();
            pg8::Gemm g{ACT, (const bf16*)(wl + W_D1), M, DM, DFF, DFF}; pg8::StaticOrder S; S.init(M, DM, G, (int)blockIdx.x);
            if (l == 0) { pg8::EpiResid<true> E{ARG_IN(I_XP), ARG_IN(I_XS) - (size_t)MP * DM, XB, ssqB, 0.5f};
                pg8::gemm_phase<pg8::EpiResid<true>, pg8::StaticOrder, true, true>(lds, g, S, E); }
            else { pg8::EpiResid<false> E{nullptr, nullptr, XB, ssqB, 0.5f};
                pg8::gemm_phase<pg8::EpiResid<false>, pg8::StaticOrder, true, true>(lds, g, S, E); }
            if (BOTH(pb + 1)) GRID_BAR();
        }
        if (EN_PH(3) && IN(pb + 2)) {
            PHASE_PTRS();
            pg8::Gemm g{XB, (const bf16*)(wl + W_IN), M, NINP, DM, DM}; pg8::StaticOrder S; S.init(M, NINP, G, (int)blockIdx.x);
#if FUSE_POST
            pg8::EpiInFused E{ws, out, l};
            pg8::gemm_phase<pg8::EpiInFused, pg8::StaticOrder, true, true>(lds, g, S, E);
#else
            pg8::EpiScaleBf16 E{HB, NINP, ssqB, 16, 1.0f / 1024.0f, ssqQ};
            pg8::gemm_phase<pg8::EpiScaleBf16, pg8::StaticOrder, true, true>(lds, g, S, E);
#endif
            if (BOTH(pb + 2)) GRID_BAR();
        }
        if (EN_PH(4) && IN(pb + 3)) {
            PHASE_PTRS();
#if FUSE_POST
            {
                pg8::Gemm g{CQ, (const bf16*)(wl + W_Q), M, NQP, 256, 256}; pg8::StaticOrder S; S.init(M, NQP, G, (int)blockIdx.x);
                pg8::EpiScaleBf16 E{QA, NQP, ssqQ, 4, 1.0f / 256.0f, nullptr};
                pg8::gemm_phase<pg8::EpiScaleBf16, pg8::StaticOrder, true, true>(lds, g, S, E);
            }
            {
                FRESH_TID();
                const float* kvn = ARG_IN(I_KVN) + l * 128; const int gw = blockIdx.x * NWAVES + wave, NGW = G * NWAVES; const int c16 = lane & 15, sub = lane >> 4;
                for (int row4 = gw * 4; row4 < M; row4 += NGW * 4) { const int row = row4 + sub;
                    const bool smp = row >= MP; const int rr = smp ? row - MP : row;
                    const v4u w = *(const v4u*)(CKV + (size_t)row * 128 + 8 * c16); float x[8];
                    x[0] = __uint_as_float(w[0] << 16); x[1] = __uint_as_float(w[0] & 0xffff0000u); x[2] = __uint_as_float(w[1] << 16); x[3] = __uint_as_float(w[1] & 0xffff0000u);
                    x[4] = __uint_as_float(w[2] << 16); x[5] = __uint_as_float(w[2] & 0xffff0000u); x[6] = __uint_as_float(w[3] << 16); x[7] = __uint_as_float(w[3] & 0xffff0000u);
                    const float rs = 1.0f / sqrtf(ssq_sum4(ssqK, row) * (1.0f / 128.0f) + EPS); const f32x4 g0 = *(const f32x4*)(kvn + 8 * c16), g1 = *(const f32x4*)(kvn + 8 * c16 + 4);
#pragma unroll
                    for (int e = 0; e < 4; ++e) { x[e] = x[e] * rs * g0[e]; x[4 + e] = x[4 + e] * rs * g1[e]; }
                    float* od = out + (smp ? O_MLA_S + ((size_t)l * MS + rr) * 160 : O_MLA_P + ((size_t)l * MP + rr) * 160) + 8 * c16;
                    *(f32x4*)od = (f32x4){x[0], x[1], x[2], x[3]}; *(f32x4*)(od + 4) = (f32x4){x[4], x[5], x[6], x[7]};
                    *(v4u*)(RA + (size_t)row * 160 + 8 * c16) = (v4u){cvtpk(x[0], x[1]), cvtpk(x[2], x[3]), cvtpk(x[4], x[5]), cvtpk(x[6], x[7])}; }
            }
            if (BOTH(pb + 3)) GRID_BAR();
#else
            for (int prep = 0; prep < POST_REPS; ++prep) {
            {
                pg8::Gemm g{HB, (const bf16*)(wl + W_Q), M, NQP, 256, NINP}; pg8::StaticOrder S; S.init(M, NQP, G, (int)blockIdx.x);
                pg8::EpiScaleBf16 E{QA, NQP, ssqQ, 4, 1.0f / 256.0f, nullptr};
                pg8::gemm_phase<pg8::EpiScaleBf16, pg8::StaticOrder, true, true>(lds, g, S, E);
            }
            FRESH_TID();
            const float* kvn = ARG_IN(I_KVN) + l * 128;
            const float scaleB = 0.125f * LOG2E, scaleD = 0.17677669529663687f * LOG2E, scaleC = 0.125f * LOG2E;
            const int gw = blockIdx.x * NWAVES + wave, NGW = G * NWAVES;
#define UP8(w, f) do { f[0] = __uint_as_float((w)[0] << 16); f[1] = __uint_as_float((w)[0] & 0xffff0000u); f[2] = __uint_as_float((w)[1] << 16); f[3] = __uint_as_float((w)[1] & 0xffff0000u); \
                       f[4] = __uint_as_float((w)[2] << 16); f[5] = __uint_as_float((w)[2] & 0xffff0000u); f[6] = __uint_as_float((w)[3] << 16); f[7] = __uint_as_float((w)[3] & 0xffff0000u); } while (0)
#define PK8(f) ((v4u){cvtpk(f[0], f[1]), cvtpk(f[2], f[3]), cvtpk(f[4], f[5]), cvtpk(f[6], f[7])})
#define ST8F(p, f) do { *(f32x4*)(p) = (f32x4){f[0], f[1], f[2], f[3]}; *(f32x4*)((p) + 4) = (f32x4){f[4], f[5], f[6], f[7]}; } while (0)
            for (int row = gw; row < M; row += NGW) {
                const bf16* h = HB + (size_t)row * NINP;
                const bool smp = row >= MP; const int rr = smp ? row - MP : row;
                const int pidx = smp ? 2048 + (rr & 63) : (rr & 2047);
                float* o_mla = out + (smp ? O_MLA_S + ((size_t)l * MS + rr) * 160 : O_MLA_P + ((size_t)l * MP + rr) * 160);
                float* o_dsa = out + (smp ? O_DSA_S + ((size_t)l * MS + rr) * 192 : O_DSA_P + ((size_t)l * MP + rr) * 192);
                float* o_sb = out + (smp ? O_SB_S + ((size_t)l * MS + rr) * 512 : O_SB_P + ((size_t)l * MP + rr) * 512);
                float* o_df = out + (smp ? O_DIFF_S + ((size_t)l * MS + rr) * 512 : O_DIFF_P + ((size_t)l * MP + rr) * 512);
                bf16* ra = RA + (size_t)row * 160; bf16* rb = RB + (size_t)row * 192; bf16* rc = RC + (size_t)row * 512; bf16* rd = RD + (size_t)row * 512;
                if (lane < 56) { const int blk = lane >> 2, j = lane & 3;
                    const int base = blk < 4 ? H_QB + 64 * blk : (blk == 4 ? H_KB : (blk < 13 ? H_QI + 64 * (blk - 5) : H_KI));
                    const v4u w1 = *(const v4u*)(h + base + 8 * j), w2 = *(const v4u*)(h + base + 32 + 8 * j); float x1[8], x2[8], a[8], b[8]; UP8(w1, x1); UP8(w2, x2);
                    const f32x4* cp = (const f32x4*)(ROPE64 + pidx * 32 + 8 * j);
#pragma unroll
                    for (int e2 = 0; e2 < 4; ++e2) { const f32x4 cs = cp[e2];
                        a[2 * e2] = x1[2 * e2] * cs[0] - x2[2 * e2] * cs[1]; b[2 * e2] = x2[2 * e2] * cs[0] + x1[2 * e2] * cs[1];
                        a[2 * e2 + 1] = x1[2 * e2 + 1] * cs[2] - x2[2 * e2 + 1] * cs[3]; b[2 * e2 + 1] = x2[2 * e2 + 1] * cs[2] + x1[2 * e2 + 1] * cs[3]; }
                    if (blk < 4) {
#pragma unroll
                        for (int e = 0; e < 8; ++e) { a[e] *= scaleB; b[e] *= scaleB; }
                        bf16* d = QB + (size_t)row * 256 + 64 * blk + 8 * j; *(v4u*)d = PK8(a); *(v4u*)(d + 32) = PK8(b); }
                    else if (blk == 4) { ST8F(o_dsa + 8 * j, a); ST8F(o_dsa + 32 + 8 * j, b); *(v4u*)(rb + 8 * j) = PK8(a); *(v4u*)(rb + 32 + 8 * j) = PK8(b); }
                    else if (blk < 13) { bf16* d = QI + (size_t)row * 512 + 64 * (blk - 5) + 8 * j; *(v4u*)d = PK8(a); *(v4u*)(d + 32) = PK8(b); }
                    else { ST8F(o_dsa + 128 + 8 * j, a); ST8F(o_dsa + 160 + 8 * j, b); *(v4u*)(rb + 128 + 8 * j) = PK8(a); *(v4u*)(rb + 160 + 8 * j) = PK8(b); }
                }
                if (lane < 34) { const int blk = lane >> 1, j = lane & 1;
                    const int base = blk == 0 ? H_KR : (blk < 9 ? H_QD + 32 * (blk - 1) : H_KD + 32 * (blk - 9));
                    const v4u w1 = *(const v4u*)(h + base + 8 * j), w2 = *(const v4u*)(h + base + 16 + 8 * j); float x1[8], x2[8], a[8], b[8]; UP8(w1, x1); UP8(w2, x2);
                    const f32x4* cp = (const f32x4*)(ROPE32 + pidx * 16 + 8 * j);
#pragma unroll
                    for (int e2 = 0; e2 < 4; ++e2) { const f32x4 cs = cp[e2];
                        a[2 * e2] = x1[2 * e2] * cs[0] - x2[2 * e2] * cs[1]; b[2 * e2] = x2[2 * e2] * cs[0] + x1[2 * e2] * cs[1];
                        a[2 * e2 + 1] = x1[2 * e2 + 1] * cs[2] - x2[2 * e2 + 1] * cs[3]; b[2 * e2 + 1] = x2[2 * e2 + 1] * cs[2] + x1[2 * e2 + 1] * cs[3]; }
                    if (blk == 0) { ST8F(o_mla + 128 + 8 * j, a); ST8F(o_mla + 144 + 8 * j, b); *(v4u*)(ra + 128 + 8 * j) = PK8(a); *(v4u*)(ra + 144 + 8 * j) = PK8(b); }
                    else if (blk < 9) {
#pragma unroll
                        for (int e = 0; e < 8; ++e) { a[e] *= scaleD; b[e] *= scaleD; }
                        bf16* d = QD + (size_t)row * 256 + 32 * (blk - 1) + 8 * j; *(v4u*)d = PK8(a); *(v4u*)(d + 16) = PK8(b); }
                    else { const int bb = blk - 9, oc = (bb >> 1) * 128 + (bb & 1) * 32 + 8 * j; ST8F(o_df + oc, a); ST8F(o_df + oc + 16, b); *(v4u*)(rd + oc) = PK8(a); *(v4u*)(rd + oc + 16) = PK8(b); }
                }
                { const int c16 = lane & 15; float x[8] = {0.f, 0.f, 0.f, 0.f, 0.f, 0.f, 0.f, 0.f}; float ss = 0.f;
                  if (lane >= 48) { const v4u w = *(const v4u*)(h + H_CKV + 8 * c16); UP8(w, x);
#pragma unroll
                      for (int e = 0; e < 8; ++e) ss += x[e] * x[e]; }
                  ss += __shfl_xor(ss, 1); ss += __shfl_xor(ss, 2); ss += __shfl_xor(ss, 4); ss += __shfl_xor(ss, 8);
                  if (lane >= 48) { const float rs = 1.0f / sqrtf(ss * (1.0f / 128.0f) + EPS); const f32x4 g0 = *(const f32x4*)(kvn + 8 * c16), g1 = *(const f32x4*)(kvn + 8 * c16 + 4);
#pragma unroll
                      for (int e = 0; e < 4; ++e) { x[e] = x[e] * rs * g0[e]; x[4 + e] = x[4 + e] * rs * g1[e]; }
                      ST8F(o_mla + 8 * c16, x); *(v4u*)(ra + 8 * c16) = PK8(x); } }
#pragma unroll
                for (int r3 = 0; r3 < 3; ++r3) { const int t = lane + 64 * r3;
                    if (t < 137) { float x[8];
                        if (t < 8) { const v4u w = *(const v4u*)(h + H_VB + 8 * t); UP8(w, x); ST8F(o_dsa + 64 + 8 * t, x); *(v4u*)(rb + 64 + 8 * t) = w; }
                        else if (t < 40) { const int k = t - 8; const v4u w = *(const v4u*)(h + H_QC + 8 * k); UP8(w, x);
#pragma unroll
                            for (int e = 0; e < 8; ++e) x[e] *= scaleC;
                            *(v4u*)(QC + (size_t)row * 256 + 8 * k) = PK8(x); }
                        else if (t < 72) { const int k = t - 40, oc = (k >> 3) * 128 + 8 * (k & 7); const v4u w = *(const v4u*)(h + H_KC + 8 * k); UP8(w, x); ST8F(o_sb + oc, x); *(v4u*)(rc + oc) = w; }
                        else if (t < 104) { const int k = t - 72, oc = (k >> 3) * 128 + 64 + 8 * (k & 7); const v4u w = *(const v4u*)(h + H_VC + 8 * k); UP8(w, x); ST8F(o_sb + oc, x); *(v4u*)(rc + oc) = w; }
                        else if (t < 136) { const int k = t - 104, oc = (k >> 3) * 128 + 64 + 8 * (k & 7); const v4u w = *(const v4u*)(h + H_VD + 8 * k); UP8(w, x); ST8F(o_df + oc, x); *(v4u*)(rd + oc) = w; }
                        else { const v4u w = *(const v4u*)(h + H_WI); UP8(w, x);
#pragma unroll
                            for (int e = 0; e < 8; ++e) x[e] *= 0.35355339059327373f;
                            ST8F(WI + (size_t)row * 8, x); }
                    } }
            }
            }
#undef UP8
#undef PK8
#undef ST8F
            if (BOTH(pb + 3)) GRID_BAR();
#endif
        }
        if (EN_PH(5) && IN(pb + 4)) {
            PHASE_PTRS();
            LAS char* tile = (LAS char*)lds;
            volatile LAS unsigned* qslot = MISC + 16;
            const int myx = (int)(xb_xcc_id() & 7u);
            { const int stage = 0, rep = 0; (void)rep;
#define MIXER_IDS() FRESH_TID(); const int r32 = lane & 31, hi = lane >> 5, hd = wave & 3, qh = wave >> 2, q4 = (lane & 15) >> 2; (void)q4; int qx = myx
#define NEXT_UNIT(kind, out) do { __syncthreads(); if (wave == 0) { int res_ = -1; gu32* heads_ = ctl + CW_Q + (((stage * 2 + l) * 4 + (kind)) * 8) * 64; int q_ = qx; \
        for (;;) { unsigned got_ = 0u; if (lane == 0) got_ = __hip_atomic_fetch_add((unsigned*)(heads_ + q_ * 64), 1u, RLX_AGENT); got_ = (unsigned)__builtin_amdgcn_readfirstlane((int)got_);     \
            if (got_ < (unsigned)QLIST) { res_ = (int)got_ + 256 * q_; break; } \
            unsigned hv_ = (unsigned)QLIST; if (lane < 8) hv_ = __hip_atomic_load((unsigned*)(heads_ + ((myx + lane) & 7) * 64), RLX_AGENT);     \
            const unsigned long long nz_ = __ballot(hv_ < (unsigned)QLIST); if (!nz_) break; \
            q_ = (myx + (int)__builtin_ctzll(nz_)) & 7; } \
        if (lane == 0) qslot[0] = (unsigned)res_; } \
    __syncthreads(); { const int r_ = (int)qslot[0]; out = r_ < 0 ? -1 : (r_ & 255); qx = (r_ < 0) ? qx : ((r_ >> 8) & 7); } } while (0)
#if EN_DSA
            if (rep == 0 || ((REP_MASK >> 1) & 1)) { MIXER_IDS();
            for (;;) {
                int uidx; NEXT_UNIT(1, uidx); if (uidx < 0) break;
                const UnitId u = decode_unit(qx, uidx);
                const float* cache_lb = ARG_IN(I_CDSA) + ((size_t)(l * NB + u.b) * PAST) * 192;
                const int myq = u.qrow0 + 32 * qh + r32;
                float* sc = (float*)(ws + WS_REGA + (size_t)blockIdx.x * DSA_SCR);
                unsigned long long* mk = (unsigned long long*)(ws + WS_REGA + (size_t)blockIdx.x * DSA_SCR + DSA_MASK_OFF);
                const bool sel = u.nt > 4;
                if (sel) {
                    {
                    float wq[8];
#pragma unroll
                    for (int hh = 0; hh < 8; ++hh) wq[hh] = WI[(size_t)myq * 8 + hh];
                    LAS char* ql_ = (LAS char*)lds + 20480;
                    { const int row0 = tid >> 6, cc = tid & 63;
#pragma unroll
                      for (int i = 0; i < 8; ++i) { const int row = row0 + 8 * i; *(LAS v4u*)(ql_ + row * T512_STRB + cc * 16) = *(const v4u*)(QI + (size_t)(u.qrow0 + row) * 512 + cc * 8); } }
                    const LAS char* qb_ = ql_ + (32 * qh + r32) * T512_STRB + 8 * hi * 2;
                    TileLd<64, 192, true, 128> ld; ld.init(); constexpr int STRB = TileLd<64, 192, true, 128>::STRB;
                    const int nt2 = (u.nt + 1) >> 1;
                    bool f32; const void* src = tile_src(u, 0, cache_lb, RB, 192, 128, f32);
                    ld.nrows_ = (u.nt >= 2) ? 128 : 64; ld.issue(src, f32, tid); ld.store(tile, f32, tid); __syncthreads();
                    const int kboffA = (32 * hd + r32) * STRB + 8 * hi * 2;
                    int cbA = 0;
                    for (int t2 = 0; t2 < nt2; ++t2) {
                        LAS char* curA = tile + cbA * 90112; LAS char* nxbA = tile + (cbA ^ 1) * 90112; cbA ^= 1;
                        const LAS char* kb = curA + kboffA;
                        const int rows_cur = (2 * t2 + 2 <= u.nt) ? 128 : 64;
                        bool f32n; { const int tn2 = (t2 + 1 < nt2) ? t2 + 1 : t2; const void* sn = tile_src(u, 2 * tn2, cache_lb, RB, 192, 128, f32n); ld.nrows_ = (2 * tn2 + 2 <= u.nt) ? 128 : 64; ld.issue(sn, f32n, tid); }
                        if (32 * hd < rows_cur) {
                            bf16x8 ka[4];
#pragma unroll
                            for (int s = 0; s < 4; ++s) ka[s] = *(const LAS bf16x8*)(kb + s * 32);
                            f32x16 I = zero16();
#pragma unroll
                            for (int hh = 0; hh < 8; ++hh) { f32x16 p = zero16();
#pragma unroll
                                for (int s = 0; s < 4; ++s) p = MFMA32(ka[s], *(const LAS bf16x8*)(qb_ + hh * 128 + s * 32), p);
#pragma unroll
                                for (int r = 0; r < 16; ++r) I[r] += wq[hh] * fmaxf(p[r], 0.f); }
                            float* srow = sc + (size_t)(32 * qh + r32) * SC_LS + t2 * 128 + 32 * hd + 4 * hi;
#pragma unroll
                            for (int g4 = 0; g4 < 4; ++g4) *(f32x4*)(srow + 8 * g4) = (f32x4){I[4 * g4], I[4 * g4 + 1], I[4 * g4 + 2], I[4 * g4 + 3]};
                        }
                        ld.store(nxbA, f32n, tid);
                        __syncthreads();
                    }
                    }
                    VM_WAIT(); __syncthreads();
                    { LAS unsigned* hist = (LAS unsigned*)(lds + wave * 16384);
                    if (u.sample) { for (int qq = 0; qq < 8; ++qq) { const int ql = wave * 8 + qq; dsa_select<65, 1>(sc + (size_t)ql * SC_LS, u.nt, hist, mk + (size_t)ql * MK_LS, lane); } }
                    else { for (int qq = 0; qq < 8; qq += 2) { const int ql = wave * 8 + qq; dsa_select<32, 2>(sc + (size_t)ql * SC_LS, u.nt, hist, mk + (size_t)ql * MK_LS, lane); } } }
                    VM_WAIT(); __syncthreads();
                }
                bf16x8 q[4];
#pragma unroll
                for (int s = 0; s < 4; ++s) q[s] = *(const bf16x8*)(QB + (size_t)myq * 256 + hd * 64 + 16 * s + 8 * hi);
                f32x16 o[2]; o[0] = zero16(); o[1] = zero16(); float m_ = -1e30f, l_ = 0.f;
                TileLd<128, 192> ld; ld.init(); constexpr int STRB = TileLd<128, 192>::STRB;
                bool f32; const void* src = tile_src(u, 0, cache_lb, RB, 192, 0, f32);
                ld.issue(src, f32, tid); ld.store(tile, f32, tid); __syncthreads();
                const int kboff = r32 * STRB + 8 * hi * 2;
                const int vboff = (4 * hi + q4) * STRB + (64 + 16 * ((lane >> 4) & 1) + 4 * (lane & 3)) * 2;
                int cb = 0;
                for (int t = 0; t < u.nt; ++t) {
                    LAS char* cur = tile + cb * 24576; LAS char* nxb = tile + (cb ^ 1) * 24576; cb ^= 1;
                    const LAS char* kb = cur + kboff; const LAS char* vb = cur + vboff;
                    bool f32n; { const int tn = (t + 1 < u.nt) ? t + 1 : t; const void* sn = tile_src(u, tn, cache_lb, RB, 192, 0, f32n); ld.issue(sn, f32n, tid); }
                    unsigned long long mw = ~0ull; if (sel) mw = mk[(size_t)(32 * qh + r32) * MK_LS + t];
                    const unsigned mlo = (unsigned)mw >> (4 * hi), mhi = (unsigned)(mw >> 32) >> (4 * hi);
                    f32x16 p0, p1; qk<4>(p0, p1, kb, STRB, q);
#pragma unroll
                    for (int r = 0; r < 16; ++r) { const int bpos = (r & 3) + 8 * (r >> 2); if (!((mlo >> bpos) & 1u)) p0[r] = -3e38f; if (!((mhi >> bpos) & 1u)) p1[r] = -3e38f; }
                    softmax_step<2>(p0, p1, m_, l_, o);
                    pv<2>(o, p0, p1, vb, STRB);
                    ld.store(nxb, f32n, tid);
                    __syncthreads();
                }
                l_ += __shfl_xor(l_, 32); const float inv = 1.0f / l_;
                bf16* orow = CC + (size_t)myq * KOUT + 512 + hd * 64;
#pragma unroll
                for (int db = 0; db < 2; ++db)
#pragma unroll
                    for (int gq = 0; gq < 4; ++gq) { v2u w; w.x = cvtpk(o[db][4 * gq] * inv, o[db][4 * gq + 1] * inv); w.y = cvtpk(o[db][4 * gq + 2] * inv, o[db][4 * gq + 3] * inv);
                        *(v2u*)(orow + 32 * db + 8 * gq + 4 * hi) = w; }
            }
            }
#endif
#if EN_DIFF
            if (rep == 0 || ((REP_MASK >> 3) & 1)) { MIXER_IDS();
            for (;;) {
                int uidx; NEXT_UNIT(3, uidx); if (uidx < 0) break;
                const UnitId u = decode_unit(qx, uidx);
                const float* cache_lb = ARG_IN(I_CDIFF) + ((size_t)(l * NB + u.b) * PAST) * 512;
                const int myq = u.qrow0 + 32 * qh + r32;
                bf16x8 qa[2], qb2[2];
#pragma unroll
                for (int s = 0; s < 2; ++s) { qa[s] = *(const bf16x8*)(QD + (size_t)myq * 256 + hd * 64 + 16 * s + 8 * hi); qb2[s] = *(const bf16x8*)(QD + (size_t)myq * 256 + hd * 64 + 32 + 16 * s + 8 * hi); }
                f32x16 o1[2], o2[2]; o1[0] = zero16(); o1[1] = zero16(); o2[0] = zero16(); o2[1] = zero16(); float m1 = -1e30f, l1 = 0.f, m2 = -1e30f, l2 = 0.f;
                constexpr int STRB = T512_STRB;
                { bool f32; const void* src = tile_src(u, 0, cache_lb, RD, 512, 0, f32);
                  if (f32) t512_cvt(src, tile, tid); else t512_dma(src, tile, wave, lane); VM_WAIT(); __syncthreads(); }
                const int kboff = r32 * STRB + (hd * 128 + 8 * hi) * 2;
                const int vboff = (4 * hi + q4) * STRB + (hd * 128 + 64 + 16 * ((lane >> 4) & 1) + 4 * (lane & 3)) * 2;
                int cb = 0;
                for (int t = 0; t < u.nt; ++t) {
                    LAS char* cur = tile + cb * T512_BYTES; LAS char* nxb = tile + (cb ^ 1) * T512_BYTES; cb ^= 1;
                    const LAS char* kb1 = cur + kboff; const LAS char* kb2 = kb1 + 64; const LAS char* vb = cur + vboff;
                    bool f32n = false; const void* sn = nullptr; if (t + 1 < u.nt) { sn = tile_src(u, t + 1, cache_lb, RD, 512, 0, f32n); if (!f32n) t512_dma(sn, nxb, wave, lane); }
#if DBG_VARIANTS
                    { f32x16 p0, p1; qk<2>(p0, p1, kb1, STRB, qa); float sx = 0.f; for (int r = 0; r < 16; ++r) { p0[r] = __builtin_amdgcn_exp2f(p0[r] - 8.f); p1[r] = __builtin_amdgcn_exp2f(p1[r] - 8.f); sx += p0[r] + p1[r]; } l1 += sx; pv<2>(o1, p0, p1, vb, STRB); }
                    { f32x16 p0, p1; qk<2>(p0, p1, kb2, STRB, qb2); float sx = 0.f; for (int r = 0; r < 16; ++r) { p0[r] = __builtin_amdgcn_exp2f(p0[r] - 8.f); p1[r] = __builtin_amdgcn_exp2f(p1[r] - 8.f); sx += p0[r] + p1[r]; } l2 += sx; pv<2>(o2, p0, p1, vb, STRB); }
#else
                    { f32x16 p0, p1; qk<2>(p0, p1, kb1, STRB, qa); softmax_step<2>(p0, p1, m1, l1, o1); pv<2>(o1, p0, p1, vb, STRB); }
                    { f32x16 p0, p1; qk<2>(p0, p1, kb2, STRB, qb2); softmax_step<2>(p0, p1, m2, l2, o2); pv<2>(o2, p0, p1, vb, STRB); }
#endif
                    if (t + 1 < u.nt && f32n) t512_cvt(sn, nxb, tid);
                    VM_WAIT(); __syncthreads();
                }
                l1 += __shfl_xor(l1, 32); l2 += __shfl_xor(l2, 32);
                const float i1 = 1.0f / l1, i2 = LAMF[l] / l2; float ss = 0.f;
#pragma unroll
                for (int db = 0; db < 2; ++db)
#pragma unroll
                    for (int r = 0; r < 16; ++r) { const float v = o1[db][r] * i1 - o2[db][r] * i2; o1[db][r] = v; ss += v * v; }
                ss += __shfl_xor(ss, 32);
                const float lam_init = 0.8f - 0.6f * expf(-0.3f * (float)l);
                const float rs = (1.0f - lam_init) / sqrtf(ss * (1.0f / 64.0f) + EPS);
                const float* dn = ARG_IN(I_DN) + l * 64;
                bf16* orow = CC + (size_t)myq * KOUT + 1024 + hd * 64;
#pragma unroll
                for (int db = 0; db < 2; ++db)
#pragma unroll
                    for (int gq = 0; gq < 4; ++gq) { const f32x4 dv = *(const f32x4*)(dn + 32 * db + 8 * gq + 4 * hi);
                        v2u w; w.x = cvtpk(o1[db][4 * gq] * rs * dv[0], o1[db][4 * gq + 1] * rs * dv[1]); w.y = cvtpk(o1[db][4 * gq + 2] * rs * dv[2], o1[db][4 * gq + 3] * rs * dv[3]);
                        *(v2u*)(orow + 32 * db + 8 * gq + 4 * hi) = w; }
            }
            }
#endif
#if EN_MLA
            if (rep == 0 || ((REP_MASK >> 0) & 1)) { MIXER_IDS();
            for (;;) {
                int uidx; NEXT_UNIT(0, uidx); if (uidx < 0) break;
                const UnitId u = decode_unit(qx, uidx);
                const float* cache_lb = ARG_IN(I_CMLA) + ((size_t)(l * NB + u.b) * PAST) * 160;
                const int myq = u.qrow0 + 32 * qh + r32;
                bf16x8 q[10];
#pragma unroll
                for (int s = 0; s < 10; ++s) q[s] = *(const bf16x8*)(QA + (size_t)myq * NQP + hd * 160 + 16 * s + 8 * hi);
                {
                    const int pidx = u.sample ? 2048 + 32 * qh + r32 : u.c * 64 + 32 * qh + r32;
                    bf16x8 a = q[8], b = q[9];
#pragma unroll
                    for (int j = 0; j < 8; ++j) { const float2 cs = ROPE32[pidx * 16 + 8 * hi + j]; const float x1 = bf2f((bf16)a[j]), x2 = bf2f((bf16)b[j]);
                        a[j] = (short)f2bf(x1 * cs.x - x2 * cs.y); b[j] = (short)f2bf(x2 * cs.x + x1 * cs.y); }
                    q[8] = a; q[9] = b;
                }
                f32x16 o[4]; o[0] = zero16(); o[1] = zero16(); o[2] = zero16(); o[3] = zero16(); float m_ = -1e30f, l_ = 0.f;
                TileLd<160, 160> ld; ld.init(); constexpr int STRB = TileLd<160, 160>::STRB;
                bool f32; const void* src = tile_src(u, 0, cache_lb, RA, 160, 0, f32);
                ld.issue(src, f32, tid); ld.store(tile, f32, tid); __syncthreads();
                const int kboff = r32 * STRB + 8 * hi * 2;
                const int vboff = (4 * hi + q4) * STRB + (16 * ((lane >> 4) & 1) + 4 * (lane & 3)) * 2;
                int cb = 0;
                for (int t = 0; t < u.nt; ++t) {
                    LAS char* cur = tile + cb * 24576; LAS char* nxb = tile + (cb ^ 1) * 24576; cb ^= 1;
                    const LAS char* kb = cur + kboff; const LAS char* vb = cur + vboff;
                    bool f32n; { const int tn = (t + 1 < u.nt) ? t + 1 : t; const void* sn = tile_src(u, tn, cache_lb, RA, 160, 0, f32n); ld.issue(sn, f32n, tid); }
                    f32x16 p0, p1; qk<10>(p0, p1, kb, STRB, q);
#if DBG_VARIANTS
                    { for (int r = 0; r < 16; ++r) { p0[r] = p0[r] * 0.f + 1.f; p1[r] = p1[r] * 0.f + 1.f; } l_ += 32.f; }
#else
                    softmax_step<4>(p0, p1, m_, l_, o);
#endif
                    pv<4>(o, p0, p1, vb, STRB);
                    ld.store(nxb, f32n, tid);
                    __syncthreads();
                }
                l_ += __shfl_xor(l_, 32); const float inv = 1.0f / l_;
                bf16* orow = CC + (size_t)myq * KOUT + hd * 128;
#pragma unroll
                for (int db = 0; db < 4; ++db)
#pragma unroll
                    for (int gq = 0; gq < 4; ++gq) { v2u w; w.x = cvtpk(o[db][4 * gq] * inv, o[db][4 * gq + 1] * inv); w.y = cvtpk(o[db][4 * gq + 2] * inv, o[db][4 * gq + 3] * inv);
                        *(v2u*)(orow + 32 * db + 8 * gq + 4 * hi) = w; }
            }
            }
#endif
#if EN_SB
            if (rep == 0 || ((REP_MASK >> 2) & 1)) { MIXER_IDS();
            for (;;) {
                int uidx; NEXT_UNIT(2, uidx); if (uidx < 0) break;
                const UnitId u = decode_unit(qx, uidx);
                const float* cache_lb = ARG_IN(I_CSB) + ((size_t)(l * NB + u.b) * PAST) * 512;
                const int myq = u.qrow0 + 32 * qh + r32, qloc = 32 * qh + r32;
                bf16x8 q[4];
#pragma unroll
                for (int s = 0; s < 4; ++s) q[s] = *(const bf16x8*)(QC + (size_t)myq * 256 + hd * 64 + 16 * s + 8 * hi);
                f32x16 o[2]; o[0] = zero16(); o[1] = zero16(); float carry = 1.0f; int it3 = 0;
                constexpr int STRB = T512_STRB;
                { bool f32; const void* src = tile_src(u, u.nt - 1, cache_lb, RC, 512, 0, f32);
                  if (f32) t512_cvt(src, tile, tid); else t512_dma(src, tile, wave, lane); VM_WAIT(); __syncthreads(); }
                const int kboff = r32 * STRB + (hd * 128 + 8 * hi) * 2;
                const int vboff = (4 * hi + q4) * STRB + (hd * 128 + 64 + 16 * ((lane >> 4) & 1) + 4 * (lane & 3)) * 2;
                volatile LAS unsigned* sbflag = MISC + 20;
                if (tid == 0) { sbflag[0] = 0u; sbflag[1] = 0u; sbflag[2] = 0u; }
                __syncthreads();
                int cb = 0;
                for (int t = u.nt - 1; t >= 0; --t) {
                    LAS char* cur = tile + cb * T512_BYTES; LAS char* nxb = tile + (cb ^ 1) * T512_BYTES; cb ^= 1;
                    const LAS char* kb = cur + kboff; const LAS char* vb = cur + vboff;
                    bool f32n = false; const void* sn = nullptr; if (t > 0) { sn = tile_src(u, t - 1, cache_lb, RC, 512, 0, f32n); if (!f32n) t512_dma(sn, nxb, wave, lane); }
                    const bool diag = (t == u.nt - 1);
                    f32x16 z0, z1; qk<4>(z0, z1, kb, STRB, q);
                    f32x16 u0, u1; float gs[8];
#pragma unroll
                    for (int r = 0; r < 16; ++r) {
                        const int key = crow(r, hi);
                        { const float e = __builtin_amdgcn_exp2f(fminf(z0[r], 80.f)); const float uu = __builtin_amdgcn_rcpf(1.0f + e); const bool ok = !diag || (key < qloc); u0[r] = ok ? uu : 1.0f; z0[r] = ok ? e * uu : 0.f; }
                        { const float e = __builtin_amdgcn_exp2f(fminf(z1[r], 80.f)); const float uu = __builtin_amdgcn_rcpf(1.0f + e); const bool ok = !diag || (key + 32 < qloc); u1[r] = ok ? uu : 1.0f; z1[r] = ok ? e * uu : 0.f; }
                    }
#pragma unroll
                    for (int g4 = 0; g4 < 4; ++g4) { gs[g4] = (u0[4 * g4] * u0[4 * g4 + 1]) * (u0[4 * g4 + 2] * u0[4 * g4 + 3]); gs[4 + g4] = (u1[4 * g4] * u1[4 * g4 + 1]) * (u1[4 * g4 + 2] * u1[4 * g4 + 3]); }
                    float pg[8];
#pragma unroll
                    for (int g8 = 0; g8 < 8; ++g8) pg[g8] = __shfl_xor(gs[g8], 32);
                    float run = carry;
#pragma unroll
                    for (int g8 = 7; g8 >= 0; --g8) {
                        float P = run * (hi == 0 ? pg[g8] : 1.0f);
                        if (g8 >= 4) { const int b4 = 4 * (g8 - 4);
                            z1[b4 + 3] *= P; P *= u1[b4 + 3]; z1[b4 + 2] *= P; P *= u1[b4 + 2]; z1[b4 + 1] *= P; P *= u1[b4 + 1]; z1[b4] *= P;
                        } else { const int b4 = 4 * g8;
                            z0[b4 + 3] *= P; P *= u0[b4 + 3]; z0[b4 + 2] *= P; P *= u0[b4 + 2]; z0[b4 + 1] *= P; P *= u0[b4 + 1]; z0[b4] *= P;
                        }
                        run *= gs[g8] * pg[g8];
                    }
                    carry = run;
                    pv<2>(o, z0, z1, vb, STRB);
                    if (t > 0 && f32n) t512_cvt(sn, nxb, tid);
                    if (tid == 0) sbflag[(it3 + 1) % 3] = 0u;
                    if (__any(carry != 0.f) && lane == 0) sbflag[it3] = 1u;
                    VM_WAIT(); __syncthreads();
                    const bool alive = sbflag[it3] != 0u; it3 = (it3 + 1) % 3;
                    if (!alive) break;
                }
                bf16* orow = CC + (size_t)myq * KOUT + 768 + hd * 64;
#pragma unroll
                for (int db = 0; db < 2; ++db)
#pragma unroll
                    for (int gq = 0; gq < 4; ++gq) { v2u w; w.x = cvtpk(o[db][4 * gq], o[db][4 * gq + 1]); w.y = cvtpk(o[db][4 * gq + 2], o[db][4 * gq + 3]);
                        *(v2u*)(orow + 32 * db + 8 * gq + 4 * hi) = w; }
            }
            }
#endif
            }
            if (BOTH(pb + 4)) GRID_BAR();
        }
        if (EN_PH(6) && IN(pb + 5)) {
            PHASE_PTRS();
            pg8::Gemm g{CC, (const bf16*)(wl + W_OUT), M, DM, KOUT, KOUT}; pg8::StaticOrder S; S.init(M, DM, G, (int)blockIdx.x);
            pg8::EpiResid<false> E{nullptr, nullptr, XB, ssqC, 1.0f};
            pg8::gemm_phase<pg8::EpiResid<false>, pg8::StaticOrder, true, true>(lds, g, S, E);
            if (BOTH(pb + 5)) GRID_BAR();
        }
        if (EN_PH(7) && IN(pb + 6)) {
            PHASE_PTRS();
            pg8::Gemm g{XB, (const bf16*)(wl + W_GU2), M, NGU, DM, DM}; pg8::StaticOrder S; S.init(M, NGU, G, (int)blockIdx.x);
            pg8::EpiSwiGLU E{ACT, ssqC};
            for (int grep = 0; grep < GU_REPS; ++grep)
            pg8::gemm_phase<pg8::EpiSwiGLU, pg8::StaticOrder, true, true>(lds, g, S, E);
            if (BOTH(pb + 6)) GRID_BAR();
        }
        if (EN_PH(8) && IN(pb + 7)) {
            PHASE_PTRS();
            pg8::Gemm g{ACT, (const bf16*)(wl + W_D2), M, DM, DFF, DFF}; pg8::StaticOrder S; S.init(M, DM, G, (int)blockIdx.x);
            pg8::EpiResid<false> E{nullptr, nullptr, XB, ssqAn, 0.5f};
            pg8::gemm_phase<pg8::EpiResid<false>, pg8::StaticOrder, true, true>(lds, g, S, E);
            if (BOTH(pb + 7)) GRID_BAR();
        }
    }
    if (EN_PH(9) && IN(17)) {
        PHASE_PTRS();
        FRESH_TID();
        const float* fn = ARG_IN(I_FN); const float* ssqF = SSQP + (size_t)2 * M * 16;
        const int gw = blockIdx.x * NWAVES + wave, NGW = G * NWAVES;
        for (int m = gw; m < M; m += NGW) {
            const float rs = 1.0f / sqrtf(ssq_sum16(ssqF, m) * (1.0f / 1024.0f) + EPS);
            const v2u* x2 = (const v2u*)(XB + (size_t)m * DM) + lane; f32x4* y4 = (f32x4*)(X + (size_t)m * DM) + lane; const f32x4* g4 = (const f32x4*)fn + lane;
#pragma unroll
            for (int j = 0; j < 4; ++j) { const v2u w = x2[64 * j]; const f32x4 gg = g4[64 * j];
                const f32x4 v = (f32x4){__uint_as_float(w.x << 16), __uint_as_float(w.x & 0xffff0000u), __uint_as_float(w.y << 16), __uint_as_float(w.y & 0xffff0000u)};
                y4[64 * j] = v * rs * gg; }
        }
    }
#undef IN
#undef BOTH
#undef GRID_BAR
#undef X
#undef XB
#undef HB
#undef ACT
#undef QA
#undef QB
#undef QI
#undef QC
#undef QD
#undef WI
#undef RA
#undef RB
#undef RC
#undef RD
#undef CC
#undef CQ
#undef CKV
#undef SSQP
#undef LAMF
#undef ROPE64
#undef ROPE32
}


#if SELFCHECK
constexpr size_t WS_CHK = 3 * MiB + 768 * 1024;
__device__ __forceinline__ unsigned hsh(unsigned x) { x ^= x >> 16; x *= 0x7feb352du; x ^= x >> 15; x *= 0x846ca68bu; x ^= x >> 16; return x; }
__device__ __forceinline__ void chk_rep(unsigned* slot, float got, float ex, float atol, float rtol) {
    float e = fabsf(got - ex) / (atol + rtol * fabsf(ex)); if (!(e == e)) e = 1e30f; atomicMax(slot, __float_as_uint(e)); }
__device__ __forceinline__ float bfr(float x) { return bf2f((bf16)f2bf(x)); }
__device__ __forceinline__ int nat_col(int np) { return np < 1376 ? np : (np < 2912 ? np + 8 : (np < 2920 ? 1376 + (np - 2912) : -1)); }
struct Ptrs { float* X; bf16 *XB, *HB, *ACT, *QA, *QB, *QI, *QC, *QD, *RA, *RB, *RC, *RD, *CC; float* WI; float* SSQ; float* LAMF; float2 *R64, *R32; unsigned* chk; float* save; unsigned char* wl; };
__device__ __forceinline__ Ptrs mkptrs(const Args& a, int l) { Ptrs p; unsigned char* ws = a.ws;
    p.X = a.out; p.XB = (bf16*)(ws + WS_XB); p.HB = (bf16*)(ws + WS_REGA); p.ACT = p.HB; p.QA = (bf16*)(ws + WS_QA); p.QB = (bf16*)(ws + WS_QB); p.QI = (bf16*)(ws + WS_QI); p.QC = (bf16*)(ws + WS_QC); p.QD = (bf16*)(ws + WS_QD);
    p.RA = (bf16*)(ws + WS_RA); p.RB = (bf16*)(ws + WS_RB); p.RC = (bf16*)(ws + WS_RC); p.RD = (bf16*)(ws + WS_RD); p.CC = (bf16*)(ws + WS_CC); p.WI = (float*)(ws + WS_WI); p.SSQ = (float*)(ws + WS_SSQ);
    p.LAMF = (float*)(ws + WS_MISC); p.R64 = (float2*)(ws + WS_MISC + MISC_ROPE64); p.R32 = (float2*)(ws + WS_MISC + MISC_ROPE32); p.chk = (unsigned*)(ws + WS_CHK); p.save = (float*)(ws + WS_CHK + 256); p.wl = ws + WS_W + (size_t)l * W_LAYER; return p; }
__device__ __forceinline__ int samp_row(unsigned h) { const unsigned r = h % 4096u; return r < 3584u ? (int)(hsh(h) % (unsigned)MP) : MP + (int)(hsh(h) % (unsigned)MS); }

__global__ void __launch_bounds__(256) check_kernel(Args a, int l, int which) {
    const Ptrs p = mkptrs(a, l); const int gt = blockIdx.x * 256 + threadIdx.x, NT = gridDim.x * 256; const int lane = threadIdx.x & 63; const int gwv = gt >> 6, NW = NT >> 6;
    const float* ssqA = p.SSQ + (size_t)l * M; const float* ssqB = p.SSQ + (size_t)(3 + l) * M; const float* ssqC = p.SSQ + (size_t)(5 + l) * M; const float* ssqQ = p.SSQ + (size_t)(7 + l) * M;
    if (which == 0) {
        for (int i = gt; i < 16384; i += NT) { const unsigned h = hsh(i * 3 + 1);
            { const int np = h % NGU, k = hsh(h) % DM, pn = np >> 8, c = np & 255, f = pn * 128 + (c & 127); const float* src = (c < 128 ? a.in[I_G1] : a.in[I_U1]) + (size_t)l * DM * DFF;
              chk_rep(p.chk + 0, bf2f(((bf16*)(p.wl + W_GU1))[(size_t)np * DM + k]), bfr(src[(size_t)k * DFF + f] * a.in[I_N1][l * DM + k]), 1e-6f, 1e-3f); }
            { const int n = h % DM, k = hsh(h + 7) % DFF; chk_rep(p.chk + 1, bf2f(((bf16*)(p.wl + W_D1))[(size_t)n * DFF + k]), bfr(a.in[I_D1][(size_t)l * DFF * DM + (size_t)k * DM + n]), 1e-6f, 1e-3f); }
            { const int np = h % NINP, k = hsh(h + 9) % DM, j = nat_col(np); const float ex = j < 0 ? 0.f : bfr(a.in[I_WIN][(size_t)l * DM * NIN + (size_t)k * NIN + j] * a.in[I_NM][l * DM + k]);
              chk_rep(p.chk + 2, bf2f(((bf16*)(p.wl + W_IN))[(size_t)np * DM + k]), ex, 1e-6f, 1e-3f); }
            if (l == 0) { const int row = samp_row(h), c = hsh(h + 11) % DM; const float xv = row < MP ? a.in[I_XP][(size_t)row * DM + c] : a.in[I_XS][(size_t)(row - MP) * DM + c];
              chk_rep(p.chk + 3, bf2f(p.XB[(size_t)row * DM + c]), bfr(xv), 1e-6f, 1e-3f); }
        }
        if (l == 0) for (int i = gwv; i < 256; i += NW) { const int row = samp_row(hsh(i + 77)); const float* xr = row < MP ? a.in[I_XP] + (size_t)row * DM : a.in[I_XS] + (size_t)(row - MP) * DM;
            float s = 0.f; for (int c = lane; c < DM; c += 64) s += xr[c] * xr[c]; s = wave_sum(s); if (lane == 0) chk_rep(p.chk + 3, ssqA[row], s, 1e-3f, 1e-3f); }
    }
    if (which == 1) {
        for (int i = gt; i < 8192; i += NT) { const unsigned h = hsh(i * 5 + 2); const int row = samp_row(h), f = hsh(h + 1) % DFF; const bf16* wg = (bf16*)(p.wl + W_GU1) + (size_t)((f >> 7) * 256 + (f & 127)) * DM; const bf16* wu = wg + (size_t)128 * DM;
            const float* ssq = ssqA; float g = 0.f, u = 0.f; for (int k = 0; k < DM; ++k) { const float xv = bf2f(p.XB[(size_t)row * DM + k]); g += xv * bf2f(wg[k]); u += xv * bf2f(wu[k]); }
            const float rs = 1.0f / sqrtf(ssq[row] / 1024.f + EPS); g *= rs; u *= rs; const float ex = g / (1.f + expf(-g)) * u;
            chk_rep(p.chk + 4, bf2f(p.ACT[(size_t)row * DFF + f]), ex, 0.01f, 0.02f); }
    }
    if (which == 2) {
        for (int i = gt; i < 8192; i += NT) { const unsigned h = hsh(i * 7 + 3); const int row = samp_row(h), c = hsh(h + 1) % DM; const bf16* wd = (bf16*)(p.wl + W_D1) + (size_t)c * DFF;
            float s = 0.f; for (int k = 0; k < DFF; ++k) s += bf2f(p.ACT[(size_t)row * DFF + k]) * bf2f(wd[k]);
            const float xin = l == 0 ? (row < MP ? a.in[I_XP][(size_t)row * DM + c] : a.in[I_XS][(size_t)(row - MP) * DM + c]) : 0.f;
            if (l == 0) chk_rep(p.chk + 5, p.X[(size_t)row * DM + c], xin + 0.5f * s, 0.01f, 0.005f);
            chk_rep(p.chk + 5, bf2f(p.XB[(size_t)row * DM + c]), bfr(p.X[(size_t)row * DM + c]), 1e-6f, 1e-3f); }
        for (int i = gwv; i < 256; i += NW) { const int row = samp_row(hsh(i + 177)); float s = 0.f; for (int c = lane; c < DM; c += 64) { const float v = p.X[(size_t)row * DM + c]; s += v * v; } s = wave_sum(s);
            if (lane == 0) chk_rep(p.chk + 5, ssqB[row], s, 1e-3f, 1e-3f); }
    }
    if (which == 3) {
        for (int i = gt; i < 8192; i += NT) { const unsigned h = hsh(i * 11 + 4); const int row = samp_row(h), np = hsh(h + 1) % NINP; const bf16* w = (bf16*)(p.wl + W_IN) + (size_t)np * DM;
            float s = 0.f; for (int k = 0; k < DM; ++k) s += bf2f(p.XB[(size_t)row * DM + k]) * bf2f(w[k]); s *= 1.0f / sqrtf(ssqB[row] / 1024.f + EPS);
            chk_rep(p.chk + 6, bf2f(p.HB[(size_t)row * NINP + np]), s, 0.01f, 0.01f); }
        for (int i = gwv; i < 256; i += NW) { const int row = samp_row(hsh(i + 277)); float s = 0.f; for (int c = lane; c < 256; c += 64) { const float v = bf2f(p.HB[(size_t)row * NINP + c]); s += v * v; } s = wave_sum(s);
            if (lane == 0) chk_rep(p.chk + 6, ssqQ[row], s, 0.05f, 0.01f); }
    }
    if (which == 4) {
        const float* wqb = a.in[I_WQB] + (size_t)l * 256 * 384; const float* wkvb = a.in[I_WKVB] + (size_t)l * 128 * 512; const float* qn = a.in[I_QN] + l * 256;
        for (int i = gt; i < 2048; i += NT) { const unsigned h = hsh(i * 13 + 5); const int row = samp_row(h), hh = (hsh(h + 1) >> 3) & 3, c = hsh(h + 2) % 160; const bf16* hr = p.HB + (size_t)row * NINP;
            const float rs = 1.0f / sqrtf(ssqQ[row] / 256.f + EPS); float ex;
            if (c < 128) { float acc = 0.f; for (int e = 0; e < 64; ++e) { float qe = 0.f; for (int k = 0; k < 256; ++k) qe += bf2f(hr[k]) * rs * qn[k] * wqb[(size_t)k * 384 + hh * 96 + e]; acc += qe * wkvb[(size_t)c * 512 + hh * 128 + e]; } ex = acc; }
            else { float qe = 0.f; for (int k = 0; k < 256; ++k) qe += bf2f(hr[k]) * rs * qn[k] * wqb[(size_t)k * 384 + hh * 96 + 64 + (c - 128)]; ex = qe; }
            ex *= 0.10206207261596575f * LOG2E;
            chk_rep(p.chk + 7, bf2f(p.QA[(size_t)row * NQP + hh * 160 + c]), ex, 0.01f, 0.02f); }
        for (int i = gt; i < 16384; i += NT) { const unsigned h = hsh(i * 17 + 6); const int row = samp_row(h); const bool smp = row >= MP; const int rr = smp ? row - MP : row; const float pos = smp ? 4096.f + (rr & 63) : (float)(rr & 2047);
            const bf16* hr = p.HB + (size_t)row * NINP;
            const float* o_mla = a.out + (smp ? O_MLA_S + ((size_t)l * MS + rr) * 160 : O_MLA_P + ((size_t)l * MP + rr) * 160);
            const float* o_dsa = a.out + (smp ? O_DSA_S + ((size_t)l * MS + rr) * 192 : O_DSA_P + ((size_t)l * MP + rr) * 192);
            const float* o_sb = a.out + (smp ? O_SB_S + ((size_t)l * MS + rr) * 512 : O_SB_P + ((size_t)l * MP + rr) * 512);
            const float* o_df = a.out + (smp ? O_DIFF_S + ((size_t)l * MS + rr) * 512 : O_DIFF_P + ((size_t)l * MP + rr) * 512);
#define HN(j) bf2f(hr[(j) < 1376 ? (j) : ((j) < 1384 ? H_WI + ((j) - 1376) : (j) - 8)])
#define ROPE(base, d, idx, res) do { const int hf = (d) / 2, ii = (idx) % hf; const float fr = (d) == 64 ? a.freq64[ii] : a.freq32[ii]; float sn, cs; sincos_acc(pos * fr, sn, cs); \
            const float x1 = HN((base) + ii), x2 = HN((base) + hf + ii); res = (idx) < hf ? x1 * cs - x2 * sn : x2 * cs + x1 * sn; } while (0)
            const int sel = hsh(h + 3) % 12; const unsigned e = hsh(h + 4);
            if (sel == 0) { const int c = e % 128; float ss = 0.f; for (int k = 0; k < 128; ++k) { const float v = HN(256 + k); ss += v * v; } const float ex = HN(256 + c) / sqrtf(ss / 128.f + EPS) * a.in[I_KVN][l * 128 + c];
                chk_rep(p.chk + 8, o_mla[c], ex, 0.01f, 0.01f); chk_rep(p.chk + 8, bf2f(p.RA[(size_t)row * 160 + c]), ex, 0.01f, 0.01f); }
            if (sel == 1) { const int c = e % 32; float ex; ROPE(384, 32, c, ex); chk_rep(p.chk + 8, o_mla[128 + c], ex, 0.01f, 0.01f); chk_rep(p.chk + 8, bf2f(p.RA[(size_t)row * 160 + 128 + c]), ex, 0.01f, 0.01f); }
            if (sel == 2) { const int c = e % 256, hd = c >> 6; float ex; ROPE(416 + hd * 64, 64, c & 63, ex); chk_rep(p.chk + 8, bf2f(p.QB[(size_t)row * 256 + c]), ex * 0.125f * LOG2E, 0.01f, 0.01f); }
            if (sel == 3) { const int c = e % 64; float ex; ROPE(672, 64, c, ex); chk_rep(p.chk + 8, o_dsa[c], ex, 0.01f, 0.01f); chk_rep(p.chk + 8, bf2f(p.RB[(size_t)row * 192 + c]), ex, 0.01f, 0.01f);
                            const float v = HN(736 + c); chk_rep(p.chk + 8, o_dsa[64 + c], v, 0.01f, 0.01f); chk_rep(p.chk + 8, bf2f(p.RB[(size_t)row * 192 + 64 + c]), v, 0.01f, 0.01f); }
            if (sel == 4) { const int c = e % 512, hd = c >> 6; float ex; ROPE(800 + hd * 64, 64, c & 63, ex); chk_rep(p.chk + 8, bf2f(p.QI[(size_t)row * 512 + c]), ex, 0.01f, 0.01f); }
            if (sel == 5) { const int c = e % 64; float ex; ROPE(1312, 64, c, ex); chk_rep(p.chk + 8, o_dsa[128 + c], ex, 0.01f, 0.01f); chk_rep(p.chk + 8, bf2f(p.RB[(size_t)row * 192 + 128 + c]), ex, 0.01f, 0.01f);
                            const int w8 = e % 8; chk_rep(p.chk + 8, p.WI[(size_t)row * 8 + w8], HN(1376 + w8) * 0.35355339f, 0.005f, 0.01f); }
            if (sel == 6) { const int c = e % 256, hd = c >> 6, d = c & 63; chk_rep(p.chk + 8, bf2f(p.QC[(size_t)row * 256 + c]), HN(1384 + c) * 0.125f, 0.005f, 0.01f);
                            chk_rep(p.chk + 8, o_sb[hd * 128 + d], HN(1640 + c), 0.01f, 0.01f); chk_rep(p.chk + 8, o_sb[hd * 128 + 64 + d], HN(1896 + c), 0.01f, 0.01f);
                            chk_rep(p.chk + 8, bf2f(p.RC[(size_t)row * 512 + hd * 128 + d]), HN(1640 + c), 0.01f, 0.01f); chk_rep(p.chk + 8, bf2f(p.RC[(size_t)row * 512 + hd * 128 + 64 + d]), HN(1896 + c), 0.01f, 0.01f); }
            if (sel == 7) { const int c = e % 256, blk = c >> 5; float ex; ROPE(2152 + blk * 32, 32, c & 31, ex); chk_rep(p.chk + 8, bf2f(p.QD[(size_t)row * 256 + c]), ex * 0.17677669529663687f * LOG2E, 0.01f, 0.01f); }
            if (sel == 8) { const int c = e % 256, blk = c >> 5, hd = c >> 6; float ex; ROPE(2408 + blk * 32, 32, c & 31, ex); chk_rep(p.chk + 8, o_df[hd * 128 + (c & 63)], ex, 0.01f, 0.01f); chk_rep(p.chk + 8, bf2f(p.RD[(size_t)row * 512 + hd * 128 + (c & 63)]), ex, 0.01f, 0.01f); }
            if (sel == 9) { const int c = e % 256, hd = c >> 6, d = c & 63; chk_rep(p.chk + 8, o_df[hd * 128 + 64 + d], HN(2664 + c), 0.01f, 0.01f); chk_rep(p.chk + 8, bf2f(p.RD[(size_t)row * 512 + hd * 128 + 64 + d]), HN(2664 + c), 0.01f, 0.01f); }
        }
    }
    if (which == 5) {
        for (int i = gwv; i < 4 * 96; i += NW) {
            int kind = i / 96; const int slot = kind; const unsigned h = hsh(i * 19 + 7); int row = samp_row(h);
            if (CHK_FILTER == 6) { row = MP + (int)(hsh(h + 5) % (unsigned)MS); if (slot == 1) { kind = 2; row = (row & ~63) | (int)(hsh(h + 9) % 3u); } if (slot == 2) row = (row & ~63) | (48 + (int)(hsh(h + 9) % 16u)); }
            if (CHK_FILTER == 1) row = (int)(hsh(h + 5) % NB) * SEQ + (int)(hsh(h + 6) % 64u);
            if (CHK_FILTER == 2) row = (int)(hsh(h + 5) % (unsigned)MP);
            if (CHK_FILTER == 3) row = MP + (int)(hsh(h + 5) % (unsigned)MS);
            if (CHK_FILTER == 5) { if (kind == 0 || kind == 2) row = MP + (int)(hsh(h + 5) % (unsigned)MS); else if (kind == 1) row = (int)(hsh(h + 5) % NB) * SEQ + 128 + (int)(hsh(h + 6) % 128u); else row = (int)(hsh(h + 5) % NB) * SEQ + 128 + (int)(hsh(h + 6) % 384u); }
            if (CHK_FILTER == 4) row = (int)(hsh(h + 5) % NB) * SEQ + 64 + (int)(hsh(h + 6) % 64u); const int hd = (hsh(h + 1) >> 5) & 3; const bool smp = row >= MP; const int rr = smp ? row - MP : row;
            const int b = smp ? rr >> 6 : rr >> 11, t = smp ? rr & 63 : rr & 2047; const int L = smp ? PAST + 64 : ((t >> 6) + 1) * 64;
            const int W = kind == 0 ? 160 : (kind == 1 ? 192 : 512);
            const float* cache = (kind == 0 ? a.in[I_CMLA] : kind == 1 ? a.in[I_CDSA] : kind == 2 ? a.in[I_CSB] : a.in[I_CDIFF]) + (size_t)(l * NB + b) * PAST * W;
            const bf16* rows = kind == 0 ? p.RA : kind == 1 ? p.RB : kind == 2 ? p.RC : p.RD;
#define SLD(ptr) __hip_atomic_load((ptr), __ATOMIC_RELAXED, __HIP_MEMORY_SCOPE_AGENT)
#define KEL(k, c) (smp ? ((k) < PAST ? bfr(cache[(size_t)(k) * W + (c)]) : bf2f(rows[(size_t)(MP + b * 64 + (k) - PAST) * W + (c)])) : bf2f(rows[(size_t)(b * SEQ + (k)) * W + (c)]))
            float* sbuf = (float*)(a.ws + WS_REGA + (size_t)300 * MiB) + (size_t)i * 8448;
            if (kind == 0) {
                const int pidx = smp ? 2048 + t : t; float mx = -1e30f;
                for (int k = lane; k < L; k += 64) { float s = 0.f; for (int c = 0; c < 128; ++c) s += bf2f(p.QA[(size_t)row * NQP + hd * 160 + c]) * KEL(k, c);
                    for (int c = 0; c < 16; ++c) { const float2 cs = p.R32[pidx * 16 + c]; const float x1 = bf2f(p.QA[(size_t)row * NQP + hd * 160 + 128 + c]), x2 = bf2f(p.QA[(size_t)row * NQP + hd * 160 + 144 + c]);
                        s += bfr(x1 * cs.x - x2 * cs.y) * KEL(k, 128 + c) + bfr(x2 * cs.x + x1 * cs.y) * KEL(k, 144 + c); }
                    sbuf[k] = s; mx = fmaxf(mx, s); }
                for (int o = 1; o < 64; o <<= 1) mx = fmaxf(mx, __shfl_xor(mx, o));
                float den = 0.f; for (int k = lane; k < L; k += 64) { float pp = exp2f(sbuf[k] - mx); if (DBG_VARIANTS) pp = 1.f; sbuf[k] = pp; den += pp; } den = wave_sum(den);
                __builtin_amdgcn_s_waitcnt(0);
                for (int d = 0; d < 128; d += 16) { const int dd = d + (lane & 15); float acc = 0.f; for (int k = lane >> 4; k < L; k += 4) acc += SLD(sbuf + k) * KEL(k, dd); acc += __shfl_xor(acc, 16); acc += __shfl_xor(acc, 32);
                    if (lane < 16) chk_rep(p.chk + 9, bf2f(p.CC[(size_t)row * KOUT + hd * 128 + dd]), acc / den, 0.004f, 0.03f); }
            }
            if (kind == 1) {
                const int nsel = 256;
                for (int k = lane; k < L; k += 64) { float sc = 0.f; for (int ih = 0; ih < 8; ++ih) { float s = 0.f; for (int c = 0; c < 64; ++c) s += bf2f(p.QI[(size_t)row * 512 + ih * 64 + c]) * KEL(k, 128 + c); sc += fmaxf(s, 0.f) * p.WI[(size_t)row * 8 + ih]; } sbuf[k] = sc; }
                __builtin_amdgcn_s_waitcnt(0);
                float mx = -1e30f; float* pb = sbuf + 4224;
                for (int k = lane; k < L; k += 64) { const float me = sbuf[k]; int rank = 0; if (L > nsel) for (int j = 0; j < L; ++j) { const float o = SLD(sbuf + j); rank += (o > me) || (o == me && j < k); }
                    float s = -1e30f; if (rank < nsel) { s = 0.f; for (int c = 0; c < 64; ++c) s += bf2f(p.QB[(size_t)row * 256 + hd * 64 + c]) * KEL(k, c); } pb[k] = s; mx = fmaxf(mx, s); }
                for (int o = 1; o < 64; o <<= 1) mx = fmaxf(mx, __shfl_xor(mx, o));
                float den = 0.f; for (int k = lane; k < L; k += 64) { const float pp = pb[k] > -1e29f ? exp2f(pb[k] - mx) : 0.f; pb[k] = pp; den += pp; } den = wave_sum(den);
                __builtin_amdgcn_s_waitcnt(0);
                for (int d = 0; d < 64; d += 16) { const int dd = d + (lane & 15); float acc = 0.f; for (int k = lane >> 4; k < L; k += 4) acc += SLD(pb + k) * KEL(k, 64 + dd); acc += __shfl_xor(acc, 16); acc += __shfl_xor(acc, 32);
                    if (lane < 16) chk_rep(p.chk + 10, bf2f(p.CC[(size_t)row * KOUT + 512 + hd * 64 + dd]), acc / den, 0.02f, 0.10f); }
            }
            if (kind == 2) {
                const int qpos = smp ? PAST + t : t; float accv[1]; (void)accv;
                for (int k = lane; k < qpos; k += 64) { float z = 0.f; for (int c = 0; c < 64; ++c) z += bf2f(p.QC[(size_t)row * 256 + hd * 64 + c]) * KEL(k, hd * 128 + c); sbuf[k] = z; }
                __builtin_amdgcn_s_waitcnt(0);
                float logafter = 0.f, acc = 0.f;
                for (int k = qpos - 1; k >= 0; --k) { const float z = SLD(sbuf + k); const float sp = fmaxf(z, 0.f) + logf(1.f + expf(-fabsf(z))); const float aw = expf(z - sp + logafter); acc += bfr(aw) * KEL(k, hd * 128 + 64 + lane); logafter -= sp; if (logafter < -60.f) break; }
                chk_rep(p.chk + 9 + slot, bf2f(p.CC[(size_t)row * KOUT + 768 + hd * 64 + lane]), acc, 0.02f, 0.05f);
            }
            if (kind == 3) {
                float outv = 0.f; float o2[2];
                for (int m2 = 0; m2 < 2; ++m2) { float mx = -1e30f;
                    for (int k = lane; k < L; k += 64) { float s = 0.f; for (int c = 0; c < 32; ++c) s += bf2f(p.QD[(size_t)row * 256 + hd * 64 + m2 * 32 + c]) * KEL(k, hd * 128 + m2 * 32 + c); sbuf[k] = s; mx = fmaxf(mx, s); }
                    for (int o = 1; o < 64; o <<= 1) mx = fmaxf(mx, __shfl_xor(mx, o));
                    float den = 0.f; for (int k = lane; k < L; k += 64) { const float pp = exp2f(sbuf[k] - (DBG_VARIANTS ? 8.f : mx)); sbuf[k] = pp; den += pp; } den = wave_sum(den);
                    __builtin_amdgcn_s_waitcnt(0);
                    float acc = 0.f; for (int k = 0; k < L; ++k) acc += SLD(sbuf + k) * KEL(k, hd * 128 + 64 + lane); o2[m2] = acc / den; __builtin_amdgcn_s_waitcnt(0); }
                outv = o2[0] - p.LAMF[l] * o2[1]; const float ss = wave_sum(outv * outv); const float lam_init = 0.8f - 0.6f * expf(-0.3f * (float)l);
                const float ex = outv / sqrtf(ss / 64.f + EPS) * a.in[I_DN][l * 64 + lane] * (1.f - lam_init);
                chk_rep(p.chk + 12, bf2f(p.CC[(size_t)row * KOUT + 1024 + hd * 64 + lane]), ex, 0.02f, 0.05f);
            }
        }
    }
    if (which == 6) { for (int i = gt; i < 4096; i += NT) { const unsigned h = hsh(i * 23 + 8); const int row = samp_row(h), c = hsh(h + 1) % DM; p.save[i] = p.X[(size_t)row * DM + c]; } }
    if (which == 7) {
        const float* wkvb = a.in[I_WKVB] + (size_t)l * 128 * 512; const float* wo = a.in[I_WO] + (size_t)l * DM * DM;
        for (int i = gt; i < 4096; i += NT) { const unsigned h = hsh(i * 23 + 8); const int row = samp_row(h), c = hsh(h + 1) % DM; const bf16* w = (bf16*)(p.wl + W_OUT) + (size_t)c * KOUT;
            float s = 0.f; for (int k = 0; k < KOUT; ++k) s += bf2f(p.CC[(size_t)row * KOUT + k]) * bf2f(w[k]);
            chk_rep(p.chk + 13, p.X[(size_t)row * DM + c], p.save[i] + s, 0.01f, 0.005f);
            float s1 = 0.f, s2 = 0.f; for (int k = 0; k < 512; ++k) s1 += bf2f(p.CC[(size_t)row * KOUT + k]) * bf2f(w[k]);
            for (int hh = 0; hh < 4; ++hh) for (int e = 0; e < 64; ++e) { float v = 0.f; for (int cc = 0; cc < 128; ++cc) v += bf2f(p.CC[(size_t)row * KOUT + hh * 128 + cc]) * wkvb[(size_t)cc * 512 + hh * 128 + 64 + e]; s2 += v * wo[(size_t)(hh * 64 + e) * DM + c]; }
            chk_rep(p.chk + 14, s1, s2, 0.01f, 0.02f);
            for (int k = 512; k < KOUT; k += 97) chk_rep(p.chk + 14, bf2f(w[k]), bfr(wo[(size_t)(256 + k - 512) * DM + c]), 1e-6f, 1e-3f); }
    }
}
#ifndef CHK_SHOW
#define CHK_SHOW -1
#endif
#ifndef CHK_MAXLI
#define CHK_MAXLI 6
#endif
__global__ void __launch_bounds__(256) report_kernel(Args a) {
    const unsigned* chk = (const unsigned*)(a.ws + WS_CHK); float A = 0.f;
    if (CHK_SHOW >= 0) { A = sqrtf(fminf(__uint_as_float(chk[CHK_SHOW >= 0 ? CHK_SHOW : 0]), 400.f)); if (A < 0.3f) A = 0.f; }
    else if (CHK_SHOW == -2) { int bits = 0; for (int f = 9; f <= 12; ++f) if (__uint_as_float(chk[f]) > 1.0f) bits |= 1 << (f - 9); A = (float)(1 + bits); }
    else for (int f = 0; f < 15; ++f) if (__uint_as_float(chk[f]) > 1.0f) { A = (float)(f + 1); break; }
    if (A == 0.f) return;
    for (size_t i = (size_t)blockIdx.x * 256 + threadIdx.x; i < (size_t)M * DM; i += (size_t)gridDim.x * 256) a.out[i] = A;
}
#endif

extern "C" void kernel_launch(void* const* d_in, const int* in_sizes, int n_in, void* d_out, int out_size, void* d_ws, size_t ws_size, hipStream_t stream) {
    static int grid = 0;
    if (grid == 0) {
        if (n_in != 24 || (size_t)out_size != O_END || ws_size < WS_END) { fprintf(stderr, "kernel_launch: unexpected shapes: n_in %d out %d ws %zu (need %zu)\n", n_in, out_size, ws_size, (size_t)WS_END); grid = -1; return; }
        int dev = 0, cus = 0, per_cu = 0;
        if (hipGetDevice(&dev) != hipSuccess || hipDeviceGetAttribute(&cus, hipDeviceAttributeMultiprocessorCount, dev) != hipSuccess) { grid = -1; return; }
        if (hipFuncSetAttribute((const void*)fwd_kernel, hipFuncAttributeMaxDynamicSharedMemorySize, LDS_BYTES) != hipSuccess) { fprintf(stderr, "kernel_launch: hipFuncSetAttribute failed\n"); grid = -1; return; }
        if (hipOccupancyMaxActiveBlocksPerMultiprocessor(&per_cu, (const void*)fwd_kernel, NWAVES * 64, LDS_BYTES) != hipSuccess || per_cu < 1) fprintf(stderr, "kernel_launch: occupancy query reports %d\n", per_cu);
        (void)hipGetLastError();
        grid = cus < 256 ? cus : 256;
    }
    if (grid < 0) return;
    (void)hipMemsetAsync((char*)d_ws + WS_CTL, 0, CTL_ZERO_BYTES, stream);
    Args a{};
    for (int i = 0; i < 24; ++i) a.in[i] = (const float*)d_in[i];
    a.out = (float*)d_out; a.ws = (unsigned char*)d_ws;
    for (int i = 0; i < 32; ++i) a.freq64[i] = (float)pow(10000.0, -(double)i * 2.0 / 64.0);
    for (int i = 0; i < 16; ++i) a.freq32[i] = (float)pow(10000.0, -(double)i * 2.0 / 32.0);
    constexpr int NPH = 18;
    for (int li = 0; li < MK_N_LAUNCHES; ++li) {
        a.ph_lo = (MK_N_LAUNCHES == 1) ? 0 : li; a.ph_hi = (MK_N_LAUNCHES == 1) ? NPH : li + 1;
#if SELFCHECK
        if (MK_N_LAUNCHES == 18 && li == 6 && CHK_MAXLI >= 6) hipLaunchKernelGGL(check_kernel, dim3(256), dim3(256), 0, stream, a, 0, 6);
#endif
        hipLaunchKernelGGL(fwd_kernel, dim3(grid), dim3(NWAVES * 64), LDS_BYTES, stream, a);
        const hipError_t le = hipPeekAtLastError();
        if (le != hipSuccess) { fprintf(stderr, "kernel_launch: launch %d failed: %s\n", li, hipGetErrorName(le)); break; }
#if SELFCHECK
        if (MK_N_LAUNCHES == 18) { const int wmap[7] = {0, 1, 2, 3, 4, 5, 7}; if (li <= CHK_MAXLI) hipLaunchKernelGGL(check_kernel, dim3(512), dim3(256), 0, stream, a, 0, wmap[li]); }
#endif
    }
#if SELFCHECK
    hipLaunchKernelGGL(report_kernel, dim3(1024), dim3(256), 0, stream, a);
#endif
}
```

```cpp
#include <hip/hip_runtime.h>
#include <cstdio>
#include <cstdint>
#include <cmath>

#ifndef DBG_VARIANTS
#define DBG_VARIANTS 0
#endif
#ifndef ATTN_REPS
#define ATTN_REPS 1
#endif
#ifndef POST_REPS
#define POST_REPS 1
#endif
#ifndef GU_REPS
#define GU_REPS 1
#endif
#ifndef P0_REPS
#define P0_REPS 1
#endif
#ifndef REP_MASK
#define REP_MASK 15
#endif
#ifndef SELFCHECK
#define SELFCHECK 0
#endif
#ifndef CHK_FILTER
#define CHK_FILTER 0
#endif
#ifndef IN_STAGGER_TICKS
#define IN_STAGGER_TICKS 0
#endif
#ifndef FUSE_POST
#define FUSE_POST 1
#endif
#ifndef MK_N_LAUNCHES
#define MK_N_LAUNCHES 1
#endif

#ifndef PHMASK
#define PHMASK 0x3ff
#endif
#define EN_PH(c) (((PHMASK) >> (c)) & 1)
#ifndef EN_MLA
#define EN_MLA 1
#endif
#ifndef EN_DSA
#define EN_DSA 1
#endif
#ifndef EN_SB
#define EN_SB 1
#endif
#ifndef EN_DIFF
#define EN_DIFF 1
#endif
#define LAS __attribute__((address_space(3)))
#define GAS __attribute__((address_space(1)))

constexpr int DM = 1024, NB = 32, SEQ = 2048, DEPTH = 2, DSEQ = 64, PAST = 4096;
constexpr int MP = NB * SEQ, MS = NB * DSEQ, M = MP + MS;
constexpr int DFF = 2816, NGU = 2 * DFF, NIN = 2920, NINP = 3072, NQ = 640, NQP = 768, KOUT = 1280;
constexpr float EPS = 1e-6f;
constexpr float LOG2E = 1.4426950408889634f;
constexpr int H_CQ = 0, H_CKV = 256, H_KR = 384, H_QB = 416, H_KB = 672, H_VB = 736, H_QI = 800, H_KI = 1312,
              H_QC = 1376, H_KC = 1632, H_VC = 1888, H_QD = 2144, H_KD = 2400, H_VD = 2656, H_WI = 2912;
constexpr size_t O_Y = 0;
constexpr size_t O_MLA_P = (size_t)M * DM;
constexpr size_t O_DSA_P = O_MLA_P + (size_t)DEPTH * MP * 160;
constexpr size_t O_SB_P = O_DSA_P + (size_t)DEPTH * MP * 192;
constexpr size_t O_DIFF_P = O_SB_P + (size_t)DEPTH * MP * 512;
constexpr size_t O_MLA_S = O_DIFF_P + (size_t)DEPTH * MP * 512;
constexpr size_t O_DSA_S = O_MLA_S + (size_t)DEPTH * MS * 160;
constexpr size_t O_SB_S = O_DSA_S + (size_t)DEPTH * MS * 192;
constexpr size_t O_DIFF_S = O_SB_S + (size_t)DEPTH * MS * 512;
constexpr size_t O_END = O_DIFF_S + (size_t)DEPTH * MS * 512;

constexpr size_t MiB = 1u << 20;
constexpr size_t WS_CTL = 0, CTL_ZERO_BYTES = SELFCHECK ? 4 * MiB : 128 * 1024;
constexpr size_t WS_SSQ = 1 * MiB;
constexpr size_t WS_MISC = 4 * MiB;
constexpr size_t MISC_ROPE64 = 4096, MISC_ROPE32 = MISC_ROPE64 + (size_t)2112 * 32 * 8;
constexpr size_t WS_W = 5 * MiB;
constexpr size_t W_GU1 = 0, W_D1 = W_GU1 + (size_t)NGU * DM * 2, W_IN = W_D1 + (size_t)DM * DFF * 2, W_Q = W_IN + (size_t)NINP * DM * 2,
                 W_OUT = W_Q + (size_t)NQP * 256 * 2, W_GU2 = W_OUT + (size_t)DM * KOUT * 2, W_D2 = W_GU2 + (size_t)NGU * DM * 2, W_LAYER = W_D2 + (size_t)DM * DFF * 2;
constexpr size_t WS_XB = 90 * MiB;
constexpr size_t WS_REGA = 222 * MiB;
constexpr size_t REGA_BYTES = (size_t)M * NINP * 2;
constexpr size_t WS_QA = 618 * MiB, WS_QB = 717 * MiB, WS_QI = 750 * MiB, WS_QC = 816 * MiB, WS_QD = 849 * MiB, WS_WI = 882 * MiB;
constexpr size_t WS_RA = 885 * MiB, WS_RB = 906 * MiB, WS_RC = 931 * MiB, WS_RD = 997 * MiB, WS_CC = 1063 * MiB, WS_SSQP = 1228 * MiB, WS_END = 1264 * MiB;
static_assert(WS_W + 2 * W_LAYER <= WS_XB && WS_XB + (size_t)M * DM * 2 <= WS_REGA && WS_REGA + REGA_BYTES <= WS_QA, "ws map");
static_assert(WS_QA + (size_t)M * NQP * 2 <= WS_QB && WS_QI + (size_t)M * 512 * 2 <= WS_QC && WS_WI + (size_t)M * 32 <= WS_RA, "ws map");
static_assert(WS_RA + (size_t)M * 160 * 2 <= WS_RB && WS_RB + (size_t)M * 192 * 2 <= WS_RC && WS_RC + (size_t)M * 1024 <= WS_RD && WS_RD + (size_t)M * 1024 <= WS_CC && WS_CC + (size_t)M * KOUT * 2 <= WS_SSQP && WS_SSQP + (size_t)M * 16 * 4 * 7 + (size_t)M * 4 * 4 * 4 <= WS_END, "ws map");
constexpr int CW_BAR = 4096, CW_Q = 8192;
constexpr int SC_LS = 4160;
constexpr int MK_LS = 72;
constexpr size_t DSA_SCR = 1105920;
constexpr size_t DSA_MASK_OFF = (size_t)64 * SC_LS * 4;
static_assert(DSA_MASK_OFF + 64 * MK_LS * 8 <= DSA_SCR && 256 * DSA_SCR <= REGA_BYTES, "dsa scratch");

constexpr int RING_BYTES = 135168, LDSCTL_OFF = RING_BYTES, MISC_OFF = LDSCTL_OFF + 320, LDS_BYTES = 147456;
constexpr int NWAVES = 8;

typedef unsigned short bf16;
typedef unsigned v4u __attribute__((ext_vector_type(4)));
typedef unsigned v2u __attribute__((ext_vector_type(2)));
typedef float f32x4 __attribute__((ext_vector_type(4)));
typedef float f32x16 __attribute__((ext_vector_type(16)));
typedef short bf16x8 __attribute__((ext_vector_type(8)));
typedef short s16x4 __attribute__((ext_vector_type(4)));
typedef GAS unsigned gu32;
#define RLX_AGENT __ATOMIC_RELAXED, __HIP_MEMORY_SCOPE_AGENT
#define LDS_WAIT() asm volatile("s_waitcnt lgkmcnt(0)" ::: "memory")
#define VM_WAIT() asm volatile("s_waitcnt vmcnt(0)" ::: "memory")

__device__ __forceinline__ unsigned f2bf(float f) { unsigned u = __builtin_bit_cast(unsigned, f); return (u + 0x7fffu + ((u >> 16) & 1u)) >> 16; }
__device__ __forceinline__ unsigned pk2(float lo, float hi) { return f2bf(lo) | (f2bf(hi) << 16); }
__device__ __forceinline__ float bf2f(bf16 b) { return __builtin_bit_cast(float, ((unsigned)b) << 16); }
typedef float f32x2_t __attribute__((ext_vector_type(2))); typedef __bf16 bf16x2_t __attribute__((ext_vector_type(2)));
__device__ __forceinline__ unsigned cvtpk(float lo, float hi) { f32x2_t v = {lo, hi}; bf16x2_t b = __builtin_convertvector(v, bf16x2_t); return __builtin_bit_cast(unsigned, b); }
__device__ __forceinline__ int opaque_s(int x) { asm volatile("" : "+s"(x)); return x; }
__device__ __forceinline__ int fresh_lane() { int l; asm volatile("v_mbcnt_lo_u32_b32 %0, -1, 0\n\tv_mbcnt_hi_u32_b32 %0, -1, %0" : "=&v"(l)); return l; }
__device__ __forceinline__ float opaque_vf(float x) { asm volatile("" : "+v"(x)); return x; }
__device__ __forceinline__ float wave_sum(float v) {
#pragma unroll
    for (int o = 1; o < 64; o <<= 1) v += __shfl_xor(v, o);
    return v;
}

__device__ __forceinline__ float ssq_sum16(const float* p, int row) { const f32x4* q = (const f32x4*)(p + (size_t)row * 16); const f32x4 a = q[0], b = q[1], c = q[2], d = q[3];
    return (((a[0] + a[1]) + (a[2] + a[3])) + ((b[0] + b[1]) + (b[2] + b[3]))) + (((c[0] + c[1]) + (c[2] + c[3])) + ((d[0] + d[1]) + (d[2] + d[3]))); }
__device__ __forceinline__ float ssq_sum4(const float* p, int row) { const f32x4 a = *(const f32x4*)(p + (size_t)row * 4); return (a[0] + a[1]) + (a[2] + a[3]); }
namespace pg8 {
#define PG8_LAS __attribute__((address_space(3)))
typedef unsigned short bf16_t;
typedef unsigned u32x4 __attribute__((ext_vector_type(4)));
constexpr int BM = 256, BK = 64, HALF = 128, HTB = HALF * BK * 2, STAGE_BYTES = 8 * HTB, NXCD = 8, WGM = 8;
__host__ __device__ __forceinline__ int lds_byte(int r, int c) { const int st = (r >> 4) * 2 + (c >> 5), rr = r & 15, cc = c & 31, ob = rr * 64 + cc * 2; return st * 1024 + (ob ^ (((ob >> 9) & 1) << 5)); }
__host__ __device__ __forceinline__ void stage_rc(int b, int& R, int& C) { const int st = b / 1024, sb = b % 1024, swz = sb ^ (((sb >> 9) & 1) << 5); R = (st >> 1) * 16 + swz / 64; C = (st & 1) * 32 + (swz % 64) / 2; }
__host__ __device__ __forceinline__ int perm32(int rho) { const int n = rho >> 4, i = rho & 15; return 8 * (i >> 2) + 4 * n + (i & 3); }
struct Unit { int pm, pn; };
struct Gemm { const bf16_t* A; const bf16_t* Bt; int M, N, K, lda, ldb; };
struct StaticOrder {
    int nM, nN, nwg, G, c;
    __host__ __device__ void init(int M_, int N_, int G_, int c_) { nM = M_ / BM; nN = N_ / BM; nwg = nM * nN; G = G_; c = c_; }
    __host__ __device__ bool next(int i, Unit& u) const {
        const long L = (long)i * G + c; if (L >= nwg) return false;
        int wgid = (int)L; { const int q = nwg / NXCD, r = nwg % NXCD, xcd = wgid % NXCD, off = wgid / NXCD; wgid = (xcd < r ? xcd * (q + 1) : r * (q + 1) + (xcd - r) * q) + off; }
        const int nig = WGM * nN, gid = wgid / nig, fm = gid * WGM, gsz = (nM - fm) < WGM ? (nM - fm) : WGM;
        u.pm = fm + ((wgid % nig) % gsz); u.pn = (wgid % nig) / gsz; return true;
    }
    __device__ __forceinline__ void a_ready(const Unit&) const {}
    __device__ __forceinline__ void done(const Unit&) const {}
};

struct EpiSwiGLU {
    static constexpr bool PERM = true, AFTER_DRAIN = false;
    bf16_t* act; const float* ssq;
    __device__ __forceinline__ void operator()(const f32x4 (&acc)[2][2][4][2], const Unit& u, int wr, int wc, int fr, int fq) const {
        const int row0 = u.pm * BM + wr * 64 + fr, col0 = u.pn * 128 + wc * 32 + 8 * fq;
#pragma unroll
        for (int ai = 0; ai < 2; ++ai)
#pragma unroll
            for (int m = 0; m < 4; ++m) {
                const int row = row0 + ai * HALF + m * 16;
                const float rs = 1.0f / sqrtf(ssq_sum16(ssq, row) * (1.0f / 1024.0f) + EPS);
                float o[8];
#pragma unroll
                for (int n = 0; n < 2; ++n)
#pragma unroll
                    for (int j = 0; j < 4; ++j) {
                        const float g = acc[ai][0][m][n][j] * rs, up = acc[ai][1][m][n][j] * rs;
                        const float sg = g * __builtin_amdgcn_rcpf(1.0f + __builtin_amdgcn_exp2f(-g * LOG2E));
                        o[n * 4 + j] = sg * up;
                    }
                u32x4 w; w.x = cvtpk(o[0], o[1]); w.y = cvtpk(o[2], o[3]); w.z = cvtpk(o[4], o[5]); w.w = cvtpk(o[6], o[7]);
                *(u32x4*)(act + (size_t)row * DFF + col0) = w;
            }
    }
};
template <bool BASE_F32> struct EpiResid {
    static constexpr bool PERM = true, AFTER_DRAIN = false;
    const float* baseP; const float* baseS; bf16_t* xb; float* ssq_out; float alpha;
    __device__ __forceinline__ void operator()(const f32x4 (&acc)[2][2][4][2], const Unit& u, int wr, int wc, int fr, int fq) const {
        const int row0 = u.pm * BM + wr * 64 + fr, col0 = u.pn * BM + wc * 32 + 8 * fq;
        const float* base = (u.pm < MP / BM) ? baseP : baseS;
#pragma unroll
        for (int ai = 0; ai < 2; ++ai)
#pragma unroll
            for (int m = 0; m < 4; ++m) {
                const int row = row0 + ai * HALF + m * 16; const size_t off = (size_t)row * DM + col0; float ss = 0.f;
#pragma unroll
                for (int bj = 0; bj < 2; ++bj) {
                    f32x4 b0, b1;
                    if (BASE_F32) { b0 = *(const f32x4*)(base + off + bj * HALF); b1 = *(const f32x4*)(base + off + bj * HALF + 4); }
                    else { const u32x4 w = *(const u32x4*)(xb + off + bj * HALF);
                        b0 = (f32x4){__uint_as_float(w.x << 16), __uint_as_float(w.x & 0xffff0000u), __uint_as_float(w.y << 16), __uint_as_float(w.y & 0xffff0000u)};
                        b1 = (f32x4){__uint_as_float(w.z << 16), __uint_as_float(w.z & 0xffff0000u), __uint_as_float(w.w << 16), __uint_as_float(w.w & 0xffff0000u)}; }
                    const f32x4 o0 = b0 + acc[ai][bj][m][0] * alpha, o1 = b1 + acc[ai][bj][m][1] * alpha;
                    u32x4 w2; w2.x = cvtpk(o0[0], o0[1]); w2.y = cvtpk(o0[2], o0[3]); w2.z = cvtpk(o1[0], o1[1]); w2.w = cvtpk(o1[2], o1[3]);
                    *(u32x4*)(xb + off + bj * HALF) = w2;
                    ss += (o0[0] * o0[0] + o0[1] * o0[1]) + (o0[2] * o0[2] + o0[3] * o0[3]) + (o1[0] * o1[0] + o1[1] * o1[1]) + (o1[2] * o1[2] + o1[3] * o1[3]);
                }
                ss += __shfl_xor(ss, 16); ss += __shfl_xor(ss, 32);
                if (fq == 0) ssq_out[(size_t)row * 16 + u.pn * 4 + wc] = ss;
                asm volatile("" ::: "memory");
            }
    }
};
struct OneUnit {
    __device__ __forceinline__ bool next(int i, Unit& u) const { if (i > 0) return false; u.pm = 0; u.pn = 0; return true; }
    __device__ __forceinline__ void a_ready(const Unit&) const {}
    __device__ __forceinline__ void done(const Unit&) const {}
};
struct EpiPartial {
    static constexpr bool PERM = true, AFTER_DRAIN = false;
    float* P;
    __device__ __forceinline__ void operator()(const f32x4 (&acc)[2][2][4][2], const Unit&, int wr, int wc, int fr, int fq) const {
        const int tid = (wr * 4 + wc) * 64 + fq * 16 + fr;
#pragma unroll
        for (int ai = 0; ai < 2; ++ai)
#pragma unroll
            for (int bj = 0; bj < 2; ++bj)
#pragma unroll
                for (int m = 0; m < 4; ++m)
#pragma unroll
                    for (int n = 0; n < 2; ++n) *(f32x4*)(P + ((size_t)((((ai * 2 + bj) * 4 + m) * 2 + n) * 512 + tid)) * 4) = acc[ai][bj][m][n];
    }
};
template <bool BASE_F32> __device__ __forceinline__ void resid_fixup(const float* Pu  , int pm, int pn, int ai, int m, const float* base, bf16_t* xb, float* ssq_out, float alpha, int tid) {
    const int wid = tid >> 6, lane = tid & 63, wr = wid >> 2, wc = wid & 3, fr = lane & 15, fq = lane >> 4;
    f32x4 S[2][2], L[8][2][2];
#pragma unroll
    for (int sl = 0; sl < 8; ++sl)
#pragma unroll
        for (int bj = 0; bj < 2; ++bj)
#pragma unroll
            for (int n = 0; n < 2; ++n) L[sl][bj][n] = *(const f32x4*)(Pu + ((size_t)((sl * 32 + ((ai * 2 + bj) * 4 + m) * 2 + n) * 512 + tid)) * 4);
    __builtin_amdgcn_sched_barrier(0);
#pragma unroll
    for (int bj = 0; bj < 2; ++bj)
#pragma unroll
        for (int n = 0; n < 2; ++n) { S[bj][n] = L[0][bj][n];
#pragma unroll
            for (int sl = 1; sl < 8; ++sl) S[bj][n] += L[sl][bj][n]; }
    const int row = pm * BM + wr * 64 + fr + ai * HALF + m * 16, col0 = pn * BM + wc * 32 + 8 * fq; const size_t off = (size_t)row * DM + col0; float ss = 0.f;
#pragma unroll
    for (int bj = 0; bj < 2; ++bj) {
        f32x4 b0, b1;
        if (BASE_F32) { b0 = *(const f32x4*)(base + off + bj * HALF); b1 = *(const f32x4*)(base + off + bj * HALF + 4); }
        else { const u32x4 w = *(const u32x4*)(xb + off + bj * HALF);
            b0 = (f32x4){__uint_as_float(w.x << 16), __uint_as_float(w.x & 0xffff0000u), __uint_as_float(w.y << 16), __uint_as_float(w.y & 0xffff0000u)};
            b1 = (f32x4){__uint_as_float(w.z << 16), __uint_as_float(w.z & 0xffff0000u), __uint_as_float(w.w << 16), __uint_as_float(w.w & 0xffff0000u)}; }
        const f32x4 o0 = b0 + S[bj][0] * alpha, o1 = b1 + S[bj][1] * alpha;
        u32x4 w2; w2.x = cvtpk(o0[0], o0[1]); w2.y = cvtpk(o0[2], o0[3]); w2.z = cvtpk(o1[0], o1[1]); w2.w = cvtpk(o1[2], o1[3]);
        *(u32x4*)(xb + off + bj * HALF) = w2;
        ss += (o0[0] * o0[0] + o0[1] * o0[1]) + (o0[2] * o0[2] + o0[3] * o0[3]) + (o1[0] * o1[0] + o1[1] * o1[1]) + (o1[2] * o1[2] + o1[3] * o1[3]);
    }
    ss += __shfl_xor(ss, 16); ss += __shfl_xor(ss, 32);
    if (fq == 0) ssq_out[(size_t)row * 16 + pn * 4 + wc] = ss;
}
struct EpiScaleBf16 {
    static constexpr bool PERM = true, AFTER_DRAIN = false;
    bf16_t* O; int ldc; const float* ssq_in; int np_in; float inv_dim; float* ssq_out;
    __device__ __forceinline__ void operator()(const f32x4 (&acc)[2][2][4][2], const Unit& u, int wr, int wc, int fr, int fq) const {
        const int row0 = u.pm * BM + wr * 64 + fr, col0 = u.pn * BM + wc * 32 + 8 * fq;
        const bool do_ssq = (ssq_out != nullptr) && (u.pn == 0);
#pragma unroll
        for (int ai = 0; ai < 2; ++ai)
#pragma unroll
            for (int m = 0; m < 4; ++m) {
                const int row = row0 + ai * HALF + m * 16;
                const float rs = 1.0f / sqrtf((np_in == 16 ? ssq_sum16(ssq_in, row) : ssq_sum4(ssq_in, row)) * inv_dim + EPS); float ss = 0.f;
                bf16_t* rowp = O + (size_t)row * ldc + col0;
#pragma unroll
                for (int bj = 0; bj < 2; ++bj) {
                    const f32x4 v0 = acc[ai][bj][m][0] * rs, v1 = acc[ai][bj][m][1] * rs;
                    u32x4 w; w.x = cvtpk(v0[0], v0[1]); w.y = cvtpk(v0[2], v0[3]); w.z = cvtpk(v1[0], v1[1]); w.w = cvtpk(v1[2], v1[3]);
                    *(u32x4*)(rowp + bj * HALF) = w;
                    ss += (v0[0] * v0[0] + v0[1] * v0[1]) + (v0[2] * v0[2] + v0[3] * v0[3]) + (v1[0] * v1[0] + v1[1] * v1[1]) + (v1[2] * v1[2] + v1[3] * v1[3]);
                }
                if (do_ssq) { ss += __shfl_xor(ss, 16); ss += __shfl_xor(ss, 32); if (fq == 0) ssq_out[(size_t)row * 4 + wc] = ss; }
            }
    }
};


struct EpiInFused {
    static constexpr bool PERM = true, AFTER_DRAIN = false;
    unsigned char* ws; float* out; int layer;
    __device__ __forceinline__ void operator()(const f32x4 (&acc)[2][2][4][2], const Unit& u, int wr, int wc, int fr_, int fq_) const {
        int fr = fr_, fq = fq_; asm volatile("" : "+v"(fr), "+v"(fq));
        const int row0 = u.pm * BM + wr * 64 + fr, c0 = wc * 32 + 8 * fq, pn = u.pn;
        float* const SSQP_ = (float*)(ws + WS_SSQP);
        const float* ssq_in = SSQP_ + (size_t)(3 + layer) * M * 16; float* ssq_cq = SSQP_ + (size_t)7 * M * 16 + (size_t)layer * M * 4; float* ssq_kv = SSQP_ + (size_t)7 * M * 16 + (size_t)(2 + layer) * M * 4;
        bf16_t* const CQ = (bf16_t*)(ws + WS_REGA + (size_t)300 * MiB); bf16_t* const CKV = (bf16_t*)(ws + WS_REGA + (size_t)340 * MiB);
        bf16_t* const QB = (bf16_t*)(ws + WS_QB); bf16_t* const QI = (bf16_t*)(ws + WS_QI); bf16_t* const QC = (bf16_t*)(ws + WS_QC); bf16_t* const QD = (bf16_t*)(ws + WS_QD);
        bf16_t* const RA = (bf16_t*)(ws + WS_RA); bf16_t* const RB = (bf16_t*)(ws + WS_RB); bf16_t* const RC = (bf16_t*)(ws + WS_RC); bf16_t* const RD = (bf16_t*)(ws + WS_RD);
        float* const WI = (float*)(ws + WS_WI); const float2* const R64 = (const float2*)(ws + WS_MISC + MISC_ROPE64); const float2* const R32 = (const float2*)(ws + WS_MISC + MISC_ROPE32);
        bf16_t* const HBdbg = SELFCHECK ? (bf16_t*)(ws + WS_REGA) : nullptr;
        const float scaleB = 0.125f * LOG2E, scaleD = 0.17677669529663687f * LOG2E, scaleC = 0.125f * LOG2E;
#define EPK8(f) ((u32x4){cvtpk(f[0], f[1]), cvtpk(f[2], f[3]), cvtpk(f[4], f[5]), cvtpk(f[6], f[7])})
#define EST8F(p, f) do { *(f32x4*)(p) = (f32x4){f[0], f[1], f[2], f[3]}; *(f32x4*)((p) + 4) = (f32x4){f[4], f[5], f[6], f[7]}; } while (0)
#pragma unroll
        for (int ai = 0; ai < 2; ++ai)
#pragma unroll
            for (int m = 0; m < 4; ++m) {
                const int row = row0 + ai * HALF + m * 16;
                const float rs = 1.0f / sqrtf(ssq_sum16(ssq_in, row) * (1.0f / 1024.0f) + EPS);
                float v0[8], v1[8];
#pragma unroll
                for (int e = 0; e < 4; ++e) { v0[e] = acc[ai][0][m][0][e] * rs; v0[4 + e] = acc[ai][0][m][1][e] * rs; v1[e] = acc[ai][1][m][0][e] * rs; v1[4 + e] = acc[ai][1][m][1][e] * rs; }
                if (HBdbg) { *(u32x4*)(HBdbg + (size_t)row * NINP + pn * 256 + c0) = EPK8(v0); *(u32x4*)(HBdbg + (size_t)row * NINP + pn * 256 + 128 + c0) = EPK8(v1); }
                const bool smp = row >= MP; const int rr = smp ? row - MP : row; const int pidx = smp ? 2048 + (rr & 63) : (rr & 2047);
                if (pn == 0) {
                    *(u32x4*)(CQ + (size_t)row * 256 + c0) = EPK8(v0); *(u32x4*)(CQ + (size_t)row * 256 + 128 + c0) = EPK8(v1);
                    float ss = 0.f;
#pragma unroll
                    for (int e = 0; e < 8; ++e) ss += v0[e] * v0[e] + v1[e] * v1[e];
                    ss += __shfl_xor(ss, 16); ss += __shfl_xor(ss, 32); if (fq == 0) ssq_cq[(size_t)row * 4 + wc] = ss;
                } else if (pn <= 6 && pn != 4) {
                    const bool d32 = pn >= 5; const int i0 = d32 ? 8 * (fq & 1) : 8 * fq;
                    const f32x4* cp = (const f32x4*)(d32 ? R32 + pidx * 16 + i0 : R64 + pidx * 32 + i0);
                    float a[8], b[8];
#pragma unroll
                    for (int e2 = 0; e2 < 4; ++e2) { const f32x4 cs = cp[e2];
                        a[2 * e2] = v0[2 * e2] * cs[0] - v1[2 * e2] * cs[1]; b[2 * e2] = v1[2 * e2] * cs[0] + v0[2 * e2] * cs[1];
                        a[2 * e2 + 1] = v0[2 * e2 + 1] * cs[2] - v1[2 * e2 + 1] * cs[3]; b[2 * e2 + 1] = v1[2 * e2 + 1] * cs[2] + v0[2 * e2 + 1] * cs[3]; }
                    if (pn == 1) {
#pragma unroll
                        for (int e = 0; e < 8; ++e) { a[e] *= scaleB; b[e] *= scaleB; }
                        bf16_t* d = QB + (size_t)row * 256 + wc * 64 + 8 * fq; *(u32x4*)d = EPK8(a); *(u32x4*)(d + 32) = EPK8(b);
                    } else if (pn <= 3) { bf16_t* d = QI + (size_t)row * 512 + (4 * (pn - 2) + wc) * 64 + 8 * fq; *(u32x4*)d = EPK8(a); *(u32x4*)(d + 32) = EPK8(b);
                    } else { const int blk = 2 * wc + (fq >> 1);
                        if (pn == 5) {
#pragma unroll
                            for (int e = 0; e < 8; ++e) { a[e] *= scaleD; b[e] *= scaleD; }
                            bf16_t* d = QD + (size_t)row * 256 + blk * 32 + i0; *(u32x4*)d = EPK8(a); *(u32x4*)(d + 16) = EPK8(b);
                        } else { const int oc = (blk >> 1) * 128 + (blk & 1) * 32 + i0;
                            float* od = out + (smp ? O_DIFF_S + ((size_t)layer * MS + rr) * 512 : O_DIFF_P + ((size_t)layer * MP + rr) * 512) + oc;
                            EST8F(od, a); EST8F(od + 16, b); bf16_t* d = RD + (size_t)row * 512 + oc; *(u32x4*)d = EPK8(a); *(u32x4*)(d + 16) = EPK8(b); } }
                } else if (pn == 4) {
                    if (wc < 2 || (wc == 2 && fq < 2)) {
                        const bool d32 = wc == 2; const f32x4* cp = (const f32x4*)(d32 ? R32 + pidx * 16 + 8 * fq : R64 + pidx * 32 + 8 * fq);
                        float a[8], b[8];
#pragma unroll
                        for (int e2 = 0; e2 < 4; ++e2) { const f32x4 cs = cp[e2];
                            a[2 * e2] = v0[2 * e2] * cs[0] - v1[2 * e2] * cs[1]; b[2 * e2] = v1[2 * e2] * cs[0] + v0[2 * e2] * cs[1];
                            a[2 * e2 + 1] = v0[2 * e2 + 1] * cs[2] - v1[2 * e2 + 1] * cs[3]; b[2 * e2 + 1] = v1[2 * e2 + 1] * cs[2] + v0[2 * e2 + 1] * cs[3]; }
                        if (!d32) { const int oc = (wc == 0 ? 0 : 128) + 8 * fq;
                            float* od = out + (smp ? O_DSA_S + ((size_t)layer * MS + rr) * 192 : O_DSA_P + ((size_t)layer * MP + rr) * 192) + oc;
                            EST8F(od, a); EST8F(od + 32, b); bf16_t* d = RB + (size_t)row * 192 + oc; *(u32x4*)d = EPK8(a); *(u32x4*)(d + 32) = EPK8(b);
                        } else { const int oc = 128 + 8 * fq;
                            float* od = out + (smp ? O_MLA_S + ((size_t)layer * MS + rr) * 160 : O_MLA_P + ((size_t)layer * MP + rr) * 160) + oc;
                            EST8F(od, a); EST8F(od + 16, b); bf16_t* d = RA + (size_t)row * 160 + oc; *(u32x4*)d = EPK8(a); *(u32x4*)(d + 16) = EPK8(b); } }
                } else if (pn == 7) {
                    *(u32x4*)(CKV + (size_t)row * 128 + c0) = EPK8(v0);
                    float ss = 0.f;
#pragma unroll
                    for (int e = 0; e < 8; ++e) ss += v0[e] * v0[e];
                    ss += __shfl_xor(ss, 16); ss += __shfl_xor(ss, 32); if (fq == 0) ssq_kv[(size_t)row * 4 + wc] = ss;
                    if (wc < 2) { const int oc = 64 + c0; float* od = out + (smp ? O_DSA_S + ((size_t)layer * MS + rr) * 192 : O_DSA_P + ((size_t)layer * MP + rr) * 192) + oc;
                        EST8F(od, v1); *(u32x4*)(RB + (size_t)row * 192 + oc) = EPK8(v1); }
                    else if (wc == 2 && fq == 0) { float w8[8];
#pragma unroll
                        for (int e = 0; e < 8; ++e) w8[e] = v1[e] * 0.35355339059327373f;
                        EST8F(WI + (size_t)row * 8, w8); }
                } else if (pn == 8) {
                    float a[8], b[8];
#pragma unroll
                    for (int e = 0; e < 8; ++e) { a[e] = v0[e] * scaleC; b[e] = v1[e] * scaleC; }
                    *(u32x4*)(QC + (size_t)row * 256 + c0) = EPK8(a); *(u32x4*)(QC + (size_t)row * 256 + 128 + c0) = EPK8(b);
                } else {
                    const int h0 = wc >> 1, d0 = 32 * (wc & 1) + 8 * fq;
                    const int voff = (pn == 9) ? 0 : 64;
                    if (pn == 11) { float* od = out + (smp ? O_DIFF_S + ((size_t)layer * MS + rr) * 512 : O_DIFF_P + ((size_t)layer * MP + rr) * 512);
                        EST8F(od + h0 * 128 + voff + d0, v0); EST8F(od + (h0 + 2) * 128 + voff + d0, v1);
                        *(u32x4*)(RD + (size_t)row * 512 + h0 * 128 + voff + d0) = EPK8(v0); *(u32x4*)(RD + (size_t)row * 512 + (h0 + 2) * 128 + voff + d0) = EPK8(v1);
                    } else { float* od = out + (smp ? O_SB_S + ((size_t)layer * MS + rr) * 512 : O_SB_P + ((size_t)layer * MP + rr) * 512);
                        EST8F(od + h0 * 128 + voff + d0, v0); EST8F(od + (h0 + 2) * 128 + voff + d0, v1);
                        *(u32x4*)(RC + (size_t)row * 512 + h0 * 128 + voff + d0) = EPK8(v0); *(u32x4*)(RC + (size_t)row * 512 + (h0 + 2) * 128 + voff + d0) = EPK8(v1); }
                }
                asm volatile("" ::: "memory");
            }
#undef EPK8
#undef EST8F
    }
};

template <class Epi, class Sched, bool ALIGN_EPI = false, bool SP2 = false>
__device__ __forceinline__ void gemm_phase(PG8_LAS unsigned char* lds, const Gemm g, const Sched& S, const Epi& E, const int wave0) {
    const int tid_ = wave0 * 64 + fresh_lane();
    const int tid = tid_, wid = __builtin_amdgcn_readfirstlane(tid >> 6), lane = tid & 63, wr = wid >> 2, wc = wid & 3, fr = lane & 15, fq = lane >> 4;
    const int K = g.K, nt = K / BK, lda = g.lda, ldb = g.ldb ? g.ldb : g.K;
    unsigned voffA[2], voffB[2];
#pragma unroll
    for (int i = 0; i < 2; ++i) { int R, C; stage_rc(tid * 16 + i * 8192, R, C); const int Rb = Epi::PERM ? ((R & ~31) + perm32(R & 31)) : R;
        voffA[i] = (unsigned)(R * lda + C) * 2u; voffB[i] = (unsigned)(Rb * ldb + C) * 2u; }
    const size_t kstep = (size_t)(BK * 2);
    const size_t hstepA = (size_t)HALF * lda * 2, hstepB = (size_t)HALF * ldb * 2;
    const size_t tstepA = 2 * hstepA, tstepB = 2 * hstepB;
    const unsigned ldsw = (unsigned)wid * 1024u;
    const int aoff = lds_byte(wr * 64 + fr, fq * 8), boff = lds_byte(wc * 32 + fr, fq * 8);
#define PG8_SA(b, h) (((b) * 2 + (h)) * HTB)
#define PG8_SB(b, h) ((4 + (b) * 2 + (h)) * HTB)
#define PG8_STAGE(bufoff, gbase, voff) do { _Pragma("unroll") for (int _i = 0; _i < 2; ++_i) \
        __builtin_amdgcn_global_load_lds((const unsigned*)((const char*)(gbase) + (voff)[_i]), (PG8_LAS unsigned*)(lds + (bufoff) + ldsw + _i * 8192), 16, 0, 0); } while (0)
#define PG8_LDA(dst, b, h) do { _Pragma("unroll") for (int m = 0; m < 4; ++m) _Pragma("unroll") for (int k = 0; k < 2; ++k) dst[m][k] = *(const PG8_LAS bf16x8*)(lds + PG8_SA(b, h) + aoff + m * 2048 + k * 1024); } while (0)
#define PG8_LDB(dst, b, h) do { _Pragma("unroll") for (int n = 0; n < 2; ++n) _Pragma("unroll") for (int k = 0; k < 2; ++k) dst[n][k] = *(const PG8_LAS bf16x8*)(lds + PG8_SB(b, h) + boff + n * 2048 + k * 1024); } while (0)
#define PG8_MMA(ai, bj, At, Bt) do { __builtin_amdgcn_s_setprio(1); _Pragma("unroll") for (int m = 0; m < 4; ++m) _Pragma("unroll") for (int n = 0; n < 2; ++n) _Pragma("unroll") for (int k = 0; k < 2; ++k) \
        acc[ai][bj][m][n] = __builtin_amdgcn_mfma_f32_16x16x32_bf16(Bt[n][k], At[m][k], acc[ai][bj][m][n], 0, 0, 0); __builtin_amdgcn_s_setprio(0); } while (0)
#define PG8_WAIT_V(n) asm volatile("s_waitcnt vmcnt(" #n ")" ::: "memory")
#define PG8_WAIT_L(n) asm volatile("s_waitcnt lgkmcnt(" #n ")" ::: "memory")
#define PG8_BAR __builtin_amdgcn_s_barrier()
#define PG8_SCHED __builtin_amdgcn_sched_barrier(0)
    Unit cur, nxt; int ui = 0;
    if (!S.next(0, cur)) return;
    f32x4 acc[2][2][4][2];
#pragma unroll
    for (int a = 0; a < 2; ++a)
#pragma unroll
        for (int b = 0; b < 2; ++b)
#pragma unroll
            for (int m = 0; m < 4; ++m)
#pragma unroll
                for (int n = 0; n < 2; ++n) acc[a][b][m][n] = (f32x4){0.f, 0.f, 0.f, 0.f};
    bf16x8 At[4][2], B0[2][2], B1[2][2];
    const char* cA = (const char*)g.A + (size_t)cur.pm * tstepA; const char* cB = (const char*)g.Bt + (size_t)cur.pn * tstepB;
    S.a_ready(cur);
    if constexpr (SP2) {
        PG8_STAGE(PG8_SB(0, 0), cB, voffB); PG8_STAGE(PG8_SB(0, 1), cB + hstepB, voffB); PG8_STAGE(PG8_SA(0, 0), cA, voffA); PG8_STAGE(PG8_SA(0, 1), cA + hstepA, voffA);
        if (wr == 1) PG8_BAR;
        PG8_WAIT_V(2); PG8_BAR;
        PG8_STAGE(PG8_SB(1, 0), cB + kstep, voffB); PG8_STAGE(PG8_SA(1, 0), cA + kstep, voffA); PG8_STAGE(PG8_SB(1, 1), cB + hstepB + kstep, voffB);
        PG8_WAIT_V(6); PG8_BAR;
    } else {
        PG8_STAGE(PG8_SB(0, 0), cB, voffB); PG8_STAGE(PG8_SA(0, 0), cA, voffA); PG8_STAGE(PG8_SB(0, 1), cB + hstepB, voffB); PG8_STAGE(PG8_SA(0, 1), cA + hstepA, voffA);
        if (wr == 1) PG8_BAR;
        PG8_WAIT_V(4); PG8_BAR;
        PG8_STAGE(PG8_SB(1, 0), cB + kstep, voffB); PG8_STAGE(PG8_SA(1, 0), cA + kstep, voffA); PG8_STAGE(PG8_SB(1, 1), cB + hstepB + kstep, voffB);
        PG8_WAIT_V(6); PG8_BAR;
    }
    for (;;) {
        const bool has_next = S.next(ui + 1, nxt);
        const char* nA = has_next ? (const char*)g.A + (size_t)nxt.pm * tstepA : cA; const char* nB = has_next ? (const char*)g.Bt + (size_t)nxt.pn * tstepB : cB;
        for (int t = 0; t < nt; t += 2) {
            const bool last = (t == nt - 2);
            const char* a1 = cA + (size_t)(t + 1) * kstep;
            const char* a2 = last ? nA : cA + (size_t)(t + 2) * kstep; const char* b2 = last ? nB : cB + (size_t)(t + 2) * kstep;
            const char* a3 = a2 + kstep; const char* b3 = b2 + kstep;
            if (last && has_next) S.a_ready(nxt);
            if constexpr (SP2) {
            PG8_LDB(B0, 0, 0); PG8_LDB(B1, 0, 1); PG8_SCHED; PG8_LDA(At, 0, 0); PG8_STAGE(PG8_SA(1, 1), a1 + hstepA, voffA);
            PG8_WAIT_V(8); PG8_WAIT_L(0); PG8_BAR; PG8_MMA(0, 0, At, B0); PG8_MMA(0, 1, At, B1); PG8_BAR; PG8_SCHED;
            PG8_LDA(At, 0, 1); PG8_STAGE(PG8_SB(0, 0), b2, voffB); PG8_STAGE(PG8_SB(0, 1), b2 + hstepB, voffB); PG8_STAGE(PG8_SA(0, 0), a2, voffA);
            PG8_WAIT_V(8); PG8_WAIT_L(0); PG8_BAR; PG8_MMA(1, 0, At, B0); PG8_MMA(1, 1, At, B1); PG8_BAR; PG8_SCHED;
            PG8_LDB(B0, 1, 0); PG8_LDB(B1, 1, 1); PG8_SCHED; PG8_LDA(At, 1, 0); PG8_STAGE(PG8_SA(0, 1), a2 + hstepA, voffA);
            PG8_WAIT_V(8); PG8_WAIT_L(0); PG8_BAR; PG8_MMA(0, 0, At, B0); PG8_MMA(0, 1, At, B1); PG8_BAR; PG8_SCHED;
            PG8_LDA(At, 1, 1); PG8_STAGE(PG8_SB(1, 0), b3, voffB); PG8_STAGE(PG8_SB(1, 1), b3 + hstepB, voffB); PG8_STAGE(PG8_SA(1, 0), a3, voffA);
            PG8_WAIT_V(8); PG8_WAIT_L(0); PG8_BAR; PG8_MMA(1, 0, At, B0); PG8_MMA(1, 1, At, B1); PG8_BAR; PG8_SCHED;
            } else {
            PG8_LDB(B0, 0, 0); PG8_SCHED; PG8_LDA(At, 0, 0); PG8_STAGE(PG8_SA(1, 1), a1 + hstepA, voffA);
            PG8_WAIT_L(8); PG8_BAR; PG8_WAIT_L(0); PG8_MMA(0, 0, At, B0); PG8_BAR; PG8_SCHED;
            PG8_LDB(B1, 0, 1); PG8_STAGE(PG8_SB(0, 0), b2, voffB);
            PG8_BAR; PG8_WAIT_L(0); PG8_MMA(0, 1, At, B1); PG8_BAR;
            PG8_LDA(At, 0, 1); PG8_STAGE(PG8_SA(0, 0), a2, voffA);
            PG8_BAR; PG8_WAIT_L(0); PG8_MMA(1, 0, At, B0); PG8_BAR; PG8_SCHED;
            PG8_STAGE(PG8_SB(0, 1), b2 + hstepB, voffB);
            PG8_WAIT_V(6); PG8_BAR; PG8_MMA(1, 1, At, B1); PG8_BAR;
            PG8_LDB(B0, 1, 0); PG8_SCHED; PG8_LDA(At, 1, 0); PG8_STAGE(PG8_SA(0, 1), a2 + hstepA, voffA);
            PG8_WAIT_L(8); PG8_BAR; PG8_WAIT_L(0); PG8_MMA(0, 0, At, B0); PG8_BAR; PG8_SCHED;
            PG8_LDB(B1, 1, 1); PG8_STAGE(PG8_SB(1, 0), b3, voffB);
            PG8_BAR; PG8_WAIT_L(0); PG8_MMA(0, 1, At, B1); PG8_BAR;
            PG8_LDA(At, 1, 1); PG8_STAGE(PG8_SA(1, 0), a3, voffA);
            PG8_BAR; PG8_WAIT_L(0); PG8_MMA(1, 0, At, B0); PG8_BAR; PG8_SCHED;
            PG8_STAGE(PG8_SB(1, 1), b3 + hstepB, voffB);
            PG8_WAIT_V(6); PG8_BAR; PG8_MMA(1, 1, At, B1); PG8_BAR;
            }
        }
        if constexpr (ALIGN_EPI) { if (wr == 0) PG8_BAR; }
        if constexpr (!Epi::AFTER_DRAIN) { E(acc, cur, wr, wc, fr, fq); S.done(cur); }
        if (!has_next) break;
#pragma unroll
        for (int a = 0; a < 2; ++a)
#pragma unroll
            for (int b = 0; b < 2; ++b)
#pragma unroll
                for (int m = 0; m < 4; ++m)
#pragma unroll
                    for (int n = 0; n < 2; ++n) acc[a][b][m][n] = (f32x4){0.f, 0.f, 0.f, 0.f};
        cur = nxt; cA = nA; cB = nB; ++ui;
        if constexpr (ALIGN_EPI) { if (wr == 1) PG8_BAR; }
    }
    PG8_WAIT_V(0);
    if constexpr (!ALIGN_EPI) { if (wr == 0) PG8_BAR; }
    PG8_BAR;
#undef PG8_SA
#undef PG8_SB
#undef PG8_STAGE
#undef PG8_LDA
#undef PG8_LDB
#undef PG8_MMA
#undef PG8_WAIT_V
#undef PG8_WAIT_L
#undef PG8_BAR
#undef PG8_SCHED
}
}

#define XB_TMO      128
#define XB_XCNT(j)  (256  + 64 * (j))
#define XB_XSUB(j)  (1280 + 64 * (j))
#define XB_XGEN(j)  (2304 + 64 * (j))
#define XB_TOP      3328
#define XB_TOPGEN   3392
#define XCD_BAR_WORDS 3456
#define XB_SPIN_CAP (1u << 18)
__device__ __forceinline__ unsigned xb_ld(unsigned* p)              { return __hip_atomic_load(p, __ATOMIC_RELAXED, __HIP_MEMORY_SCOPE_AGENT); }
__device__ __forceinline__ unsigned xb_add(unsigned* p, unsigned v) { return __hip_atomic_fetch_add(p, v, __ATOMIC_RELAXED, __HIP_MEMORY_SCOPE_AGENT); }
__device__ __forceinline__ unsigned xb_xcc_id() { return (unsigned)__builtin_amdgcn_s_getreg((3 << 11) | 20) & 0xFu; }
#define XB_SPIN(cond, bar) do { unsigned _sp = 0; while (cond) { __builtin_amdgcn_s_sleep(1); \
    if ((++_sp & 255u) == 0u) { if (xb_ld(&(bar)[XB_TMO])) break; if (_sp > XB_SPIN_CAP) { atomicAdd(&(bar)[XB_TMO], 1u); break; } } } } while (0)
struct XcdBarrier { unsigned* bar; unsigned x; volatile LAS unsigned* st; int wave0; };
__device__ __forceinline__ XcdBarrier xcd_barrier_post(unsigned* bar, volatile LAS unsigned* st, int wave0) {
    XcdBarrier b; b.bar = bar; b.x = xb_xcc_id(); b.st = st; b.wave0 = wave0;
    if (wave0 == 0 && fresh_lane() == 0) (void)xb_add(&bar[XB_XCNT(b.x)], 1u);
    return b;
}
__device__ __forceinline__ void xcd_barrier_complete(unsigned* bar, unsigned x, unsigned& nloc, unsigned& nx) {
    const unsigned G = gridDim.x * gridDim.y * gridDim.z;
    unsigned sum, cnt, mine, sp = 0u;
    for (;;) {
        sum = 0u; cnt = 0u; mine = 0u;
#pragma unroll
        for (unsigned j = 0; j < 16; ++j) { const unsigned c = xb_ld(&bar[XB_XCNT(j)]); sum += c; cnt += (c > 0u) ? 1u : 0u; mine = (j == x) ? c : mine; }
        if (sum == G) break;
        __builtin_amdgcn_s_sleep(1);
        if ((++sp & 255u) == 0u) { if (xb_ld(&bar[XB_TMO])) break; if (sp > XB_SPIN_CAP) { atomicAdd(&bar[XB_TMO], 1u); break; } }
    }
    nloc = mine > 0u ? mine : 1u; nx = cnt > 0u ? cnt : 1u;
}
__device__ __forceinline__ void xcd_barrier(const XcdBarrier& b) {
    asm volatile("s_waitcnt vmcnt(0)" ::: "memory");
    __syncthreads();
    if (b.wave0 == 0 && fresh_lane() == 0) {
        unsigned* bar = b.bar;
        __builtin_amdgcn_s_waitcnt(0);
        unsigned nloc = b.st[0], nx = b.st[1];
        if (nloc == 0u) { xcd_barrier_complete(bar, b.x, nloc, nx); b.st[0] = nloc; b.st[1] = nx; }
        const unsigned old = xb_add(&bar[XB_XSUB(b.x)], 1u);
        const unsigned gen = old / nloc;
        if (old + 1u == (gen + 1u) * nloc) {
            __builtin_amdgcn_fence(__ATOMIC_RELEASE, "agent");
            asm volatile("s_waitcnt vmcnt(0)" ::: "memory");
            const unsigned og = xb_add(&bar[XB_TOP], 1u);
            const unsigned tg = og / nx;
            if (og + 1u == (tg + 1u) * nx) xb_add(&bar[XB_TOPGEN], 1u);
            else XB_SPIN(xb_ld(&bar[XB_TOPGEN]) == tg, bar);
            __builtin_amdgcn_fence(__ATOMIC_ACQUIRE, "agent");
            xb_add(&bar[XB_XGEN(b.x)], 1u);
            asm volatile("s_waitcnt vmcnt(0)" ::: "memory");
        } else {
            XB_SPIN(xb_ld(&bar[XB_XGEN(b.x)]) == gen, bar);
            __builtin_amdgcn_fence(__ATOMIC_ACQUIRE, "agent");
            asm volatile("s_waitcnt vmcnt(0)" ::: "memory");
        }
    }
    __syncthreads();
}

struct Args { const float* in[24]; float* out; unsigned char* ws; float freq64[32]; float freq32[16]; int ph_lo, ph_hi; };
enum { I_XP = 0, I_XS, I_CMLA, I_CDSA, I_CSB, I_CDIFF, I_N1, I_G1, I_U1, I_D1, I_NM, I_WIN, I_QN, I_WQB, I_KVN, I_WKVB, I_LAM, I_DN, I_WO, I_N2, I_G2, I_U2, I_D2, I_FN };

__host__ __device__ __forceinline__ int mycol(int j) {
    if (j < 256) return j;
    if (j < 384) return 7 * 256 + (j - 256);
    if (j < 416) { const int t = j - 384; return 4 * 256 + (t >> 4) * 128 + 64 + (t & 15); }
    if (j < 672) { const int t = j - 416; return 1 * 256 + ((t >> 5) & 1) * 128 + (t >> 6) * 32 + (t & 31); }
    if (j < 736) { const int t = j - 672; return 4 * 256 + (t >> 5) * 128 + (t & 31); }
    if (j < 800) return 7 * 256 + 128 + (j - 736);
    if (j < 1312) { const int t = j - 800, h8 = t >> 6; return (2 + (h8 >> 2)) * 256 + ((t >> 5) & 1) * 128 + (h8 & 3) * 32 + (t & 31); }
    if (j < 1376) { const int t = j - 1312; return 4 * 256 + (t >> 5) * 128 + 32 + (t & 31); }
    if (j < 1384) return 7 * 256 + 128 + 64 + (j - 1376);
    if (j < 1640) return 8 * 256 + (j - 1384);
    if (j < 1896) return 9 * 256 + (j - 1640);
    if (j < 2152) return 10 * 256 + (j - 1896);
    if (j < 2408) { const int t = j - 2152; return 5 * 256 + ((t >> 4) & 1) * 128 + (t >> 5) * 16 + (t & 15); }
    if (j < 2664) { const int t = j - 2408; return 6 * 256 + ((t >> 4) & 1) * 128 + (t >> 5) * 16 + (t & 15); }
    return 11 * 256 + (j - 2664);
}
__host__ __device__ __forceinline__ bool mycol_is_pad(int np) { const int t = np >> 8, c = np & 127, hf = (np >> 7) & 1; return (t == 4 && c >= 80) || (t == 7 && hf == 1 && c >= 72); }
typedef __attribute__((address_space(4))) const char* kaptr_t;
__device__ __forceinline__ kaptr_t kargs() { kaptr_t p = (kaptr_t)__builtin_amdgcn_kernarg_segment_ptr(); asm volatile("" : "+s"(p)); return p; }
typedef const float* cfp_t; typedef float* fp_t; typedef unsigned char* ucp_t;
typedef __attribute__((address_space(4))) const cfp_t* ka_cfp_t; typedef __attribute__((address_space(4))) const fp_t* ka_fp_t; typedef __attribute__((address_space(4))) const ucp_t* ka_ucp_t;
typedef __attribute__((address_space(4))) const float* ka_f_t; typedef __attribute__((address_space(4))) const int* ka_i_t;
#define GLB __attribute__((address_space(1)))
#define ARG_IN(i) ((const float*)(GLB const float*)(*(ka_cfp_t)(kargs() + 8 * (i))))
#define ARG_OUT (*(ka_fp_t)(kargs() + 192))
#define ARG_WS (*(ka_ucp_t)(kargs() + 200))
#define ARG_FREQ64(j) (((ka_f_t)(kargs() + 208))[j])
#define ARG_FREQ32(j) (((ka_f_t)(kargs() + 336))[j])
#define ARG_PH_LO (*(ka_i_t)(kargs() + 400))
#define ARG_PH_HI (*(ka_i_t)(kargs() + 404))
static_assert(sizeof(Args) == 408, "kernarg offsets above follow struct Args");
template <int MAP> __device__ __forceinline__ int rowmap(int n) {
    if (MAP == 1) return (n >> 7) * 256 + (n & 127);
    if (MAP == 2) return (n >> 7) * 256 + 128 + (n & 127);
    if (MAP == 3) return FUSE_POST ? mycol(n) : (n < 1376 ? n : (n < 1384 ? H_WI + (n - 1376) : n - 8));
    return n;
}
template <int MAP> __device__ __forceinline__ void transpose_item(const float* W, int K, int N, const float* g, bf16* dst, int ldd, int koff, LAS float* scr, int item, int lane) {
    const int nblk = (N + 31) / 32, kb = item / nblk, nb = item % nblk, k0 = 64 * kb, n0 = 32 * nb;
    const int nn = n0 + (lane & 31); const bool nok = nn < N;
    float tv[32];
#pragma unroll
    for (int i = 0; i < 32; ++i) { const int kk = 2 * i + (lane >> 5); tv[i] = nok ? W[(size_t)(k0 + kk) * N + nn] : 0.f; }
#pragma unroll
    for (int i = 0; i < 32; ++i) { const int kk = 2 * i + (lane >> 5); float v = tv[i]; if (g) v *= g[k0 + kk]; scr[kk * 33 + (lane & 31)] = v; }
    LDS_WAIT(); asm volatile("" ::: "memory");
    const int c = lane & 7;
#pragma unroll
    for (int j = 0; j < 4; ++j) { const int n = (lane >> 3) + 8 * j; const LAS float* s = scr + (8 * c) * 33 + n;
        v4u o; o.x = pk2(s[0 * 33], s[1 * 33]); o.y = pk2(s[2 * 33], s[3 * 33]); o.z = pk2(s[4 * 33], s[5 * 33]); o.w = pk2(s[6 * 33], s[7 * 33]);
        if (n0 + n < N) *(v4u*)(dst + (size_t)rowmap<MAP>(n0 + n) * ldd + koff + k0 + 8 * c) = o; }
    LDS_WAIT(); asm volatile("" ::: "memory");
}
__device__ __forceinline__ void sincos_acc(float ang, float& sn, float& cs) {
    const double a = (double)ang; const double k = rint(a * 0.15915494309189533577); const double x = fma(-k, 6.283185307179586476925, a); const double x2 = x * x;
    double s = 1.0, c = 1.0;
#pragma unroll
    for (int n = 14; n >= 1; --n) { s = 1.0 - x2 * (1.0 / (double)((2 * n) * (2 * n + 1))) * s; c = 1.0 - x2 * (1.0 / (double)((2 * n - 1) * (2 * n))) * c; }
    sn = (float)(x * s); cs = (float)c;
}

#define MFMA32(a, b, c) __builtin_amdgcn_mfma_f32_32x32x16_bf16((a), (b), (c), 0, 0, 0)
__device__ __forceinline__ f32x16 zero16() { f32x16 z;
#pragma unroll
    for (int i = 0; i < 16; ++i) z[i] = 0.f; return z; }
__device__ __forceinline__ s16x4 vtr(const LAS char* p) { return __builtin_bit_cast(s16x4, __builtin_amdgcn_ds_read_tr16_b64_v4i16((LAS s16x4*)p)); }
template <int BASE> __device__ __forceinline__ bf16x8 pack8(const f32x16& p) {
    v4u w; w.x = cvtpk(p[BASE], p[BASE + 1]); w.y = cvtpk(p[BASE + 2], p[BASE + 3]); w.z = cvtpk(p[BASE + 4], p[BASE + 5]); w.w = cvtpk(p[BASE + 6], p[BASE + 7]);
    return __builtin_bit_cast(bf16x8, w);
}
template <int NS> __device__ __forceinline__ void qk(f32x16& p0, f32x16& p1, const LAS char* kb, int strideB, const bf16x8 (&q)[NS]) {
    p0 = zero16(); p1 = zero16();
#pragma unroll
    for (int s = 0; s < NS; ++s) {
        const bf16x8 a0 = *(const LAS bf16x8*)(kb + s * 32);
        const bf16x8 a1 = *(const LAS bf16x8*)(kb + 32 * strideB + s * 32);
        p0 = MFMA32(a0, q[s], p0); p1 = MFMA32(a1, q[s], p1);
    }
}
template <int NDB> __device__ __forceinline__ void pv(f32x16 (&o)[NDB], const f32x16& p0, const f32x16& p1, const LAS char* vb, int strideB) {
    const bf16x8 pb0 = pack8<0>(p0), pb1 = pack8<8>(p0), pb2 = pack8<0>(p1), pb3 = pack8<8>(p1);
#pragma unroll
    for (int kk = 0; kk < 4; ++kk) {
        const bf16x8 pb = kk == 0 ? pb0 : (kk == 1 ? pb1 : (kk == 2 ? pb2 : pb3));
#pragma unroll
        for (int db = 0; db < NDB; ++db) {
            const s16x4 lo = vtr(vb + (16 * kk) * strideB + db * 64);
            const s16x4 hh = vtr(vb + (16 * kk + 8) * strideB + db * 64);
            const bf16x8 a = __builtin_shufflevector(lo, hh, 0, 1, 2, 3, 4, 5, 6, 7);
            o[db] = MFMA32(a, pb, o[db]);
        }
    }
}
template <int NS> __device__ __forceinline__ void k_ld(bf16x8 (&k)[2 * NS], const LAS char* kb, int strideB) {
#pragma unroll
    for (int s = 0; s < NS; ++s) { k[2 * s] = *(const LAS bf16x8*)(kb + s * 32); k[2 * s + 1] = *(const LAS bf16x8*)(kb + 32 * strideB + s * 32); }
}
template <int NS> __device__ __forceinline__ void qk_r(f32x16& p0, f32x16& p1, const bf16x8 (&k)[2 * NS], const bf16x8 (&q)[NS]) {
    p0 = zero16(); p1 = zero16();
#pragma unroll
    for (int s = 0; s < NS; ++s) { p0 = MFMA32(k[2 * s], q[s], p0); p1 = MFMA32(k[2 * s + 1], q[s], p1); }
}
template <int NDB> __device__ __forceinline__ void v_ld(bf16x8 (&v)[4 * NDB], const LAS char* vb, int strideB) {
#pragma unroll
    for (int kk = 0; kk < 4; ++kk)
#pragma unroll
        for (int db = 0; db < NDB; ++db) {
            const s16x4 lo = vtr(vb + (16 * kk) * strideB + db * 64);
            const s16x4 hh = vtr(vb + (16 * kk + 8) * strideB + db * 64);
            v[kk * NDB + db] = __builtin_shufflevector(lo, hh, 0, 1, 2, 3, 4, 5, 6, 7);
        }
}
template <int NDB> __device__ __forceinline__ void pv_r(f32x16 (&o)[NDB], const f32x16& p0, const f32x16& p1, const bf16x8 (&v)[4 * NDB]) {
    const bf16x8 pb0 = pack8<0>(p0), pb1 = pack8<8>(p0), pb2 = pack8<0>(p1), pb3 = pack8<8>(p1);
#pragma unroll
    for (int kk = 0; kk < 4; ++kk) {
        const bf16x8 pb = kk == 0 ? pb0 : (kk == 1 ? pb1 : (kk == 2 ? pb2 : pb3));
#pragma unroll
        for (int db = 0; db < NDB; ++db) o[db] = MFMA32(v[kk * NDB + db], pb, o[db]);
    }
}
template <int NDB> __device__ __forceinline__ void softmax_step(f32x16& p0, f32x16& p1, float& m, float& l, f32x16 (&o)[NDB]) {
    float mx = p0[0];
#pragma unroll
    for (int r = 1; r < 16; ++r) mx = fmaxf(mx, p0[r]);
#pragma unroll
    for (int r = 0; r < 16; ++r) mx = fmaxf(mx, p1[r]);
    { const unsigned ux_ = __float_as_uint(mx); const auto sw_ = __builtin_amdgcn_permlane32_swap(ux_, ux_, false, false);
      mx = fmaxf(__uint_as_float(sw_[0]), __uint_as_float(sw_[1])); }
    const float mn = fmaxf(m, mx);
    if (__any(mn > m)) {
        const float alpha = __builtin_amdgcn_exp2f(m - mn);
        l *= alpha;
#pragma unroll
        for (int db = 0; db < NDB; ++db)
#pragma unroll
            for (int r = 0; r < 16; ++r) o[db][r] *= alpha;
    }
    m = mn;
    typedef float f32x2_t __attribute__((ext_vector_type(2)));
    const f32x2_t mn2 = {mn, mn}; f32x2_t s2 = {0.f, 0.f};
#pragma unroll
    for (int r = 0; r < 8; ++r) { f32x2_t d = {p0[2 * r], p0[2 * r + 1]}; d -= mn2; d.x = __builtin_amdgcn_exp2f(d.x); d.y = __builtin_amdgcn_exp2f(d.y); p0[2 * r] = d.x; p0[2 * r + 1] = d.y; s2 += d; }
#pragma unroll
    for (int r = 0; r < 8; ++r) { f32x2_t d = {p1[2 * r], p1[2 * r + 1]}; d -= mn2; d.x = __builtin_amdgcn_exp2f(d.x); d.y = __builtin_amdgcn_exp2f(d.y); p1[2 * r] = d.x; p1[2 * r + 1] = d.y; s2 += d; }
    l += s2.x + s2.y;
}
__device__ __forceinline__ v4u cvt8f(const v4u a, const v4u b) {
    const unsigned a0 = a[0], a1 = a[1], a2 = a[2], a3 = a[3], b0 = b[0], b1 = b[1], b2 = b[2], b3 = b[3]; v4u v;
    v[0] = cvtpk(__uint_as_float(a0), __uint_as_float(a1)); v[1] = cvtpk(__uint_as_float(a2), __uint_as_float(a3));
    v[2] = cvtpk(__uint_as_float(b0), __uint_as_float(b1)); v[3] = cvtpk(__uint_as_float(b2), __uint_as_float(b3)); return v; }
template <int W, int STRIDE, bool F32PF = true, int ROWS = 64> struct TileLd {
    static constexpr int CH = W / 8, RPP = 512 / CH, PER = (ROWS + RPP - 1) / RPP, STRB = (W + 8) * 2;
    int nrows_ = ROWS;
    v4u raw[PER][F32PF ? 2 : 1];
    const char* src_;
    __device__ __forceinline__ void init() { src_ = nullptr;
#pragma unroll
        for (int i = 0; i < PER; ++i) { raw[i][0] = (v4u){0u, 0u, 0u, 0u}; raw[i][F32PF ? 1 : 0] = (v4u){0u, 0u, 0u, 0u}; } }
    __device__ __forceinline__ void issue(const void* src, bool f32, int tid) {
        src_ = (const char*)src;
        if (!F32PF && f32) return;
        const int row0 = tid / CH, cc = tid % CH; const bool act = tid < RPP * CH;
        const unsigned loff = (unsigned)(row0 * STRIDE + cc * 8);
#pragma unroll
        for (int i = 0; i < PER; ++i) {
            if (act && (row0 + i * RPP < nrows_)) {
                if (F32PF && f32) { const GLB v4u* p = (const GLB v4u*)(src_ + (size_t)i * RPP * STRIDE * 4 + (size_t)loff * 4); raw[i][0] = p[0]; raw[i][F32PF ? 1 : 0] = p[1]; }
                else { raw[i][0] = *(const GLB v4u*)(src_ + (size_t)i * RPP * STRIDE * 2 + (size_t)loff * 2); } } }
    }
    __device__ __forceinline__ static v4u cvt8(const v4u a, const v4u b) { return cvt8f(a, b); }
    __device__ __forceinline__ void store(LAS char* tile, bool f32, int tid) {
        const int row0 = tid / CH, cc = tid % CH; const bool act = tid < RPP * CH;
        const unsigned loff = (unsigned)(row0 * STRIDE + cc * 8);
        LAS char* dst = tile + row0 * STRB + cc * 16;
#pragma unroll
        for (int i = 0; i < PER; ++i) {
            if (act && (row0 + i * RPP < nrows_)) { v4u v = raw[i][0];
                if (f32) {
                    if (F32PF) v = cvt8(raw[i][0], raw[i][F32PF ? 1 : 0]);
                    else { const GLB v4u* p = (const GLB v4u*)(src_ + (size_t)i * RPP * STRIDE * 4 + (size_t)loff * 4); v = cvt8(p[0], p[1]); } }
                *(LAS v4u*)(dst + i * RPP * STRB) = v; } }
    }
};
constexpr int T512_STRB = 1040, T512_BYTES = 64 * T512_STRB;
__device__ __forceinline__ void t512_dma(const void* src, LAS char* buf, int wave, int lane) {
#pragma unroll
    for (int j = 0; j < 8; ++j) { const int row = wave * 8 + j;
        __builtin_amdgcn_global_load_lds((const unsigned*)((const char*)src + (size_t)row * 1024 + lane * 16), (LAS unsigned*)(buf + row * T512_STRB), 16, 0, 0); }
}
__device__ __forceinline__ void t512_cvt(const void* src, LAS char* buf, int tid) {
    const int row0 = tid >> 6, cc = tid & 63; const char* p0 = (const char*)src + (size_t)row0 * 2048 + cc * 32; LAS char* d0 = buf + row0 * T512_STRB + cc * 16;
    v4u a[8], b[8];
#pragma unroll
    for (int i = 0; i < 8; ++i) { const GLB v4u* p = (const GLB v4u*)(p0 + (size_t)i * 8 * 2048); a[i] = p[0]; b[i] = p[1]; }
    __builtin_amdgcn_sched_barrier(0);
#pragma unroll
    for (int i = 0; i < 8; ++i) *(LAS v4u*)(d0 + i * 8 * T512_STRB) = cvt8f(a[i], b[i]);
}
__device__ __forceinline__ int crow(int r, int hi) { return (r & 3) + 8 * (r >> 2) + 4 * hi; }

struct UnitId { int sample, b, c, nt, qrow0, krow0; };
constexpr int QLIST = 4 + 4 * 32;
__device__ __forceinline__ UnitId decode_unit(int x, int idx) {
    UnitId u;
    if (idx < 4) { u.sample = 1; u.b = x + 8 * idx; u.c = 0; u.nt = PAST / 64 + 1; u.qrow0 = MP + u.b * DSEQ; u.krow0 = MP + u.b * DSEQ; }
    else { const int j = idx - 4; u.sample = 0; u.c = 31 - (j & 31); u.b = x + 8 * (j >> 5); u.nt = u.c + 1; u.qrow0 = u.b * SEQ + u.c * 64; u.krow0 = u.b * SEQ; }
    return u;
}
constexpr int N_UNITS = NB + NB * (SEQ / 64);

__device__ __forceinline__ const void* tile_src(const UnitId& u, int t, const float* cache_lb  , const bf16* rows, int W, int coloff, bool& f32) {
    if (u.sample && t < PAST / 64) { f32 = true; return cache_lb + (size_t)t * 64 * W + coloff; }
    f32 = false; const int tt = u.sample ? 0 : t;
    return rows + (size_t)(u.krow0 + tt * 64) * W + coloff;
}

template <int NQ> __device__ __forceinline__ void hist_pick(LAS unsigned* hist, int lane, int (&kk)[NQ], int (&bin_out)[NQ], unsigned (&cnt_out)[NQ], const bool (&act)[NQ]) {
    unsigned sl[NQ], incl[NQ];
#pragma unroll
    for (int a = 0; a < NQ; ++a) { sl[a] = 0u;
#pragma unroll
        for (int j = 0; j < 8; ++j) { const v4u c4 = ((LAS v4u*)(hist + a * 2048))[lane * 8 + j]; sl[a] += (c4[0] + c4[1]) + (c4[2] + c4[3]); }
        incl[a] = sl[a]; }
#pragma unroll
    for (int o = 1; o < 64; o <<= 1) {
        unsigned t2[NQ];
#pragma unroll
        for (int a = 0; a < NQ; ++a) t2[a] = (unsigned)__shfl_down((int)incl[a], o);
#pragma unroll
        for (int a = 0; a < NQ; ++a) incl[a] += (lane + o < 64) ? t2[a] : 0u; }
    int hl[NQ]; unsigned above_h[NQ], v[NQ], inc2[NQ];
#pragma unroll
    for (int a = 0; a < NQ; ++a) { const unsigned above_l = incl[a] - sl[a]; const bool hit = (above_l < (unsigned)kk[a]) && ((unsigned)kk[a] <= incl[a]);
        const unsigned long long hb = __ballot(hit); hl[a] = hb ? (int)__builtin_ctzll(hb) : 0; above_h[a] = (unsigned)__builtin_amdgcn_readlane((int)above_l, hl[a]);
        v[a] = (lane < 32) ? hist[a * 2048 + hl[a] * 32 + lane] : 0u; inc2[a] = v[a]; }
#pragma unroll
    for (int o = 1; o < 32; o <<= 1) {
        unsigned t2[NQ];
#pragma unroll
        for (int a = 0; a < NQ; ++a) t2[a] = (unsigned)__shfl_down((int)inc2[a], o);
#pragma unroll
        for (int a = 0; a < NQ; ++a) inc2[a] += (lane + o < 32) ? t2[a] : 0u; }
#pragma unroll
    for (int a = 0; a < NQ; ++a) { const unsigned above2 = above_h[a] + inc2[a] - v[a];
        const bool hit2 = (lane < 32) && (above2 < (unsigned)kk[a]) && ((unsigned)kk[a] <= above2 + v[a]);
        const unsigned long long hb2 = __ballot(hit2); const int l2 = hb2 ? (int)__builtin_ctzll(hb2) : 0;
        if (act[a]) { bin_out[a] = hl[a] * 32 + l2; kk[a] -= __builtin_amdgcn_readlane((int)above2, l2); cnt_out[a] = (unsigned)__builtin_amdgcn_readlane((int)v[a], l2); } }
}
template <int NI, int NQ, int ES = 1> __device__ __forceinline__ void dsa_select(const float* srow, int nt, LAS unsigned* hist, unsigned long long* mrow, int lane) {
    float xv[NQ][NI]; float lo[NQ], hi[NQ];
#pragma unroll
    for (int a = 0; a < NQ; ++a) { lo[a] = 3e38f; hi[a] = -3e38f; }
    { const int nt_ = opaque_s(nt);
#pragma unroll
    for (int i = 0; i < NI; ++i) {
#pragma unroll
        for (int a = 0; a < NQ; ++a) xv[a][i] = 0.f;
        if (i < nt_) {
#pragma unroll
            for (int a = 0; a < NQ; ++a) { xv[a][i] = srow[(size_t)a * SC_LS + (size_t)(i * 64 + lane) * ES]; lo[a] = fminf(lo[a], xv[a][i]); hi[a] = fmaxf(hi[a], xv[a][i]); } } } }
#pragma unroll
    for (int o = 1; o < 64; o <<= 1)
#pragma unroll
        for (int a = 0; a < NQ; ++a) { lo[a] = fminf(lo[a], __shfl_xor(lo[a], o)); hi[a] = fmaxf(hi[a], __shfl_xor(hi[a], o)); }
    float scale[NQ]; int kk[NQ], b0[NQ]; unsigned c0n[NQ];
#pragma unroll
    for (int a = 0; a < NQ; ++a) { const float range = hi[a] - lo[a]; scale[a] = (range > 1e-30f) ? 2047.0f / range : 0.f; kk[a] = 256; b0[a] = 0; c0n[a] = 0u; }
#pragma unroll
    for (int j = 0; j < 8 * NQ; ++j) ((LAS v4u*)hist)[lane + 64 * j] = (v4u){0u, 0u, 0u, 0u};
    LDS_WAIT();
    { const int nt_ = opaque_s(nt); float sc_[NQ];
#pragma unroll
    for (int a = 0; a < NQ; ++a) sc_[a] = opaque_vf(scale[a]);
#pragma unroll
    for (int i = 0; i < NI; ++i) if (i < nt_) {
#pragma unroll
        for (int a = 0; a < NQ; ++a) { const int b = min(2047, (int)((xv[a][i] - lo[a]) * sc_[a])); __hip_atomic_fetch_add(hist + a * 2048 + b, 1u, __ATOMIC_RELAXED, __HIP_MEMORY_SCOPE_WORKGROUP); } } }
    LDS_WAIT();
    { bool all_[NQ];
#pragma unroll
      for (int a = 0; a < NQ; ++a) all_[a] = true;
      hist_pick<NQ>(hist, lane, kk, b0, c0n, all_); }
    unsigned prefix[NQ], pmask[NQ]; bool whole[NQ], live[NQ]; bool any_live = false;
#pragma unroll
    for (int a = 0; a < NQ; ++a) { prefix[a] = 0u; pmask[a] = 0u; whole[a] = ((unsigned)kk[a] == c0n[a]); live[a] = !whole[a]; any_live = any_live || live[a]; }
    if (any_live) {
#pragma unroll
        for (int pass = 0; pass < 3; ++pass) {
            const int SH = pass == 0 ? 21 : (pass == 1 ? 10 : 0); const unsigned BM_ = pass == 2 ? 1023u : 2047u;
#pragma unroll
            for (int j = 0; j < 8 * NQ; ++j) ((LAS v4u*)hist)[lane + 64 * j] = (v4u){0u, 0u, 0u, 0u};
            LDS_WAIT();
            const int nt_ = opaque_s(nt); float sc_[NQ];
#pragma unroll
            for (int a = 0; a < NQ; ++a) sc_[a] = opaque_vf(scale[a]);
#pragma unroll
            for (int i = 0; i < NI; ++i) if (i < nt_) {
#pragma unroll
                for (int a = 0; a < NQ; ++a) { const int b = min(2047, (int)((xv[a][i] - lo[a]) * sc_[a])); const unsigned bts = __float_as_uint(xv[a][i]); const unsigned x = bts ^ ((bts >> 31) ? 0xFFFFFFFFu : 0x80000000u);
                    if (live[a] && b == b0[a] && (x & pmask[a]) == prefix[a]) __hip_atomic_fetch_add(hist + a * 2048 + ((x >> SH) & BM_), 1u, __ATOMIC_RELAXED, __HIP_MEMORY_SCOPE_WORKGROUP); } }
            LDS_WAIT();
            bool more = false; int bin[NQ]; unsigned c_u[NQ];
#pragma unroll
            for (int a = 0; a < NQ; ++a) { bin[a] = 0; c_u[a] = 0u; }
            hist_pick<NQ>(hist, lane, kk, bin, c_u, live);
#pragma unroll
            for (int a = 0; a < NQ; ++a) if (live[a]) {
                prefix[a] |= ((unsigned)bin[a] & BM_) << SH; pmask[a] |= BM_ << SH;
                if ((unsigned)kk[a] == c_u[a]) live[a] = false;
                more = more || live[a]; }
            if (!more) break;
        }
    }
    const int nt2_ = opaque_s(nt); float sc2_[NQ];
#pragma unroll
    for (int a = 0; a < NQ; ++a) sc2_[a] = opaque_vf(scale[a]);
#pragma unroll
    for (int i = 0; i < NI; ++i) if (i < nt2_) {
#pragma unroll
        for (int a = 0; a < NQ; ++a) { const int b = min(2047, (int)((xv[a][i] - lo[a]) * sc2_[a])); const unsigned bts = __float_as_uint(xv[a][i]); const unsigned x = bts ^ ((bts >> 31) ? 0xFFFFFFFFu : 0x80000000u);
            const bool selq = b > b0[a] || (b == b0[a] && (whole[a] || x >= prefix[a]));
            const unsigned long long mw = __ballot(selq); if (lane == 0) mrow[(size_t)a * MK_LS + i] = mw; } }
}
#define FRESH_TID() const int tid_o = wave0 * 64 + fresh_lane(); const int tid = tid_o, lane = tid & 63, wave = __builtin_amdgcn_readfirstlane(tid >> 6); (void)lane; (void)wave
__global__ void __launch_bounds__(NWAVES * 64, 2) fwd_kernel(Args args) {
    extern __shared__ __attribute__((aligned(16))) unsigned char lds_raw[];
    LAS unsigned char* lds = (LAS unsigned char*)lds_raw;
    volatile LAS unsigned* MISC = (volatile LAS unsigned*)(lds + MISC_OFF);
    const int wave0 = __builtin_amdgcn_readfirstlane((int)threadIdx.x >> 6);
    const int tid = wave0 * 64 + fresh_lane();
    const int G = gridDim.x;
    unsigned char* ws = args.ws;
    gu32* ctl = (gu32*)(ws + WS_CTL);
    float* const out = args.out;
#define X (out + O_Y)
#define XB ((bf16*)(ws + WS_XB))
#define HB ((bf16*)(ws + WS_REGA))
#define ACT ((bf16*)(ws + WS_REGA))
#define QA ((bf16*)(ws + WS_QA))
#define QB ((bf16*)(ws + WS_QB))
#define QI ((bf16*)(ws + WS_QI))
#define QC ((bf16*)(ws + WS_QC))
#define QD ((bf16*)(ws + WS_QD))
#define WI ((float*)(ws + WS_WI))
#define RA ((bf16*)(ws + WS_RA))
#define RB ((bf16*)(ws + WS_RB))
#define RC ((bf16*)(ws + WS_RC))
#define RD ((bf16*)(ws + WS_RD))
#define CC ((bf16*)(ws + WS_CC))
#define CQ ((bf16*)(ws + WS_REGA + (size_t)300 * MiB))
#define CKV ((bf16*)(ws + WS_REGA + (size_t)340 * MiB))
#define SSQP ((float*)(ws + WS_SSQP))
#define LAMF ((float*)(ws + WS_MISC))
#define ROPE64 ((float2*)(ws + WS_MISC + MISC_ROPE64))
#define ROPE32 ((float2*)(ws + WS_MISC + MISC_ROPE32))
    for (int u = tid; u < (LDS_BYTES - LDSCTL_OFF) / 4; u += NWAVES * 64) ((LAS unsigned*)(lds + LDSCTL_OFF))[u] = 0u;
    __syncthreads();
    XcdBarrier bar; bar.bar = (unsigned*)(ctl + CW_BAR); bar.x = 0; bar.st = nullptr; bar.wave0 = wave0;
    const int lo = args.ph_lo, hi_ph = args.ph_hi;
    if (hi_ph - lo > 1) bar = xcd_barrier_post((unsigned*)(ctl + CW_BAR), MISC + 8, wave0);
#define IN(k) (opaque_s(lo) <= (k) && (k) < opaque_s(hi_ph))
#define BOTH(k) (IN(k) && IN((k) + 1))
#define GRID_BAR() xcd_barrier(bar)

    if (EN_PH(0) && IN(0)) {
        FRESH_TID();
        for (int p0rep = 0; p0rep < P0_REPS; ++p0rep) {
        LAS float* scr = (LAS float*)(lds + wave * 16384);
        const int gw = blockIdx.x * NWAVES + wave, NGW = G * NWAVES;
        for (int l = 0; l < DEPTH; ++l) {
            unsigned char* wl = ws + WS_W + (size_t)l * W_LAYER;
            const int I_GU = (DM / 64) * (DFF / 32), I_D = (DFF / 64) * (DM / 32), I_INN = (DM / 64) * ((NIN + 31) / 32), I_O = (768 / 64) * (DM / 32);
            const int NIT = 4 * I_GU + 2 * I_D + I_INN + I_O;
            for (int it = gw; it < NIT; it += NGW) {
                int r = it;
                if (r < I_GU) { transpose_item<1>(ARG_IN(I_G1) + (size_t)l * DM * DFF, DM, DFF, ARG_IN(I_N1) + l * DM, (bf16*)(wl + W_GU1), DM, 0, scr, r, lane); continue; } r -= I_GU;
                if (r < I_GU) { transpose_item<2>(ARG_IN(I_U1) + (size_t)l * DM * DFF, DM, DFF, ARG_IN(I_N1) + l * DM, (bf16*)(wl + W_GU1), DM, 0, scr, r, lane); continue; } r -= I_GU;
                if (r < I_GU) { transpose_item<1>(ARG_IN(I_G2) + (size_t)l * DM * DFF, DM, DFF, ARG_IN(I_N2) + l * DM, (bf16*)(wl + W_GU2), DM, 0, scr, r, lane); continue; } r -= I_GU;
                if (r < I_GU) { transpose_item<2>(ARG_IN(I_U2) + (size_t)l * DM * DFF, DM, DFF, ARG_IN(I_N2) + l * DM, (bf16*)(wl + W_GU2), DM, 0, scr, r, lane); continue; } r -= I_GU;
                if (r < I_D) { transpose_item<0>(ARG_IN(I_D1) + (size_t)l * DFF * DM, DFF, DM, nullptr, (bf16*)(wl + W_D1), DFF, 0, scr, r, lane); continue; } r -= I_D;
                if (r < I_D) { transpose_item<0>(ARG_IN(I_D2) + (size_t)l * DFF * DM, DFF, DM, nullptr, (bf16*)(wl + W_D2), DFF, 0, scr, r, lane); continue; } r -= I_D;
                if (r < I_INN) { transpose_item<3>(ARG_IN(I_WIN) + (size_t)l * DM * NIN, DM, NIN, ARG_IN(I_NM) + l * DM, (bf16*)(wl + W_IN), DM, 0, scr, r, lane); continue; } r -= I_INN;
                transpose_item<0>(ARG_IN(I_WO) + (size_t)l * DM * DM + (size_t)256 * DM, 768, DM, nullptr, (bf16*)(wl + W_OUT), KOUT, 512, scr, r, lane);
            }
            const int gt = blockIdx.x * 512 + tid, NGT = G * 512;
            if (FUSE_POST) { for (int i = gt; i < NINP * (DM / 8); i += NGT) { const int np = i / (DM / 8); if (mycol_is_pad(np)) *(v4u*)((bf16*)(wl + W_IN) + (size_t)np * DM + 8 * (i % (DM / 8))) = (v4u){0u, 0u, 0u, 0u}; } }
            else for (int i = gt; i < (NINP - NIN) * DM; i += NGT) ((bf16*)(wl + W_IN))[(size_t)NIN * DM + i] = 0;
            for (int i = gt; i < (NQP - NQ) * 256; i += NGT) ((bf16*)(wl + W_Q))[(size_t)NQ * 256 + i] = 0;
            const float* wqb = ARG_IN(I_WQB) + (size_t)l * 256 * 384; const float* wkvb = ARG_IN(I_WKVB) + (size_t)l * 128 * 512; const float* qn = ARG_IN(I_QN) + l * 256;
            const float scaleA = 0.10206207261596575f * LOG2E;
            for (int i = gt; i < NQ * 256; i += NGT) {
                const int np = i >> 8, k = i & 255, hh = np / 160, c = np % 160; float v;
                if (c < 128) { float s = 0.f; for (int e = 0; e < 64; ++e) s += wqb[(size_t)k * 384 + hh * 96 + e] * wkvb[(size_t)c * 512 + hh * 128 + e]; v = s; }
                else v = wqb[(size_t)k * 384 + hh * 96 + 64 + (c - 128)];
                ((bf16*)(wl + W_Q))[(size_t)np * 256 + k] = (bf16)f2bf(v * qn[k] * scaleA);
            }
            const float* wo = ARG_IN(I_WO) + (size_t)l * DM * DM;
            for (int i = gt; i < 512 * DM; i += NGT) {
                const int n = i & 1023, kc = i >> 10, hh = kc >> 7, c = kc & 127; float s = 0.f;
                for (int e = 0; e < 64; ++e) s += wkvb[(size_t)c * 512 + hh * 128 + 64 + e] * wo[(size_t)(hh * 64 + e) * DM + n];
                ((bf16*)(wl + W_OUT))[(size_t)n * KOUT + kc] = (bf16)f2bf(s);
            }
            if (blockIdx.x == 0 && wave == 0) {
                const float* lf = ARG_IN(I_LAM) + l * 128;
                float a = lane < 32 ? lf[lane] * lf[32 + lane] : 0.f, b = lane < 32 ? lf[64 + lane] * lf[96 + lane] : 0.f;
                a = wave_sum(a); b = wave_sum(b);
                const float lam_init = 0.8f - 0.6f * expf(-0.3f * (float)l);
                if (lane == 0) LAMF[l] = expf(a) - expf(b) + lam_init;
            }
        }
        {
            const int gt = blockIdx.x * 512 + tid, NGT = G * 512;
            for (int i = gt; i < 2112 * 48; i += NGT) {
                const int pidx = i / 48, j = i % 48; const float pos = (float)(pidx < 2048 ? pidx : 4096 + (pidx - 2048));
                const float fr = j < 32 ? ARG_FREQ64(j) : ARG_FREQ32(j - 32);
                float sn, cs; sincos_acc(pos * fr, sn, cs);
                if (j < 32) ROPE64[pidx * 32 + j] = make_float2(cs, sn); else ROPE32[pidx * 16 + (j - 32)] = make_float2(cs, sn);
            }
        }
        for (int m = 2 * gw; m < M; m += 2 * NGW) {
            f32x4 v[2][4]; float sq[2];
#pragma unroll
            for (int r2 = 0; r2 < 2; ++r2) { const int mr = m + r2; const float* xr = (mr < MP) ? ARG_IN(I_XP) + (size_t)mr * DM : ARG_IN(I_XS) + (size_t)(mr - MP) * DM; const f32x4* x4 = (const f32x4*)xr + lane;
#pragma unroll
                for (int j = 0; j < 4; ++j) v[r2][j] = x4[64 * j]; }
#pragma unroll
            for (int r2 = 0; r2 < 2; ++r2) { const int mr = m + r2; float s2 = 0.f; unsigned long long* o8 = (unsigned long long*)(XB + (size_t)mr * DM) + lane;
#pragma unroll
                for (int j = 0; j < 4; ++j) { const f32x4 w = v[r2][j]; s2 += (w.x * w.x + w.y * w.y) + (w.z * w.z + w.w * w.w);
                    o8[64 * j] = (unsigned long long)cvtpk(w.x, w.y) | ((unsigned long long)cvtpk(w.z, w.w) << 32); }
                sq[r2] = wave_sum(s2); }
#pragma unroll
            for (int r2 = 0; r2 < 2; ++r2) if (lane < 16) SSQP[(size_t)(m + r2) * 16 + lane] = lane == 0 ? sq[r2] : 0.f;
        }
        }
        if (BOTH(0)) GRID_BAR();
    }

#pragma unroll 1
    for (int l = 0; l < DEPTH; ++l) {
        const int pb = 1 + 8 * l;
        unsigned char* wl = ws + WS_W + (size_t)l * W_LAYER;
        float* ssqA = SSQP + (size_t)l * M * 16; float* ssqAn = SSQP + (size_t)(l + 1) * M * 16; float* ssqB = SSQP + (size_t)(3 + l) * M * 16; float* ssqC = SSQP + (size_t)(5 + l) * M * 16; float* ssqQ = SSQP + (size_t)7 * M * 16 + (size_t)l * M * 4; float* ssqK = SSQP + (size_t)7 * M * 16 + (size_t)(2 + l) * M * 4; (void)ssqK;
        if (EN_PH(1) && IN(pb + 0)) {
            pg8::Gemm g{XB, (const bf16*)(wl + W_GU1), M, NGU, DM, DM}; pg8::StaticOrder S; S.init(M, NGU, G, (int)blockIdx.x);
            pg8::EpiSwiGLU E{ACT, ssqA};
            for (int grep = 0; grep < GU_REPS; ++grep)
            pg8::gemm_phase<pg8::EpiSwiGLU, pg8::StaticOrder, true, true>(lds, g, S, E, wave0);
            if (BOTH(pb + 0)) GRID_BAR();
        }
#define SPLITK_SAMPLE(WOFF) do { const int sl_ = (int)blockIdx.x & 7, un_ = (int)blockIdx.x >> 3; const int kb_ = sl_ < 6 ? 3 * sl_ : 18 + 2 * (sl_ - 6), kl_ = sl_ < 6 ? 3 : 2; \
        pg8::Gemm g2{ACT + (size_t)(MP + 256 * (un_ >> 2)) * DFF + kb_ * 128, (const bf16*)(wl + WOFF) + (size_t)(256 * (un_ & 3)) * DFF + kb_ * 128, 256, 256, kl_ * 128, DFF, DFF}; \
        pg8::OneUnit S2; pg8::EpiPartial E2{(float*)(ws + WS_QA) + (size_t)(un_ * 8 + sl_) * 32 * 512 * 4}; \
        pg8::gemm_phase<pg8::EpiPartial, pg8::OneUnit, true, true>(lds, g2, S2, E2, wave0); } while (0)
        if (EN_PH(2) && IN(pb + 1)) {
            pg8::Gemm g{ACT, (const bf16*)(wl + W_D1), M, DM, DFF, DFF}; pg8::StaticOrder S; S.init(MP, DM, G, (int)blockIdx.x);
            SPLITK_SAMPLE(W_D1);
            if (l == 0) { pg8::EpiResid<true> E{ARG_IN(I_XP), ARG_IN(I_XS) - (size_t)MP * DM, XB, ssqB, 0.5f};
                pg8::gemm_phase<pg8::EpiResid<true>, pg8::StaticOrder, true, true>(lds, g, S, E, wave0); }
            else { pg8::EpiResid<false> E{nullptr, nullptr, XB, ssqB, 0.5f};
                pg8::gemm_phase<pg8::EpiResid<false>, pg8::StaticOrder, true, true>(lds, g, S, E, wave0); }
            GRID_BAR();
            { FRESH_TID(); const int un_ = (int)blockIdx.x >> 3, j_ = (int)blockIdx.x & 7; const float* Pu = (const float*)(ws + WS_QA) + (size_t)un_ * 8 * 32 * 512 * 4;
              if (l == 0) pg8::resid_fixup<true>(Pu, MP / 256 + (un_ >> 2), un_ & 3, j_ >> 2, j_ & 3, ARG_IN(I_XS) - (size_t)MP * DM, XB, ssqB, 0.5f, tid);
              else pg8::resid_fixup<false>(Pu, MP / 256 + (un_ >> 2), un_ & 3, j_ >> 2, j_ & 3, nullptr, XB, ssqB, 0.5f, tid); }
            if (BOTH(pb + 1)) GRID_BAR();
        }
        if (EN_PH(3) && IN(pb + 2)) {
            pg8::Gemm g{XB, (const bf16*)(wl + W_IN), M, NINP, DM, DM}; pg8::StaticOrder S; S.init(M, NINP, G, (int)blockIdx.x);
#if FUSE_POST
#if IN_STAGGER_TICKS > 0
            if (blockIdx.x & 1) { const unsigned long long t0 = __builtin_amdgcn_s_memrealtime(); while (__builtin_amdgcn_s_memrealtime() - t0 < (unsigned long long)IN_STAGGER_TICKS) __builtin_amdgcn_s_sleep(8); }
#endif
            pg8::EpiInFused E{ws, out, l};
            pg8::gemm_phase<pg8::EpiInFused, pg8::StaticOrder, true, true>(lds, g, S, E, wave0);
#else
            pg8::EpiScaleBf16 E{HB, NINP, ssqB, 16, 1.0f / 1024.0f, ssqQ};
            pg8::gemm_phase<pg8::EpiScaleBf16, pg8::StaticOrder, true, true>(lds, g, S, E, wave0);
#endif
            if (BOTH(pb + 2)) GRID_BAR();
        }
        if (EN_PH(4) && IN(pb + 3)) {
#if FUSE_POST
            {
                pg8::Gemm g{CQ, (const bf16*)(wl + W_Q), M, NQP, 256, 256}; pg8::StaticOrder S; S.init(M, NQP, G, (int)blockIdx.x);
                pg8::EpiScaleBf16 E{QA, NQP, ssqQ, 4, 1.0f / 256.0f, nullptr};
                pg8::gemm_phase<pg8::EpiScaleBf16, pg8::StaticOrder, true, true>(lds, g, S, E, wave0);
            }
            {
                FRESH_TID();
                const float* kvn = ARG_IN(I_KVN) + l * 128; const int gw = blockIdx.x * NWAVES + wave, NGW = G * NWAVES; const int c16 = lane & 15, sub = lane >> 4;
                for (int row4 = gw * 4; row4 < M; row4 += NGW * 4) { const int row = row4 + sub;
                    const bool smp = row >= MP; const int rr = smp ? row - MP : row;
                    const v4u w = *(const v4u*)(CKV + (size_t)row * 128 + 8 * c16); float x[8];
                    x[0] = __uint_as_float(w[0] << 16); x[1] = __uint_as_float(w[0] & 0xffff0000u); x[2] = __uint_as_float(w[1] << 16); x[3] = __uint_as_float(w[1] & 0xffff0000u);
                    x[4] = __uint_as_float(w[2] << 16); x[5] = __uint_as_float(w[2] & 0xffff0000u); x[6] = __uint_as_float(w[3] << 16); x[7] = __uint_as_float(w[3] & 0xffff0000u);
                    const float rs = 1.0f / sqrtf(ssq_sum4(ssqK, row) * (1.0f / 128.0f) + EPS); const f32x4 g0 = *(const f32x4*)(kvn + 8 * c16), g1 = *(const f32x4*)(kvn + 8 * c16 + 4);
#pragma unroll
                    for (int e = 0; e < 4; ++e) { x[e] = x[e] * rs * g0[e]; x[4 + e] = x[4 + e] * rs * g1[e]; }
                    float* od = out + (smp ? O_MLA_S + ((size_t)l * MS + rr) * 160 : O_MLA_P + ((size_t)l * MP + rr) * 160) + 8 * c16;
                    *(f32x4*)od = (f32x4){x[0], x[1], x[2], x[3]}; *(f32x4*)(od + 4) = (f32x4){x[4], x[5], x[6], x[7]};
                    *(v4u*)(RA + (size_t)row * 160 + 8 * c16) = (v4u){cvtpk(x[0], x[1]), cvtpk(x[2], x[3]), cvtpk(x[4], x[5]), cvtpk(x[6], x[7])}; }
            }
            if (BOTH(pb + 3)) GRID_BAR();
#else
            for (int prep = 0; prep < POST_REPS; ++prep) {
            {
                pg8::Gemm g{HB, (const bf16*)(wl + W_Q), M, NQP, 256, NINP}; pg8::StaticOrder S; S.init(M, NQP, G, (int)blockIdx.x);
                pg8::EpiScaleBf16 E{QA, NQP, ssqQ, 4, 1.0f / 256.0f, nullptr};
                pg8::gemm_phase<pg8::EpiScaleBf16, pg8::StaticOrder, true, true>(lds, g, S, E, wave0);
            }
            FRESH_TID();
            const float* kvn = ARG_IN(I_KVN) + l * 128;
            const float scaleB = 0.125f * LOG2E, scaleD = 0.17677669529663687f * LOG2E, scaleC = 0.125f * LOG2E;
            const int gw = blockIdx.x * NWAVES + wave, NGW = G * NWAVES;
#define UP8(w, f) do { f[0] = __uint_as_float((w)[0] << 16); f[1] = __uint_as_float((w)[0] & 0xffff0000u); f[2] = __uint_as_float((w)[1] << 16); f[3] = __uint_as_float((w)[1] & 0xffff0000u); \
                       f[4] = __uint_as_float((w)[2] << 16); f[5] = __uint_as_float((w)[2] & 0xffff0000u); f[6] = __uint_as_float((w)[3] << 16); f[7] = __uint_as_float((w)[3] & 0xffff0000u); } while (0)
#define PK8(f) ((v4u){cvtpk(f[0], f[1]), cvtpk(f[2], f[3]), cvtpk(f[4], f[5]), cvtpk(f[6], f[7])})
#define ST8F(p, f) do { *(f32x4*)(p) = (f32x4){f[0], f[1], f[2], f[3]}; *(f32x4*)((p) + 4) = (f32x4){f[4], f[5], f[6], f[7]}; } while (0)
            for (int row = gw; row < M; row += NGW) {
                const bf16* h = HB + (size_t)row * NINP;
                const bool smp = row >= MP; const int rr = smp ? row - MP : row;
                const int pidx = smp ? 2048 + (rr & 63) : (rr & 2047);
                float* o_mla = out + (smp ? O_MLA_S + ((size_t)l * MS + rr) * 160 : O_MLA_P + ((size_t)l * MP + rr) * 160);
                float* o_dsa = out + (smp ? O_DSA_S + ((size_t)l * MS + rr) * 192 : O_DSA_P + ((size_t)l * MP + rr) * 192);
                float* o_sb = out + (smp ? O_SB_S + ((size_t)l * MS + rr) * 512 : O_SB_P + ((size_t)l * MP + rr) * 512);
                float* o_df = out + (smp ? O_DIFF_S + ((size_t)l * MS + rr) * 512 : O_DIFF_P + ((size_t)l * MP + rr) * 512);
                bf16* ra = RA + (size_t)row * 160; bf16* rb = RB + (size_t)row * 192; bf16* rc = RC + (size_t)row * 512; bf16* rd = RD + (size_t)row * 512;
                if (lane < 56) { const int blk = lane >> 2, j = lane & 3;
                    const int base = blk < 4 ? H_QB + 64 * blk : (blk == 4 ? H_KB : (blk < 13 ? H_QI + 64 * (blk - 5) : H_KI));
                    const v4u w1 = *(const v4u*)(h + base + 8 * j), w2 = *(const v4u*)(h + base + 32 + 8 * j); float x1[8], x2[8], a[8], b[8]; UP8(w1, x1); UP8(w2, x2);
                    const f32x4* cp = (const f32x4*)(ROPE64 + pidx * 32 + 8 * j);
#pragma unroll
                    for (int e2 = 0; e2 < 4; ++e2) { const f32x4 cs = cp[e2];
                        a[2 * e2] = x1[2 * e2] * cs[0] - x2[2 * e2] * cs[1]; b[2 * e2] = x2[2 * e2] * cs[0] + x1[2 * e2] * cs[1];
                        a[2 * e2 + 1] = x1[2 * e2 + 1] * cs[2] - x2[2 * e2 + 1] * cs[3]; b[2 * e2 + 1] = x2[2 * e2 + 1] * cs[2] + x1[2 * e2 + 1] * cs[3]; }
                    if (blk < 4) {
#pragma unroll
                        for (int e = 0; e < 8; ++e) { a[e] *= scaleB; b[e] *= scaleB; }
                        bf16* d = QB + (size_t)row * 256 + 64 * blk + 8 * j; *(v4u*)d = PK8(a); *(v4u*)(d + 32) = PK8(b); }
                    else if (blk == 4) { ST8F(o_dsa + 8 * j, a); ST8F(o_dsa + 32 + 8 * j, b); *(v4u*)(rb + 8 * j) = PK8(a); *(v4u*)(rb + 32 + 8 * j) = PK8(b); }
                    else if (blk < 13) { bf16* d = QI + (size_t)row * 512 + 64 * (blk - 5) + 8 * j; *(v4u*)d = PK8(a); *(v4u*)(d + 32) = PK8(b); }
                    else { ST8F(o_dsa + 128 + 8 * j, a); ST8F(o_dsa + 160 + 8 * j, b); *(v4u*)(rb + 128 + 8 * j) = PK8(a); *(v4u*)(rb + 160 + 8 * j) = PK8(b); }
                }
                if (lane < 34) { const int blk = lane >> 1, j = lane & 1;
                    const int base = blk == 0 ? H_KR : (blk < 9 ? H_QD + 32 * (blk - 1) : H_KD + 32 * (blk - 9));
                    const v4u w1 = *(const v4u*)(h + base + 8 * j), w2 = *(const v4u*)(h + base + 16 + 8 * j); float x1[8], x2[8], a[8], b[8]; UP8(w1, x1); UP8(w2, x2);
                    const f32x4* cp = (const f32x4*)(ROPE32 + pidx * 16 + 8 * j);
#pragma unroll
                    for (int e2 = 0; e2 < 4; ++e2) { const f32x4 cs = cp[e2];
                        a[2 * e2] = x1[2 * e2] * cs[0] - x2[2 * e2] * cs[1]; b[2 * e2] = x2[2 * e2] * cs[0] + x1[2 * e2] * cs[1];
                        a[2 * e2 + 1] = x1[2 * e2 + 1] * cs[2] - x2[2 * e2 + 1] * cs[3]; b[2 * e2 + 1] = x2[2 * e2 + 1] * cs[2] + x1[2 * e2 + 1] * cs[3]; }
                    if (blk == 0) { ST8F(o_mla + 128 + 8 * j, a); ST8F(o_mla + 144 + 8 * j, b); *(v4u*)(ra + 128 + 8 * j) = PK8(a); *(v4u*)(ra + 144 + 8 * j) = PK8(b); }
                    else if (blk < 9) {
#pragma unroll
                        for (int e = 0; e < 8; ++e) { a[e] *= scaleD; b[e] *= scaleD; }
                        bf16* d = QD + (size_t)row * 256 + 32 * (blk - 1) + 8 * j; *(v4u*)d = PK8(a); *(v4u*)(d + 16) = PK8(b); }
                    else { const int bb = blk - 9, oc = (bb >> 1) * 128 + (bb & 1) * 32 + 8 * j; ST8F(o_df + oc, a); ST8F(o_df + oc + 16, b); *(v4u*)(rd + oc) = PK8(a); *(v4u*)(rd + oc + 16) = PK8(b); }
                }
                { const int c16 = lane & 15; float x[8] = {0.f, 0.f, 0.f, 0.f, 0.f, 0.f, 0.f, 0.f}; float ss = 0.f;
                  if (lane >= 48) { const v4u w = *(const v4u*)(h + H_CKV + 8 * c16); UP8(w, x);
#pragma unroll
                      for (int e = 0; e < 8; ++e) ss += x[e] * x[e]; }
                  ss += __shfl_xor(ss, 1); ss += __shfl_xor(ss, 2); ss += __shfl_xor(ss, 4); ss += __shfl_xor(ss, 8);
                  if (lane >= 48) { const float rs = 1.0f / sqrtf(ss * (1.0f / 128.0f) + EPS); const f32x4 g0 = *(const f32x4*)(kvn + 8 * c16), g1 = *(const f32x4*)(kvn + 8 * c16 + 4);
#pragma unroll
                      for (int e = 0; e < 4; ++e) { x[e] = x[e] * rs * g0[e]; x[4 + e] = x[4 + e] * rs * g1[e]; }
                      ST8F(o_mla + 8 * c16, x); *(v4u*)(ra + 8 * c16) = PK8(x); } }
#pragma unroll
                for (int r3 = 0; r3 < 3; ++r3) { const int t = lane + 64 * r3;
                    if (t < 137) { float x[8];
                        if (t < 8) { const v4u w = *(const v4u*)(h + H_VB + 8 * t); UP8(w, x); ST8F(o_dsa + 64 + 8 * t, x); *(v4u*)(rb + 64 + 8 * t) = w; }
                        else if (t < 40) { const int k = t - 8; const v4u w = *(const v4u*)(h + H_QC + 8 * k); UP8(w, x);
#pragma unroll
                            for (int e = 0; e < 8; ++e) x[e] *= scaleC;
                            *(v4u*)(QC + (size_t)row * 256 + 8 * k) = PK8(x); }
                        else if (t < 72) { const int k = t - 40, oc = (k >> 3) * 128 + 8 * (k & 7); const v4u w = *(const v4u*)(h + H_KC + 8 * k); UP8(w, x); ST8F(o_sb + oc, x); *(v4u*)(rc + oc) = w; }
                        else if (t < 104) { const int k = t - 72, oc = (k >> 3) * 128 + 64 + 8 * (k & 7); const v4u w = *(const v4u*)(h + H_VC + 8 * k); UP8(w, x); ST8F(o_sb + oc, x); *(v4u*)(rc + oc) = w; }
                        else if (t < 136) { const int k = t - 104, oc = (k >> 3) * 128 + 64 + 8 * (k & 7); const v4u w = *(const v4u*)(h + H_VD + 8 * k); UP8(w, x); ST8F(o_df + oc, x); *(v4u*)(rd + oc) = w; }
                        else { const v4u w = *(const v4u*)(h + H_WI); UP8(w, x);
#pragma unroll
                            for (int e = 0; e < 8; ++e) x[e] *= 0.35355339059327373f;
                            ST8F(WI + (size_t)row * 8, x); }
                    } }
            }
            }
#undef UP8
#undef PK8
#undef ST8F
            if (BOTH(pb + 3)) GRID_BAR();
#endif
        }
        if (EN_PH(5) && IN(pb + 4)) {
            GLB unsigned char* wsg_ = (GLB unsigned char*)args.ws; asm volatile("" : "+s"(wsg_)); unsigned char* ws = (unsigned char*)wsg_;
            LAS char* tile = (LAS char*)lds;
            volatile LAS unsigned* qslot = MISC + 16;
            const int myx = (int)(xb_xcc_id() & 7u);
            for (int rep = 0; rep < ATTN_REPS; ++rep) {
#define MIXER_IDS() FRESH_TID(); const int r32 = lane & 31, hi = lane >> 5, hd = wave & 3, qh = wave >> 2, q4 = (lane & 15) >> 2; (void)q4; int qx = myx
#define NEXT_UNIT(kind, out) do { __syncthreads(); if (tid == 0) { int res_ = -1, q_ = qx; gu32* heads_ = ctl + CW_Q + (((rep * 2 + l) * 4 + (kind)) * 8) * 64; \
        for (;;) { const unsigned got_ = __hip_atomic_fetch_add((unsigned*)(heads_ + q_ * 64), 1u, RLX_AGENT); if (got_ < (unsigned)QLIST) { res_ = (int)got_ + 256 * q_; break; } \
            unsigned hv_[8]; _Pragma("unroll") for (int s_ = 0; s_ < 8; ++s_) hv_[s_] = __hip_atomic_load((unsigned*)(heads_ + ((myx + s_) & 7) * 64), RLX_AGENT); \
            int pick_ = -1; _Pragma("unroll") for (int s_ = 7; s_ >= 0; --s_) if (hv_[s_] < (unsigned)QLIST) pick_ = s_; \
            if (pick_ < 0) break; q_ = (myx + pick_) & 7; } \
        qslot[0] = (unsigned)res_; } \
    __syncthreads(); { const int r_ = (int)qslot[0]; out = r_ < 0 ? -1 : (r_ & 255); qx = r_ < 0 ? qx : ((r_ >> 8) & 7); } } while (0)
#if EN_DSA
            if (rep == 0 || ((REP_MASK >> 1) & 1)) { MIXER_IDS();
            for (;;) {
                int uidx; NEXT_UNIT(1, uidx); if (uidx < 0) break;
                const UnitId u = decode_unit(qx, uidx);
                const float* cache_lb = ARG_IN(I_CDSA) + ((size_t)(l * NB + u.b) * PAST) * 192;
                const int myq = u.qrow0 + 32 * qh + r32;
                float* sc = (float*)(ws + WS_REGA + (size_t)blockIdx.x * DSA_SCR);
                unsigned long long* mk = (unsigned long long*)(ws + WS_REGA + (size_t)blockIdx.x * DSA_SCR + DSA_MASK_OFF);
                const bool sel = u.nt > 4;
                if (sel) {
                    {
                    float wq[8]; float smin = 3e38f, smax = -3e38f;
                    LAS unsigned* mmq = (LAS unsigned*)(lds + 110592);
                    if (tid < 64) { mmq[tid] = 0xFFFFFFFFu; mmq[64 + tid] = 0u; }
#pragma unroll
                    for (int hh = 0; hh < 8; ++hh) wq[hh] = WI[(size_t)myq * 8 + hh];
                    LAS char* ql_ = (LAS char*)lds + 20480;
                    { const int row0 = tid >> 6, cc = tid & 63;
#pragma unroll
                      for (int i = 0; i < 8; ++i) { const int row = row0 + 8 * i; *(LAS v4u*)(ql_ + row * T512_STRB + cc * 16) = *(const v4u*)(QI + (size_t)(u.qrow0 + row) * 512 + cc * 8); } }
                    const LAS char* qb_ = ql_ + (32 * qh + r32) * T512_STRB + 8 * hi * 2;
                    TileLd<64, 192, true, 128> ld; ld.init(); constexpr int STRB = TileLd<64, 192, true, 128>::STRB;
                    const int nt2 = (u.nt + 1) >> 1;
                    bool f32; const void* src = tile_src(u, 0, cache_lb, RB, 192, 128, f32);
                    ld.nrows_ = (u.nt >= 2) ? 128 : 64; ld.issue(src, f32, tid); ld.store(tile, f32, tid); __syncthreads();
                    const int kboffA = (32 * hd + r32) * STRB + 8 * hi * 2;
                    int cbA = 0;
                    for (int t2 = 0; t2 < nt2; ++t2) {
                        LAS char* curA = tile + cbA * 90112; LAS char* nxbA = tile + (cbA ^ 1) * 90112; cbA ^= 1;
                        const LAS char* kb = curA + kboffA;
                        const int rows_cur = (2 * t2 + 2 <= u.nt) ? 128 : 64;
                        bool f32n; { const int tn2 = (t2 + 1 < nt2) ? t2 + 1 : t2; const void* sn = tile_src(u, 2 * tn2, cache_lb, RB, 192, 128, f32n); ld.nrows_ = (2 * tn2 + 2 <= u.nt) ? 128 : 64; ld.issue(sn, f32n, tid); }
                        if (32 * hd < rows_cur) {
                            bf16x8 ka[4];
#pragma unroll
                            for (int s = 0; s < 4; ++s) ka[s] = *(const LAS bf16x8*)(kb + s * 32);
                            typedef float f32x2_t __attribute__((ext_vector_type(2)));
                            f32x2_t I2[8];
#pragma unroll
                            for (int r = 0; r < 8; ++r) I2[r] = (f32x2_t){0.f, 0.f};
                            bf16x8 qf[2][4];
#pragma unroll
                            for (int s = 0; s < 4; ++s) qf[0][s] = *(const LAS bf16x8*)(qb_ + s * 32);
#pragma unroll
                            for (int hh = 0; hh < 8; ++hh) { f32x16 p = zero16(); const f32x2_t w2 = {wq[hh], wq[hh]};
                                if (hh < 7) {
#pragma unroll
                                    for (int s = 0; s < 4; ++s) qf[(hh + 1) & 1][s] = *(const LAS bf16x8*)(qb_ + (hh + 1) * 128 + s * 32); }
                                __builtin_amdgcn_sched_barrier(0);
#pragma unroll
                                for (int s = 0; s < 4; ++s) p = MFMA32(ka[s], qf[hh & 1][s], p);
#pragma unroll
                                for (int r = 0; r < 8; ++r) { const f32x2_t rl = {__int_as_float(max(__float_as_int(p[2 * r]), 0)), __int_as_float(max(__float_as_int(p[2 * r + 1]), 0))};        I2[r] = w2 * rl + I2[r]; } }
                            f32x16 I;
#pragma unroll
                            for (int r = 0; r < 8; ++r) { I[2 * r] = I2[r].x; I[2 * r + 1] = I2[r].y; }
                            GLB float* scol = (GLB float*)sc + (size_t)(t2 * 128 + 32 * hd + 4 * hi) * 64 + 32 * qh + r32;
#pragma unroll
                            for (int r = 0; r < 16; ++r) { scol[(size_t)((r & 3) + 8 * (r >> 2)) * 64] = I[r]; smin = fminf(smin, I[r]); smax = fmaxf(smax, I[r]); }
                        }
                        ld.store(nxbA, f32n, tid);
                        __syncthreads();
                    }
                    { const unsigned bmn = __float_as_uint(smin), bmx = __float_as_uint(smax);
                      __hip_atomic_fetch_min(mmq + 32 * qh + r32, bmn ^ ((bmn >> 31) ? 0xFFFFFFFFu : 0x80000000u), __ATOMIC_RELAXED, __HIP_MEMORY_SCOPE_WORKGROUP);
                      __hip_atomic_fetch_max(mmq + 64 + 32 * qh + r32, bmx ^ ((bmx >> 31) ? 0xFFFFFFFFu : 0x80000000u), __ATOMIC_RELAXED, __HIP_MEMORY_SCOPE_WORKGROUP); }
                    }
                    VM_WAIT(); __syncthreads();
                    {
                    LAS unsigned* hist = (LAS unsigned*)lds;
                    LAS unsigned* part = (LAS unsigned*)(lds + 65536);
                    LAS float* qlo = (LAS float*)(lds + 67584); LAS float* qsc = qlo + 64; LAS int* qkk = (LAS int*)(qsc + 64); LAS unsigned* qT = (LAS unsigned*)(qkk + 64); LAS int* qwhole = (LAS int*)(qT + 64);
                    LAS int* qcn = qwhole + 64;
                    LAS unsigned long long* mkl = (LAS unsigned long long*)(lds + 69632);
                    LAS unsigned* cval = (LAS unsigned*)(lds + 106496);
                    LAS unsigned short* ckey = (LAS unsigned short*)(lds + 122880);
                    constexpr int CMAX = 64;
                    const int pq = tid & 63, ps = tid >> 6;
                    LAS unsigned* mmq = (LAS unsigned*)(lds + 110592);
                    if (tid < 64) { const unsigned a = mmq[tid], b = mmq[64 + tid];
                        const float lo_ = __uint_as_float((a & 0x80000000u) ? (a ^ 0x80000000u) : ~a), hi_ = __uint_as_float((b & 0x80000000u) ? (b ^ 0x80000000u) : ~b);
                        const float range = hi_ - lo_; qlo[tid] = lo_; qsc[tid] = (range > 1e-30f) ? 255.99f / range : 0.f; qcn[tid] = 0; }
#pragma unroll
                    for (int j = 0; j < 8; ++j) ((LAS v4u*)hist)[tid + 512 * j] = (v4u){0u, 0u, 0u, 0u};
                    __syncthreads();
                    const float lo_q = qlo[pq], sc_q = qsc[pq];
                    const GLB float* scq = (const GLB float*)sc + pq;
                    for (int t = ps; t < u.nt; t += 8) { const GLB float* sp = scq + (size_t)t * 4096;
                        { float xs[64];
#pragma unroll
                            for (int j = 0; j < 64; ++j) xs[j] = sp[j * 64];
#pragma unroll
                            for (int j = 0; j < 64; ++j) { const int b0 = min(255, (int)((xs[j] - lo_q) * sc_q)); __hip_atomic_fetch_add(hist + b0 * 64 + pq, 1u, __ATOMIC_RELAXED, __HIP_MEMORY_SCOPE_WORKGROUP); } } }
                    __syncthreads();
                    { unsigned sm = 0u;
#pragma unroll 8
                      for (int j = 0; j < 32; ++j) sm += hist[(32 * ps + j) * 64 + pq];
                      part[ps * 64 + pq] = sm; }
                    __syncthreads();
                    if (tid < 64) { const unsigned kk_ = 256u; unsigned acc = 0u; int sl_ = -1; unsigned abv = 0u;
#pragma unroll
                        for (int s2 = 7; s2 >= 0; --s2) { const unsigned c = part[s2 * 64 + tid]; const bool take = (sl_ < 0) && (acc + c >= kk_); if (take) { sl_ = s2; abv = acc; } acc += c; }
                        sl_ = sl_ < 0 ? 0 : sl_; unsigned acc2 = abv; int bsel = -1; unsigned abv2 = 0u, csel = 0u;
#pragma unroll 8
                        for (int j = 31; j >= 0; --j) { const unsigned c = hist[(32 * sl_ + j) * 64 + tid]; const bool take = (bsel < 0) && (acc2 + c >= kk_); if (take) { bsel = j; abv2 = acc2; csel = c; } acc2 += c; }
                        bsel = bsel < 0 ? 0 : bsel;
                        qT[tid] = (unsigned)(32 * sl_ + bsel); qkk[tid] = (int)(kk_ - abv2); qwhole[tid] = ((kk_ - abv2) == csel) ? 1 : 0; }
                    __syncthreads();
                    { const int T0 = (int)qT[pq]; const bool whole = qwhole[pq] != 0;
                      for (int t = ps; t < u.nt; t += 8) { const GLB float* sp = scq + (size_t)t * 4096; unsigned long long w = 0ull;
#pragma unroll 1
                        for (int k0 = 0; k0 < 64; k0 += 32) { float xs[32];
#pragma unroll
                            for (int j = 0; j < 32; ++j) xs[j] = sp[(k0 + j) * 64];
#pragma unroll
                            for (int j = 0; j < 32; ++j) { const int b0 = min(255, (int)((xs[j] - lo_q) * sc_q));
                                const bool selq = b0 > T0 || (whole && b0 == T0); w |= (unsigned long long)(selq ? 1u : 0u) << (k0 + j);
                                if (!whole && b0 == T0) { const int ix = __hip_atomic_fetch_add(qcn + pq, 1, __ATOMIC_RELAXED, __HIP_MEMORY_SCOPE_WORKGROUP);
                                    if (ix < CMAX) { const unsigned bts = __float_as_uint(xs[j]); cval[pq * CMAX + ix] = bts ^ ((bts >> 31) ? 0xFFFFFFFFu : 0x80000000u); ckey[pq * CMAX + ix] = (unsigned short)(t * 64 + k0 + j); } } } }
                        mkl[pq * 72 + t] = w; } }
                    __syncthreads();
                    if (!qwhole[pq]) { const int n = qcn[pq], kk_ = qkk[pq];
                        if (n <= CMAX) { for (int i = ps; i < n; i += 8) { const unsigned vi = cval[pq * CMAX + i]; const unsigned ki = ckey[pq * CMAX + i]; int rank = 0;
                                for (int j = 0; j < n; ++j) { const unsigned vj = cval[pq * CMAX + j]; const unsigned kj = ckey[pq * CMAX + j]; rank += (vj > vi || (vj == vi && kj < ki)) ? 1 : 0; }
                                if (rank < kk_) __hip_atomic_fetch_or((LAS unsigned*)mkl + (pq * 72 + (int)(ki >> 6)) * 2 + (int)((ki >> 5) & 1u), 1u << (ki & 31u), __ATOMIC_RELAXED, __HIP_MEMORY_SCOPE_WORKGROUP); } } }
                    __syncthreads();
                    if (wave == 0) { unsigned long long und = __ballot(!qwhole[lane] && qcn[lane] > CMAX);
                        while (und) { const int qf = (int)__builtin_ctzll(und); und &= und - 1ull;
                            if (u.sample) dsa_select<65, 1, 64>(sc + qf, u.nt, hist, (unsigned long long*)(mkl + qf * 72), lane); else dsa_select<32, 1, 64>(sc + qf, u.nt, hist, (unsigned long long*)(mkl + qf * 72), lane); } }
                    }
                    VM_WAIT(); __syncthreads();
                }
                bf16x8 q[4];
#pragma unroll
                for (int s = 0; s < 4; ++s) q[s] = *(const bf16x8*)(QB + (size_t)myq * 256 + hd * 64 + 16 * s + 8 * hi);
                f32x16 o[2]; o[0] = zero16(); o[1] = zero16(); float m_ = -1e30f, l_ = 0.f;
                TileLd<128, 192> ld; ld.init(); constexpr int STRB = TileLd<128, 192>::STRB;
                bool f32; const void* src = tile_src(u, 0, cache_lb, RB, 192, 0, f32);
                ld.issue(src, f32, tid); ld.store(tile, f32, tid); __syncthreads();
                const int kboff = r32 * STRB + 8 * hi * 2;
                const int vboff = (4 * hi + q4) * STRB + (64 + 16 * ((lane >> 4) & 1) + 4 * (lane & 3)) * 2;
                int cb = 0;
                for (int t = 0; t < u.nt; ++t) {
                    LAS char* cur = tile + cb * 24576; LAS char* nxb = tile + (cb ^ 1) * 24576; cb ^= 1;
                    const LAS char* kb = cur + kboff; const LAS char* vb = cur + vboff;
                    bool f32n; { const int tn = (t + 1 < u.nt) ? t + 1 : t; const void* sn = tile_src(u, tn, cache_lb, RB, 192, 0, f32n); ld.issue(sn, f32n, tid); }
                    unsigned long long mw = ~0ull; if (sel) mw = ((const LAS unsigned long long*)(lds + 69632))[(32 * qh + r32) * 72 + t];
                    const unsigned mlo = (unsigned)mw >> (4 * hi), mhi = (unsigned)(mw >> 32) >> (4 * hi);
                    f32x16 p0, p1; bf16x8 kf[8], vf[8];
                    k_ld<4>(kf, kb, STRB); __builtin_amdgcn_sched_barrier(0); qk_r<4>(p0, p1, kf, q); v_ld<2>(vf, vb, STRB); __builtin_amdgcn_sched_barrier(0);
#pragma unroll
                    for (int r = 0; r < 16; ++r) { const int bpos = (r & 3) + 8 * (r >> 2);
                        const unsigned s0 = (unsigned)__builtin_amdgcn_sbfe((int)mlo, bpos, 1), s1 = (unsigned)__builtin_amdgcn_sbfe((int)mhi, bpos, 1);
                        p0[r] = __uint_as_float((__float_as_uint(p0[r]) & s0) | (0xff61b1e6u & ~s0)); p1[r] = __uint_as_float((__float_as_uint(p1[r]) & s1) | (0xff61b1e6u & ~s1)); }
                    softmax_step<2>(p0, p1, m_, l_, o);
                    pv_r<2>(o, p0, p1, vf);
                    ld.store(nxb, f32n, tid);
                    __syncthreads();
                }
                l_ += __shfl_xor(l_, 32); const float inv = 1.0f / l_;
                bf16* orow = CC + (size_t)myq * KOUT + 512 + hd * 64;
#pragma unroll
                for (int db = 0; db < 2; ++db)
#pragma unroll
                    for (int gq = 0; gq < 4; ++gq) { v2u w; w.x = cvtpk(o[db][4 * gq] * inv, o[db][4 * gq + 1] * inv); w.y = cvtpk(o[db][4 * gq + 2] * inv, o[db][4 * gq + 3] * inv);
                        *(v2u*)(orow + 32 * db + 8 * gq + 4 * hi) = w; }
            }
            }
#endif
#if EN_DIFF
            if (rep == 0 || ((REP_MASK >> 3) & 1)) { MIXER_IDS();
            for (;;) {
                int uidx; NEXT_UNIT(3, uidx); if (uidx < 0) break;
                const UnitId u = decode_unit(qx, uidx);
                const float* cache_lb = ARG_IN(I_CDIFF) + ((size_t)(l * NB + u.b) * PAST) * 512;
                const int myq = u.qrow0 + 32 * qh + r32;
                bf16x8 qa[2], qb2[2];
#pragma unroll
                for (int s = 0; s < 2; ++s) { qa[s] = *(const bf16x8*)(QD + (size_t)myq * 256 + hd * 64 + 16 * s + 8 * hi); qb2[s] = *(const bf16x8*)(QD + (size_t)myq * 256 + hd * 64 + 32 + 16 * s + 8 * hi); }
                f32x16 o1[2], o2[2]; o1[0] = zero16(); o1[1] = zero16(); o2[0] = zero16(); o2[1] = zero16(); float m1 = -1e30f, l1 = 0.f, m2 = -1e30f, l2 = 0.f;
                constexpr int STRB = T512_STRB;
                { bool f32; const void* src = tile_src(u, 0, cache_lb, RD, 512, 0, f32);
                  if (f32) t512_cvt(src, tile, tid); else t512_dma(src, tile, wave, lane); VM_WAIT(); __syncthreads(); }
                const int kboff = r32 * STRB + (hd * 128 + 8 * hi) * 2;
                const int vboff = (4 * hi + q4) * STRB + (hd * 128 + 64 + 16 * ((lane >> 4) & 1) + 4 * (lane & 3)) * 2;
                int cb = 0;
                for (int t = 0; t < u.nt; ++t) {
                    LAS char* cur = tile + cb * T512_BYTES; LAS char* nxb = tile + (cb ^ 1) * T512_BYTES; cb ^= 1;
                    const LAS char* kb1 = cur + kboff; const LAS char* kb2 = kb1 + 64; const LAS char* vb = cur + vboff;
                    bool f32n = false; const void* sn = nullptr; if (t + 1 < u.nt) sn = tile_src(u, t + 1, cache_lb, RD, 512, 0, f32n);
#if DBG_VARIANTS
                    { f32x16 p0, p1; qk<2>(p0, p1, kb1, STRB, qa); float sx = 0.f; for (int r = 0; r < 16; ++r) { p0[r] = __builtin_amdgcn_exp2f(p0[r] - 8.f); p1[r] = __builtin_amdgcn_exp2f(p1[r] - 8.f); sx += p0[r] + p1[r]; } l1 += sx; pv<2>(o1, p0, p1, vb, STRB); }
                    { f32x16 p0, p1; qk<2>(p0, p1, kb2, STRB, qb2); float sx = 0.f; for (int r = 0; r < 16; ++r) { p0[r] = __builtin_amdgcn_exp2f(p0[r] - 8.f); p1[r] = __builtin_amdgcn_exp2f(p1[r] - 8.f); sx += p0[r] + p1[r]; } l2 += sx; pv<2>(o2, p0, p1, vb, STRB); }
#else
                    { bf16x8 kA[4], kB[4], vf[8]; f32x16 pa0, pa1, pb0, pb1;
                      k_ld<2>(kA, kb1, STRB); k_ld<2>(kB, kb2, STRB); __builtin_amdgcn_sched_barrier(0);
                      qk_r<2>(pa0, pa1, kA, qa); qk_r<2>(pb0, pb1, kB, qb2); v_ld<2>(vf, vb, STRB); __builtin_amdgcn_sched_barrier(0);
                      if (t + 1 < u.nt && !f32n) t512_dma(sn, nxb, wave, lane);
                      __builtin_amdgcn_sched_barrier(0);
                      softmax_step<2>(pa0, pa1, m1, l1, o1); pv_r<2>(o1, pa0, pa1, vf);
                      softmax_step<2>(pb0, pb1, m2, l2, o2); pv_r<2>(o2, pb0, pb1, vf); }
#endif
                    if (t + 1 < u.nt && f32n) t512_cvt(sn, nxb, tid);
                    VM_WAIT(); __syncthreads();
                }
                l1 += __shfl_xor(l1, 32); l2 += __shfl_xor(l2, 32);
                const float i1 = 1.0f / l1, i2 = LAMF[l] / l2; float ss = 0.f;
#pragma unroll
                for (int db = 0; db < 2; ++db)
#pragma unroll
                    for (int r = 0; r < 16; ++r) { const float v = o1[db][r] * i1 - o2[db][r] * i2; o1[db][r] = v; ss += v * v; }
                ss += __shfl_xor(ss, 32);
                const float lam_init = 0.8f - 0.6f * expf(-0.3f * (float)l);
                const float rs = (1.0f - lam_init) / sqrtf(ss * (1.0f / 64.0f) + EPS);
                const float* dn = ARG_IN(I_DN) + l * 64;
                bf16* orow = CC + (size_t)myq * KOUT + 1024 + hd * 64;
#pragma unroll
                for (int db = 0; db < 2; ++db)
#pragma unroll
                    for (int gq = 0; gq < 4; ++gq) { const f32x4 dv = *(const f32x4*)(dn + 32 * db + 8 * gq + 4 * hi);
                        v2u w; w.x = cvtpk(o1[db][4 * gq] * rs * dv[0], o1[db][4 * gq + 1] * rs * dv[1]); w.y = cvtpk(o1[db][4 * gq + 2] * rs * dv[2], o1[db][4 * gq + 3] * rs * dv[3]);
                        *(v2u*)(orow + 32 * db + 8 * gq + 4 * hi) = w; }
            }
            }
#endif
#if EN_MLA
            if (rep == 0 || ((REP_MASK >> 0) & 1)) { MIXER_IDS();
            for (;;) {
                int uidx; NEXT_UNIT(0, uidx); if (uidx < 0) break;
                const UnitId u = decode_unit(qx, uidx);
                const float* cache_lb = ARG_IN(I_CMLA) + ((size_t)(l * NB + u.b) * PAST) * 160;
                const int myq = u.qrow0 + 32 * qh + r32;
                bf16x8 q[10];
#pragma unroll
                for (int s = 0; s < 10; ++s) q[s] = *(const bf16x8*)(QA + (size_t)myq * NQP + hd * 160 + 16 * s + 8 * hi);
                {
                    const int pidx = u.sample ? 2048 + 32 * qh + r32 : u.c * 64 + 32 * qh + r32;
                    bf16x8 a = q[8], b = q[9];
#pragma unroll
                    for (int j = 0; j < 8; ++j) { const float2 cs = ROPE32[pidx * 16 + 8 * hi + j]; const float x1 = bf2f((bf16)a[j]), x2 = bf2f((bf16)b[j]);
                        a[j] = (short)f2bf(x1 * cs.x - x2 * cs.y); b[j] = (short)f2bf(x2 * cs.x + x1 * cs.y); }
                    q[8] = a; q[9] = b;
                }
                f32x16 o[4]; o[0] = zero16(); o[1] = zero16(); o[2] = zero16(); o[3] = zero16(); float m_ = -1e30f, l_ = 0.f;
                TileLd<160, 160> ld; ld.init(); constexpr int STRB = TileLd<160, 160>::STRB;
                bool f32; const void* src = tile_src(u, 0, cache_lb, RA, 160, 0, f32);
                ld.issue(src, f32, tid); ld.store(tile, f32, tid); __syncthreads();
                const int kboff = r32 * STRB + 8 * hi * 2;
                const int vboff = (4 * hi + q4) * STRB + (16 * ((lane >> 4) & 1) + 4 * (lane & 3)) * 2;
                int cb = 0;
                for (int t = 0; t < u.nt; ++t) {
                    LAS char* cur = tile + cb * 24576; LAS char* nxb = tile + (cb ^ 1) * 24576; cb ^= 1;
                    const LAS char* kb = cur + kboff; const LAS char* vb = cur + vboff;
                    bool f32n; { const int tn = (t + 1 < u.nt) ? t + 1 : t; const void* sn = tile_src(u, tn, cache_lb, RA, 160, 0, f32n); ld.issue(sn, f32n, tid); }
                    f32x16 p0, p1; qk<10>(p0, p1, kb, STRB, q);
#if DBG_VARIANTS
                    { for (int r = 0; r < 16; ++r) { p0[r] = p0[r] * 0.f + 1.f; p1[r] = p1[r] * 0.f + 1.f; } l_ += 32.f; }
#else
                    softmax_step<4>(p0, p1, m_, l_, o);
#endif
                    pv<4>(o, p0, p1, vb, STRB);
                    ld.store(nxb, f32n, tid);
                    __syncthreads();
                }
                l_ += __shfl_xor(l_, 32); const float inv = 1.0f / l_;
                bf16* orow = CC + (size_t)myq * KOUT + hd * 128;
#pragma unroll
                for (int db = 0; db < 4; ++db)
#pragma unroll
                    for (int gq = 0; gq < 4; ++gq) { v2u w; w.x = cvtpk(o[db][4 * gq] * inv, o[db][4 * gq + 1] * inv); w.y = cvtpk(o[db][4 * gq + 2] * inv, o[db][4 * gq + 3] * inv);
                        *(v2u*)(orow + 32 * db + 8 * gq + 4 * hi) = w; }
            }
            }
#endif
#if EN_SB
            if (rep == 0 || ((REP_MASK >> 2) & 1)) { MIXER_IDS();
            for (;;) {
                int uidx; NEXT_UNIT(2, uidx); if (uidx < 0) break;
                const UnitId u = decode_unit(qx, uidx);
                const float* cache_lb = ARG_IN(I_CSB) + ((size_t)(l * NB + u.b) * PAST) * 512;
                const int myq = u.qrow0 + 32 * qh + r32, qloc = 32 * qh + r32;
                bf16x8 q[4];
#pragma unroll
                for (int s = 0; s < 4; ++s) q[s] = *(const bf16x8*)(QC + (size_t)myq * 256 + hd * 64 + 16 * s + 8 * hi);
                f32x16 o[2]; o[0] = zero16(); o[1] = zero16(); float carry = 1.0f; int it3 = 0;
                constexpr int STRB = T512_STRB;
                { bool f32; const void* src = tile_src(u, u.nt - 1, cache_lb, RC, 512, 0, f32);
                  if (f32) t512_cvt(src, tile, tid); else t512_dma(src, tile, wave, lane); VM_WAIT(); __syncthreads(); }
                const int kboff = r32 * STRB + (hd * 128 + 8 * hi) * 2;
                const int vboff = (4 * hi + q4) * STRB + (hd * 128 + 64 + 16 * ((lane >> 4) & 1) + 4 * (lane & 3)) * 2;
                volatile LAS unsigned* sbflag = MISC + 20;
                if (tid == 0) { sbflag[0] = 0u; sbflag[1] = 0u; sbflag[2] = 0u; }
                __syncthreads();
                int cb = 0;
                for (int t = u.nt - 1; t >= 0; --t) {
                    LAS char* cur = tile + cb * T512_BYTES; LAS char* nxb = tile + (cb ^ 1) * T512_BYTES; cb ^= 1;
                    const LAS char* kb = cur + kboff; const LAS char* vb = cur + vboff;
                    bool f32n = false; const void* sn = nullptr; if (t > 0) { sn = tile_src(u, t - 1, cache_lb, RC, 512, 0, f32n); if (!f32n) t512_dma(sn, nxb, wave, lane); }
                    const bool diag = (t == u.nt - 1);
                    f32x16 z0, z1; qk<4>(z0, z1, kb, STRB, q);
                    f32x16 u0, u1; float gs[8];
#pragma unroll
                    for (int r = 0; r < 16; ++r) {
                        const int key = crow(r, hi);
                        { const float e = __builtin_amdgcn_exp2f(fminf(z0[r], 80.f)); const float uu = __builtin_amdgcn_rcpf(1.0f + e); const bool ok = !diag || (key < qloc); u0[r] = ok ? uu : 1.0f; z0[r] = ok ? e * uu : 0.f; }
                        { const float e = __builtin_amdgcn_exp2f(fminf(z1[r], 80.f)); const float uu = __builtin_amdgcn_rcpf(1.0f + e); const bool ok = !diag || (key + 32 < qloc); u1[r] = ok ? uu : 1.0f; z1[r] = ok ? e * uu : 0.f; }
                    }
#pragma unroll
                    for (int g4 = 0; g4 < 4; ++g4) { gs[g4] = (u0[4 * g4] * u0[4 * g4 + 1]) * (u0[4 * g4 + 2] * u0[4 * g4 + 3]); gs[4 + g4] = (u1[4 * g4] * u1[4 * g4 + 1]) * (u1[4 * g4 + 2] * u1[4 * g4 + 3]); }
                    float pg[8];
#pragma unroll
                    for (int g8 = 0; g8 < 8; ++g8) pg[g8] = __shfl_xor(gs[g8], 32);
                    float run = carry;
#pragma unroll
                    for (int g8 = 7; g8 >= 0; --g8) {
                        float P = run * (hi == 0 ? pg[g8] : 1.0f);
                        if (g8 >= 4) { const int b4 = 4 * (g8 - 4);
                            z1[b4 + 3] *= P; P *= u1[b4 + 3]; z1[b4 + 2] *= P; P *= u1[b4 + 2]; z1[b4 + 1] *= P; P *= u1[b4 + 1]; z1[b4] *= P;
                        } else { const int b4 = 4 * g8;
                            z0[b4 + 3] *= P; P *= u0[b4 + 3]; z0[b4 + 2] *= P; P *= u0[b4 + 2]; z0[b4 + 1] *= P; P *= u0[b4 + 1]; z0[b4] *= P;
                        }
                        run *= gs[g8] * pg[g8];
                    }
                    carry = run;
                    pv<2>(o, z0, z1, vb, STRB);
                    if (t > 0 && f32n) t512_cvt(sn, nxb, tid);
                    if (tid == 0) sbflag[(it3 + 1) % 3] = 0u;
                    if (__any(carry != 0.f) && lane == 0) sbflag[it3] = 1u;
                    VM_WAIT(); __syncthreads();
                    const bool alive = sbflag[it3] != 0u; it3 = (it3 + 1) % 3;
                    if (!alive) break;
                }
                bf16* orow = CC + (size_t)myq * KOUT + 768 + hd * 64;
#pragma unroll
                for (int db = 0; db < 2; ++db)
#pragma unroll
                    for (int gq = 0; gq < 4; ++gq) { v2u w; w.x = cvtpk(o[db][4 * gq], o[db][4 * gq + 1]); w.y = cvtpk(o[db][4 * gq + 2], o[db][4 * gq + 3]);
                        *(v2u*)(orow + 32 * db + 8 * gq + 4 * hi) = w; }
            }
            }
#endif
            }
            if (BOTH(pb + 4)) GRID_BAR();
        }
        if (EN_PH(6) && IN(pb + 5)) {
            pg8::Gemm g{CC, (const bf16*)(wl + W_OUT), M, DM, KOUT, KOUT}; pg8::StaticOrder S; S.init(M, DM, G, (int)blockIdx.x);
            pg8::EpiResid<false> E{nullptr, nullptr, XB, ssqC, 1.0f};
            pg8::gemm_phase<pg8::EpiResid<false>, pg8::StaticOrder, true, true>(lds, g, S, E, wave0);
            if (BOTH(pb + 5)) GRID_BAR();
        }
        if (EN_PH(7) && IN(pb + 6)) {
            pg8::Gemm g{XB, (const bf16*)(wl + W_GU2), M, NGU, DM, DM}; pg8::StaticOrder S; S.init(M, NGU, G, (int)blockIdx.x);
            pg8::EpiSwiGLU E{ACT, ssqC};
            for (int grep = 0; grep < GU_REPS; ++grep)
            pg8::gemm_phase<pg8::EpiSwiGLU, pg8::StaticOrder, true, true>(lds, g, S, E, wave0);
            if (BOTH(pb + 6)) GRID_BAR();
        }
        if (EN_PH(8) && IN(pb + 7)) {
            pg8::Gemm g{ACT, (const bf16*)(wl + W_D2), M, DM, DFF, DFF}; pg8::StaticOrder S; S.init(MP, DM, G, (int)blockIdx.x);
            SPLITK_SAMPLE(W_D2);
            pg8::EpiResid<false> E{nullptr, nullptr, XB, ssqAn, 0.5f};
            pg8::gemm_phase<pg8::EpiResid<false>, pg8::StaticOrder, true, true>(lds, g, S, E, wave0);
            GRID_BAR();
            { FRESH_TID(); const int un_ = (int)blockIdx.x >> 3, j_ = (int)blockIdx.x & 7; const float* Pu = (const float*)(ws + WS_QA) + (size_t)un_ * 8 * 32 * 512 * 4;
              pg8::resid_fixup<false>(Pu, MP / 256 + (un_ >> 2), un_ & 3, j_ >> 2, j_ & 3, nullptr, XB, ssqAn, 0.5f, tid); }
            if (BOTH(pb + 7)) GRID_BAR();
        }
    }
    if (EN_PH(9) && IN(17)) {
        FRESH_TID();
        const float* fn = ARG_IN(I_FN); const float* ssqF = SSQP + (size_t)2 * M * 16;
        const int gw = blockIdx.x * NWAVES + wave, NGW = G * NWAVES;
        for (int m = gw; m < M; m += NGW) {
            const float rs = 1.0f / sqrtf(ssq_sum16(ssqF, m) * (1.0f / 1024.0f) + EPS);
            const v2u* x2 = (const v2u*)(XB + (size_t)m * DM) + lane; f32x4* y4 = (f32x4*)(X + (size_t)m * DM) + lane; const f32x4* g4 = (const f32x4*)fn + lane;
#pragma unroll
            for (int j = 0; j < 4; ++j) { const v2u w = x2[64 * j]; const f32x4 gg = g4[64 * j];
                const f32x4 v = (f32x4){__uint_as_float(w.x << 16), __uint_as_float(w.x & 0xffff0000u), __uint_as_float(w.y << 16), __uint_as_float(w.y & 0xffff0000u)};
                y4[64 * j] = v * rs * gg; }
        }
    }
#undef IN
#undef BOTH
#undef GRID_BAR
#undef X
#undef XB
#undef HB
#undef ACT
#undef QA
#undef QB
#undef QI
#undef QC
#undef QD
#undef WI
#undef RA
#undef RB
#undef RC
#undef RD
#undef CC
#undef CQ
#undef CKV
#undef SSQP
#undef LAMF
#undef ROPE64
#undef ROPE32
}


#if SELFCHECK
constexpr size_t WS_CHK = 3 * MiB + 768 * 1024;
__device__ __forceinline__ unsigned hsh(unsigned x) { x ^= x >> 16; x *= 0x7feb352du; x ^= x >> 15; x *= 0x846ca68bu; x ^= x >> 16; return x; }
__device__ __forceinline__ void chk_rep(unsigned* slot, float got, float ex, float atol, float rtol) {
    float e = fabsf(got - ex) / (atol + rtol * fabsf(ex)); if (!(e == e)) e = 1e30f; atomicMax(slot, __float_as_uint(e)); }
__device__ __forceinline__ float bfr(float x) { return bf2f((bf16)f2bf(x)); }
__device__ __forceinline__ int nat_col(int np) { return np < 1376 ? np : (np < 2912 ? np + 8 : (np < 2920 ? 1376 + (np - 2912) : -1)); }
struct Ptrs { float* X; bf16 *XB, *HB, *ACT, *QA, *QB, *QI, *QC, *QD, *RA, *RB, *RC, *RD, *CC; float* WI; float* SSQ; float* LAMF; float2 *R64, *R32; unsigned* chk; float* save; unsigned char* wl; };
__device__ __forceinline__ Ptrs mkptrs(const Args& a, int l) { Ptrs p; unsigned char* ws = a.ws;
    p.X = a.out; p.XB = (bf16*)(ws + WS_XB); p.HB = (bf16*)(ws + WS_REGA); p.ACT = p.HB; p.QA = (bf16*)(ws + WS_QA); p.QB = (bf16*)(ws + WS_QB); p.QI = (bf16*)(ws + WS_QI); p.QC = (bf16*)(ws + WS_QC); p.QD = (bf16*)(ws + WS_QD);
    p.RA = (bf16*)(ws + WS_RA); p.RB = (bf16*)(ws + WS_RB); p.RC = (bf16*)(ws + WS_RC); p.RD = (bf16*)(ws + WS_RD); p.CC = (bf16*)(ws + WS_CC); p.WI = (float*)(ws + WS_WI); p.SSQ = (float*)(ws + WS_SSQ);
    p.LAMF = (float*)(ws + WS_MISC); p.R64 = (float2*)(ws + WS_MISC + MISC_ROPE64); p.R32 = (float2*)(ws + WS_MISC + MISC_ROPE32); p.chk = (unsigned*)(ws + WS_CHK); p.save = (float*)(ws + WS_CHK + 256); p.wl = ws + WS_W + (size_t)l * W_LAYER; return p; }
__device__ __forceinline__ int samp_row(unsigned h) { const unsigned r = h % 4096u; return r < 3584u ? (int)(hsh(h) % (unsigned)MP) : MP + (int)(hsh(h) % (unsigned)MS); }

__global__ void __launch_bounds__(256) check_kernel(Args a, int l, int which) {
    const Ptrs p = mkptrs(a, l); const int gt = blockIdx.x * 256 + threadIdx.x, NT = gridDim.x * 256; const int lane = threadIdx.x & 63; const int gwv = gt >> 6, NW = NT >> 6;
    const float* ssqA = p.SSQ + (size_t)l * M; const float* ssqB = p.SSQ + (size_t)(3 + l) * M; const float* ssqC = p.SSQ + (size_t)(5 + l) * M; const float* ssqQ = p.SSQ + (size_t)(7 + l) * M;
    if (which == 0) {
        for (int i = gt; i < 16384; i += NT) { const unsigned h = hsh(i * 3 + 1);
            { const int np = h % NGU, k = hsh(h) % DM, pn = np >> 8, c = np & 255, f = pn * 128 + (c & 127); const float* src = (c < 128 ? a.in[I_G1] : a.in[I_U1]) + (size_t)l * DM * DFF;
              chk_rep(p.chk + 0, bf2f(((bf16*)(p.wl + W_GU1))[(size_t)np * DM + k]), bfr(src[(size_t)k * DFF + f] * a.in[I_N1][l * DM + k]), 1e-6f, 1e-3f); }
            { const int n = h % DM, k = hsh(h + 7) % DFF; chk_rep(p.chk + 1, bf2f(((bf16*)(p.wl + W_D1))[(size_t)n * DFF + k]), bfr(a.in[I_D1][(size_t)l * DFF * DM + (size_t)k * DM + n]), 1e-6f, 1e-3f); }
            { const int np = h % NINP, k = hsh(h + 9) % DM, j = nat_col(np); const float ex = j < 0 ? 0.f : bfr(a.in[I_WIN][(size_t)l * DM * NIN + (size_t)k * NIN + j] * a.in[I_NM][l * DM + k]);
              chk_rep(p.chk + 2, bf2f(((bf16*)(p.wl + W_IN))[(size_t)np * DM + k]), ex, 1e-6f, 1e-3f); }
            if (l == 0) { const int row = samp_row(h), c = hsh(h + 11) % DM; const float xv = row < MP ? a.in[I_XP][(size_t)row * DM + c] : a.in[I_XS][(size_t)(row - MP) * DM + c];
              chk_rep(p.chk + 3, bf2f(p.XB[(size_t)row * DM + c]), bfr(xv), 1e-6f, 1e-3f); }
        }
        if (l == 0) for (int i = gwv; i < 256; i += NW) { const int row = samp_row(hsh(i + 77)); const float* xr = row < MP ? a.in[I_XP] + (size_t)row * DM : a.in[I_XS] + (size_t)(row - MP) * DM;
            float s = 0.f; for (int c = lane; c < DM; c += 64) s += xr[c] * xr[c]; s = wave_sum(s); if (lane == 0) chk_rep(p.chk + 3, ssqA[row], s, 1e-3f, 1e-3f); }
    }
    if (which == 1) {
        for (int i = gt; i < 8192; i += NT) { const unsigned h = hsh(i * 5 + 2); const int row = samp_row(h), f = hsh(h + 1) % DFF; const bf16* wg = (bf16*)(p.wl + W_GU1) + (size_t)((f >> 7) * 256 + (f & 127)) * DM; const bf16* wu = wg + (size_t)128 * DM;
            const float* ssq = ssqA; float g = 0.f, u = 0.f; for (int k = 0; k < DM; ++k) { const float xv = bf2f(p.XB[(size_t)row * DM + k]); g += xv * bf2f(wg[k]); u += xv * bf2f(wu[k]); }
            const float rs = 1.0f / sqrtf(ssq[row] / 1024.f + EPS); g *= rs; u *= rs; const float ex = g / (1.f + expf(-g)) * u;
            chk_rep(p.chk + 4, bf2f(p.ACT[(size_t)row * DFF + f]), ex, 0.01f, 0.02f); }
    }
    if (which == 2) {
        for (int i = gt; i < 8192; i += NT) { const unsigned h = hsh(i * 7 + 3); const int row = samp_row(h), c = hsh(h + 1) % DM; const bf16* wd = (bf16*)(p.wl + W_D1) + (size_t)c * DFF;
            float s = 0.f; for (int k = 0; k < DFF; ++k) s += bf2f(p.ACT[(size_t)row * DFF + k]) * bf2f(wd[k]);
            const float xin = l == 0 ? (row < MP ? a.in[I_XP][(size_t)row * DM + c] : a.in[I_XS][(size_t)(row - MP) * DM + c]) : 0.f;
            if (l == 0) chk_rep(p.chk + 5, p.X[(size_t)row * DM + c], xin + 0.5f * s, 0.01f, 0.005f);
            chk_rep(p.chk + 5, bf2f(p.XB[(size_t)row * DM + c]), bfr(p.X[(size_t)row * DM + c]), 1e-6f, 1e-3f); }
        for (int i = gwv; i < 256; i += NW) { const int row = samp_row(hsh(i + 177)); float s = 0.f; for (int c = lane; c < DM; c += 64) { const float v = p.X[(size_t)row * DM + c]; s += v * v; } s = wave_sum(s);
            if (lane == 0) chk_rep(p.chk + 5, ssqB[row], s, 1e-3f, 1e-3f); }
    }
    if (which == 3) {
        for (int i = gt; i < 8192; i += NT) { const unsigned h = hsh(i * 11 + 4); const int row = samp_row(h), np = hsh(h + 1) % NINP; const bf16* w = (bf16*)(p.wl + W_IN) + (size_t)np * DM;
            float s = 0.f; for (int k = 0; k < DM; ++k) s += bf2f(p.XB[(size_t)row * DM + k]) * bf2f(w[k]); s *= 1.0f / sqrtf(ssqB[row] / 1024.f + EPS);
            chk_rep(p.chk + 6, bf2f(p.HB[(size_t)row * NINP + np]), s, 0.01f, 0.01f); }
        for (int i = gwv; i < 256; i += NW) { const int row = samp_row(hsh(i + 277)); float s = 0.f; for (int c = lane; c < 256; c += 64) { const float v = bf2f(p.HB[(size_t)row * NINP + c]); s += v * v; } s = wave_sum(s);
            if (lane == 0) chk_rep(p.chk + 6, ssqQ[row], s, 0.05f, 0.01f); }
    }
    if (which == 4) {
        const float* wqb = a.in[I_WQB] + (size_t)l * 256 * 384; const float* wkvb = a.in[I_WKVB] + (size_t)l * 128 * 512; const float* qn = a.in[I_QN] + l * 256;
        for (int i = gt; i < 2048; i += NT) { const unsigned h = hsh(i * 13 + 5); const int row = samp_row(h), hh = (hsh(h + 1) >> 3) & 3, c = hsh(h + 2) % 160; const bf16* hr = p.HB + (size_t)row * NINP;
            const float rs = 1.0f / sqrtf(ssqQ[row] / 256.f + EPS); float ex;
            if (c < 128) { float acc = 0.f; for (int e = 0; e < 64; ++e) { float qe = 0.f; for (int k = 0; k < 256; ++k) qe += bf2f(hr[k]) * rs * qn[k] * wqb[(size_t)k * 384 + hh * 96 + e]; acc += qe * wkvb[(size_t)c * 512 + hh * 128 + e]; } ex = acc; }
            else { float qe = 0.f; for (int k = 0; k < 256; ++k) qe += bf2f(hr[k]) * rs * qn[k] * wqb[(size_t)k * 384 + hh * 96 + 64 + (c - 128)]; ex = qe; }
            ex *= 0.10206207261596575f * LOG2E;
            chk_rep(p.chk + 7, bf2f(p.QA[(size_t)row * NQP + hh * 160 + c]), ex, 0.01f, 0.02f); }
        for (int i = gt; i < 16384; i += NT) { const unsigned h = hsh(i * 17 + 6); const int row = samp_row(h); const bool smp = row >= MP; const int rr = smp ? row - MP : row; const float pos = smp ? 4096.f + (rr & 63) : (float)(rr & 2047);
            const bf16* hr = p.HB + (size_t)row * NINP;
            const float* o_mla = a.out + (smp ? O_MLA_S + ((size_t)l * MS + rr) * 160 : O_MLA_P + ((size_t)l * MP + rr) * 160);
            const float* o_dsa = a.out + (smp ? O_DSA_S + ((size_t)l * MS + rr) * 192 : O_DSA_P + ((size_t)l * MP + rr) * 192);
            const float* o_sb = a.out + (smp ? O_SB_S + ((size_t)l * MS + rr) * 512 : O_SB_P + ((size_t)l * MP + rr) * 512);
            const float* o_df = a.out + (smp ? O_DIFF_S + ((size_t)l * MS + rr) * 512 : O_DIFF_P + ((size_t)l * MP + rr) * 512);
#define HN(j) bf2f(hr[(j) < 1376 ? (j) : ((j) < 1384 ? H_WI + ((j) - 1376) : (j) - 8)])
#define ROPE(base, d, idx, res) do { const int hf = (d) / 2, ii = (idx) % hf; const float fr = (d) == 64 ? a.freq64[ii] : a.freq32[ii]; float sn, cs; sincos_acc(pos * fr, sn, cs); \
            const float x1 = HN((base) + ii), x2 = HN((base) + hf + ii); res = (idx) < hf ? x1 * cs - x2 * sn : x2 * cs + x1 * sn; } while (0)
            const int sel = hsh(h + 3) % 12; const unsigned e = hsh(h + 4);
            if (sel == 0) { const int c = e % 128; float ss = 0.f; for (int k = 0; k < 128; ++k) { const float v = HN(256 + k); ss += v * v; } const float ex = HN(256 + c) / sqrtf(ss / 128.f + EPS) * a.in[I_KVN][l * 128 + c];
                chk_rep(p.chk + 8, o_mla[c], ex, 0.01f, 0.01f); chk_rep(p.chk + 8, bf2f(p.RA[(size_t)row * 160 + c]), ex, 0.01f, 0.01f); }
            if (sel == 1) { const int c = e % 32; float ex; ROPE(384, 32, c, ex); chk_rep(p.chk + 8, o_mla[128 + c], ex, 0.01f, 0.01f); chk_rep(p.chk + 8, bf2f(p.RA[(size_t)row * 160 + 128 + c]), ex, 0.01f, 0.01f); }
            if (sel == 2) { const int c = e % 256, hd = c >> 6; float ex; ROPE(416 + hd * 64, 64, c & 63, ex); chk_rep(p.chk + 8, bf2f(p.QB[(size_t)row * 256 + c]), ex * 0.125f * LOG2E, 0.01f, 0.01f); }
            if (sel == 3) { const int c = e % 64; float ex; ROPE(672, 64, c, ex); chk_rep(p.chk + 8, o_dsa[c], ex, 0.01f, 0.01f); chk_rep(p.chk + 8, bf2f(p.RB[(size_t)row * 192 + c]), ex, 0.01f, 0.01f);
                            const float v = HN(736 + c); chk_rep(p.chk + 8, o_dsa[64 + c], v, 0.01f, 0.01f); chk_rep(p.chk + 8, bf2f(p.RB[(size_t)row * 192 + 64 + c]), v, 0.01f, 0.01f); }
            if (sel == 4) { const int c = e % 512, hd = c >> 6; float ex; ROPE(800 + hd * 64, 64, c & 63, ex); chk_rep(p.chk + 8, bf2f(p.QI[(size_t)row * 512 + c]), ex, 0.01f, 0.01f); }
            if (sel == 5) { const int c = e % 64; float ex; ROPE(1312, 64, c, ex); chk_rep(p.chk + 8, o_dsa[128 + c], ex, 0.01f, 0.01f); chk_rep(p.chk + 8, bf2f(p.RB[(size_t)row * 192 + 128 + c]), ex, 0.01f, 0.01f);
                            const int w8 = e % 8; chk_rep(p.chk + 8, p.WI[(size_t)row * 8 + w8], HN(1376 + w8) * 0.35355339f, 0.005f, 0.01f); }
            if (sel == 6) { const int c = e % 256, hd = c >> 6, d = c & 63; chk_rep(p.chk + 8, bf2f(p.QC[(size_t)row * 256 + c]), HN(1384 + c) * 0.125f, 0.005f, 0.01f);
                            chk_rep(p.chk + 8, o_sb[hd * 128 + d], HN(1640 + c), 0.01f, 0.01f); chk_rep(p.chk + 8, o_sb[hd * 128 + 64 + d], HN(1896 + c), 0.01f, 0.01f);
                            chk_rep(p.chk + 8, bf2f(p.RC[(size_t)row * 512 + hd * 128 + d]), HN(1640 + c), 0.01f, 0.01f); chk_rep(p.chk + 8, bf2f(p.RC[(size_t)row * 512 + hd * 128 + 64 + d]), HN(1896 + c), 0.01f, 0.01f); }
            if (sel == 7) { const int c = e % 256, blk = c >> 5; float ex; ROPE(2152 + blk * 32, 32, c & 31, ex); chk_rep(p.chk + 8, bf2f(p.QD[(size_t)row * 256 + c]), ex * 0.17677669529663687f * LOG2E, 0.01f, 0.01f); }
            if (sel == 8) { const int c = e % 256, blk = c >> 5, hd = c >> 6; float ex; ROPE(2408 + blk * 32, 32, c & 31, ex); chk_rep(p.chk + 8, o_df[hd * 128 + (c & 63)], ex, 0.01f, 0.01f); chk_rep(p.chk + 8, bf2f(p.RD[(size_t)row * 512 + hd * 128 + (c & 63)]), ex, 0.01f, 0.01f); }
            if (sel == 9) { const int c = e % 256, hd = c >> 6, d = c & 63; chk_rep(p.chk + 8, o_df[hd * 128 + 64 + d], HN(2664 + c), 0.01f, 0.01f); chk_rep(p.chk + 8, bf2f(p.RD[(size_t)row * 512 + hd * 128 + 64 + d]), HN(2664 + c), 0.01f, 0.01f); }
        }
    }
    if (which == 5) {
        for (int i = gwv; i < 4 * 96; i += NW) {
            int kind = i / 96; const int slot = kind; const unsigned h = hsh(i * 19 + 7); int row = samp_row(h);
            if (CHK_FILTER == 6) { row = MP + (int)(hsh(h + 5) % (unsigned)MS); if (slot == 1) { kind = 2; row = (row & ~63) | (int)(hsh(h + 9) % 3u); } if (slot == 2) row = (row & ~63) | (48 + (int)(hsh(h + 9) % 16u)); }
            if (CHK_FILTER == 1) row = (int)(hsh(h + 5) % NB) * SEQ + (int)(hsh(h + 6) % 64u);
            if (CHK_FILTER == 2) row = (int)(hsh(h + 5) % (unsigned)MP);
            if (CHK_FILTER == 3) row = MP + (int)(hsh(h + 5) % (unsigned)MS);
            if (CHK_FILTER == 5) { if (kind == 0 || kind == 2) row = MP + (int)(hsh(h + 5) % (unsigned)MS); else if (kind == 1) row = (int)(hsh(h + 5) % NB) * SEQ + 128 + (int)(hsh(h + 6) % 128u); else row = (int)(hsh(h + 5) % NB) * SEQ + 128 + (int)(hsh(h + 6) % 384u); }
            if (CHK_FILTER == 4) row = (int)(hsh(h + 5) % NB) * SEQ + 64 + (int)(hsh(h + 6) % 64u); const int hd = (hsh(h + 1) >> 5) & 3; const bool smp = row >= MP; const int rr = smp ? row - MP : row;
            const int b = smp ? rr >> 6 : rr >> 11, t = smp ? rr & 63 : rr & 2047; const int L = smp ? PAST + 64 : ((t >> 6) + 1) * 64;
            const int W = kind == 0 ? 160 : (kind == 1 ? 192 : 512);
            const float* cache = (kind == 0 ? a.in[I_CMLA] : kind == 1 ? a.in[I_CDSA] : kind == 2 ? a.in[I_CSB] : a.in[I_CDIFF]) + (size_t)(l * NB + b) * PAST * W;
            const bf16* rows = kind == 0 ? p.RA : kind == 1 ? p.RB : kind == 2 ? p.RC : p.RD;
#define SLD(ptr) __hip_atomic_load((ptr), __ATOMIC_RELAXED, __HIP_MEMORY_SCOPE_AGENT)
#define KEL(k, c) (smp ? ((k) < PAST ? bfr(cache[(size_t)(k) * W + (c)]) : bf2f(rows[(size_t)(MP + b * 64 + (k) - PAST) * W + (c)])) : bf2f(rows[(size_t)(b * SEQ + (k)) * W + (c)]))
            float* sbuf = (float*)(a.ws + WS_REGA + (size_t)300 * MiB) + (size_t)i * 8448;
            if (kind == 0) {
                const int pidx = smp ? 2048 + t : t; float mx = -1e30f;
                for (int k = lane; k < L; k += 64) { float s = 0.f; for (int c = 0; c < 128; ++c) s += bf2f(p.QA[(size_t)row * NQP + hd * 160 + c]) * KEL(k, c);
                    for (int c = 0; c < 16; ++c) { const float2 cs = p.R32[pidx * 16 + c]; const float x1 = bf2f(p.QA[(size_t)row * NQP + hd * 160 + 128 + c]), x2 = bf2f(p.QA[(size_t)row * NQP + hd * 160 + 144 + c]);
                        s += bfr(x1 * cs.x - x2 * cs.y) * KEL(k, 128 + c) + bfr(x2 * cs.x + x1 * cs.y) * KEL(k, 144 + c); }
                    sbuf[k] = s; mx = fmaxf(mx, s); }
                for (int o = 1; o < 64; o <<= 1) mx = fmaxf(mx, __shfl_xor(mx, o));
                float den = 0.f; for (int k = lane; k < L; k += 64) { float pp = exp2f(sbuf[k] - mx); if (DBG_VARIANTS) pp = 1.f; sbuf[k] = pp; den += pp; } den = wave_sum(den);
                __builtin_amdgcn_s_waitcnt(0);
                for (int d = 0; d < 128; d += 16) { const int dd = d + (lane & 15); float acc = 0.f; for (int k = lane >> 4; k < L; k += 4) acc += SLD(sbuf + k) * KEL(k, dd); acc += __shfl_xor(acc, 16); acc += __shfl_xor(acc, 32);
                    if (lane < 16) chk_rep(p.chk + 9, bf2f(p.CC[(size_t)row * KOUT + hd * 128 + dd]), acc / den, 0.004f, 0.03f); }
            }
            if (kind == 1) {
                const int nsel = 256;
                for (int k = lane; k < L; k += 64) { float sc = 0.f; for (int ih = 0; ih < 8; ++ih) { float s = 0.f; for (int c = 0; c < 64; ++c) s += bf2f(p.QI[(size_t)row * 512 + ih * 64 + c]) * KEL(k, 128 + c); sc += fmaxf(s, 0.f) * p.WI[(size_t)row * 8 + ih]; } sbuf[k] = sc; }
                __builtin_amdgcn_s_waitcnt(0);
                float mx = -1e30f; float* pb = sbuf + 4224;
                for (int k = lane; k < L; k += 64) { const float me = sbuf[k]; int rank = 0; if (L > nsel) for (int j = 0; j < L; ++j) { const float o = SLD(sbuf + j); rank += (o > me) || (o == me && j < k); }
                    float s = -1e30f; if (rank < nsel) { s = 0.f; for (int c = 0; c < 64; ++c) s += bf2f(p.QB[(size_t)row * 256 + hd * 64 + c]) * KEL(k, c); } pb[k] = s; mx = fmaxf(mx, s); }
                for (int o = 1; o < 64; o <<= 1) mx = fmaxf(mx, __shfl_xor(mx, o));
                float den = 0.f; for (int k = lane; k < L; k += 64) { const float pp = pb[k] > -1e29f ? exp2f(pb[k] - mx) : 0.f; pb[k] = pp; den += pp; } den = wave_sum(den);
                __builtin_amdgcn_s_waitcnt(0);
                for (int d = 0; d < 64; d += 16) { const int dd = d + (lane & 15); float acc = 0.f; for (int k = lane >> 4; k < L; k += 4) acc += SLD(pb + k) * KEL(k, 64 + dd); acc += __shfl_xor(acc, 16); acc += __shfl_xor(acc, 32);
                    if (lane < 16) chk_rep(p.chk + 10, bf2f(p.CC[(size_t)row * KOUT + 512 + hd * 64 + dd]), acc / den, 0.02f, 0.10f); }
            }
            if (kind == 2) {
                const int qpos = smp ? PAST + t : t; float accv[1]; (void)accv;
                for (int k = lane; k < qpos; k += 64) { float z = 0.f; for (int c = 0; c < 64; ++c) z += bf2f(p.QC[(size_t)row * 256 + hd * 64 + c]) * KEL(k, hd * 128 + c); sbuf[k] = z; }
                __builtin_amdgcn_s_waitcnt(0);
                float logafter = 0.f, acc = 0.f;
                for (int k = qpos - 1; k >= 0; --k) { const float z = SLD(sbuf + k); const float sp = fmaxf(z, 0.f) + logf(1.f + expf(-fabsf(z))); const float aw = expf(z - sp + logafter); acc += bfr(aw) * KEL(k, hd * 128 + 64 + lane); logafter -= sp; if (logafter < -60.f) break; }
                chk_rep(p.chk + 9 + slot, bf2f(p.CC[(size_t)row * KOUT + 768 + hd * 64 + lane]), acc, 0.02f, 0.05f);
            }
            if (kind == 3) {
                float outv = 0.f; float o2[2];
                for (int m2 = 0; m2 < 2; ++m2) { float mx = -1e30f;
                    for (int k = lane; k < L; k += 64) { float s = 0.f; for (int c = 0; c < 32; ++c) s += bf2f(p.QD[(size_t)row * 256 + hd * 64 + m2 * 32 + c]) * KEL(k, hd * 128 + m2 * 32 + c); sbuf[k] = s; mx = fmaxf(mx, s); }
                    for (int o = 1; o < 64; o <<= 1) mx = fmaxf(mx, __shfl_xor(mx, o));
                    float den = 0.f; for (int k = lane; k < L; k += 64) { const float pp = exp2f(sbuf[k] - (DBG_VARIANTS ? 8.f : mx)); sbuf[k] = pp; den += pp; } den = wave_sum(den);
                    __builtin_amdgcn_s_waitcnt(0);
                    float acc = 0.f; for (int k = 0; k < L; ++k) acc += SLD(sbuf + k) * KEL(k, hd * 128 + 64 + lane); o2[m2] = acc / den; __builtin_amdgcn_s_waitcnt(0); }
                outv = o2[0] - p.LAMF[l] * o2[1]; const float ss = wave_sum(outv * outv); const float lam_init = 0.8f - 0.6f * expf(-0.3f * (float)l);
                const float ex = outv / sqrtf(ss / 64.f + EPS) * a.in[I_DN][l * 64 + lane] * (1.f - lam_init);
                chk_rep(p.chk + 12, bf2f(p.CC[(size_t)row * KOUT + 1024 + hd * 64 + lane]), ex, 0.02f, 0.05f);
            }
        }
    }
    if (which == 6) { for (int i = gt; i < 4096; i += NT) { const unsigned h = hsh(i * 23 + 8); const int row = samp_row(h), c = hsh(h + 1) % DM; p.save[i] = p.X[(size_t)row * DM + c]; } }
    if (which == 7) {
        const float* wkvb = a.in[I_WKVB] + (size_t)l * 128 * 512; const float* wo = a.in[I_WO] + (size_t)l * DM * DM;
        for (int i = gt; i < 4096; i += NT) { const unsigned h = hsh(i * 23 + 8); const int row = samp_row(h), c = hsh(h + 1) % DM; const bf16* w = (bf16*)(p.wl + W_OUT) + (size_t)c * KOUT;
            float s = 0.f; for (int k = 0; k < KOUT; ++k) s += bf2f(p.CC[(size_t)row * KOUT + k]) * bf2f(w[k]);
            chk_rep(p.chk + 13, p.X[(size_t)row * DM + c], p.save[i] + s, 0.01f, 0.005f);
            float s1 = 0.f, s2 = 0.f; for (int k = 0; k < 512; ++k) s1 += bf2f(p.CC[(size_t)row * KOUT + k]) * bf2f(w[k]);
            for (int hh = 0; hh < 4; ++hh) for (int e = 0; e < 64; ++e) { float v = 0.f; for (int cc = 0; cc < 128; ++cc) v += bf2f(p.CC[(size_t)row * KOUT + hh * 128 + cc]) * wkvb[(size_t)cc * 512 + hh * 128 + 64 + e]; s2 += v * wo[(size_t)(hh * 64 + e) * DM + c]; }
            chk_rep(p.chk + 14, s1, s2, 0.01f, 0.02f);
            for (int k = 512; k < KOUT; k += 97) chk_rep(p.chk + 14, bf2f(w[k]), bfr(wo[(size_t)(256 + k - 512) * DM + c]), 1e-6f, 1e-3f); }
    }
}
#ifndef CHK_SHOW
#define CHK_SHOW -1
#endif
#ifndef CHK_MAXLI
#define CHK_MAXLI 6
#endif
__global__ void __launch_bounds__(256) report_kernel(Args a) {
    const unsigned* chk = (const unsigned*)(a.ws + WS_CHK); float A = 0.f;
    if (CHK_SHOW >= 0) { A = sqrtf(fminf(__uint_as_float(chk[CHK_SHOW >= 0 ? CHK_SHOW : 0]), 400.f)); if (A < 0.3f) A = 0.f; }
    else if (CHK_SHOW == -2) { int bits = 0; for (int f = 9; f <= 12; ++f) if (__uint_as_float(chk[f]) > 1.0f) bits |= 1 << (f - 9); A = (float)(1 + bits); }
    else for (int f = 0; f < 15; ++f) if (__uint_as_float(chk[f]) > 1.0f) { A = (float)(f + 1); break; }
    if (A == 0.f) return;
    for (size_t i = (size_t)blockIdx.x * 256 + threadIdx.x; i < (size_t)M * DM; i += (size_t)gridDim.x * 256) a.out[i] = A;
}
#endif

extern "C" void kernel_launch(void* const* d_in, const int* in_sizes, int n_in, void* d_out, int out_size, void* d_ws, size_t ws_size, hipStream_t stream) {
    static int grid = 0;
    if (grid == 0) {
        if (n_in != 24 || (size_t)out_size != O_END || ws_size < WS_END) { fprintf(stderr, "kernel_launch: unexpected shapes: n_in %d out %d ws %zu (need %zu)\n", n_in, out_size, ws_size, (size_t)WS_END); grid = -1; return; }
        int dev = 0, cus = 0, per_cu = 0;
        if (hipGetDevice(&dev) != hipSuccess || hipDeviceGetAttribute(&cus, hipDeviceAttributeMultiprocessorCount, dev) != hipSuccess) { grid = -1; return; }
        if (hipFuncSetAttribute((const void*)fwd_kernel, hipFuncAttributeMaxDynamicSharedMemorySize, LDS_BYTES) != hipSuccess) { fprintf(stderr, "kernel_launch: hipFuncSetAttribute failed\n"); grid = -1; return; }
        if (hipOccupancyMaxActiveBlocksPerMultiprocessor(&per_cu, (const void*)fwd_kernel, NWAVES * 64, LDS_BYTES) != hipSuccess || per_cu < 1) fprintf(stderr, "kernel_launch: occupancy query reports %d\n", per_cu);
        (void)hipGetLastError();
        grid = cus < 256 ? cus : 256;
    }
    if (grid < 0) return;
    (void)hipMemsetAsync((char*)d_ws + WS_CTL, 0, CTL_ZERO_BYTES, stream);
    Args a{};
    for (int i = 0; i < 24; ++i) a.in[i] = (const float*)d_in[i];
    a.out = (float*)d_out; a.ws = (unsigned char*)d_ws;
    for (int i = 0; i < 32; ++i) a.freq64[i] = (float)pow(10000.0, -(double)i * 2.0 / 64.0);
    for (int i = 0; i < 16; ++i) a.freq32[i] = (float)pow(10000.0, -(double)i * 2.0 / 32.0);
    constexpr int NPH = 18;
    for (int li = 0; li < MK_N_LAUNCHES; ++li) {
        a.ph_lo = (MK_N_LAUNCHES == 1) ? 0 : li; a.ph_hi = (MK_N_LAUNCHES == 1) ? NPH : li + 1;
#if SELFCHECK
        if (MK_N_LAUNCHES == 18 && li == 6 && CHK_MAXLI >= 6) hipLaunchKernelGGL(check_kernel, dim3(256), dim3(256), 0, stream, a, 0, 6);
#endif
        hipLaunchKernelGGL(fwd_kernel, dim3(grid), dim3(NWAVES * 64), LDS_BYTES, stream, a);
        const hipError_t le = hipPeekAtLastError();
        if (le != hipSuccess) { fprintf(stderr, "kernel_launch: launch %d failed: %s\n", li, hipGetErrorName(le)); break; }
#if SELFCHECK
        if (MK_N_LAUNCHES == 18) { const int wmap[7] = {0, 1, 2, 3, 4, 5, 7}; if (li <= CHK_MAXLI) hipLaunchKernelGGL(check_kernel, dim3(512), dim3(256), 0, stream, a, 0, wmap[li]); }
#endif
    }
#if SELFCHECK
    hipLaunchKernelGGL(report_kernel, dim3(1024), dim3(256), 0, stream, a);
#endif
}
```

```cpp
#include <hip/hip_runtime.h>
#include <cstdio>
#include <cstdint>
#include <cmath>

#ifndef DBG_VARIANTS
#define DBG_VARIANTS 0
#endif
#ifndef ATTN_REPS
#define ATTN_REPS 1
#endif
#ifndef POST_REPS
#define POST_REPS 1
#endif
#ifndef GU_REPS
#define GU_REPS 1
#endif
#ifndef P0_REPS
#define P0_REPS 1
#endif
#ifndef REP_MASK
#define REP_MASK 15
#endif
#ifndef SELFCHECK
#define SELFCHECK 0
#endif
#ifndef CHK_FILTER
#define CHK_FILTER 0
#endif
#ifndef IN_STAGGER_TICKS
#define IN_STAGGER_TICKS 0
#endif
#ifndef FUSE_POST
#define FUSE_POST 1
#endif
#ifndef MK_N_LAUNCHES
#define MK_N_LAUNCHES 1
#endif

#ifndef PHMASK
#define PHMASK 0x3ff
#endif
#define EN_PH(c) (((PHMASK) >> (c)) & 1)
#ifndef EN_MLA
#define EN_MLA 1
#endif
#ifndef EN_DSA
#define EN_DSA 1
#endif
#ifndef EN_SB
#define EN_SB 1
#endif
#ifndef EN_DIFF
#define EN_DIFF 1
#endif
#define LAS __attribute__((address_space(3)))
#define GAS __attribute__((address_space(1)))

constexpr int DM = 1024, NB = 32, SEQ = 2048, DEPTH = 2, DSEQ = 64, PAST = 4096;
constexpr int MP = NB * SEQ, MS = NB * DSEQ, M = MP + MS;
constexpr int DFF = 2816, NGU = 2 * DFF, NIN = 2920, NINP = 3072, NQ = 640, NQP = 768, KOUT = 1280;
constexpr float EPS = 1e-6f;
constexpr float LOG2E = 1.4426950408889634f;
constexpr int H_CQ = 0, H_CKV = 256, H_KR = 384, H_QB = 416, H_KB = 672, H_VB = 736, H_QI = 800, H_KI = 1312,
              H_QC = 1376, H_KC = 1632, H_VC = 1888, H_QD = 2144, H_KD = 2400, H_VD = 2656, H_WI = 2912;
constexpr size_t O_Y = 0;
constexpr size_t O_MLA_P = (size_t)M * DM;
constexpr size_t O_DSA_P = O_MLA_P + (size_t)DEPTH * MP * 160;
constexpr size_t O_SB_P = O_DSA_P + (size_t)DEPTH * MP * 192;
constexpr size_t O_DIFF_P = O_SB_P + (size_t)DEPTH * MP * 512;
constexpr size_t O_MLA_S = O_DIFF_P + (size_t)DEPTH * MP * 512;
constexpr size_t O_DSA_S = O_MLA_S + (size_t)DEPTH * MS * 160;
constexpr size_t O_SB_S = O_DSA_S + (size_t)DEPTH * MS * 192;
constexpr size_t O_DIFF_S = O_SB_S + (size_t)DEPTH * MS * 512;
constexpr size_t O_END = O_DIFF_S + (size_t)DEPTH * MS * 512;

constexpr size_t MiB = 1u << 20;
constexpr size_t WS_CTL = 0, CTL_ZERO_BYTES = SELFCHECK ? 4 * MiB : 128 * 1024;
constexpr size_t WS_SSQ = 1 * MiB;
constexpr size_t WS_MISC = 4 * MiB;
constexpr size_t MISC_ROPE64 = 4096, MISC_ROPE32 = MISC_ROPE64 + (size_t)2112 * 32 * 8;
constexpr size_t WS_W = 5 * MiB;
constexpr size_t W_GU1 = 0, W_D1 = W_GU1 + (size_t)NGU * DM * 2, W_IN = W_D1 + (size_t)DM * DFF * 2, W_Q = W_IN + (size_t)NINP * DM * 2,
                 W_OUT = W_Q + (size_t)NQP * 256 * 2, W_GU2 = W_OUT + (size_t)DM * KOUT * 2, W_D2 = W_GU2 + (size_t)NGU * DM * 2, W_LAYER = W_D2 + (size_t)DM * DFF * 2;
constexpr size_t WS_XB = 90 * MiB;
constexpr size_t WS_REGA = 222 * MiB;
constexpr size_t REGA_BYTES = (size_t)M * NINP * 2;
constexpr size_t WS_QA = 618 * MiB, WS_QB = 717 * MiB, WS_QI = 750 * MiB, WS_QC = 816 * MiB, WS_QD = 849 * MiB, WS_WI = 882 * MiB;
constexpr size_t WS_RA = 885 * MiB, WS_RB = 906 * MiB, WS_RC = 931 * MiB, WS_RD = 997 * MiB, WS_CC = 1063 * MiB, WS_SSQP = 1228 * MiB, WS_END = 1264 * MiB;
static_assert(WS_W + 2 * W_LAYER <= WS_XB && WS_XB + (size_t)M * DM * 2 <= WS_REGA && WS_REGA + REGA_BYTES <= WS_QA, "ws map");
static_assert(WS_QA + (size_t)M * NQP * 2 <= WS_QB && WS_QI + (size_t)M * 512 * 2 <= WS_QC && WS_WI + (size_t)M * 32 <= WS_RA, "ws map");
static_assert(WS_RA + (size_t)M * 160 * 2 <= WS_RB && WS_RB + (size_t)M * 192 * 2 <= WS_RC && WS_RC + (size_t)M * 1024 <= WS_RD && WS_RD + (size_t)M * 1024 <= WS_CC && WS_CC + (size_t)M * KOUT * 2 <= WS_SSQP && WS_SSQP + (size_t)M * 16 * 4 * 7 + (size_t)M * 4 * 4 * 4 <= WS_END, "ws map");
constexpr int CW_BAR = 4096, CW_Q = 8192;
constexpr int SC_LS = 4160;
constexpr int MK_LS = 72;
constexpr size_t DSA_SCR = 1105920;
constexpr size_t DSA_MASK_OFF = (size_t)64 * SC_LS * 4;
static_assert(DSA_MASK_OFF + 64 * MK_LS * 8 <= DSA_SCR && 256 * DSA_SCR <= REGA_BYTES, "dsa scratch");

constexpr int RING_BYTES = 135168, LDSCTL_OFF = RING_BYTES, MISC_OFF = LDSCTL_OFF + 320, LDS_BYTES = 147456;
constexpr int NWAVES = 8;

typedef unsigned short bf16;
typedef unsigned v4u __attribute__((ext_vector_type(4)));
typedef unsigned v2u __attribute__((ext_vector_type(2)));
typedef float f32x4 __attribute__((ext_vector_type(4)));
typedef float f32x16 __attribute__((ext_vector_type(16)));
typedef short bf16x8 __attribute__((ext_vector_type(8)));
typedef short s16x4 __attribute__((ext_vector_type(4)));
typedef GAS unsigned gu32;
#define RLX_AGENT __ATOMIC_RELAXED, __HIP_MEMORY_SCOPE_AGENT
#define LDS_WAIT() asm volatile("s_waitcnt lgkmcnt(0)" ::: "memory")
#define VM_WAIT() asm volatile("s_waitcnt vmcnt(0)" ::: "memory")

__device__ __forceinline__ unsigned f2bf(float f) { unsigned u = __builtin_bit_cast(unsigned, f); return (u + 0x7fffu + ((u >> 16) & 1u)) >> 16; }
__device__ __forceinline__ unsigned pk2(float lo, float hi) { return f2bf(lo) | (f2bf(hi) << 16); }
__device__ __forceinline__ float bf2f(bf16 b) { return __builtin_bit_cast(float, ((unsigned)b) << 16); }
typedef float f32x2_t __attribute__((ext_vector_type(2))); typedef __bf16 bf16x2_t __attribute__((ext_vector_type(2)));
__device__ __forceinline__ unsigned cvtpk(float lo, float hi) { f32x2_t v = {lo, hi}; bf16x2_t b = __builtin_convertvector(v, bf16x2_t); return __builtin_bit_cast(unsigned, b); }
__device__ __forceinline__ int opaque_s(int x) { asm volatile("" : "+s"(x)); return x; }
__device__ __forceinline__ int fresh_lane() { int l; asm volatile("v_mbcnt_lo_u32_b32 %0, -1, 0\n\tv_mbcnt_hi_u32_b32 %0, -1, %0" : "=&v"(l)); return l; }
__device__ __forceinline__ float opaque_vf(float x) { asm volatile("" : "+v"(x)); return x; }
__device__ __forceinline__ float wave_sum(float v) {
#pragma unroll
    for (int o = 1; o < 64; o <<= 1) v += __shfl_xor(v, o);
    return v;
}

__device__ __forceinline__ float ssq_sum16(const float* p, int row) { const f32x4* q = (const f32x4*)(p + (size_t)row * 16); const f32x4 a = q[0], b = q[1], c = q[2], d = q[3];
    return (((a[0] + a[1]) + (a[2] + a[3])) + ((b[0] + b[1]) + (b[2] + b[3]))) + (((c[0] + c[1]) + (c[2] + c[3])) + ((d[0] + d[1]) + (d[2] + d[3]))); }
__device__ __forceinline__ float ssq_sum4(const float* p, int row) { const f32x4 a = *(const f32x4*)(p + (size_t)row * 4); return (a[0] + a[1]) + (a[2] + a[3]); }
namespace pg8 {
#define PG8_LAS __attribute__((address_space(3)))
typedef unsigned short bf16_t;
typedef unsigned u32x4 __attribute__((ext_vector_type(4)));
constexpr int BM = 256, BK = 64, HALF = 128, HTB = HALF * BK * 2, STAGE_BYTES = 8 * HTB, NXCD = 8, WGM = 8;
__host__ __device__ __forceinline__ int lds_byte(int r, int c) { const int st = (r >> 4) * 2 + (c >> 5), rr = r & 15, cc = c & 31, ob = rr * 64 + cc * 2; return st * 1024 + (ob ^ (((ob >> 9) & 1) << 5)); }
__host__ __device__ __forceinline__ void stage_rc(int b, int& R, int& C) { const int st = b / 1024, sb = b % 1024, swz = sb ^ (((sb >> 9) & 1) << 5); R = (st >> 1) * 16 + swz / 64; C = (st & 1) * 32 + (swz % 64) / 2; }
__host__ __device__ __forceinline__ int perm32(int rho) { const int n = rho >> 4, i = rho & 15; return 8 * (i >> 2) + 4 * n + (i & 3); }
struct Unit { int pm, pn; };
struct Gemm { const bf16_t* A; const bf16_t* Bt; int M, N, K, lda, ldb; };
struct StaticOrder {
    int nM, nN, nwg, G, c;
    __host__ __device__ void init(int M_, int N_, int G_, int c_) { nM = M_ / BM; nN = N_ / BM; nwg = nM * nN; G = G_; c = c_; }
    __host__ __device__ bool next(int i, Unit& u) const {
        const long L = (long)i * G + c; if (L >= nwg) return false;
        int wgid = (int)L; { const int q = nwg / NXCD, r = nwg % NXCD, xcd = wgid % NXCD, off = wgid / NXCD; wgid = (xcd < r ? xcd * (q + 1) : r * (q + 1) + (xcd - r) * q) + off; }
        const int nig = WGM * nN, gid = wgid / nig, fm = gid * WGM, gsz = (nM - fm) < WGM ? (nM - fm) : WGM;
        u.pm = fm + ((wgid % nig) % gsz); u.pn = (wgid % nig) / gsz; return true;
    }
    __device__ __forceinline__ void a_ready(const Unit&) const {}
    __device__ __forceinline__ void done(const Unit&) const {}
};

struct EpiSwiGLU {
    static constexpr bool PERM = true, AFTER_DRAIN = false;
    bf16_t* act; const float* ssq;
    __device__ __forceinline__ void operator()(const f32x4 (&acc)[2][2][4][2], const Unit& u, int wr, int wc, int fr, int fq) const {
        const int row0 = u.pm * BM + wr * 64 + fr, col0 = u.pn * 128 + wc * 32 + 8 * fq;
#pragma unroll
        for (int ai = 0; ai < 2; ++ai)
#pragma unroll
            for (int m = 0; m < 4; ++m) {
                const int row = row0 + ai * HALF + m * 16;
                const float rs = 1.0f / sqrtf(ssq_sum16(ssq, row) * (1.0f / 1024.0f) + EPS);
                float o[8];
#pragma unroll
                for (int n = 0; n < 2; ++n)
#pragma unroll
                    for (int j = 0; j < 4; ++j) {
                        const float g = acc[ai][0][m][n][j] * rs, up = acc[ai][1][m][n][j] * rs;
                        const float sg = g * __builtin_amdgcn_rcpf(1.0f + __builtin_amdgcn_exp2f(-g * LOG2E));
                        o[n * 4 + j] = sg * up;
                    }
                u32x4 w; w.x = cvtpk(o[0], o[1]); w.y = cvtpk(o[2], o[3]); w.z = cvtpk(o[4], o[5]); w.w = cvtpk(o[6], o[7]);
                *(u32x4*)(act + (size_t)row * DFF + col0) = w;
            }
    }
};
template <bool BASE_F32> struct EpiResid {
    static constexpr bool PERM = true, AFTER_DRAIN = false;
    const float* baseP; const float* baseS; bf16_t* xb; float* ssq_out; float alpha;
    __device__ __forceinline__ void operator()(const f32x4 (&acc)[2][2][4][2], const Unit& u, int wr, int wc, int fr, int fq) const {
        const int row0 = u.pm * BM + wr * 64 + fr, col0 = u.pn * BM + wc * 32 + 8 * fq;
        const float* base = (u.pm < MP / BM) ? baseP : baseS;
#pragma unroll
        for (int ai = 0; ai < 2; ++ai)
#pragma unroll
            for (int m = 0; m < 4; ++m) {
                const int row = row0 + ai * HALF + m * 16; const size_t off = (size_t)row * DM + col0; float ss = 0.f;
#pragma unroll
                for (int bj = 0; bj < 2; ++bj) {
                    f32x4 b0, b1;
                    if (BASE_F32) { b0 = *(const f32x4*)(base + off + bj * HALF); b1 = *(const f32x4*)(base + off + bj * HALF + 4); }
                    else { const u32x4 w = *(const u32x4*)(xb + off + bj * HALF);
                        b0 = (f32x4){__uint_as_float(w.x << 16), __uint_as_float(w.x & 0xffff0000u), __uint_as_float(w.y << 16), __uint_as_float(w.y & 0xffff0000u)};
                        b1 = (f32x4){__uint_as_float(w.z << 16), __uint_as_float(w.z & 0xffff0000u), __uint_as_float(w.w << 16), __uint_as_float(w.w & 0xffff0000u)}; }
                    const f32x4 o0 = b0 + acc[ai][bj][m][0] * alpha, o1 = b1 + acc[ai][bj][m][1] * alpha;
                    u32x4 w2; w2.x = cvtpk(o0[0], o0[1]); w2.y = cvtpk(o0[2], o0[3]); w2.z = cvtpk(o1[0], o1[1]); w2.w = cvtpk(o1[2], o1[3]);
                    *(u32x4*)(xb + off + bj * HALF) = w2;
                    ss += (o0[0] * o0[0] + o0[1] * o0[1]) + (o0[2] * o0[2] + o0[3] * o0[3]) + (o1[0] * o1[0] + o1[1] * o1[1]) + (o1[2] * o1[2] + o1[3] * o1[3]);
                }
                ss += __shfl_xor(ss, 16); ss += __shfl_xor(ss, 32);
                if (fq == 0) ssq_out[(size_t)row * 16 + u.pn * 4 + wc] = ss;
                asm volatile("" ::: "memory");
            }
    }
};
struct OneUnit {
    __device__ __forceinline__ bool next(int i, Unit& u) const { if (i > 0) return false; u.pm = 0; u.pn = 0; return true; }
    __device__ __forceinline__ void a_ready(const Unit&) const {}
    __device__ __forceinline__ void done(const Unit&) const {}
};
struct EpiPartial {
    static constexpr bool PERM = true, AFTER_DRAIN = false;
    float* P;
    __device__ __forceinline__ void operator()(const f32x4 (&acc)[2][2][4][2], const Unit&, int wr, int wc, int fr, int fq) const {
        const int tid = (wr * 4 + wc) * 64 + fq * 16 + fr;
#pragma unroll
        for (int ai = 0; ai < 2; ++ai)
#pragma unroll
            for (int bj = 0; bj < 2; ++bj)
#pragma unroll
                for (int m = 0; m < 4; ++m)
#pragma unroll
                    for (int n = 0; n < 2; ++n) *(f32x4*)(P + ((size_t)((((ai * 2 + bj) * 4 + m) * 2 + n) * 512 + tid)) * 4) = acc[ai][bj][m][n];
    }
};
template <bool BASE_F32, int NSL = 4> __device__ __forceinline__ void resid_fixup(const float* Pu  , int pm, int pn, int ai, int m, const float* base, bf16_t* xb, float* ssq_out, float alpha, int tid) {
    const int wid = tid >> 6, lane = tid & 63, wr = wid >> 2, wc = wid & 3, fr = lane & 15, fq = lane >> 4;
    f32x4 S[2][2], L[NSL][2][2];
#pragma unroll
    for (int sl = 0; sl < NSL; ++sl)
#pragma unroll
        for (int bj = 0; bj < 2; ++bj)
#pragma unroll
            for (int n = 0; n < 2; ++n) L[sl][bj][n] = *(const f32x4*)(Pu + ((size_t)((sl * 32 + ((ai * 2 + bj) * 4 + m) * 2 + n) * 512 + tid)) * 4);
    __builtin_amdgcn_sched_barrier(0);
#pragma unroll
    for (int bj = 0; bj < 2; ++bj)
#pragma unroll
        for (int n = 0; n < 2; ++n) { S[bj][n] = L[0][bj][n];
#pragma unroll
            for (int sl = 1; sl < NSL; ++sl) S[bj][n] += L[sl][bj][n]; }
    const int row = pm * BM + wr * 64 + fr + ai * HALF + m * 16, col0 = pn * BM + wc * 32 + 8 * fq; const size_t off = (size_t)row * DM + col0; float ss = 0.f;
#pragma unroll
    for (int bj = 0; bj < 2; ++bj) {
        f32x4 b0, b1;
        if (BASE_F32) { b0 = *(const f32x4*)(base + off + bj * HALF); b1 = *(const f32x4*)(base + off + bj * HALF + 4); }
        else { const u32x4 w = *(const u32x4*)(xb + off + bj * HALF);
            b0 = (f32x4){__uint_as_float(w.x << 16), __uint_as_float(w.x & 0xffff0000u), __uint_as_float(w.y << 16), __uint_as_float(w.y & 0xffff0000u)};
            b1 = (f32x4){__uint_as_float(w.z << 16), __uint_as_float(w.z & 0xffff0000u), __uint_as_float(w.w << 16), __uint_as_float(w.w & 0xffff0000u)}; }
        const f32x4 o0 = b0 + S[bj][0] * alpha, o1 = b1 + S[bj][1] * alpha;
        u32x4 w2; w2.x = cvtpk(o0[0], o0[1]); w2.y = cvtpk(o0[2], o0[3]); w2.z = cvtpk(o1[0], o1[1]); w2.w = cvtpk(o1[2], o1[3]);
        *(u32x4*)(xb + off + bj * HALF) = w2;
        ss += (o0[0] * o0[0] + o0[1] * o0[1]) + (o0[2] * o0[2] + o0[3] * o0[3]) + (o1[0] * o1[0] + o1[1] * o1[1]) + (o1[2] * o1[2] + o1[3] * o1[3]);
    }
    ss += __shfl_xor(ss, 16); ss += __shfl_xor(ss, 32);
    if (fq == 0) ssq_out[(size_t)row * 16 + pn * 4 + wc] = ss;
}
struct EpiScaleBf16 {
    static constexpr bool PERM = true, AFTER_DRAIN = false;
    bf16_t* O; int ldc; const float* ssq_in; int np_in; float inv_dim; float* ssq_out;
    __device__ __forceinline__ void operator()(const f32x4 (&acc)[2][2][4][2], const Unit& u, int wr, int wc, int fr, int fq) const {
        const int row0 = u.pm * BM + wr * 64 + fr, col0 = u.pn * BM + wc * 32 + 8 * fq;
        const bool do_ssq = (ssq_out != nullptr) && (u.pn == 0);
#pragma unroll
        for (int ai = 0; ai < 2; ++ai)
#pragma unroll
            for (int m = 0; m < 4; ++m) {
                const int row = row0 + ai * HALF + m * 16;
                const float rs = 1.0f / sqrtf((np_in == 16 ? ssq_sum16(ssq_in, row) : ssq_sum4(ssq_in, row)) * inv_dim + EPS); float ss = 0.f;
                bf16_t* rowp = O + (size_t)row * ldc + col0;
#pragma unroll
                for (int bj = 0; bj < 2; ++bj) {
                    const f32x4 v0 = acc[ai][bj][m][0] * rs, v1 = acc[ai][bj][m][1] * rs;
                    u32x4 w; w.x = cvtpk(v0[0], v0[1]); w.y = cvtpk(v0[2], v0[3]); w.z = cvtpk(v1[0], v1[1]); w.w = cvtpk(v1[2], v1[3]);
                    *(u32x4*)(rowp + bj * HALF) = w;
                    ss += (v0[0] * v0[0] + v0[1] * v0[1]) + (v0[2] * v0[2] + v0[3] * v0[3]) + (v1[0] * v1[0] + v1[1] * v1[1]) + (v1[2] * v1[2] + v1[3] * v1[3]);
                }
                if (do_ssq) { ss += __shfl_xor(ss, 16); ss += __shfl_xor(ss, 32); if (fq == 0) ssq_out[(size_t)row * 4 + wc] = ss; }
            }
    }
};


struct EpiInFused {
    static constexpr bool PERM = true, AFTER_DRAIN = false;
    unsigned char* ws; float* out; int layer;
    __device__ __forceinline__ void operator()(const f32x4 (&acc)[2][2][4][2], const Unit& u, int wr, int wc, int fr_, int fq_) const {
        int fr = fr_, fq = fq_; asm volatile("" : "+v"(fr), "+v"(fq));
        const int row0 = u.pm * BM + wr * 64 + fr, c0 = wc * 32 + 8 * fq, pn = u.pn;
        float* const SSQP_ = (float*)(ws + WS_SSQP);
        const float* ssq_in = SSQP_ + (size_t)(3 + layer) * M * 16; float* ssq_cq = SSQP_ + (size_t)7 * M * 16 + (size_t)layer * M * 4; float* ssq_kv = SSQP_ + (size_t)7 * M * 16 + (size_t)(2 + layer) * M * 4;
        bf16_t* const CQ = (bf16_t*)(ws + WS_REGA + (size_t)300 * MiB); bf16_t* const CKV = (bf16_t*)(ws + WS_REGA + (size_t)340 * MiB);
        bf16_t* const QB = (bf16_t*)(ws + WS_QB); bf16_t* const QI = (bf16_t*)(ws + WS_QI); bf16_t* const QC = (bf16_t*)(ws + WS_QC); bf16_t* const QD = (bf16_t*)(ws + WS_QD);
        bf16_t* const RA = (bf16_t*)(ws + WS_RA); bf16_t* const RB = (bf16_t*)(ws + WS_RB); bf16_t* const RC = (bf16_t*)(ws + WS_RC); bf16_t* const RD = (bf16_t*)(ws + WS_RD);
        float* const WI = (float*)(ws + WS_WI); const float2* const R64 = (const float2*)(ws + WS_MISC + MISC_ROPE64); const float2* const R32 = (const float2*)(ws + WS_MISC + MISC_ROPE32);
        bf16_t* const HBdbg = SELFCHECK ? (bf16_t*)(ws + WS_REGA) : nullptr;
        const float scaleB = 0.125f * LOG2E, scaleD = 0.17677669529663687f * LOG2E, scaleC = 0.125f * LOG2E;
#define EPK8(f) ((u32x4){cvtpk(f[0], f[1]), cvtpk(f[2], f[3]), cvtpk(f[4], f[5]), cvtpk(f[6], f[7])})
#define EST8F(p, f) do { *(f32x4*)(p) = (f32x4){f[0], f[1], f[2], f[3]}; *(f32x4*)((p) + 4) = (f32x4){f[4], f[5], f[6], f[7]}; } while (0)
#pragma unroll
        for (int ai = 0; ai < 2; ++ai)
#pragma unroll
            for (int m = 0; m < 4; ++m) {
                const int row = row0 + ai * HALF + m * 16;
                const float rs = 1.0f / sqrtf(ssq_sum16(ssq_in, row) * (1.0f / 1024.0f) + EPS);
                float v0[8], v1[8];
#pragma unroll
                for (int e = 0; e < 4; ++e) { v0[e] = acc[ai][0][m][0][e] * rs; v0[4 + e] = acc[ai][0][m][1][e] * rs; v1[e] = acc[ai][1][m][0][e] * rs; v1[4 + e] = acc[ai][1][m][1][e] * rs; }
                if (HBdbg) { *(u32x4*)(HBdbg + (size_t)row * NINP + pn * 256 + c0) = EPK8(v0); *(u32x4*)(HBdbg + (size_t)row * NINP + pn * 256 + 128 + c0) = EPK8(v1); }
                const bool smp = row >= MP; const int rr = smp ? row - MP : row; const int pidx = smp ? 2048 + (rr & 63) : (rr & 2047);
                if (pn == 0) {
                    *(u32x4*)(CQ + (size_t)row * 256 + c0) = EPK8(v0); *(u32x4*)(CQ + (size_t)row * 256 + 128 + c0) = EPK8(v1);
                    float ss = 0.f;
#pragma unroll
                    for (int e = 0; e < 8; ++e) ss += v0[e] * v0[e] + v1[e] * v1[e];
                    ss += __shfl_xor(ss, 16); ss += __shfl_xor(ss, 32); if (fq == 0) ssq_cq[(size_t)row * 4 + wc] = ss;
                } else if (pn <= 6 && pn != 4) {
                    const bool d32 = pn >= 5; const int i0 = d32 ? 8 * (fq & 1) : 8 * fq;
                    const f32x4* cp = (const f32x4*)(d32 ? R32 + pidx * 16 + i0 : R64 + pidx * 32 + i0);
                    float a[8], b[8];
#pragma unroll
                    for (int e2 = 0; e2 < 4; ++e2) { const f32x4 cs = cp[e2];
                        a[2 * e2] = v0[2 * e2] * cs[0] - v1[2 * e2] * cs[1]; b[2 * e2] = v1[2 * e2] * cs[0] + v0[2 * e2] * cs[1];
                        a[2 * e2 + 1] = v0[2 * e2 + 1] * cs[2] - v1[2 * e2 + 1] * cs[3]; b[2 * e2 + 1] = v1[2 * e2 + 1] * cs[2] + v0[2 * e2 + 1] * cs[3]; }
                    if (pn == 1) {
#pragma unroll
                        for (int e = 0; e < 8; ++e) { a[e] *= scaleB; b[e] *= scaleB; }
                        bf16_t* d = QB + (size_t)row * 256 + wc * 64 + 8 * fq; *(u32x4*)d = EPK8(a); *(u32x4*)(d + 32) = EPK8(b);
                    } else if (pn <= 3) { bf16_t* d = QI + (size_t)row * 512 + (4 * (pn - 2) + wc) * 64 + 8 * fq; *(u32x4*)d = EPK8(a); *(u32x4*)(d + 32) = EPK8(b);
                    } else { const int blk = 2 * wc + (fq >> 1);
                        if (pn == 5) {
#pragma unroll
                            for (int e = 0; e < 8; ++e) { a[e] *= scaleD; b[e] *= scaleD; }
                            bf16_t* d = QD + (size_t)row * 256 + blk * 32 + i0; *(u32x4*)d = EPK8(a); *(u32x4*)(d + 16) = EPK8(b);
                        } else { const int oc = (blk >> 1) * 128 + (blk & 1) * 32 + i0;
                            float* od = out + (smp ? O_DIFF_S + ((size_t)layer * MS + rr) * 512 : O_DIFF_P + ((size_t)layer * MP + rr) * 512) + oc;
                            EST8F(od, a); EST8F(od + 16, b); bf16_t* d = RD + (size_t)row * 512 + oc; *(u32x4*)d = EPK8(a); *(u32x4*)(d + 16) = EPK8(b); } }
                } else if (pn == 4) {
                    if (wc < 2 || (wc == 2 && fq < 2)) {
                        const bool d32 = wc == 2; const f32x4* cp = (const f32x4*)(d32 ? R32 + pidx * 16 + 8 * fq : R64 + pidx * 32 + 8 * fq);
                        float a[8], b[8];
#pragma unroll
                        for (int e2 = 0; e2 < 4; ++e2) { const f32x4 cs = cp[e2];
                            a[2 * e2] = v0[2 * e2] * cs[0] - v1[2 * e2] * cs[1]; b[2 * e2] = v1[2 * e2] * cs[0] + v0[2 * e2] * cs[1];
                            a[2 * e2 + 1] = v0[2 * e2 + 1] * cs[2] - v1[2 * e2 + 1] * cs[3]; b[2 * e2 + 1] = v1[2 * e2 + 1] * cs[2] + v0[2 * e2 + 1] * cs[3]; }
                        if (!d32) { const int oc = (wc == 0 ? 0 : 128) + 8 * fq;
                            float* od = out + (smp ? O_DSA_S + ((size_t)layer * MS + rr) * 192 : O_DSA_P + ((size_t)layer * MP + rr) * 192) + oc;
                            EST8F(od, a); EST8F(od + 32, b); bf16_t* d = RB + (size_t)row * 192 + oc; *(u32x4*)d = EPK8(a); *(u32x4*)(d + 32) = EPK8(b);
                        } else { const int oc = 128 + 8 * fq;
                            float* od = out + (smp ? O_MLA_S + ((size_t)layer * MS + rr) * 160 : O_MLA_P + ((size_t)layer * MP + rr) * 160) + oc;
                            EST8F(od, a); EST8F(od + 16, b); bf16_t* d = RA + (size_t)row * 160 + oc; *(u32x4*)d = EPK8(a); *(u32x4*)(d + 16) = EPK8(b); } }
                } else if (pn == 7) {
                    *(u32x4*)(CKV + (size_t)row * 128 + c0) = EPK8(v0);
                    float ss = 0.f;
#pragma unroll
                    for (int e = 0; e < 8; ++e) ss += v0[e] * v0[e];
                    ss += __shfl_xor(ss, 16); ss += __shfl_xor(ss, 32); if (fq == 0) ssq_kv[(size_t)row * 4 + wc] = ss;
                    if (wc < 2) { const int oc = 64 + c0; float* od = out + (smp ? O_DSA_S + ((size_t)layer * MS + rr) * 192 : O_DSA_P + ((size_t)layer * MP + rr) * 192) + oc;
                        EST8F(od, v1); *(u32x4*)(RB + (size_t)row * 192 + oc) = EPK8(v1); }
                    else if (wc == 2 && fq == 0) { float w8[8];
#pragma unroll
                        for (int e = 0; e < 8; ++e) w8[e] = v1[e] * 0.35355339059327373f;
                        EST8F(WI + (size_t)row * 8, w8); }
                } else if (pn == 8) {
                    float a[8], b[8];
#pragma unroll
                    for (int e = 0; e < 8; ++e) { a[e] = v0[e] * scaleC; b[e] = v1[e] * scaleC; }
                    *(u32x4*)(QC + (size_t)row * 256 + c0) = EPK8(a); *(u32x4*)(QC + (size_t)row * 256 + 128 + c0) = EPK8(b);
                } else {
                    const int h0 = wc >> 1, d0 = 32 * (wc & 1) + 8 * fq;
                    const int voff = (pn == 9) ? 0 : 64;
                    if (pn == 11) { float* od = out + (smp ? O_DIFF_S + ((size_t)layer * MS + rr) * 512 : O_DIFF_P + ((size_t)layer * MP + rr) * 512);
                        EST8F(od + h0 * 128 + voff + d0, v0); EST8F(od + (h0 + 2) * 128 + voff + d0, v1);
                        *(u32x4*)(RD + (size_t)row * 512 + h0 * 128 + voff + d0) = EPK8(v0); *(u32x4*)(RD + (size_t)row * 512 + (h0 + 2) * 128 + voff + d0) = EPK8(v1);
                    } else { float* od = out + (smp ? O_SB_S + ((size_t)layer * MS + rr) * 512 : O_SB_P + ((size_t)layer * MP + rr) * 512);
                        EST8F(od + h0 * 128 + voff + d0, v0); EST8F(od + (h0 + 2) * 128 + voff + d0, v1);
                        *(u32x4*)(RC + (size_t)row * 512 + h0 * 128 + voff + d0) = EPK8(v0); *(u32x4*)(RC + (size_t)row * 512 + (h0 + 2) * 128 + voff + d0) = EPK8(v1); }
                }
                asm volatile("" ::: "memory");
            }
#undef EPK8
#undef EST8F
    }
};

template <class Epi, class Sched, bool ALIGN_EPI = false, bool SP2 = false>
__device__ __forceinline__ void gemm_phase(PG8_LAS unsigned char* lds, const Gemm g, const Sched& S, const Epi& E, const int wave0) {
    const int tid_ = wave0 * 64 + fresh_lane();
    const int tid = tid_, wid = __builtin_amdgcn_readfirstlane(tid >> 6), lane = tid & 63, wr = wid >> 2, wc = wid & 3, fr = lane & 15, fq = lane >> 4;
    const int K = g.K, nt = K / BK, lda = g.lda, ldb = g.ldb ? g.ldb : g.K;
    unsigned voffA[2], voffB[2];
#pragma unroll
    for (int i = 0; i < 2; ++i) { int R, C; stage_rc(tid * 16 + i * 8192, R, C); const int Rb = Epi::PERM ? ((R & ~31) + perm32(R & 31)) : R;
        voffA[i] = (unsigned)(R * lda + C) * 2u; voffB[i] = (unsigned)(Rb * ldb + C) * 2u; }
    const size_t kstep = (size_t)(BK * 2);
    const size_t hstepA = (size_t)HALF * lda * 2, hstepB = (size_t)HALF * ldb * 2;
    const size_t tstepA = 2 * hstepA, tstepB = 2 * hstepB;
    const unsigned ldsw = (unsigned)wid * 1024u;
    const int aoff = lds_byte(wr * 64 + fr, fq * 8), boff = lds_byte(wc * 32 + fr, fq * 8);
#define PG8_SA(b, h) (((b) * 2 + (h)) * HTB)
#define PG8_SB(b, h) ((4 + (b) * 2 + (h)) * HTB)
#define PG8_STAGE(bufoff, gbase, voff) do { _Pragma("unroll") for (int _i = 0; _i < 2; ++_i) \
        __builtin_amdgcn_global_load_lds((const unsigned*)((const char*)(gbase) + (voff)[_i]), (PG8_LAS unsigned*)(lds + (bufoff) + ldsw + _i * 8192), 16, 0, 0); } while (0)
#define PG8_LDA(dst, b, h) do { _Pragma("unroll") for (int m = 0; m < 4; ++m) _Pragma("unroll") for (int k = 0; k < 2; ++k) dst[m][k] = *(const PG8_LAS bf16x8*)(lds + PG8_SA(b, h) + aoff + m * 2048 + k * 1024); } while (0)
#define PG8_LDB(dst, b, h) do { _Pragma("unroll") for (int n = 0; n < 2; ++n) _Pragma("unroll") for (int k = 0; k < 2; ++k) dst[n][k] = *(const PG8_LAS bf16x8*)(lds + PG8_SB(b, h) + boff + n * 2048 + k * 1024); } while (0)
#define PG8_MMA(ai, bj, At, Bt) do { __builtin_amdgcn_s_setprio(1); _Pragma("unroll") for (int m = 0; m < 4; ++m) _Pragma("unroll") for (int n = 0; n < 2; ++n) _Pragma("unroll") for (int k = 0; k < 2; ++k) \
        acc[ai][bj][m][n] = __builtin_amdgcn_mfma_f32_16x16x32_bf16(Bt[n][k], At[m][k], acc[ai][bj][m][n], 0, 0, 0); __builtin_amdgcn_s_setprio(0); } while (0)
#define PG8_WAIT_V(n) asm volatile("s_waitcnt vmcnt(" #n ")" ::: "memory")
#define PG8_WAIT_L(n) asm volatile("s_waitcnt lgkmcnt(" #n ")" ::: "memory")
#define PG8_BAR __builtin_amdgcn_s_barrier()
#define PG8_SCHED __builtin_amdgcn_sched_barrier(0)
    Unit cur, nxt; int ui = 0;
    if (!S.next(0, cur)) return;
    f32x4 acc[2][2][4][2];
#pragma unroll
    for (int a = 0; a < 2; ++a)
#pragma unroll
        for (int b = 0; b < 2; ++b)
#pragma unroll
            for (int m = 0; m < 4; ++m)
#pragma unroll
                for (int n = 0; n < 2; ++n) acc[a][b][m][n] = (f32x4){0.f, 0.f, 0.f, 0.f};
    bf16x8 At[4][2], B0[2][2], B1[2][2];
    const char* cA = (const char*)g.A + (size_t)cur.pm * tstepA; const char* cB = (const char*)g.Bt + (size_t)cur.pn * tstepB;
    S.a_ready(cur);
    if constexpr (SP2) {
        PG8_STAGE(PG8_SB(0, 0), cB, voffB); PG8_STAGE(PG8_SB(0, 1), cB + hstepB, voffB); PG8_STAGE(PG8_SA(0, 0), cA, voffA); PG8_STAGE(PG8_SA(0, 1), cA + hstepA, voffA);
        if (wr == 1) PG8_BAR;
        PG8_WAIT_V(2); PG8_BAR;
        PG8_STAGE(PG8_SB(1, 0), cB + kstep, voffB); PG8_STAGE(PG8_SA(1, 0), cA + kstep, voffA); PG8_STAGE(PG8_SB(1, 1), cB + hstepB + kstep, voffB);
        PG8_WAIT_V(6); PG8_BAR;
    } else {
        PG8_STAGE(PG8_SB(0, 0), cB, voffB); PG8_STAGE(PG8_SA(0, 0), cA, voffA); PG8_STAGE(PG8_SB(0, 1), cB + hstepB, voffB); PG8_STAGE(PG8_SA(0, 1), cA + hstepA, voffA);
        if (wr == 1) PG8_BAR;
        PG8_WAIT_V(4); PG8_BAR;
        PG8_STAGE(PG8_SB(1, 0), cB + kstep, voffB); PG8_STAGE(PG8_SA(1, 0), cA + kstep, voffA); PG8_STAGE(PG8_SB(1, 1), cB + hstepB + kstep, voffB);
        PG8_WAIT_V(6); PG8_BAR;
    }
    for (;;) {
        const bool has_next = S.next(ui + 1, nxt);
        const char* nA = has_next ? (const char*)g.A + (size_t)nxt.pm * tstepA : cA; const char* nB = has_next ? (const char*)g.Bt + (size_t)nxt.pn * tstepB : cB;
        for (int t = 0; t < nt; t += 2) {
            const bool last = (t == nt - 2);
            const char* a1 = cA + (size_t)(t + 1) * kstep;
            const char* a2 = last ? nA : cA + (size_t)(t + 2) * kstep; const char* b2 = last ? nB : cB + (size_t)(t + 2) * kstep;
            const char* a3 = a2 + kstep; const char* b3 = b2 + kstep;
            if (last && has_next) S.a_ready(nxt);
            if constexpr (SP2) {
            PG8_LDB(B0, 0, 0); PG8_LDB(B1, 0, 1); PG8_SCHED; PG8_LDA(At, 0, 0); PG8_STAGE(PG8_SA(1, 1), a1 + hstepA, voffA);
            PG8_WAIT_V(8); PG8_WAIT_L(0); PG8_BAR; PG8_MMA(0, 0, At, B0); PG8_MMA(0, 1, At, B1); PG8_BAR; PG8_SCHED;
            PG8_LDA(At, 0, 1); PG8_STAGE(PG8_SB(0, 0), b2, voffB); PG8_STAGE(PG8_SB(0, 1), b2 + hstepB, voffB); PG8_STAGE(PG8_SA(0, 0), a2, voffA);
            PG8_WAIT_V(8); PG8_WAIT_L(0); PG8_BAR; PG8_MMA(1, 0, At, B0); PG8_MMA(1, 1, At, B1); PG8_BAR; PG8_SCHED;
            PG8_LDB(B0, 1, 0); PG8_LDB(B1, 1, 1); PG8_SCHED; PG8_LDA(At, 1, 0); PG8_STAGE(PG8_SA(0, 1), a2 + hstepA, voffA);
            PG8_WAIT_V(8); PG8_WAIT_L(0); PG8_BAR; PG8_MMA(0, 0, At, B0); PG8_MMA(0, 1, At, B1); PG8_BAR; PG8_SCHED;
            PG8_LDA(At, 1, 1); PG8_STAGE(PG8_SB(1, 0), b3, voffB); PG8_STAGE(PG8_SB(1, 1), b3 + hstepB, voffB); PG8_STAGE(PG8_SA(1, 0), a3, voffA);
            PG8_WAIT_V(8); PG8_WAIT_L(0); PG8_BAR; PG8_MMA(1, 0, At, B0); PG8_MMA(1, 1, At, B1); PG8_BAR; PG8_SCHED;
            } else {
            PG8_LDB(B0, 0, 0); PG8_SCHED; PG8_LDA(At, 0, 0); PG8_STAGE(PG8_SA(1, 1), a1 + hstepA, voffA);
            PG8_WAIT_L(8); PG8_BAR; PG8_WAIT_L(0); PG8_MMA(0, 0, At, B0); PG8_BAR; PG8_SCHED;
            PG8_LDB(B1, 0, 1); PG8_STAGE(PG8_SB(0, 0), b2, voffB);
            PG8_BAR; PG8_WAIT_L(0); PG8_MMA(0, 1, At, B1); PG8_BAR;
            PG8_LDA(At, 0, 1); PG8_STAGE(PG8_SA(0, 0), a2, voffA);
            PG8_BAR; PG8_WAIT_L(0); PG8_MMA(1, 0, At, B0); PG8_BAR; PG8_SCHED;
            PG8_STAGE(PG8_SB(0, 1), b2 + hstepB, voffB);
            PG8_WAIT_V(6); PG8_BAR; PG8_MMA(1, 1, At, B1); PG8_BAR;
            PG8_LDB(B0, 1, 0); PG8_SCHED; PG8_LDA(At, 1, 0); PG8_STAGE(PG8_SA(0, 1), a2 + hstepA, voffA);
            PG8_WAIT_L(8); PG8_BAR; PG8_WAIT_L(0); PG8_MMA(0, 0, At, B0); PG8_BAR; PG8_SCHED;
            PG8_LDB(B1, 1, 1); PG8_STAGE(PG8_SB(1, 0), b3, voffB);
            PG8_BAR; PG8_WAIT_L(0); PG8_MMA(0, 1, At, B1); PG8_BAR;
            PG8_LDA(At, 1, 1); PG8_STAGE(PG8_SA(1, 0), a3, voffA);
            PG8_BAR; PG8_WAIT_L(0); PG8_MMA(1, 0, At, B0); PG8_BAR; PG8_SCHED;
            PG8_STAGE(PG8_SB(1, 1), b3 + hstepB, voffB);
            PG8_WAIT_V(6); PG8_BAR; PG8_MMA(1, 1, At, B1); PG8_BAR;
            }
        }
        if constexpr (ALIGN_EPI) { if (wr == 0) PG8_BAR; }
        if constexpr (!Epi::AFTER_DRAIN) { E(acc, cur, wr, wc, fr, fq); S.done(cur); }
        if (!has_next) break;
#pragma unroll
        for (int a = 0; a < 2; ++a)
#pragma unroll
            for (int b = 0; b < 2; ++b)
#pragma unroll
                for (int m = 0; m < 4; ++m)
#pragma unroll
                    for (int n = 0; n < 2; ++n) acc[a][b][m][n] = (f32x4){0.f, 0.f, 0.f, 0.f};
        cur = nxt; cA = nA; cB = nB; ++ui;
        if constexpr (ALIGN_EPI) { if (wr == 1) PG8_BAR; }
    }
    PG8_WAIT_V(0);
    if constexpr (!ALIGN_EPI) { if (wr == 0) PG8_BAR; }
    PG8_BAR;
#undef PG8_SA
#undef PG8_SB
#undef PG8_STAGE
#undef PG8_LDA
#undef PG8_LDB
#undef PG8_MMA
#undef PG8_WAIT_V
#undef PG8_WAIT_L
#undef PG8_BAR
#undef PG8_SCHED
}
}

#define XB_TMO      128
#define XB_XCNT(j)  (256  + 64 * (j))
#define XB_XSUB(j)  (1280 + 64 * (j))
#define XB_XGEN(j)  (2304 + 64 * (j))
#define XB_TOP      3328
#define XB_TOPGEN   3392
#define XCD_BAR_WORDS 3456
#define XB_SPIN_CAP (1u << 18)
__device__ __forceinline__ unsigned xb_ld(unsigned* p)              { return __hip_atomic_load(p, __ATOMIC_RELAXED, __HIP_MEMORY_SCOPE_AGENT); }
__device__ __forceinline__ unsigned xb_add(unsigned* p, unsigned v) { return __hip_atomic_fetch_add(p, v, __ATOMIC_RELAXED, __HIP_MEMORY_SCOPE_AGENT); }
__device__ __forceinline__ unsigned xb_xcc_id() { return (unsigned)__builtin_amdgcn_s_getreg((3 << 11) | 20) & 0xFu; }
#define XB_SPIN(cond, bar) do { unsigned _sp = 0; while (cond) { __builtin_amdgcn_s_sleep(1); \
    if ((++_sp & 255u) == 0u) { if (xb_ld(&(bar)[XB_TMO])) break; if (_sp > XB_SPIN_CAP) { atomicAdd(&(bar)[XB_TMO], 1u); break; } } } } while (0)
struct XcdBarrier { unsigned* bar; unsigned x; volatile LAS unsigned* st; int wave0; };
__device__ __forceinline__ XcdBarrier xcd_barrier_post(unsigned* bar, volatile LAS unsigned* st, int wave0) {
    XcdBarrier b; b.bar = bar; b.x = xb_xcc_id(); b.st = st; b.wave0 = wave0;
    if (wave0 == 0 && fresh_lane() == 0) (void)xb_add(&bar[XB_XCNT(b.x)], 1u);
    return b;
}
__device__ __forceinline__ void xcd_barrier_complete(unsigned* bar, unsigned x, unsigned& nloc, unsigned& nx) {
    const unsigned G = gridDim.x * gridDim.y * gridDim.z;
    unsigned sum, cnt, mine, sp = 0u;
    for (;;) {
        sum = 0u; cnt = 0u; mine = 0u;
#pragma unroll
        for (unsigned j = 0; j < 16; ++j) { const unsigned c = xb_ld(&bar[XB_XCNT(j)]); sum += c; cnt += (c > 0u) ? 1u : 0u; mine = (j == x) ? c : mine; }
        if (sum == G) break;
        __builtin_amdgcn_s_sleep(1);
        if ((++sp & 255u) == 0u) { if (xb_ld(&bar[XB_TMO])) break; if (sp > XB_SPIN_CAP) { atomicAdd(&bar[XB_TMO], 1u); break; } }
    }
    nloc = mine > 0u ? mine : 1u; nx = cnt > 0u ? cnt : 1u;
}
__device__ __forceinline__ void xcd_barrier(const XcdBarrier& b) {
    asm volatile("s_waitcnt vmcnt(0)" ::: "memory");
    __syncthreads();
    if (b.wave0 == 0 && fresh_lane() == 0) {
        unsigned* bar = b.bar;
        __builtin_amdgcn_s_waitcnt(0);
        unsigned nloc = b.st[0], nx = b.st[1];
        if (nloc == 0u) { xcd_barrier_complete(bar, b.x, nloc, nx); b.st[0] = nloc; b.st[1] = nx; }
        const unsigned old = xb_add(&bar[XB_XSUB(b.x)], 1u);
        const unsigned gen = old / nloc;
        if (old + 1u == (gen + 1u) * nloc) {
            __builtin_amdgcn_fence(__ATOMIC_RELEASE, "agent");
            asm volatile("s_waitcnt vmcnt(0)" ::: "memory");
            const unsigned og = xb_add(&bar[XB_TOP], 1u);
            const unsigned tg = og / nx;
            if (og + 1u == (tg + 1u) * nx) xb_add(&bar[XB_TOPGEN], 1u);
            else XB_SPIN(xb_ld(&bar[XB_TOPGEN]) == tg, bar);
            __builtin_amdgcn_fence(__ATOMIC_ACQUIRE, "agent");
            xb_add(&bar[XB_XGEN(b.x)], 1u);
            asm volatile("s_waitcnt vmcnt(0)" ::: "memory");
        } else {
            XB_SPIN(xb_ld(&bar[XB_XGEN(b.x)]) == gen, bar);
            __builtin_amdgcn_fence(__ATOMIC_ACQUIRE, "agent");
            asm volatile("s_waitcnt vmcnt(0)" ::: "memory");
        }
    }
    __syncthreads();
}

struct Args { const float* in[24]; float* out; unsigned char* ws; float freq64[32]; float freq32[16]; int ph_lo, ph_hi; };
enum { I_XP = 0, I_XS, I_CMLA, I_CDSA, I_CSB, I_CDIFF, I_N1, I_G1, I_U1, I_D1, I_NM, I_WIN, I_QN, I_WQB, I_KVN, I_WKVB, I_LAM, I_DN, I_WO, I_N2, I_G2, I_U2, I_D2, I_FN };

__host__ __device__ __forceinline__ int mycol(int j) {
    if (j < 256) return j;
    if (j < 384) return 7 * 256 + (j - 256);
    if (j < 416) { const int t = j - 384; return 4 * 256 + (t >> 4) * 128 + 64 + (t & 15); }
    if (j < 672) { const int t = j - 416; return 1 * 256 + ((t >> 5) & 1) * 128 + (t >> 6) * 32 + (t & 31); }
    if (j < 736) { const int t = j - 672; return 4 * 256 + (t >> 5) * 128 + (t & 31); }
    if (j < 800) return 7 * 256 + 128 + (j - 736);
    if (j < 1312) { const int t = j - 800, h8 = t >> 6; return (2 + (h8 >> 2)) * 256 + ((t >> 5) & 1) * 128 + (h8 & 3) * 32 + (t & 31); }
    if (j < 1376) { const int t = j - 1312; return 4 * 256 + (t >> 5) * 128 + 32 + (t & 31); }
    if (j < 1384) return 7 * 256 + 128 + 64 + (j - 1376);
    if (j < 1640) return 8 * 256 + (j - 1384);
    if (j < 1896) return 9 * 256 + (j - 1640);
    if (j < 2152) return 10 * 256 + (j - 1896);
    if (j < 2408) { const int t = j - 2152; return 5 * 256 + ((t >> 4) & 1) * 128 + (t >> 5) * 16 + (t & 15); }
    if (j < 2664) { const int t = j - 2408; return 6 * 256 + ((t >> 4) & 1) * 128 + (t >> 5) * 16 + (t & 15); }
    return 11 * 256 + (j - 2664);
}
__host__ __device__ __forceinline__ bool mycol_is_pad(int np) { const int t = np >> 8, c = np & 127, hf = (np >> 7) & 1; return (t == 4 && c >= 80) || (t == 7 && hf == 1 && c >= 72); }
typedef __attribute__((address_space(4))) const char* kaptr_t;
__device__ __forceinline__ kaptr_t kargs() { kaptr_t p = (kaptr_t)__builtin_amdgcn_kernarg_segment_ptr(); asm volatile("" : "+s"(p)); return p; }
typedef const float* cfp_t; typedef float* fp_t; typedef unsigned char* ucp_t;
typedef __attribute__((address_space(4))) const cfp_t* ka_cfp_t; typedef __attribute__((address_space(4))) const fp_t* ka_fp_t; typedef __attribute__((address_space(4))) const ucp_t* ka_ucp_t;
typedef __attribute__((address_space(4))) const float* ka_f_t; typedef __attribute__((address_space(4))) const int* ka_i_t;
#define GLB __attribute__((address_space(1)))
#define ARG_IN(i) ((const float*)(GLB const float*)(*(ka_cfp_t)(kargs() + 8 * (i))))
#define ARG_OUT (*(ka_fp_t)(kargs() + 192))
#define ARG_WS (*(ka_ucp_t)(kargs() + 200))
#define ARG_FREQ64(j) (((ka_f_t)(kargs() + 208))[j])
#define ARG_FREQ32(j) (((ka_f_t)(kargs() + 336))[j])
#define ARG_PH_LO (*(ka_i_t)(kargs() + 400))
#define ARG_PH_HI (*(ka_i_t)(kargs() + 404))
static_assert(sizeof(Args) == 408, "kernarg offsets above follow struct Args");
template <int MAP> __device__ __forceinline__ int rowmap(int n) {
    if (MAP == 1) return (n >> 7) * 256 + (n & 127);
    if (MAP == 2) return (n >> 7) * 256 + 128 + (n & 127);
    if (MAP == 3) return FUSE_POST ? mycol(n) : (n < 1376 ? n : (n < 1384 ? H_WI + (n - 1376) : n - 8));
    return n;
}
template <int MAP> __device__ __forceinline__ void transpose_item(const float* W, int K, int N, const float* g, bf16* dst, int ldd, int koff, LAS float* scr, int item, int lane) {
    const int nblk = (N + 31) / 32, kb = item / nblk, nb = item % nblk, k0 = 64 * kb, n0 = 32 * nb;
    const int nn = n0 + (lane & 31); const bool nok = nn < N;
    float tv[32];
#pragma unroll
    for (int i = 0; i < 32; ++i) { const int kk = 2 * i + (lane >> 5); tv[i] = nok ? W[(size_t)(k0 + kk) * N + nn] : 0.f; }
#pragma unroll
    for (int i = 0; i < 32; ++i) { const int kk = 2 * i + (lane >> 5); float v = tv[i]; if (g) v *= g[k0 + kk]; scr[kk * 33 + (lane & 31)] = v; }
    LDS_WAIT(); asm volatile("" ::: "memory");
    const int c = lane & 7;
#pragma unroll
    for (int j = 0; j < 4; ++j) { const int n = (lane >> 3) + 8 * j; const LAS float* s = scr + (8 * c) * 33 + n;
        v4u o; o.x = pk2(s[0 * 33], s[1 * 33]); o.y = pk2(s[2 * 33], s[3 * 33]); o.z = pk2(s[4 * 33], s[5 * 33]); o.w = pk2(s[6 * 33], s[7 * 33]);
        if (n0 + n < N) *(v4u*)(dst + (size_t)rowmap<MAP>(n0 + n) * ldd + koff + k0 + 8 * c) = o; }
    LDS_WAIT(); asm volatile("" ::: "memory");
}
__device__ __forceinline__ void sincos_acc(float ang, float& sn, float& cs) {
    const double a = (double)ang; const double k = rint(a * 0.15915494309189533577); const double x = fma(-k, 6.283185307179586476925, a); const double x2 = x * x;
    double s = 1.0, c = 1.0;
#pragma unroll
    for (int n = 14; n >= 1; --n) { s = 1.0 - x2 * (1.0 / (double)((2 * n) * (2 * n + 1))) * s; c = 1.0 - x2 * (1.0 / (double)((2 * n - 1) * (2 * n))) * c; }
    sn = (float)(x * s); cs = (float)c;
}

#define MFMA32(a, b, c) __builtin_amdgcn_mfma_f32_32x32x16_bf16((a), (b), (c), 0, 0, 0)
__device__ __forceinline__ f32x16 zero16() { f32x16 z;
#pragma unroll
    for (int i = 0; i < 16; ++i) z[i] = 0.f; return z; }
__device__ __forceinline__ s16x4 vtr(const LAS char* p) { return __builtin_bit_cast(s16x4, __builtin_amdgcn_ds_read_tr16_b64_v4i16((LAS s16x4*)p)); }
template <int BASE> __device__ __forceinline__ bf16x8 pack8(const f32x16& p) {
    v4u w; w.x = cvtpk(p[BASE], p[BASE + 1]); w.y = cvtpk(p[BASE + 2], p[BASE + 3]); w.z = cvtpk(p[BASE + 4], p[BASE + 5]); w.w = cvtpk(p[BASE + 6], p[BASE + 7]);
    return __builtin_bit_cast(bf16x8, w);
}
template <int NS> __device__ __forceinline__ void qk(f32x16& p0, f32x16& p1, const LAS char* kb, int strideB, const bf16x8 (&q)[NS]) {
    p0 = zero16(); p1 = zero16();
#pragma unroll
    for (int s = 0; s < NS; ++s) {
        const bf16x8 a0 = *(const LAS bf16x8*)(kb + s * 32);
        const bf16x8 a1 = *(const LAS bf16x8*)(kb + 32 * strideB + s * 32);
        p0 = MFMA32(a0, q[s], p0); p1 = MFMA32(a1, q[s], p1);
    }
}
template <int NDB> __device__ __forceinline__ void pv(f32x16 (&o)[NDB], const f32x16& p0, const f32x16& p1, const LAS char* vb, int strideB) {
    const bf16x8 pb0 = pack8<0>(p0), pb1 = pack8<8>(p0), pb2 = pack8<0>(p1), pb3 = pack8<8>(p1);
#pragma unroll
    for (int kk = 0; kk < 4; ++kk) {
        const bf16x8 pb = kk == 0 ? pb0 : (kk == 1 ? pb1 : (kk == 2 ? pb2 : pb3));
#pragma unroll
        for (int db = 0; db < NDB; ++db) {
            const s16x4 lo = vtr(vb + (16 * kk) * strideB + db * 64);
            const s16x4 hh = vtr(vb + (16 * kk + 8) * strideB + db * 64);
            const bf16x8 a = __builtin_shufflevector(lo, hh, 0, 1, 2, 3, 4, 5, 6, 7);
            o[db] = MFMA32(a, pb, o[db]);
        }
    }
}
template <int NS> __device__ __forceinline__ void k_ld(bf16x8 (&k)[2 * NS], const LAS char* kb, int strideB) {
#pragma unroll
    for (int s = 0; s < NS; ++s) { k[2 * s] = *(const LAS bf16x8*)(kb + s * 32); k[2 * s + 1] = *(const LAS bf16x8*)(kb + 32 * strideB + s * 32); }
}
template <int NS> __device__ __forceinline__ void qk_r(f32x16& p0, f32x16& p1, const bf16x8 (&k)[2 * NS], const bf16x8 (&q)[NS]) {
    p0 = zero16(); p1 = zero16();
#pragma unroll
    for (int s = 0; s < NS; ++s) { p0 = MFMA32(k[2 * s], q[s], p0); p1 = MFMA32(k[2 * s + 1], q[s], p1); }
}
template <int NDB> __device__ __forceinline__ void v_ld(bf16x8 (&v)[4 * NDB], const LAS char* vb, int strideB) {
#pragma unroll
    for (int kk = 0; kk < 4; ++kk)
#pragma unroll
        for (int db = 0; db < NDB; ++db) {
            const s16x4 lo = vtr(vb + (16 * kk) * strideB + db * 64);
            const s16x4 hh = vtr(vb + (16 * kk + 8) * strideB + db * 64);
            v[kk * NDB + db] = __builtin_shufflevector(lo, hh, 0, 1, 2, 3, 4, 5, 6, 7);
        }
}
template <int NDB> __device__ __forceinline__ void pv_r(f32x16 (&o)[NDB], const f32x16& p0, const f32x16& p1, const bf16x8 (&v)[4 * NDB]) {
    const bf16x8 pb0 = pack8<0>(p0), pb1 = pack8<8>(p0), pb2 = pack8<0>(p1), pb3 = pack8<8>(p1);
#pragma unroll
    for (int kk = 0; kk < 4; ++kk) {
        const bf16x8 pb = kk == 0 ? pb0 : (kk == 1 ? pb1 : (kk == 2 ? pb2 : pb3));
#pragma unroll
        for (int db = 0; db < NDB; ++db) o[db] = MFMA32(v[kk * NDB + db], pb, o[db]);
    }
}
template <int NDB> __device__ __forceinline__ void softmax_step(f32x16& p0, f32x16& p1, float& m, float& l, f32x16 (&o)[NDB]) {
    float mx = p0[0];
#pragma unroll
    for (int r = 1; r < 16; ++r) mx = fmaxf(mx, p0[r]);
#pragma unroll
    for (int r = 0; r < 16; ++r) mx = fmaxf(mx, p1[r]);
    { const unsigned ux_ = __float_as_uint(mx); const auto sw_ = __builtin_amdgcn_permlane32_swap(ux_, ux_, false, false);
      mx = fmaxf(__uint_as_float(sw_[0]), __uint_as_float(sw_[1])); }
    const float mn = fmaxf(m, mx);
    if (__any(mn > m)) {
        const float alpha = __builtin_amdgcn_exp2f(m - mn);
        l *= alpha;
#pragma unroll
        for (int db = 0; db < NDB; ++db)
#pragma unroll
            for (int r = 0; r < 16; ++r) o[db][r] *= alpha;
    }
    m = mn;
    typedef float f32x2_t __attribute__((ext_vector_type(2)));
    const f32x2_t mn2 = {mn, mn}; f32x2_t s2 = {0.f, 0.f};
#pragma unroll
    for (int r = 0; r < 8; ++r) { f32x2_t d = {p0[2 * r], p0[2 * r + 1]}; d -= mn2; d.x = __builtin_amdgcn_exp2f(d.x); d.y = __builtin_amdgcn_exp2f(d.y); p0[2 * r] = d.x; p0[2 * r + 1] = d.y; s2 += d; }
#pragma unroll
    for (int r = 0; r < 8; ++r) { f32x2_t d = {p1[2 * r], p1[2 * r + 1]}; d -= mn2; d.x = __builtin_amdgcn_exp2f(d.x); d.y = __builtin_amdgcn_exp2f(d.y); p1[2 * r] = d.x; p1[2 * r + 1] = d.y; s2 += d; }
    l += s2.x + s2.y;
}
__device__ __forceinline__ v4u cvt8f(const v4u a, const v4u b) {
    const unsigned a0 = a[0], a1 = a[1], a2 = a[2], a3 = a[3], b0 = b[0], b1 = b[1], b2 = b[2], b3 = b[3]; v4u v;
    v[0] = cvtpk(__uint_as_float(a0), __uint_as_float(a1)); v[1] = cvtpk(__uint_as_float(a2), __uint_as_float(a3));
    v[2] = cvtpk(__uint_as_float(b0), __uint_as_float(b1)); v[3] = cvtpk(__uint_as_float(b2), __uint_as_float(b3)); return v; }
template <int W, int STRIDE, bool F32PF = true, int ROWS = 64> struct TileLd {
    static constexpr int CH = W / 8, RPP = 512 / CH, PER = (ROWS + RPP - 1) / RPP, STRB = (W + 8) * 2;
    int nrows_ = ROWS;
    v4u raw[PER][F32PF ? 2 : 1];
    const char* src_;
    __device__ __forceinline__ void init() { src_ = nullptr;
#pragma unroll
        for (int i = 0; i < PER; ++i) { raw[i][0] = (v4u){0u, 0u, 0u, 0u}; raw[i][F32PF ? 1 : 0] = (v4u){0u, 0u, 0u, 0u}; } }
    __device__ __forceinline__ void issue(const void* src, bool f32, int tid) {
        src_ = (const char*)src;
        if (!F32PF && f32) return;
        const int row0 = tid / CH, cc = tid % CH; const bool act = tid < RPP * CH;
        const unsigned loff = (unsigned)(row0 * STRIDE + cc * 8);
#pragma unroll
        for (int i = 0; i < PER; ++i) {
            if (act && (row0 + i * RPP < nrows_)) {
                if (F32PF && f32) { const GLB v4u* p = (const GLB v4u*)(src_ + (size_t)i * RPP * STRIDE * 4 + (size_t)loff * 4); raw[i][0] = p[0]; raw[i][F32PF ? 1 : 0] = p[1]; }
                else { raw[i][0] = *(const GLB v4u*)(src_ + (size_t)i * RPP * STRIDE * 2 + (size_t)loff * 2); } } }
    }
    __device__ __forceinline__ static v4u cvt8(const v4u a, const v4u b) { return cvt8f(a, b); }
    __device__ __forceinline__ void store(LAS char* tile, bool f32, int tid) {
        const int row0 = tid / CH, cc = tid % CH; const bool act = tid < RPP * CH;
        const unsigned loff = (unsigned)(row0 * STRIDE + cc * 8);
        LAS char* dst = tile + row0 * STRB + cc * 16;
#pragma unroll
        for (int i = 0; i < PER; ++i) {
            if (act && (row0 + i * RPP < nrows_)) { v4u v = raw[i][0];
                if (f32) {
                    if (F32PF) v = cvt8(raw[i][0], raw[i][F32PF ? 1 : 0]);
                    else { const GLB v4u* p = (const GLB v4u*)(src_ + (size_t)i * RPP * STRIDE * 4 + (size_t)loff * 4); v = cvt8(p[0], p[1]); } }
                *(LAS v4u*)(dst + i * RPP * STRB) = v; } }
    }
};
constexpr int T512_STRB = 1040, T512_BYTES = 64 * T512_STRB;
__device__ __forceinline__ void t512_dma(const void* src, LAS char* buf, int wave, int lane) {
#pragma unroll
    for (int j = 0; j < 8; ++j) { const int row = wave * 8 + j;
        __builtin_amdgcn_global_load_lds((const unsigned*)((const char*)src + (size_t)row * 1024 + lane * 16), (LAS unsigned*)(buf + row * T512_STRB), 16, 0, 0); }
}
__device__ __forceinline__ void t512_cvt(const void* src, LAS char* buf, int tid) {
    const int row0 = tid >> 6, cc = tid & 63; const char* p0 = (const char*)src + (size_t)row0 * 2048 + cc * 32; LAS char* d0 = buf + row0 * T512_STRB + cc * 16;
    v4u a[8], b[8];
#pragma unroll
    for (int i = 0; i < 8; ++i) { const GLB v4u* p = (const GLB v4u*)(p0 + (size_t)i * 8 * 2048); a[i] = p[0]; b[i] = p[1]; }
    __builtin_amdgcn_sched_barrier(0);
#pragma unroll
    for (int i = 0; i < 8; ++i) *(LAS v4u*)(d0 + i * 8 * T512_STRB) = cvt8f(a[i], b[i]);
}
__device__ __forceinline__ int crow(int r, int hi) { return (r & 3) + 8 * (r >> 2) + 4 * hi; }

struct UnitId { int sample, b, c, nt, qrow0, krow0; };
constexpr int QLIST = 4 + 4 * 32;
__device__ __forceinline__ UnitId decode_unit(int x, int idx) {
    UnitId u;
    if (idx < 4) { u.sample = 1; u.b = x + 8 * idx; u.c = 0; u.nt = PAST / 64 + 1; u.qrow0 = MP + u.b * DSEQ; u.krow0 = MP + u.b * DSEQ; }
    else { const int j = idx - 4; u.sample = 0; u.c = 31 - (j & 31); u.b = x + 8 * (j >> 5); u.nt = u.c + 1; u.qrow0 = u.b * SEQ + u.c * 64; u.krow0 = u.b * SEQ; }
    return u;
}
constexpr int N_UNITS = NB + NB * (SEQ / 64);

__device__ __forceinline__ const void* tile_src(const UnitId& u, int t, const float* cache_lb  , const bf16* rows, int W, int coloff, bool& f32) {
    if (u.sample && t < PAST / 64) { f32 = true; return cache_lb + (size_t)t * 64 * W + coloff; }
    f32 = false; const int tt = u.sample ? 0 : t;
    return rows + (size_t)(u.krow0 + tt * 64) * W + coloff;
}

template <int NQ> __device__ __forceinline__ void hist_pick(LAS unsigned* hist, int lane, int (&kk)[NQ], int (&bin_out)[NQ], unsigned (&cnt_out)[NQ], const bool (&act)[NQ]) {
    unsigned sl[NQ], incl[NQ];
#pragma unroll
    for (int a = 0; a < NQ; ++a) { sl[a] = 0u;
#pragma unroll
        for (int j = 0; j < 8; ++j) { const v4u c4 = ((LAS v4u*)(hist + a * 2048))[lane * 8 + j]; sl[a] += (c4[0] + c4[1]) + (c4[2] + c4[3]); }
        incl[a] = sl[a]; }
#pragma unroll
    for (int o = 1; o < 64; o <<= 1) {
        unsigned t2[NQ];
#pragma unroll
        for (int a = 0; a < NQ; ++a) t2[a] = (unsigned)__shfl_down((int)incl[a], o);
#pragma unroll
        for (int a = 0; a < NQ; ++a) incl[a] += (lane + o < 64) ? t2[a] : 0u; }
    int hl[NQ]; unsigned above_h[NQ], v[NQ], inc2[NQ];
#pragma unroll
    for (int a = 0; a < NQ; ++a) { const unsigned above_l = incl[a] - sl[a]; const bool hit = (above_l < (unsigned)kk[a]) && ((unsigned)kk[a] <= incl[a]);
        const unsigned long long hb = __ballot(hit); hl[a] = hb ? (int)__builtin_ctzll(hb) : 0; above_h[a] = (unsigned)__builtin_amdgcn_readlane((int)above_l, hl[a]);
        v[a] = (lane < 32) ? hist[a * 2048 + hl[a] * 32 + lane] : 0u; inc2[a] = v[a]; }
#pragma unroll
    for (int o = 1; o < 32; o <<= 1) {
        unsigned t2[NQ];
#pragma unroll
        for (int a = 0; a < NQ; ++a) t2[a] = (unsigned)__shfl_down((int)inc2[a], o);
#pragma unroll
        for (int a = 0; a < NQ; ++a) inc2[a] += (lane + o < 32) ? t2[a] : 0u; }
#pragma unroll
    for (int a = 0; a < NQ; ++a) { const unsigned above2 = above_h[a] + inc2[a] - v[a];
        const bool hit2 = (lane < 32) && (above2 < (unsigned)kk[a]) && ((unsigned)kk[a] <= above2 + v[a]);
        const unsigned long long hb2 = __ballot(hit2); const int l2 = hb2 ? (int)__builtin_ctzll(hb2) : 0;
        if (act[a]) { bin_out[a] = hl[a] * 32 + l2; kk[a] -= __builtin_amdgcn_readlane((int)above2, l2); cnt_out[a] = (unsigned)__builtin_amdgcn_readlane((int)v[a], l2); } }
}
template <int NI, int NQ, int ES = 1> __device__ __forceinline__ void dsa_select(const float* srow, int nt, LAS unsigned* hist, unsigned long long* mrow, int lane) {
    float xv[NQ][NI]; float lo[NQ], hi[NQ];
#pragma unroll
    for (int a = 0; a < NQ; ++a) { lo[a] = 3e38f; hi[a] = -3e38f; }
    { const int nt_ = opaque_s(nt);
#pragma unroll
    for (int i = 0; i < NI; ++i) {
#pragma unroll
        for (int a = 0; a < NQ; ++a) xv[a][i] = 0.f;
        if (i < nt_) {
#pragma unroll
            for (int a = 0; a < NQ; ++a) { xv[a][i] = srow[(size_t)a * SC_LS + (size_t)(i * 64 + lane) * ES]; lo[a] = fminf(lo[a], xv[a][i]); hi[a] = fmaxf(hi[a], xv[a][i]); } } } }
#pragma unroll
    for (int o = 1; o < 64; o <<= 1)
#pragma unroll
        for (int a = 0; a < NQ; ++a) { lo[a] = fminf(lo[a], __shfl_xor(lo[a], o)); hi[a] = fmaxf(hi[a], __shfl_xor(hi[a], o)); }
    float scale[NQ]; int kk[NQ], b0[NQ]; unsigned c0n[NQ];
#pragma unroll
    for (int a = 0; a < NQ; ++a) { const float range = hi[a] - lo[a]; scale[a] = (range > 1e-30f) ? 2047.0f / range : 0.f; kk[a] = 256; b0[a] = 0; c0n[a] = 0u; }
#pragma unroll
    for (int j = 0; j < 8 * NQ; ++j) ((LAS v4u*)hist)[lane + 64 * j] = (v4u){0u, 0u, 0u, 0u};
    LDS_WAIT();
    { const int nt_ = opaque_s(nt); float sc_[NQ];
#pragma unroll
    for (int a = 0; a < NQ; ++a) sc_[a] = opaque_vf(scale[a]);
#pragma unroll
    for (int i = 0; i < NI; ++i) if (i < nt_) {
#pragma unroll
        for (int a = 0; a < NQ; ++a) { const int b = min(2047, (int)((xv[a][i] - lo[a]) * sc_[a])); __hip_atomic_fetch_add(hist + a * 2048 + b, 1u, __ATOMIC_RELAXED, __HIP_MEMORY_SCOPE_WORKGROUP); } } }
    LDS_WAIT();
    { bool all_[NQ];
#pragma unroll
      for (int a = 0; a < NQ; ++a) all_[a] = true;
      hist_pick<NQ>(hist, lane, kk, b0, c0n, all_); }
    unsigned prefix[NQ], pmask[NQ]; bool whole[NQ], live[NQ]; bool any_live = false;
#pragma unroll
    for (int a = 0; a < NQ; ++a) { prefix[a] = 0u; pmask[a] = 0u; whole[a] = ((unsigned)kk[a] == c0n[a]); live[a] = !whole[a]; any_live = any_live || live[a]; }
    if (any_live) {
#pragma unroll
        for (int pass = 0; pass < 3; ++pass) {
            const int SH = pass == 0 ? 21 : (pass == 1 ? 10 : 0); const unsigned BM_ = pass == 2 ? 1023u : 2047u;
#pragma unroll
            for (int j = 0; j < 8 * NQ; ++j) ((LAS v4u*)hist)[lane + 64 * j] = (v4u){0u, 0u, 0u, 0u};
            LDS_WAIT();
            const int nt_ = opaque_s(nt); float sc_[NQ];
#pragma unroll
            for (int a = 0; a < NQ; ++a) sc_[a] = opaque_vf(scale[a]);
#pragma unroll
            for (int i = 0; i < NI; ++i) if (i < nt_) {
#pragma unroll
                for (int a = 0; a < NQ; ++a) { const int b = min(2047, (int)((xv[a][i] - lo[a]) * sc_[a])); const unsigned bts = __float_as_uint(xv[a][i]); const unsigned x = bts ^ ((bts >> 31) ? 0xFFFFFFFFu : 0x80000000u);
                    if (live[a] && b == b0[a] && (x & pmask[a]) == prefix[a]) __hip_atomic_fetch_add(hist + a * 2048 + ((x >> SH) & BM_), 1u, __ATOMIC_RELAXED, __HIP_MEMORY_SCOPE_WORKGROUP); } }
            LDS_WAIT();
            bool more = false; int bin[NQ]; unsigned c_u[NQ];
#pragma unroll
            for (int a = 0; a < NQ; ++a) { bin[a] = 0; c_u[a] = 0u; }
            hist_pick<NQ>(hist, lane, kk, bin, c_u, live);
#pragma unroll
            for (int a = 0; a < NQ; ++a) if (live[a]) {
                prefix[a] |= ((unsigned)bin[a] & BM_) << SH; pmask[a] |= BM_ << SH;
                if ((unsigned)kk[a] == c_u[a]) live[a] = false;
                more = more || live[a]; }
            if (!more) break;
        }
    }
    const int nt2_ = opaque_s(nt); float sc2_[NQ];
#pragma unroll
    for (int a = 0; a < NQ; ++a) sc2_[a] = opaque_vf(scale[a]);
#pragma unroll
    for (int i = 0; i < NI; ++i) if (i < nt2_) {
#pragma unroll
        for (int a = 0; a < NQ; ++a) { const int b = min(2047, (int)((xv[a][i] - lo[a]) * sc2_[a])); const unsigned bts = __float_as_uint(xv[a][i]); const unsigned x = bts ^ ((bts >> 31) ? 0xFFFFFFFFu : 0x80000000u);
            const bool selq = b > b0[a] || (b == b0[a] && (whole[a] || x >= prefix[a]));
            const unsigned long long mw = __ballot(selq); if (lane == 0) mrow[(size_t)a * MK_LS + i] = mw; } }
}
#define FRESH_TID() const int tid_o = wave0 * 64 + fresh_lane(); const int tid = tid_o, lane = tid & 63, wave = __builtin_amdgcn_readfirstlane(tid >> 6); (void)lane; (void)wave
__global__ void __launch_bounds__(NWAVES * 64, 2) fwd_kernel(Args args) {
    extern __shared__ __attribute__((aligned(16))) unsigned char lds_raw[];
    LAS unsigned char* lds = (LAS unsigned char*)lds_raw;
    volatile LAS unsigned* MISC = (volatile LAS unsigned*)(lds + MISC_OFF);
    const int wave0 = __builtin_amdgcn_readfirstlane((int)threadIdx.x >> 6);
    const int tid = wave0 * 64 + fresh_lane();
    const int G = gridDim.x;
    unsigned char* ws = args.ws;
    gu32* ctl = (gu32*)(ws + WS_CTL);
    float* const out = args.out;
#define X (out + O_Y)
#define XB ((bf16*)(ws + WS_XB))
#define HB ((bf16*)(ws + WS_REGA))
#define ACT ((bf16*)(ws + WS_REGA))
#define QA ((bf16*)(ws + WS_QA))
#define QB ((bf16*)(ws + WS_QB))
#define QI ((bf16*)(ws + WS_QI))
#define QC ((bf16*)(ws + WS_QC))
#define QD ((bf16*)(ws + WS_QD))
#define WI ((float*)(ws + WS_WI))
#define RA ((bf16*)(ws + WS_RA))
#define RB ((bf16*)(ws + WS_RB))
#define RC ((bf16*)(ws + WS_RC))
#define RD ((bf16*)(ws + WS_RD))
#define CC ((bf16*)(ws + WS_CC))
#define CQ ((bf16*)(ws + WS_REGA + (size_t)300 * MiB))
#define CKV ((bf16*)(ws + WS_REGA + (size_t)340 * MiB))
#define SSQP ((float*)(ws + WS_SSQP))
#define LAMF ((float*)(ws + WS_MISC))
#define ROPE64 ((float2*)(ws + WS_MISC + MISC_ROPE64))
#define ROPE32 ((float2*)(ws + WS_MISC + MISC_ROPE32))
    for (int u = tid; u < (LDS_BYTES - LDSCTL_OFF) / 4; u += NWAVES * 64) ((LAS unsigned*)(lds + LDSCTL_OFF))[u] = 0u;
    __syncthreads();
    XcdBarrier bar; bar.bar = (unsigned*)(ctl + CW_BAR); bar.x = 0; bar.st = nullptr; bar.wave0 = wave0;
    const int lo = args.ph_lo, hi_ph = args.ph_hi;
    if (hi_ph - lo > 1) bar = xcd_barrier_post((unsigned*)(ctl + CW_BAR), MISC + 8, wave0);
#define IN(k) (opaque_s(lo) <= (k) && (k) < opaque_s(hi_ph))
#define BOTH(k) (IN(k) && IN((k) + 1))
#define GRID_BAR() xcd_barrier(bar)

    if (EN_PH(0) && IN(0)) {
        FRESH_TID();
        for (int p0rep = 0; p0rep < P0_REPS; ++p0rep) {
        LAS float* scr = (LAS float*)(lds + wave * 16384);
        const int gw = blockIdx.x * NWAVES + wave, NGW = G * NWAVES;
        for (int l = 0; l < DEPTH; ++l) {
            unsigned char* wl = ws + WS_W + (size_t)l * W_LAYER;
            const int I_GU = (DM / 64) * (DFF / 32), I_D = (DFF / 64) * (DM / 32), I_INN = (DM / 64) * ((NIN + 31) / 32), I_O = (768 / 64) * (DM / 32);
            const int NIT = 4 * I_GU + 2 * I_D + I_INN + I_O;
            for (int it = gw; it < NIT; it += NGW) {
                int r = it;
                if (r < I_GU) { transpose_item<1>(ARG_IN(I_G1) + (size_t)l * DM * DFF, DM, DFF, ARG_IN(I_N1) + l * DM, (bf16*)(wl + W_GU1), DM, 0, scr, r, lane); continue; } r -= I_GU;
                if (r < I_GU) { transpose_item<2>(ARG_IN(I_U1) + (size_t)l * DM * DFF, DM, DFF, ARG_IN(I_N1) + l * DM, (bf16*)(wl + W_GU1), DM, 0, scr, r, lane); continue; } r -= I_GU;
                if (r < I_GU) { transpose_item<1>(ARG_IN(I_G2) + (size_t)l * DM * DFF, DM, DFF, ARG_IN(I_N2) + l * DM, (bf16*)(wl + W_GU2), DM, 0, scr, r, lane); continue; } r -= I_GU;
                if (r < I_GU) { transpose_item<2>(ARG_IN(I_U2) + (size_t)l * DM * DFF, DM, DFF, ARG_IN(I_N2) + l * DM, (bf16*)(wl + W_GU2), DM, 0, scr, r, lane); continue; } r -= I_GU;
                if (r < I_D) { transpose_item<0>(ARG_IN(I_D1) + (size_t)l * DFF * DM, DFF, DM, nullptr, (bf16*)(wl + W_D1), DFF, 0, scr, r, lane); continue; } r -= I_D;
                if (r < I_D) { transpose_item<0>(ARG_IN(I_D2) + (size_t)l * DFF * DM, DFF, DM, nullptr, (bf16*)(wl + W_D2), DFF, 0, scr, r, lane); continue; } r -= I_D;
                if (r < I_INN) { transpose_item<3>(ARG_IN(I_WIN) + (size_t)l * DM * NIN, DM, NIN, ARG_IN(I_NM) + l * DM, (bf16*)(wl + W_IN), DM, 0, scr, r, lane); continue; } r -= I_INN;
                transpose_item<0>(ARG_IN(I_WO) + (size_t)l * DM * DM + (size_t)256 * DM, 768, DM, nullptr, (bf16*)(wl + W_OUT), KOUT, 512, scr, r, lane);
            }
            const int gt = blockIdx.x * 512 + tid, NGT = G * 512;
            if (FUSE_POST) { for (int i = gt; i < NINP * (DM / 8); i += NGT) { const int np = i / (DM / 8); if (mycol_is_pad(np)) *(v4u*)((bf16*)(wl + W_IN) + (size_t)np * DM + 8 * (i % (DM / 8))) = (v4u){0u, 0u, 0u, 0u}; } }
            else for (int i = gt; i < (NINP - NIN) * DM; i += NGT) ((bf16*)(wl + W_IN))[(size_t)NIN * DM + i] = 0;
            for (int i = gt; i < (NQP - NQ) * 256; i += NGT) ((bf16*)(wl + W_Q))[(size_t)NQ * 256 + i] = 0;
            const float* wqb = ARG_IN(I_WQB) + (size_t)l * 256 * 384; const float* wkvb = ARG_IN(I_WKVB) + (size_t)l * 128 * 512; const float* qn = ARG_IN(I_QN) + l * 256;
            const float scaleA = 0.10206207261596575f * LOG2E;
            for (int i = gt; i < NQ * 256; i += NGT) {
                const int np = i >> 8, k = i & 255, hh = np / 160, c = np % 160; float v;
                if (c < 128) { float s = 0.f; for (int e = 0; e < 64; ++e) s += wqb[(size_t)k * 384 + hh * 96 + e] * wkvb[(size_t)c * 512 + hh * 128 + e]; v = s; }
                else v = wqb[(size_t)k * 384 + hh * 96 + 64 + (c - 128)];
                ((bf16*)(wl + W_Q))[(size_t)np * 256 + k] = (bf16)f2bf(v * qn[k] * scaleA);
            }
            const float* wo = ARG_IN(I_WO) + (size_t)l * DM * DM;
            for (int i = gt; i < 512 * DM; i += NGT) {
                const int n = i & 1023, kc = i >> 10, hh = kc >> 7, c = kc & 127; float s = 0.f;
                for (int e = 0; e < 64; ++e) s += wkvb[(size_t)c * 512 + hh * 128 + 64 + e] * wo[(size_t)(hh * 64 + e) * DM + n];
                ((bf16*)(wl + W_OUT))[(size_t)n * KOUT + kc] = (bf16)f2bf(s);
            }
            if (blockIdx.x == 0 && wave == 0) {
                const float* lf = ARG_IN(I_LAM) + l * 128;
                float a = lane < 32 ? lf[lane] * lf[32 + lane] : 0.f, b = lane < 32 ? lf[64 + lane] * lf[96 + lane] : 0.f;
                a = wave_sum(a); b = wave_sum(b);
                const float lam_init = 0.8f - 0.6f * expf(-0.3f * (float)l);
                if (lane == 0) LAMF[l] = expf(a) - expf(b) + lam_init;
            }
        }
        {
            const int gt = blockIdx.x * 512 + tid, NGT = G * 512;
            for (int i = gt; i < 2112 * 48; i += NGT) {
                const int pidx = i / 48, j = i % 48; const float pos = (float)(pidx < 2048 ? pidx : 4096 + (pidx - 2048));
                const float fr = j < 32 ? ARG_FREQ64(j) : ARG_FREQ32(j - 32);
                float sn, cs; sincos_acc(pos * fr, sn, cs);
                if (j < 32) ROPE64[pidx * 32 + j] = make_float2(cs, sn); else ROPE32[pidx * 16 + (j - 32)] = make_float2(cs, sn);
            }
        }
        for (int m = 2 * gw; m < M; m += 2 * NGW) {
            f32x4 v[2][4]; float sq[2];
#pragma unroll
            for (int r2 = 0; r2 < 2; ++r2) { const int mr = m + r2; const float* xr = (mr < MP) ? ARG_IN(I_XP) + (size_t)mr * DM : ARG_IN(I_XS) + (size_t)(mr - MP) * DM; const f32x4* x4 = (const f32x4*)xr + lane;
#pragma unroll
                for (int j = 0; j < 4; ++j) v[r2][j] = x4[64 * j]; }
#pragma unroll
            for (int r2 = 0; r2 < 2; ++r2) { const int mr = m + r2; float s2 = 0.f; unsigned long long* o8 = (unsigned long long*)(XB + (size_t)mr * DM) + lane;
#pragma unroll
                for (int j = 0; j < 4; ++j) { const f32x4 w = v[r2][j]; s2 += (w.x * w.x + w.y * w.y) + (w.z * w.z + w.w * w.w);
                    o8[64 * j] = (unsigned long long)cvtpk(w.x, w.y) | ((unsigned long long)cvtpk(w.z, w.w) << 32); }
                sq[r2] = wave_sum(s2); }
#pragma unroll
            for (int r2 = 0; r2 < 2; ++r2) if (lane < 16) SSQP[(size_t)(m + r2) * 16 + lane] = lane == 0 ? sq[r2] : 0.f;
        }
        }
        if (BOTH(0)) GRID_BAR();
    }

#pragma unroll 1
    for (int l = 0; l < DEPTH; ++l) {
        const int pb = 1 + 8 * l;
        unsigned char* wl = ws + WS_W + (size_t)l * W_LAYER;
        float* ssqA = SSQP + (size_t)l * M * 16; float* ssqAn = SSQP + (size_t)(l + 1) * M * 16; float* ssqB = SSQP + (size_t)(3 + l) * M * 16; float* ssqC = SSQP + (size_t)(5 + l) * M * 16; float* ssqQ = SSQP + (size_t)7 * M * 16 + (size_t)l * M * 4; float* ssqK = SSQP + (size_t)7 * M * 16 + (size_t)(2 + l) * M * 4; (void)ssqK;
        if (EN_PH(1) && IN(pb + 0)) {
            pg8::Gemm g{XB, (const bf16*)(wl + W_GU1), M, NGU, DM, DM}; pg8::StaticOrder S; S.init(M, NGU, G, (int)blockIdx.x);
            pg8::EpiSwiGLU E{ACT, ssqA};
            for (int grep = 0; grep < GU_REPS; ++grep)
            pg8::gemm_phase<pg8::EpiSwiGLU, pg8::StaticOrder, true, true>(lds, g, S, E, wave0);
            if (BOTH(pb + 0)) GRID_BAR();
        }
#define SPLITK_SAMPLE(WOFF) do { if ((int)blockIdx.x < 128) { const int sl_ = (int)blockIdx.x & 3, un_ = (int)blockIdx.x >> 2; const int kb_ = sl_ < 2 ? 6 * sl_ : 12 + 5 * (sl_ - 2), kl_ = sl_ < 2 ? 6 : 5; \
        pg8::Gemm g2{ACT + (size_t)(MP + 256 * (un_ >> 2)) * DFF + kb_ * 128, (const bf16*)(wl + WOFF) + (size_t)(256 * (un_ & 3)) * DFF + kb_ * 128, 256, 256, kl_ * 128, DFF, DFF}; \
        pg8::OneUnit S2; pg8::EpiPartial E2{(float*)(ws + WS_QA) + (size_t)(un_ * 8 + sl_) * 32 * 512 * 4}; \
        pg8::gemm_phase<pg8::EpiPartial, pg8::OneUnit, true, true>(lds, g2, S2, E2, wave0); } } while (0)
        if (EN_PH(2) && IN(pb + 1)) {
            pg8::Gemm g{ACT, (const bf16*)(wl + W_D1), M, DM, DFF, DFF}; pg8::StaticOrder S; S.init(MP, DM, G, (int)blockIdx.x);
            if (l == 0) { pg8::EpiResid<true> E{ARG_IN(I_XP), ARG_IN(I_XS) - (size_t)MP * DM, XB, ssqB, 0.5f};
                pg8::gemm_phase<pg8::EpiResid<true>, pg8::StaticOrder, true, true>(lds, g, S, E, wave0); }
            else { pg8::EpiResid<false> E{nullptr, nullptr, XB, ssqB, 0.5f};
                pg8::gemm_phase<pg8::EpiResid<false>, pg8::StaticOrder, true, true>(lds, g, S, E, wave0); }
            SPLITK_SAMPLE(W_D1);
            GRID_BAR();
            { FRESH_TID(); const int un_ = (int)blockIdx.x >> 3, j_ = (int)blockIdx.x & 7; const float* Pu = (const float*)(ws + WS_QA) + (size_t)un_ * 8 * 32 * 512 * 4;
              if (l == 0) pg8::resid_fixup<true>(Pu, MP / 256 + (un_ >> 2), un_ & 3, j_ >> 2, j_ & 3, ARG_IN(I_XS) - (size_t)MP * DM, XB, ssqB, 0.5f, tid);
              else pg8::resid_fixup<false>(Pu, MP / 256 + (un_ >> 2), un_ & 3, j_ >> 2, j_ & 3, nullptr, XB, ssqB, 0.5f, tid); }
            if (BOTH(pb + 1)) GRID_BAR();
        }
        if (EN_PH(3) && IN(pb + 2)) {
            pg8::Gemm g{XB, (const bf16*)(wl + W_IN), M, NINP, DM, DM}; pg8::StaticOrder S; S.init(M, NINP, G, (int)blockIdx.x);
#if FUSE_POST
#if IN_STAGGER_TICKS > 0
            if (blockIdx.x & 1) { const unsigned long long t0 = __builtin_amdgcn_s_memrealtime(); while (__builtin_amdgcn_s_memrealtime() - t0 < (unsigned long long)IN_STAGGER_TICKS) __builtin_amdgcn_s_sleep(8); }
#endif
            pg8::EpiInFused E{ws, out, l};
            pg8::gemm_phase<pg8::EpiInFused, pg8::StaticOrder, true, true>(lds, g, S, E, wave0);
#else
            pg8::EpiScaleBf16 E{HB, NINP, ssqB, 16, 1.0f / 1024.0f, ssqQ};
            pg8::gemm_phase<pg8::EpiScaleBf16, pg8::StaticOrder, true, true>(lds, g, S, E, wave0);
#endif
            if (BOTH(pb + 2)) GRID_BAR();
        }
        if (EN_PH(4) && IN(pb + 3)) {
#if FUSE_POST
            {
                pg8::Gemm g{CQ, (const bf16*)(wl + W_Q), M, NQP, 256, 256}; pg8::StaticOrder S; S.init(M, NQP, G, (int)blockIdx.x);
                pg8::EpiScaleBf16 E{QA, NQP, ssqQ, 4, 1.0f / 256.0f, nullptr};
                pg8::gemm_phase<pg8::EpiScaleBf16, pg8::StaticOrder, true, true>(lds, g, S, E, wave0);
            }
            {
                FRESH_TID();
                const float* kvn = ARG_IN(I_KVN) + l * 128; const int gw = blockIdx.x * NWAVES + wave, NGW = G * NWAVES; const int c16 = lane & 15, sub = lane >> 4;
                for (int row4 = gw * 4; row4 < M; row4 += NGW * 4) { const int row = row4 + sub;
                    const bool smp = row >= MP; const int rr = smp ? row - MP : row;
                    const v4u w = *(const v4u*)(CKV + (size_t)row * 128 + 8 * c16); float x[8];
                    x[0] = __uint_as_float(w[0] << 16); x[1] = __uint_as_float(w[0] & 0xffff0000u); x[2] = __uint_as_float(w[1] << 16); x[3] = __uint_as_float(w[1] & 0xffff0000u);
                    x[4] = __uint_as_float(w[2] << 16); x[5] = __uint_as_float(w[2] & 0xffff0000u); x[6] = __uint_as_float(w[3] << 16); x[7] = __uint_as_float(w[3] & 0xffff0000u);
                    const float rs = 1.0f / sqrtf(ssq_sum4(ssqK, row) * (1.0f / 128.0f) + EPS); const f32x4 g0 = *(const f32x4*)(kvn + 8 * c16), g1 = *(const f32x4*)(kvn + 8 * c16 + 4);
#pragma unroll
                    for (int e = 0; e < 4; ++e) { x[e] = x[e] * rs * g0[e]; x[4 + e] = x[4 + e] * rs * g1[e]; }
                    float* od = out + (smp ? O_MLA_S + ((size_t)l * MS + rr) * 160 : O_MLA_P + ((size_t)l * MP + rr) * 160) + 8 * c16;
                    *(f32x4*)od = (f32x4){x[0], x[1], x[2], x[3]}; *(f32x4*)(od + 4) = (f32x4){x[4], x[5], x[6], x[7]};
                    *(v4u*)(RA + (size_t)row * 160 + 8 * c16) = (v4u){cvtpk(x[0], x[1]), cvtpk(x[2], x[3]), cvtpk(x[4], x[5]), cvtpk(x[6], x[7])}; }
            }
            if (BOTH(pb + 3)) GRID_BAR();
#else
            for (int prep = 0; prep < POST_REPS; ++prep) {
            {
                pg8::Gemm g{HB, (const bf16*)(wl + W_Q), M, NQP, 256, NINP}; pg8::StaticOrder S; S.init(M, NQP, G, (int)blockIdx.x);
                pg8::EpiScaleBf16 E{QA, NQP, ssqQ, 4, 1.0f / 256.0f, nullptr};
                pg8::gemm_phase<pg8::EpiScaleBf16, pg8::StaticOrder, true, true>(lds, g, S, E, wave0);
            }
            FRESH_TID();
            const float* kvn = ARG_IN(I_KVN) + l * 128;
            const float scaleB = 0.125f * LOG2E, scaleD = 0.17677669529663687f * LOG2E, scaleC = 0.125f * LOG2E;
            const int gw = blockIdx.x * NWAVES + wave, NGW = G * NWAVES;
#define UP8(w, f) do { f[0] = __uint_as_float((w)[0] << 16); f[1] = __uint_as_float((w)[0] & 0xffff0000u); f[2] = __uint_as_float((w)[1] << 16); f[3] = __uint_as_float((w)[1] & 0xffff0000u); \
                       f[4] = __uint_as_float((w)[2] << 16); f[5] = __uint_as_float((w)[2] & 0xffff0000u); f[6] = __uint_as_float((w)[3] << 16); f[7] = __uint_as_float((w)[3] & 0xffff0000u); } while (0)
#define PK8(f) ((v4u){cvtpk(f[0], f[1]), cvtpk(f[2], f[3]), cvtpk(f[4], f[5]), cvtpk(f[6], f[7])})
#define ST8F(p, f) do { *(f32x4*)(p) = (f32x4){f[0], f[1], f[2], f[3]}; *(f32x4*)((p) + 4) = (f32x4){f[4], f[5], f[6], f[7]}; } while (0)
            for (int row = gw; row < M; row += NGW) {
                const bf16* h = HB + (size_t)row * NINP;
                const bool smp = row >= MP; const int rr = smp ? row - MP : row;
                const int pidx = smp ? 2048 + (rr & 63) : (rr & 2047);
                float* o_mla = out + (smp ? O_MLA_S + ((size_t)l * MS + rr) * 160 : O_MLA_P + ((size_t)l * MP + rr) * 160);
                float* o_dsa = out + (smp ? O_DSA_S + ((size_t)l * MS + rr) * 192 : O_DSA_P + ((size_t)l * MP + rr) * 192);
                float* o_sb = out + (smp ? O_SB_S + ((size_t)l * MS + rr) * 512 : O_SB_P + ((size_t)l * MP + rr) * 512);
                float* o_df = out + (smp ? O_DIFF_S + ((size_t)l * MS + rr) * 512 : O_DIFF_P + ((size_t)l * MP + rr) * 512);
                bf16* ra = RA + (size_t)row * 160; bf16* rb = RB + (size_t)row * 192; bf16* rc = RC + (size_t)row * 512; bf16* rd = RD + (size_t)row * 512;
                if (lane < 56) { const int blk = lane >> 2, j = lane & 3;
                    const int base = blk < 4 ? H_QB + 64 * blk : (blk == 4 ? H_KB : (blk < 13 ? H_QI + 64 * (blk - 5) : H_KI));
                    const v4u w1 = *(const v4u*)(h + base + 8 * j), w2 = *(const v4u*)(h + base + 32 + 8 * j); float x1[8], x2[8], a[8], b[8]; UP8(w1, x1); UP8(w2, x2);
                    const f32x4* cp = (const f32x4*)(ROPE64 + pidx * 32 + 8 * j);
#pragma unroll
                    for (int e2 = 0; e2 < 4; ++e2) { const f32x4 cs = cp[e2];
                        a[2 * e2] = x1[2 * e2] * cs[0] - x2[2 * e2] * cs[1]; b[2 * e2] = x2[2 * e2] * cs[0] + x1[2 * e2] * cs[1];
                        a[2 * e2 + 1] = x1[2 * e2 + 1] * cs[2] - x2[2 * e2 + 1] * cs[3]; b[2 * e2 + 1] = x2[2 * e2 + 1] * cs[2] + x1[2 * e2 + 1] * cs[3]; }
                    if (blk < 4) {
#pragma unroll
                        for (int e = 0; e < 8; ++e) { a[e] *= scaleB; b[e] *= scaleB; }
                        bf16* d = QB + (size_t)row * 256 + 64 * blk + 8 * j; *(v4u*)d = PK8(a); *(v4u*)(d + 32) = PK8(b); }
                    else if (blk == 4) { ST8F(o_dsa + 8 * j, a); ST8F(o_dsa + 32 + 8 * j, b); *(v4u*)(rb + 8 * j) = PK8(a); *(v4u*)(rb + 32 + 8 * j) = PK8(b); }
                    else if (blk < 13) { bf16* d = QI + (size_t)row * 512 + 64 * (blk - 5) + 8 * j; *(v4u*)d = PK8(a); *(v4u*)(d + 32) = PK8(b); }
                    else { ST8F(o_dsa + 128 + 8 * j, a); ST8F(o_dsa + 160 + 8 * j, b); *(v4u*)(rb + 128 + 8 * j) = PK8(a); *(v4u*)(rb + 160 + 8 * j) = PK8(b); }
                }
                if (lane < 34) { const int blk = lane >> 1, j = lane & 1;
                    const int base = blk == 0 ? H_KR : (blk < 9 ? H_QD + 32 * (blk - 1) : H_KD + 32 * (blk - 9));
                    const v4u w1 = *(const v4u*)(h + base + 8 * j), w2 = *(const v4u*)(h + base + 16 + 8 * j); float x1[8], x2[8], a[8], b[8]; UP8(w1, x1); UP8(w2, x2);
                    const f32x4* cp = (const f32x4*)(ROPE32 + pidx * 16 + 8 * j);
#pragma unroll
                    for (int e2 = 0; e2 < 4; ++e2) { const f32x4 cs = cp[e2];
                        a[2 * e2] = x1[2 * e2] * cs[0] - x2[2 * e2] * cs[1]; b[2 * e2] = x2[2 * e2] * cs[0] + x1[2 * e2] * cs[1];
                        a[2 * e2 + 1] = x1[2 * e2 + 1] * cs[2] - x2[2 * e2 + 1] * cs[3]; b[2 * e2 + 1] = x2[2 * e2 + 1] * cs[2] + x1[2 * e2 + 1] * cs[3]; }
                    if (blk == 0) { ST8F(o_mla + 128 + 8 * j, a); ST8F(o_mla + 144 + 8 * j, b); *(v4u*)(ra + 128 + 8 * j) = PK8(a); *(v4u*)(ra + 144 + 8 * j) = PK8(b); }
                    else if (blk < 9) {
#pragma unroll
                        for (int e = 0; e < 8; ++e) { a[e] *= scaleD; b[e] *= scaleD; }
                        bf16* d = QD + (size_t)row * 256 + 32 * (blk - 1) + 8 * j; *(v4u*)d = PK8(a); *(v4u*)(d + 16) = PK8(b); }
                    else { const int bb = blk - 9, oc = (bb >> 1) * 128 + (bb & 1) * 32 + 8 * j; ST8F(o_df + oc, a); ST8F(o_df + oc + 16, b); *(v4u*)(rd + oc) = PK8(a); *(v4u*)(rd + oc + 16) = PK8(b); }
                }
                { const int c16 = lane & 15; float x[8] = {0.f, 0.f, 0.f, 0.f, 0.f, 0.f, 0.f, 0.f}; float ss = 0.f;
                  if (lane >= 48) { const v4u w = *(const v4u*)(h + H_CKV + 8 * c16); UP8(w, x);
#pragma unroll
                      for (int e = 0; e < 8; ++e) ss += x[e] * x[e]; }
                  ss += __shfl_xor(ss, 1); ss += __shfl_xor(ss, 2); ss += __shfl_xor(ss, 4); ss += __shfl_xor(ss, 8);
                  if (lane >= 48) { const float rs = 1.0f / sqrtf(ss * (1.0f / 128.0f) + EPS); const f32x4 g0 = *(const f32x4*)(kvn + 8 * c16), g1 = *(const f32x4*)(kvn + 8 * c16 + 4);
#pragma unroll
                      for (int e = 0; e < 4; ++e) { x[e] = x[e] * rs * g0[e]; x[4 + e] = x[4 + e] * rs * g1[e]; }
                      ST8F(o_mla + 8 * c16, x); *(v4u*)(ra + 8 * c16) = PK8(x); } }
#pragma unroll
                for (int r3 = 0; r3 < 3; ++r3) { const int t = lane + 64 * r3;
                    if (t < 137) { float x[8];
                        if (t < 8) { const v4u w = *(const v4u*)(h + H_VB + 8 * t); UP8(w, x); ST8F(o_dsa + 64 + 8 * t, x); *(v4u*)(rb + 64 + 8 * t) = w; }
                        else if (t < 40) { const int k = t - 8; const v4u w = *(const v4u*)(h + H_QC + 8 * k); UP8(w, x);
#pragma unroll
                            for (int e = 0; e < 8; ++e) x[e] *= scaleC;
                            *(v4u*)(QC + (size_t)row * 256 + 8 * k) = PK8(x); }
                        else if (t < 72) { const int k = t - 40, oc = (k >> 3) * 128 + 8 * (k & 7); const v4u w = *(const v4u*)(h + H_KC + 8 * k); UP8(w, x); ST8F(o_sb + oc, x); *(v4u*)(rc + oc) = w; }
                        else if (t < 104) { const int k = t - 72, oc = (k >> 3) * 128 + 64 + 8 * (k & 7); const v4u w = *(const v4u*)(h + H_VC + 8 * k); UP8(w, x); ST8F(o_sb + oc, x); *(v4u*)(rc + oc) = w; }
                        else if (t < 136) { const int k = t - 104, oc = (k >> 3) * 128 + 64 + 8 * (k & 7); const v4u w = *(const v4u*)(h + H_VD + 8 * k); UP8(w, x); ST8F(o_df + oc, x); *(v4u*)(rd + oc) = w; }
                        else { const v4u w = *(const v4u*)(h + H_WI); UP8(w, x);
#pragma unroll
                            for (int e = 0; e < 8; ++e) x[e] *= 0.35355339059327373f;
                            ST8F(WI + (size_t)row * 8, x); }
                    } }
            }
            }
#undef UP8
#undef PK8
#undef ST8F
            if (BOTH(pb + 3)) GRID_BAR();
#endif
        }
        if (EN_PH(5) && IN(pb + 4)) {
            GLB unsigned char* wsg_ = (GLB unsigned char*)args.ws; asm volatile("" : "+s"(wsg_)); unsigned char* ws = (unsigned char*)wsg_;
            LAS char* tile = (LAS char*)lds;
            volatile LAS unsigned* qslot = MISC + 16;
            const int myx = (int)(xb_xcc_id() & 7u);
            for (int rep = 0; rep < ATTN_REPS; ++rep) {
#define MIXER_IDS() FRESH_TID(); const int r32 = lane & 31, hi = lane >> 5, hd = wave & 3, qh = wave >> 2, q4 = (lane & 15) >> 2; (void)q4; int qx = myx
#define NEXT_UNIT(kind, out) do { __syncthreads(); if (tid == 0) { int res_ = -1, q_ = qx; gu32* heads_ = ctl + CW_Q + (((rep * 2 + l) * 4 + (kind)) * 8) * 64; \
        for (;;) { const unsigned got_ = __hip_atomic_fetch_add((unsigned*)(heads_ + q_ * 64), 1u, RLX_AGENT); if (got_ < (unsigned)QLIST) { res_ = (int)got_ + 256 * q_; break; } \
            unsigned hv_[8]; _Pragma("unroll") for (int s_ = 0; s_ < 8; ++s_) hv_[s_] = __hip_atomic_load((unsigned*)(heads_ + ((myx + s_) & 7) * 64), RLX_AGENT); \
            int pick_ = -1; _Pragma("unroll") for (int s_ = 7; s_ >= 0; --s_) if (hv_[s_] < (unsigned)QLIST) pick_ = s_; \
            if (pick_ < 0) break; q_ = (myx + pick_) & 7; } \
        qslot[0] = (unsigned)res_; } \
    __syncthreads(); { const int r_ = (int)qslot[0]; out = r_ < 0 ? -1 : (r_ & 255); qx = r_ < 0 ? qx : ((r_ >> 8) & 7); } } while (0)
#if EN_DSA
            if (rep == 0 || ((REP_MASK >> 1) & 1)) { MIXER_IDS();
            for (;;) {
                int uidx; NEXT_UNIT(1, uidx); if (uidx < 0) break;
                const UnitId u = decode_unit(qx, uidx);
                const float* cache_lb = ARG_IN(I_CDSA) + ((size_t)(l * NB + u.b) * PAST) * 192;
                const int myq = u.qrow0 + 32 * qh + r32;
                float* sc = (float*)(ws + WS_REGA + (size_t)blockIdx.x * DSA_SCR);
                unsigned long long* mk = (unsigned long long*)(ws + WS_REGA + (size_t)blockIdx.x * DSA_SCR + DSA_MASK_OFF);
                const bool sel = u.nt > 4;
                if (sel) {
                    {
                    float wq[8]; float smin = 3e38f, smax = -3e38f;
                    LAS unsigned* mmq = (LAS unsigned*)(lds + 110592);
                    if (tid < 64) { mmq[tid] = 0xFFFFFFFFu; mmq[64 + tid] = 0u; }
#pragma unroll
                    for (int hh = 0; hh < 8; ++hh) wq[hh] = WI[(size_t)myq * 8 + hh];
                    LAS char* ql_ = (LAS char*)lds + 20480;
                    { const int row0 = tid >> 6, cc = tid & 63;
#pragma unroll
                      for (int i = 0; i < 8; ++i) { const int row = row0 + 8 * i; *(LAS v4u*)(ql_ + row * T512_STRB + cc * 16) = *(const v4u*)(QI + (size_t)(u.qrow0 + row) * 512 + cc * 8); } }
                    const LAS char* qb_ = ql_ + (32 * qh + r32) * T512_STRB + 8 * hi * 2;
                    TileLd<64, 192, true, 128> ld; ld.init(); constexpr int STRB = TileLd<64, 192, true, 128>::STRB;
                    const int nt2 = (u.nt + 1) >> 1;
                    bool f32; const void* src = tile_src(u, 0, cache_lb, RB, 192, 128, f32);
                    ld.nrows_ = (u.nt >= 2) ? 128 : 64; ld.issue(src, f32, tid); ld.store(tile, f32, tid); __syncthreads();
                    const int kboffA = (32 * hd + r32) * STRB + 8 * hi * 2;
                    int cbA = 0;
                    for (int t2 = 0; t2 < nt2; ++t2) {
                        LAS char* curA = tile + cbA * 90112; LAS char* nxbA = tile + (cbA ^ 1) * 90112; cbA ^= 1;
                        const LAS char* kb = curA + kboffA;
                        const int rows_cur = (2 * t2 + 2 <= u.nt) ? 128 : 64;
                        bool f32n; { const int tn2 = (t2 + 1 < nt2) ? t2 + 1 : t2; const void* sn = tile_src(u, 2 * tn2, cache_lb, RB, 192, 128, f32n); ld.nrows_ = (2 * tn2 + 2 <= u.nt) ? 128 : 64; ld.issue(sn, f32n, tid); }
                        if (32 * hd < rows_cur) {
                            bf16x8 ka[4];
#pragma unroll
                            for (int s = 0; s < 4; ++s) ka[s] = *(const LAS bf16x8*)(kb + s * 32);
                            typedef float f32x2_t __attribute__((ext_vector_type(2)));
                            f32x2_t I2[8];
#pragma unroll
                            for (int r = 0; r < 8; ++r) I2[r] = (f32x2_t){0.f, 0.f};
                            bf16x8 qf[2][4];
#pragma unroll
                            for (int s = 0; s < 4; ++s) qf[0][s] = *(const LAS bf16x8*)(qb_ + s * 32);
#pragma unroll
                            for (int hh = 0; hh < 8; ++hh) { f32x16 p = zero16(); const f32x2_t w2 = {wq[hh], wq[hh]};
                                if (hh < 7) {
#pragma unroll
                                    for (int s = 0; s < 4; ++s) qf[(hh + 1) & 1][s] = *(const LAS bf16x8*)(qb_ + (hh + 1) * 128 + s * 32); }
                                __builtin_amdgcn_sched_barrier(0);
#pragma unroll
                                for (int s = 0; s < 4; ++s) p = MFMA32(ka[s], qf[hh & 1][s], p);
#pragma unroll
                                for (int r = 0; r < 8; ++r) { const f32x2_t rl = {__int_as_float(max(__float_as_int(p[2 * r]), 0)), __int_as_float(max(__float_as_int(p[2 * r + 1]), 0))};        I2[r] = w2 * rl + I2[r]; } }
                            f32x16 I;
#pragma unroll
                            for (int r = 0; r < 8; ++r) { I[2 * r] = I2[r].x; I[2 * r + 1] = I2[r].y; }
                            GLB float* scol = (GLB float*)sc + (size_t)(t2 * 128 + 32 * hd + 4 * hi) * 64 + 32 * qh + r32;
#pragma unroll
                            for (int r = 0; r < 16; ++r) { scol[(size_t)((r & 3) + 8 * (r >> 2)) * 64] = I[r]; smin = fminf(smin, I[r]); smax = fmaxf(smax, I[r]); }
                        }
                        ld.store(nxbA, f32n, tid);
                        __syncthreads();
                    }
                    { const unsigned bmn = __float_as_uint(smin), bmx = __float_as_uint(smax);
                      __hip_atomic_fetch_min(mmq + 32 * qh + r32, bmn ^ ((bmn >> 31) ? 0xFFFFFFFFu : 0x80000000u), __ATOMIC_RELAXED, __HIP_MEMORY_SCOPE_WORKGROUP);
                      __hip_atomic_fetch_max(mmq + 64 + 32 * qh + r32, bmx ^ ((bmx >> 31) ? 0xFFFFFFFFu : 0x80000000u), __ATOMIC_RELAXED, __HIP_MEMORY_SCOPE_WORKGROUP); }
                    }
                    VM_WAIT(); __syncthreads();
                    {
                    LAS unsigned* hist = (LAS unsigned*)lds;
                    LAS unsigned* part = (LAS unsigned*)(lds + 65536);
                    LAS float* qlo = (LAS float*)(lds + 67584); LAS float* qsc = qlo + 64; LAS int* qkk = (LAS int*)(qsc + 64); LAS unsigned* qT = (LAS unsigned*)(qkk + 64); LAS int* qwhole = (LAS int*)(qT + 64);
                    LAS int* qcn = qwhole + 64;
                    LAS unsigned long long* mkl = (LAS unsigned long long*)(lds + 69632);
                    LAS unsigned* cval = (LAS unsigned*)(lds + 106496);
                    LAS unsigned short* ckey = (LAS unsigned short*)(lds + 122880);
                    constexpr int CMAX = 64;
                    const int pq = tid & 63, ps = tid >> 6;
                    LAS unsigned* mmq = (LAS unsigned*)(lds + 110592);
                    if (tid < 64) { const unsigned a = mmq[tid], b = mmq[64 + tid];
                        const float lo_ = __uint_as_float((a & 0x80000000u) ? (a ^ 0x80000000u) : ~a), hi_ = __uint_as_float((b & 0x80000000u) ? (b ^ 0x80000000u) : ~b);
                        const float range = hi_ - lo_; qlo[tid] = lo_; qsc[tid] = (range > 1e-30f) ? 255.99f / range : 0.f; qcn[tid] = 0; }
#pragma unroll
                    for (int j = 0; j < 8; ++j) ((LAS v4u*)hist)[tid + 512 * j] = (v4u){0u, 0u, 0u, 0u};
                    __syncthreads();
                    const float lo_q = qlo[pq], sc_q = qsc[pq];
                    const GLB float* scq = (const GLB float*)sc + pq;
                    for (int t = ps; t < u.nt; t += 8) { const GLB float* sp = scq + (size_t)t * 4096;
                        { float xs[64];
#pragma unroll
                            for (int j = 0; j < 64; ++j) xs[j] = sp[j * 64];
#pragma unroll
                            for (int j = 0; j < 64; ++j) { const int b0 = min(255, (int)((xs[j] - lo_q) * sc_q)); __hip_atomic_fetch_add(hist + b0 * 64 + pq, 1u, __ATOMIC_RELAXED, __HIP_MEMORY_SCOPE_WORKGROUP); } } }
                    __syncthreads();
                    { unsigned sm = 0u;
#pragma unroll 8
                      for (int j = 0; j < 32; ++j) sm += hist[(32 * ps + j) * 64 + pq];
                      part[ps * 64 + pq] = sm; }
                    __syncthreads();
                    if (tid < 64) { const unsigned kk_ = 256u; unsigned acc = 0u; int sl_ = -1; unsigned abv = 0u;
#pragma unroll
                        for (int s2 = 7; s2 >= 0; --s2) { const unsigned c = part[s2 * 64 + tid]; const bool take = (sl_ < 0) && (acc + c >= kk_); if (take) { sl_ = s2; abv = acc; } acc += c; }
                        sl_ = sl_ < 0 ? 0 : sl_; unsigned acc2 = abv; int bsel = -1; unsigned abv2 = 0u, csel = 0u;
#pragma unroll 8
                        for (int j = 31; j >= 0; --j) { const unsigned c = hist[(32 * sl_ + j) * 64 + tid]; const bool take = (bsel < 0) && (acc2 + c >= kk_); if (take) { bsel = j; abv2 = acc2; csel = c; } acc2 += c; }
                        bsel = bsel < 0 ? 0 : bsel;
                        qT[tid] = (unsigned)(32 * sl_ + bsel); qkk[tid] = (int)(kk_ - abv2); qwhole[tid] = ((kk_ - abv2) == csel) ? 1 : 0; }
                    __syncthreads();
                    { const int T0 = (int)qT[pq]; const bool whole = qwhole[pq] != 0;
                      for (int t = ps; t < u.nt; t += 8) { const GLB float* sp = scq + (size_t)t * 4096; unsigned long long w = 0ull;
#pragma unroll 1
                        for (int k0 = 0; k0 < 64; k0 += 32) { float xs[32];
#pragma unroll
                            for (int j = 0; j < 32; ++j) xs[j] = sp[(k0 + j) * 64];
#pragma unroll
                            for (int j = 0; j < 32; ++j) { const int b0 = min(255, (int)((xs[j] - lo_q) * sc_q));
                                const bool selq = b0 > T0 || (whole && b0 == T0); w |= (unsigned long long)(selq ? 1u : 0u) << (k0 + j);
                                if (!whole && b0 == T0) { const int ix = __hip_atomic_fetch_add(qcn + pq, 1, __ATOMIC_RELAXED, __HIP_MEMORY_SCOPE_WORKGROUP);
                                    if (ix < CMAX) { const unsigned bts = __float_as_uint(xs[j]); cval[pq * CMAX + ix] = bts ^ ((bts >> 31) ? 0xFFFFFFFFu : 0x80000000u); ckey[pq * CMAX + ix] = (unsigned short)(t * 64 + k0 + j); } } } }
                        mkl[pq * 72 + t] = w; } }
                    __syncthreads();
                    if (!qwhole[pq]) { const int n = qcn[pq], kk_ = qkk[pq];
                        if (n <= CMAX) { for (int i = ps; i < n; i += 8) { const unsigned vi = cval[pq * CMAX + i]; const unsigned ki = ckey[pq * CMAX + i]; int rank = 0;
                                for (int j = 0; j < n; ++j) { const unsigned vj = cval[pq * CMAX + j]; const unsigned kj = ckey[pq * CMAX + j]; rank += (vj > vi || (vj == vi && kj < ki)) ? 1 : 0; }
                                if (rank < kk_) __hip_atomic_fetch_or((LAS unsigned*)mkl + (pq * 72 + (int)(ki >> 6)) * 2 + (int)((ki >> 5) & 1u), 1u << (ki & 31u), __ATOMIC_RELAXED, __HIP_MEMORY_SCOPE_WORKGROUP); } } }
                    __syncthreads();
                    if (wave == 0) { unsigned long long und = __ballot(!qwhole[lane] && qcn[lane] > CMAX);
                        while (und) { const int qf = (int)__builtin_ctzll(und); und &= und - 1ull;
                            if (u.sample) dsa_select<65, 1, 64>(sc + qf, u.nt, hist, (unsigned long long*)(mkl + qf * 72), lane); else dsa_select<32, 1, 64>(sc + qf, u.nt, hist, (unsigned long long*)(mkl + qf * 72), lane); } }
                    }
                    VM_WAIT(); __syncthreads();
                }
                bf16x8 q[4];
#pragma unroll
                for (int s = 0; s < 4; ++s) q[s] = *(const bf16x8*)(QB + (size_t)myq * 256 + hd * 64 + 16 * s + 8 * hi);
                f32x16 o[2]; o[0] = zero16(); o[1] = zero16(); float m_ = -1e30f, l_ = 0.f;
                TileLd<128, 192> ld; ld.init(); constexpr int STRB = TileLd<128, 192>::STRB;
                bool f32; const void* src = tile_src(u, 0, cache_lb, RB, 192, 0, f32);
                ld.issue(src, f32, tid); ld.store(tile, f32, tid); __syncthreads();
                const int kboff = r32 * STRB + 8 * hi * 2;
                const int vboff = (4 * hi + q4) * STRB + (64 + 16 * ((lane >> 4) & 1) + 4 * (lane & 3)) * 2;
                int cb = 0;
                for (int t = 0; t < u.nt; ++t) {
                    LAS char* cur = tile + cb * 24576; LAS char* nxb = tile + (cb ^ 1) * 24576; cb ^= 1;
                    const LAS char* kb = cur + kboff; const LAS char* vb = cur + vboff;
                    bool f32n; { const int tn = (t + 1 < u.nt) ? t + 1 : t; const void* sn = tile_src(u, tn, cache_lb, RB, 192, 0, f32n); ld.issue(sn, f32n, tid); }
                    unsigned long long mw = ~0ull; if (sel) mw = ((const LAS unsigned long long*)(lds + 69632))[(32 * qh + r32) * 72 + t];
                    const unsigned mlo = (unsigned)mw >> (4 * hi), mhi = (unsigned)(mw >> 32) >> (4 * hi);
                    f32x16 p0, p1; bf16x8 kf[8], vf[8];
                    k_ld<4>(kf, kb, STRB); __builtin_amdgcn_sched_barrier(0); qk_r<4>(p0, p1, kf, q); v_ld<2>(vf, vb, STRB); __builtin_amdgcn_sched_barrier(0);
#pragma unroll
                    for (int r = 0; r < 16; ++r) { const int bpos = (r & 3) + 8 * (r >> 2);
                        const unsigned s0 = (unsigned)__builtin_amdgcn_sbfe((int)mlo, bpos, 1), s1 = (unsigned)__builtin_amdgcn_sbfe((int)mhi, bpos, 1);
                        p0[r] = __uint_as_float((__float_as_uint(p0[r]) & s0) | (0xff61b1e6u & ~s0)); p1[r] = __uint_as_float((__float_as_uint(p1[r]) & s1) | (0xff61b1e6u & ~s1)); }
                    softmax_step<2>(p0, p1, m_, l_, o);
                    pv_r<2>(o, p0, p1, vf);
                    ld.store(nxb, f32n, tid);
                    __syncthreads();
                }
                l_ += __shfl_xor(l_, 32); const float inv = 1.0f / l_;
                bf16* orow = CC + (size_t)myq * KOUT + 512 + hd * 64;
#pragma unroll
                for (int db = 0; db < 2; ++db)
#pragma unroll
                    for (int gq = 0; gq < 4; ++gq) { v2u w; w.x = cvtpk(o[db][4 * gq] * inv, o[db][4 * gq + 1] * inv); w.y = cvtpk(o[db][4 * gq + 2] * inv, o[db][4 * gq + 3] * inv);
                        *(v2u*)(orow + 32 * db + 8 * gq + 4 * hi) = w; }
            }
            }
#endif
#if EN_DIFF
            if (rep == 0 || ((REP_MASK >> 3) & 1)) { MIXER_IDS();
            for (;;) {
                int uidx; NEXT_UNIT(3, uidx); if (uidx < 0) break;
                const UnitId u = decode_unit(qx, uidx);
                const float* cache_lb = ARG_IN(I_CDIFF) + ((size_t)(l * NB + u.b) * PAST) * 512;
                const int myq = u.qrow0 + 32 * qh + r32;
                bf16x8 qa[2], qb2[2];
#pragma unroll
                for (int s = 0; s < 2; ++s) { qa[s] = *(const bf16x8*)(QD + (size_t)myq * 256 + hd * 64 + 16 * s + 8 * hi); qb2[s] = *(const bf16x8*)(QD + (size_t)myq * 256 + hd * 64 + 32 + 16 * s + 8 * hi); }
                f32x16 o1[2], o2[2]; o1[0] = zero16(); o1[1] = zero16(); o2[0] = zero16(); o2[1] = zero16(); float m1 = -1e30f, l1 = 0.f, m2 = -1e30f, l2 = 0.f;
                constexpr int STRB = T512_STRB;
                { bool f32; const void* src = tile_src(u, 0, cache_lb, RD, 512, 0, f32);
                  if (f32) t512_cvt(src, tile, tid); else t512_dma(src, tile, wave, lane); VM_WAIT(); __syncthreads(); }
                const int kboff = r32 * STRB + (hd * 128 + 8 * hi) * 2;
                const int vboff = (4 * hi + q4) * STRB + (hd * 128 + 64 + 16 * ((lane >> 4) & 1) + 4 * (lane & 3)) * 2;
                int cb = 0;
                for (int t = 0; t < u.nt; ++t) {
                    LAS char* cur = tile + cb * T512_BYTES; LAS char* nxb = tile + (cb ^ 1) * T512_BYTES; cb ^= 1;
                    const LAS char* kb1 = cur + kboff; const LAS char* kb2 = kb1 + 64; const LAS char* vb = cur + vboff;
                    bool f32n = false; const void* sn = nullptr; if (t + 1 < u.nt) sn = tile_src(u, t + 1, cache_lb, RD, 512, 0, f32n);
#if DBG_VARIANTS
                    { f32x16 p0, p1; qk<2>(p0, p1, kb1, STRB, qa); float sx = 0.f; for (int r = 0; r < 16; ++r) { p0[r] = __builtin_amdgcn_exp2f(p0[r] - 8.f); p1[r] = __builtin_amdgcn_exp2f(p1[r] - 8.f); sx += p0[r] + p1[r]; } l1 += sx; pv<2>(o1, p0, p1, vb, STRB); }
                    { f32x16 p0, p1; qk<2>(p0, p1, kb2, STRB, qb2); float sx = 0.f; for (int r = 0; r < 16; ++r) { p0[r] = __builtin_amdgcn_exp2f(p0[r] - 8.f); p1[r] = __builtin_amdgcn_exp2f(p1[r] - 8.f); sx += p0[r] + p1[r]; } l2 += sx; pv<2>(o2, p0, p1, vb, STRB); }
#else
                    { bf16x8 kA[4], kB[4], vf[8]; f32x16 pa0, pa1, pb0, pb1;
                      k_ld<2>(kA, kb1, STRB); k_ld<2>(kB, kb2, STRB); __builtin_amdgcn_sched_barrier(0);
                      qk_r<2>(pa0, pa1, kA, qa); qk_r<2>(pb0, pb1, kB, qb2); v_ld<2>(vf, vb, STRB); __builtin_amdgcn_sched_barrier(0);
                      if (t + 1 < u.nt && !f32n) t512_dma(sn, nxb, wave, lane);
                      __builtin_amdgcn_sched_barrier(0);
                      softmax_step<2>(pa0, pa1, m1, l1, o1); pv_r<2>(o1, pa0, pa1, vf);
                      softmax_step<2>(pb0, pb1, m2, l2, o2); pv_r<2>(o2, pb0, pb1, vf); }
#endif
                    if (t + 1 < u.nt && f32n) t512_cvt(sn, nxb, tid);
                    VM_WAIT(); __syncthreads();
                }
                l1 += __shfl_xor(l1, 32); l2 += __shfl_xor(l2, 32);
                const float i1 = 1.0f / l1, i2 = LAMF[l] / l2; float ss = 0.f;
#pragma unroll
                for (int db = 0; db < 2; ++db)
#pragma unroll
                    for (int r = 0; r < 16; ++r) { const float v = o1[db][r] * i1 - o2[db][r] * i2; o1[db][r] = v; ss += v * v; }
                ss += __shfl_xor(ss, 32);
                const float lam_init = 0.8f - 0.6f * expf(-0.3f * (float)l);
                const float rs = (1.0f - lam_init) / sqrtf(ss * (1.0f / 64.0f) + EPS);
                const float* dn = ARG_IN(I_DN) + l * 64;
                bf16* orow = CC + (size_t)myq * KOUT + 1024 + hd * 64;
#pragma unroll
                for (int db = 0; db < 2; ++db)
#pragma unroll
                    for (int gq = 0; gq < 4; ++gq) { const f32x4 dv = *(const f32x4*)(dn + 32 * db + 8 * gq + 4 * hi);
                        v2u w; w.x = cvtpk(o1[db][4 * gq] * rs * dv[0], o1[db][4 * gq + 1] * rs * dv[1]); w.y = cvtpk(o1[db][4 * gq + 2] * rs * dv[2], o1[db][4 * gq + 3] * rs * dv[3]);
                        *(v2u*)(orow + 32 * db + 8 * gq + 4 * hi) = w; }
            }
            }
#endif
#if EN_MLA
            if (rep == 0 || ((REP_MASK >> 0) & 1)) { MIXER_IDS();
            for (;;) {
                int uidx; NEXT_UNIT(0, uidx); if (uidx < 0) break;
                const UnitId u = decode_unit(qx, uidx);
                const float* cache_lb = ARG_IN(I_CMLA) + ((size_t)(l * NB + u.b) * PAST) * 160;
                const int myq = u.qrow0 + 32 * qh + r32;
                bf16x8 q[10];
#pragma unroll
                for (int s = 0; s < 10; ++s) q[s] = *(const bf16x8*)(QA + (size_t)myq * NQP + hd * 160 + 16 * s + 8 * hi);
                {
                    const int pidx = u.sample ? 2048 + 32 * qh + r32 : u.c * 64 + 32 * qh + r32;
                    bf16x8 a = q[8], b = q[9];
#pragma unroll
                    for (int j = 0; j < 8; ++j) { const float2 cs = ROPE32[pidx * 16 + 8 * hi + j]; const float x1 = bf2f((bf16)a[j]), x2 = bf2f((bf16)b[j]);
                        a[j] = (short)f2bf(x1 * cs.x - x2 * cs.y); b[j] = (short)f2bf(x2 * cs.x + x1 * cs.y); }
                    q[8] = a; q[9] = b;
                }
                f32x16 o[4]; o[0] = zero16(); o[1] = zero16(); o[2] = zero16(); o[3] = zero16(); float m_ = -1e30f, l_ = 0.f;
                TileLd<160, 160> ld; ld.init(); constexpr int STRB = TileLd<160, 160>::STRB;
                bool f32; const void* src = tile_src(u, 0, cache_lb, RA, 160, 0, f32);
                ld.issue(src, f32, tid); ld.store(tile, f32, tid); __syncthreads();
                const int kboff = r32 * STRB + 8 * hi * 2;
                const int vboff = (4 * hi + q4) * STRB + (16 * ((lane >> 4) & 1) + 4 * (lane & 3)) * 2;
                int cb = 0;
                for (int t = 0; t < u.nt; ++t) {
                    LAS char* cur = tile + cb * 24576; LAS char* nxb = tile + (cb ^ 1) * 24576; cb ^= 1;
                    const LAS char* kb = cur + kboff; const LAS char* vb = cur + vboff;
                    bool f32n; { const int tn = (t + 1 < u.nt) ? t + 1 : t; const void* sn = tile_src(u, tn, cache_lb, RA, 160, 0, f32n); ld.issue(sn, f32n, tid); }
                    f32x16 p0, p1; qk<10>(p0, p1, kb, STRB, q);
#if DBG_VARIANTS
                    { for (int r = 0; r < 16; ++r) { p0[r] = p0[r] * 0.f + 1.f; p1[r] = p1[r] * 0.f + 1.f; } l_ += 32.f; }
#else
                    softmax_step<4>(p0, p1, m_, l_, o);
#endif
                    pv<4>(o, p0, p1, vb, STRB);
                    ld.store(nxb, f32n, tid);
                    __syncthreads();
                }
                l_ += __shfl_xor(l_, 32); const float inv = 1.0f / l_;
                bf16* orow = CC + (size_t)myq * KOUT + hd * 128;
#pragma unroll
                for (int db = 0; db < 4; ++db)
#pragma unroll
                    for (int gq = 0; gq < 4; ++gq) { v2u w; w.x = cvtpk(o[db][4 * gq] * inv, o[db][4 * gq + 1] * inv); w.y = cvtpk(o[db][4 * gq + 2] * inv, o[db][4 * gq + 3] * inv);
                        *(v2u*)(orow + 32 * db + 8 * gq + 4 * hi) = w; }
            }
            }
#endif
#if EN_SB
            if (rep == 0 || ((REP_MASK >> 2) & 1)) { MIXER_IDS();
            for (;;) {
                int uidx; NEXT_UNIT(2, uidx); if (uidx < 0) break;
                const UnitId u = decode_unit(qx, uidx);
                const float* cache_lb = ARG_IN(I_CSB) + ((size_t)(l * NB + u.b) * PAST) * 512;
                const int myq = u.qrow0 + 32 * qh + r32, qloc = 32 * qh + r32;
                bf16x8 q[4];
#pragma unroll
                for (int s = 0; s < 4; ++s) q[s] = *(const bf16x8*)(QC + (size_t)myq * 256 + hd * 64 + 16 * s + 8 * hi);
                f32x16 o[2]; o[0] = zero16(); o[1] = zero16(); float carry = 1.0f; int it3 = 0;
                constexpr int STRB = T512_STRB;
                { bool f32; const void* src = tile_src(u, u.nt - 1, cache_lb, RC, 512, 0, f32);
                  if (f32) t512_cvt(src, tile, tid); else t512_dma(src, tile, wave, lane); VM_WAIT(); __syncthreads(); }
                const int kboff = r32 * STRB + (hd * 128 + 8 * hi) * 2;
                const int vboff = (4 * hi + q4) * STRB + (hd * 128 + 64 + 16 * ((lane >> 4) & 1) + 4 * (lane & 3)) * 2;
                volatile LAS unsigned* sbflag = MISC + 20;
                if (tid == 0) { sbflag[0] = 0u; sbflag[1] = 0u; sbflag[2] = 0u; }
                __syncthreads();
                int cb = 0;
                for (int t = u.nt - 1; t >= 0; --t) {
                    LAS char* cur = tile + cb * T512_BYTES; LAS char* nxb = tile + (cb ^ 1) * T512_BYTES; cb ^= 1;
                    const LAS char* kb = cur + kboff; const LAS char* vb = cur + vboff;
                    bool f32n = false; const void* sn = nullptr; if (t > 0) { sn = tile_src(u, t - 1, cache_lb, RC, 512, 0, f32n); if (!f32n) t512_dma(sn, nxb, wave, lane); }
                    const bool diag = (t == u.nt - 1);
                    f32x16 z0, z1; qk<4>(z0, z1, kb, STRB, q);
                    f32x16 u0, u1; float gs[8];
#pragma unroll
                    for (int r = 0; r < 16; ++r) {
                        const int key = crow(r, hi);
                        { const float e = __builtin_amdgcn_exp2f(fminf(z0[r], 80.f)); const float uu = __builtin_amdgcn_rcpf(1.0f + e); const bool ok = !diag || (key < qloc); u0[r] = ok ? uu : 1.0f; z0[r] = ok ? e * uu : 0.f; }
                        { const float e = __builtin_amdgcn_exp2f(fminf(z1[r], 80.f)); const float uu = __builtin_amdgcn_rcpf(1.0f + e); const bool ok = !diag || (key + 32 < qloc); u1[r] = ok ? uu : 1.0f; z1[r] = ok ? e * uu : 0.f; }
                    }
#pragma unroll
                    for (int g4 = 0; g4 < 4; ++g4) { gs[g4] = (u0[4 * g4] * u0[4 * g4 + 1]) * (u0[4 * g4 + 2] * u0[4 * g4 + 3]); gs[4 + g4] = (u1[4 * g4] * u1[4 * g4 + 1]) * (u1[4 * g4 + 2] * u1[4 * g4 + 3]); }
                    float pg[8];
#pragma unroll
                    for (int g8 = 0; g8 < 8; ++g8) pg[g8] = __shfl_xor(gs[g8], 32);
                    float run = carry;
#pragma unroll
                    for (int g8 = 7; g8 >= 0; --g8) {
                        float P = run * (hi == 0 ? pg[g8] : 1.0f);
                        if (g8 >= 4) { const int b4 = 4 * (g8 - 4);
                            z1[b4 + 3] *= P; P *= u1[b4 + 3]; z1[b4 + 2] *= P; P *= u1[b4 + 2]; z1[b4 + 1] *= P; P *= u1[b4 + 1]; z1[b4] *= P;
                        } else { const int b4 = 4 * g8;
                            z0[b4 + 3] *= P; P *= u0[b4 + 3]; z0[b4 + 2] *= P; P *= u0[b4 + 2]; z0[b4 + 1] *= P; P *= u0[b4 + 1]; z0[b4] *= P;
                        }
                        run *= gs[g8] * pg[g8];
                    }
                    carry = run;
                    pv<2>(o, z0, z1, vb, STRB);
                    if (t > 0 && f32n) t512_cvt(sn, nxb, tid);
                    if (tid == 0) sbflag[(it3 + 1) % 3] = 0u;
                    if (__any(carry != 0.f) && lane == 0) sbflag[it3] = 1u;
                    VM_WAIT(); __syncthreads();
                    const bool alive = sbflag[it3] != 0u; it3 = (it3 + 1) % 3;
                    if (!alive) break;
                }
                bf16* orow = CC + (size_t)myq * KOUT + 768 + hd * 64;
#pragma unroll
                for (int db = 0; db < 2; ++db)
#pragma unroll
                    for (int gq = 0; gq < 4; ++gq) { v2u w; w.x = cvtpk(o[db][4 * gq], o[db][4 * gq + 1]); w.y = cvtpk(o[db][4 * gq + 2], o[db][4 * gq + 3]);
                        *(v2u*)(orow + 32 * db + 8 * gq + 4 * hi) = w; }
            }
            }
#endif
            }
            if (BOTH(pb + 4)) GRID_BAR();
        }
        if (EN_PH(6) && IN(pb + 5)) {
            pg8::Gemm g{CC, (const bf16*)(wl + W_OUT), M, DM, KOUT, KOUT}; pg8::StaticOrder S; S.init(M, DM, G, (int)blockIdx.x);
            pg8::EpiResid<false> E{nullptr, nullptr, XB, ssqC, 1.0f};
            pg8::gemm_phase<pg8::EpiResid<false>, pg8::StaticOrder, true, true>(lds, g, S, E, wave0);
            if (BOTH(pb + 5)) GRID_BAR();
        }
        if (EN_PH(7) && IN(pb + 6)) {
            pg8::Gemm g{XB, (const bf16*)(wl + W_GU2), M, NGU, DM, DM}; pg8::StaticOrder S; S.init(M, NGU, G, (int)blockIdx.x);
            pg8::EpiSwiGLU E{ACT, ssqC};
            for (int grep = 0; grep < GU_REPS; ++grep)
            pg8::gemm_phase<pg8::EpiSwiGLU, pg8::StaticOrder, true, true>(lds, g, S, E, wave0);
            if (BOTH(pb + 6)) GRID_BAR();
        }
        if (EN_PH(8) && IN(pb + 7)) {
            pg8::Gemm g{ACT, (const bf16*)(wl + W_D2), M, DM, DFF, DFF}; pg8::StaticOrder S; S.init(MP, DM, G, (int)blockIdx.x);
            pg8::EpiResid<false> E{nullptr, nullptr, XB, ssqAn, 0.5f};
            pg8::gemm_phase<pg8::EpiResid<false>, pg8::StaticOrder, true, true>(lds, g, S, E, wave0);
            SPLITK_SAMPLE(W_D2);
            GRID_BAR();
            { FRESH_TID(); const int un_ = (int)blockIdx.x >> 3, j_ = (int)blockIdx.x & 7; const float* Pu = (const float*)(ws + WS_QA) + (size_t)un_ * 8 * 32 * 512 * 4;
              pg8::resid_fixup<false>(Pu, MP / 256 + (un_ >> 2), un_ & 3, j_ >> 2, j_ & 3, nullptr, XB, ssqAn, 0.5f, tid); }
            if (BOTH(pb + 7)) GRID_BAR();
        }
    }
    if (EN_PH(9) && IN(17)) {
        FRESH_TID();
        const float* fn = ARG_IN(I_FN); const float* ssqF = SSQP + (size_t)2 * M * 16;
        const int gw = blockIdx.x * NWAVES + wave, NGW = G * NWAVES;
        for (int m = gw; m < M; m += NGW) {
            const float rs = 1.0f / sqrtf(ssq_sum16(ssqF, m) * (1.0f / 1024.0f) + EPS);
            const v2u* x2 = (const v2u*)(XB + (size_t)m * DM) + lane; f32x4* y4 = (f32x4*)(X + (size_t)m * DM) + lane; const f32x4* g4 = (const f32x4*)fn + lane;
#pragma unroll
            for (int j = 0; j < 4; ++j) { const v2u w = x2[64 * j]; const f32x4 gg = g4[64 * j];
                const f32x4 v = (f32x4){__uint_as_float(w.x << 16), __uint_as_float(w.x & 0xffff0000u), __uint_as_float(w.y << 16), __uint_as_float(w.y & 0xffff0000u)};
                y4[64 * j] = v * rs * gg; }
        }
    }
#undef IN
#undef BOTH
#undef GRID_BAR
#undef X
#undef XB
#undef HB
#undef ACT
#undef QA
#undef QB
#undef QI
#undef QC
#undef QD
#undef WI
#undef RA
#undef RB
#undef RC
#undef RD
#undef CC
#undef CQ
#undef CKV
#undef SSQP
#undef LAMF
#undef ROPE64
#undef ROPE32
}


#if SELFCHECK
constexpr size_t WS_CHK = 3 * MiB + 768 * 1024;
__device__ __forceinline__ unsigned hsh(unsigned x) { x ^= x >> 16; x *= 0x7feb352du; x ^= x >> 15; x *= 0x846ca68bu; x ^= x >> 16; return x; }
__device__ __forceinline__ void chk_rep(unsigned* slot, float got, float ex, float atol, float rtol) {
    float e = fabsf(got - ex) / (atol + rtol * fabsf(ex)); if (!(e == e)) e = 1e30f; atomicMax(slot, __float_as_uint(e)); }
__device__ __forceinline__ float bfr(float x) { return bf2f((bf16)f2bf(x)); }
__device__ __forceinline__ int nat_col(int np) { return np < 1376 ? np : (np < 2912 ? np + 8 : (np < 2920 ? 1376 + (np - 2912) : -1)); }
struct Ptrs { float* X; bf16 *XB, *HB, *ACT, *QA, *QB, *QI, *QC, *QD, *RA, *RB, *RC, *RD, *CC; float* WI; float* SSQ; float* LAMF; float2 *R64, *R32; unsigned* chk; float* save; unsigned char* wl; };
__device__ __forceinline__ Ptrs mkptrs(const Args& a, int l) { Ptrs p; unsigned char* ws = a.ws;
    p.X = a.out; p.XB = (bf16*)(ws + WS_XB); p.HB = (bf16*)(ws + WS_REGA); p.ACT = p.HB; p.QA = (bf16*)(ws + WS_QA); p.QB = (bf16*)(ws + WS_QB); p.QI = (bf16*)(ws + WS_QI); p.QC = (bf16*)(ws + WS_QC); p.QD = (bf16*)(ws + WS_QD);
    p.RA = (bf16*)(ws + WS_RA); p.RB = (bf16*)(ws + WS_RB); p.RC = (bf16*)(ws + WS_RC); p.RD = (bf16*)(ws + WS_RD); p.CC = (bf16*)(ws + WS_CC); p.WI = (float*)(ws + WS_WI); p.SSQ = (float*)(ws + WS_SSQ);
    p.LAMF = (float*)(ws + WS_MISC); p.R64 = (float2*)(ws + WS_MISC + MISC_ROPE64); p.R32 = (float2*)(ws + WS_MISC + MISC_ROPE32); p.chk = (unsigned*)(ws + WS_CHK); p.save = (float*)(ws + WS_CHK + 256); p.wl = ws + WS_W + (size_t)l * W_LAYER; return p; }
__device__ __forceinline__ int samp_row(unsigned h) { const unsigned r = h % 4096u; return r < 3584u ? (int)(hsh(h) % (unsigned)MP) : MP + (int)(hsh(h) % (unsigned)MS); }

__global__ void __launch_bounds__(256) check_kernel(Args a, int l, int which) {
    const Ptrs p = mkptrs(a, l); const int gt = blockIdx.x * 256 + threadIdx.x, NT = gridDim.x * 256; const int lane = threadIdx.x & 63; const int gwv = gt >> 6, NW = NT >> 6;
    const float* ssqA = p.SSQ + (size_t)l * M; const float* ssqB = p.SSQ + (size_t)(3 + l) * M; const float* ssqC = p.SSQ + (size_t)(5 + l) * M; const float* ssqQ = p.SSQ + (size_t)(7 + l) * M;
    if (which == 0) {
        for (int i = gt; i < 16384; i += NT) { const unsigned h = hsh(i * 3 + 1);
            { const int np = h % NGU, k = hsh(h) % DM, pn = np >> 8, c = np & 255, f = pn * 128 + (c & 127); const float* src = (c < 128 ? a.in[I_G1] : a.in[I_U1]) + (size_t)l * DM * DFF;
              chk_rep(p.chk + 0, bf2f(((bf16*)(p.wl + W_GU1))[(size_t)np * DM + k]), bfr(src[(size_t)k * DFF + f] * a.in[I_N1][l * DM + k]), 1e-6f, 1e-3f); }
            { const int n = h % DM, k = hsh(h + 7) % DFF; chk_rep(p.chk + 1, bf2f(((bf16*)(p.wl + W_D1))[(size_t)n * DFF + k]), bfr(a.in[I_D1][(size_t)l * DFF * DM + (size_t)k * DM + n]), 1e-6f, 1e-3f); }
            { const int np = h % NINP, k = hsh(h + 9) % DM, j = nat_col(np); const float ex = j < 0 ? 0.f : bfr(a.in[I_WIN][(size_t)l * DM * NIN + (size_t)k * NIN + j] * a.in[I_NM][l * DM + k]);
              chk_rep(p.chk + 2, bf2f(((bf16*)(p.wl + W_IN))[(size_t)np * DM + k]), ex, 1e-6f, 1e-3f); }
            if (l == 0) { const int row = samp_row(h), c = hsh(h + 11) % DM; const float xv = row < MP ? a.in[I_XP][(size_t)row * DM + c] : a.in[I_XS][(size_t)(row - MP) * DM + c];
              chk_rep(p.chk + 3, bf2f(p.XB[(size_t)row * DM + c]), bfr(xv), 1e-6f, 1e-3f); }
        }
        if (l == 0) for (int i = gwv; i < 256; i += NW) { const int row = samp_row(hsh(i + 77)); const float* xr = row < MP ? a.in[I_XP] + (size_t)row * DM : a.in[I_XS] + (size_t)(row - MP) * DM;
            float s = 0.f; for (int c = lane; c < DM; c += 64) s += xr[c] * xr[c]; s = wave_sum(s); if (lane == 0) chk_rep(p.chk + 3, ssqA[row], s, 1e-3f, 1e-3f); }
    }
    if (which == 1) {
        for (int i = gt; i < 8192; i += NT) { const unsigned h = hsh(i * 5 + 2); const int row = samp_row(h), f = hsh(h + 1) % DFF; const bf16* wg = (bf16*)(p.wl + W_GU1) + (size_t)((f >> 7) * 256 + (f & 127)) * DM; const bf16* wu = wg + (size_t)128 * DM;
            const float* ssq = ssqA; float g = 0.f, u = 0.f; for (int k = 0; k < DM; ++k) { const float xv = bf2f(p.XB[(size_t)row * DM + k]); g += xv * bf2f(wg[k]); u += xv * bf2f(wu[k]); }
            const float rs = 1.0f / sqrtf(ssq[row] / 1024.f + EPS); g *= rs; u *= rs; const float ex = g / (1.f + expf(-g)) * u;
            chk_rep(p.chk + 4, bf2f(p.ACT[(size_t)row * DFF + f]), ex, 0.01f, 0.02f); }
    }
    if (which == 2) {
        for (int i = gt; i < 8192; i += NT) { const unsigned h = hsh(i * 7 + 3); const int row = samp_row(h), c = hsh(h + 1) % DM; const bf16* wd = (bf16*)(p.wl + W_D1) + (size_t)c * DFF;
            float s = 0.f; for (int k = 0; k < DFF; ++k) s += bf2f(p.ACT[(size_t)row * DFF + k]) * bf2f(wd[k]);
            const float xin = l == 0 ? (row < MP ? a.in[I_XP][(size_t)row * DM + c] : a.in[I_XS][(size_t)(row - MP) * DM + c]) : 0.f;
            if (l == 0) chk_rep(p.chk + 5, p.X[(size_t)row * DM + c], xin + 0.5f * s, 0.01f, 0.005f);
            chk_rep(p.chk + 5, bf2f(p.XB[(size_t)row * DM + c]), bfr(p.X[(size_t)row * DM + c]), 1e-6f, 1e-3f); }
        for (int i = gwv; i < 256; i += NW) { const int row = samp_row(hsh(i + 177)); float s = 0.f; for (int c = lane; c < DM; c += 64) { const float v = p.X[(size_t)row * DM + c]; s += v * v; } s = wave_sum(s);
            if (lane == 0) chk_rep(p.chk + 5, ssqB[row], s, 1e-3f, 1e-3f); }
    }
    if (which == 3) {
        for (int i = gt; i < 8192; i += NT) { const unsigned h = hsh(i * 11 + 4); const int row = samp_row(h), np = hsh(h + 1) % NINP; const bf16* w = (bf16*)(p.wl + W_IN) + (size_t)np * DM;
            float s = 0.f; for (int k = 0; k < DM; ++k) s += bf2f(p.XB[(size_t)row * DM + k]) * bf2f(w[k]); s *= 1.0f / sqrtf(ssqB[row] / 1024.f + EPS);
            chk_rep(p.chk + 6, bf2f(p.HB[(size_t)row * NINP + np]), s, 0.01f, 0.01f); }
        for (int i = gwv; i < 256; i += NW) { const int row = samp_row(hsh(i + 277)); float s = 0.f; for (int c = lane; c < 256; c += 64) { const float v = bf2f(p.HB[(size_t)row * NINP + c]); s += v * v; } s = wave_sum(s);
            if (lane == 0) chk_rep(p.chk + 6, ssqQ[row], s, 0.05f, 0.01f); }
    }
    if (which == 4) {
        const float* wqb = a.in[I_WQB] + (size_t)l * 256 * 384; const float* wkvb = a.in[I_WKVB] + (size_t)l * 128 * 512; const float* qn = a.in[I_QN] + l * 256;
        for (int i = gt; i < 2048; i += NT) { const unsigned h = hsh(i * 13 + 5); const int row = samp_row(h), hh = (hsh(h + 1) >> 3) & 3, c = hsh(h + 2) % 160; const bf16* hr = p.HB + (size_t)row * NINP;
            const float rs = 1.0f / sqrtf(ssqQ[row] / 256.f + EPS); float ex;
            if (c < 128) { float acc = 0.f; for (int e = 0; e < 64; ++e) { float qe = 0.f; for (int k = 0; k < 256; ++k) qe += bf2f(hr[k]) * rs * qn[k] * wqb[(size_t)k * 384 + hh * 96 + e]; acc += qe * wkvb[(size_t)c * 512 + hh * 128 + e]; } ex = acc; }
            else { float qe = 0.f; for (int k = 0; k < 256; ++k) qe += bf2f(hr[k]) * rs * qn[k] * wqb[(size_t)k * 384 + hh * 96 + 64 + (c - 128)]; ex = qe; }
            ex *= 0.10206207261596575f * LOG2E;
            chk_rep(p.chk + 7, bf2f(p.QA[(size_t)row * NQP + hh * 160 + c]), ex, 0.01f, 0.02f); }
        for (int i = gt; i < 16384; i += NT) { const unsigned h = hsh(i * 17 + 6); const int row = samp_row(h); const bool smp = row >= MP; const int rr = smp ? row - MP : row; const float pos = smp ? 4096.f + (rr & 63) : (float)(rr & 2047);
            const bf16* hr = p.HB + (size_t)row * NINP;
            const float* o_mla = a.out + (smp ? O_MLA_S + ((size_t)l * MS + rr) * 160 : O_MLA_P + ((size_t)l * MP + rr) * 160);
            const float* o_dsa = a.out + (smp ? O_DSA_S + ((size_t)l * MS + rr) * 192 : O_DSA_P + ((size_t)l * MP + rr) * 192);
            const float* o_sb = a.out + (smp ? O_SB_S + ((size_t)l * MS + rr) * 512 : O_SB_P + ((size_t)l * MP + rr) * 512);
            const float* o_df = a.out + (smp ? O_DIFF_S + ((size_t)l * MS + rr) * 512 : O_DIFF_P + ((size_t)l * MP + rr) * 512);
#define HN(j) bf2f(hr[(j) < 1376 ? (j) : ((j) < 1384 ? H_WI + ((j) - 1376) : (j) - 8)])
#define ROPE(base, d, idx, res) do { const int hf = (d) / 2, ii = (idx) % hf; const float fr = (d) == 64 ? a.freq64[ii] : a.freq32[ii]; float sn, cs; sincos_acc(pos * fr, sn, cs); \
            const float x1 = HN((base) + ii), x2 = HN((base) + hf + ii); res = (idx) < hf ? x1 * cs - x2 * sn : x2 * cs + x1 * sn; } while (0)
            const int sel = hsh(h + 3) % 12; const unsigned e = hsh(h + 4);
            if (sel == 0) { const int c = e % 128; float ss = 0.f; for (int k = 0; k < 128; ++k) { const float v = HN(256 + k); ss += v * v; } const float ex = HN(256 + c) / sqrtf(ss / 128.f + EPS) * a.in[I_KVN][l * 128 + c];
                chk_rep(p.chk + 8, o_mla[c], ex, 0.01f, 0.01f); chk_rep(p.chk + 8, bf2f(p.RA[(size_t)row * 160 + c]), ex, 0.01f, 0.01f); }
            if (sel == 1) { const int c = e % 32; float ex; ROPE(384, 32, c, ex); chk_rep(p.chk + 8, o_mla[128 + c], ex, 0.01f, 0.01f); chk_rep(p.chk + 8, bf2f(p.RA[(size_t)row * 160 + 128 + c]), ex, 0.01f, 0.01f); }
            if (sel == 2) { const int c = e % 256, hd = c >> 6; float ex; ROPE(416 + hd * 64, 64, c & 63, ex); chk_rep(p.chk + 8, bf2f(p.QB[(size_t)row * 256 + c]), ex * 0.125f * LOG2E, 0.01f, 0.01f); }
            if (sel == 3) { const int c = e % 64; float ex; ROPE(672, 64, c, ex); chk_rep(p.chk + 8, o_dsa[c], ex, 0.01f, 0.01f); chk_rep(p.chk + 8, bf2f(p.RB[(size_t)row * 192 + c]), ex, 0.01f, 0.01f);
                            const float v = HN(736 + c); chk_rep(p.chk + 8, o_dsa[64 + c], v, 0.01f, 0.01f); chk_rep(p.chk + 8, bf2f(p.RB[(size_t)row * 192 + 64 + c]), v, 0.01f, 0.01f); }
            if (sel == 4) { const int c = e % 512, hd = c >> 6; float ex; ROPE(800 + hd * 64, 64, c & 63, ex); chk_rep(p.chk + 8, bf2f(p.QI[(size_t)row * 512 + c]), ex, 0.01f, 0.01f); }
            if (sel == 5) { const int c = e % 64; float ex; ROPE(1312, 64, c, ex); chk_rep(p.chk + 8, o_dsa[128 + c], ex, 0.01f, 0.01f); chk_rep(p.chk + 8, bf2f(p.RB[(size_t)row * 192 + 128 + c]), ex, 0.01f, 0.01f);
                            const int w8 = e % 8; chk_rep(p.chk + 8, p.WI[(size_t)row * 8 + w8], HN(1376 + w8) * 0.35355339f, 0.005f, 0.01f); }
            if (sel == 6) { const int c = e % 256, hd = c >> 6, d = c & 63; chk_rep(p.chk + 8, bf2f(p.QC[(size_t)row * 256 + c]), HN(1384 + c) * 0.125f, 0.005f, 0.01f);
                            chk_rep(p.chk + 8, o_sb[hd * 128 + d], HN(1640 + c), 0.01f, 0.01f); chk_rep(p.chk + 8, o_sb[hd * 128 + 64 + d], HN(1896 + c), 0.01f, 0.01f);
                            chk_rep(p.chk + 8, bf2f(p.RC[(size_t)row * 512 + hd * 128 + d]), HN(1640 + c), 0.01f, 0.01f); chk_rep(p.chk + 8, bf2f(p.RC[(size_t)row * 512 + hd * 128 + 64 + d]), HN(1896 + c), 0.01f, 0.01f); }
            if (sel == 7) { const int c = e % 256, blk = c >> 5; float ex; ROPE(2152 + blk * 32, 32, c & 31, ex); chk_rep(p.chk + 8, bf2f(p.QD[(size_t)row * 256 + c]), ex * 0.17677669529663687f * LOG2E, 0.01f, 0.01f); }
            if (sel == 8) { const int c = e % 256, blk = c >> 5, hd = c >> 6; float ex; ROPE(2408 + blk * 32, 32, c & 31, ex); chk_rep(p.chk + 8, o_df[hd * 128 + (c & 63)], ex, 0.01f, 0.01f); chk_rep(p.chk + 8, bf2f(p.RD[(size_t)row * 512 + hd * 128 + (c & 63)]), ex, 0.01f, 0.01f); }
            if (sel == 9) { const int c = e % 256, hd = c >> 6, d = c & 63; chk_rep(p.chk + 8, o_df[hd * 128 + 64 + d], HN(2664 + c), 0.01f, 0.01f); chk_rep(p.chk + 8, bf2f(p.RD[(size_t)row * 512 + hd * 128 + 64 + d]), HN(2664 + c), 0.01f, 0.01f); }
        }
    }
    if (which == 5) {
        for (int i = gwv; i < 4 * 96; i += NW) {
            int kind = i / 96; const int slot = kind; const unsigned h = hsh(i * 19 + 7); int row = samp_row(h);
            if (CHK_FILTER == 6) { row = MP + (int)(hsh(h + 5) % (unsigned)MS); if (slot == 1) { kind = 2; row = (row & ~63) | (int)(hsh(h + 9) % 3u); } if (slot == 2) row = (row & ~63) | (48 + (int)(hsh(h + 9) % 16u)); }
            if (CHK_FILTER == 1) row = (int)(hsh(h + 5) % NB) * SEQ + (int)(hsh(h + 6) % 64u);
            if (CHK_FILTER == 2) row = (int)(hsh(h + 5) % (unsigned)MP);
            if (CHK_FILTER == 3) row = MP + (int)(hsh(h + 5) % (unsigned)MS);
            if (CHK_FILTER == 5) { if (kind == 0 || kind == 2) row = MP + (int)(hsh(h + 5) % (unsigned)MS); else if (kind == 1) row = (int)(hsh(h + 5) % NB) * SEQ + 128 + (int)(hsh(h + 6) % 128u); else row = (int)(hsh(h + 5) % NB) * SEQ + 128 + (int)(hsh(h + 6) % 384u); }
            if (CHK_FILTER == 4) row = (int)(hsh(h + 5) % NB) * SEQ + 64 + (int)(hsh(h + 6) % 64u); const int hd = (hsh(h + 1) >> 5) & 3; const bool smp = row >= MP; const int rr = smp ? row - MP : row;
            const int b = smp ? rr >> 6 : rr >> 11, t = smp ? rr & 63 : rr & 2047; const int L = smp ? PAST + 64 : ((t >> 6) + 1) * 64;
            const int W = kind == 0 ? 160 : (kind == 1 ? 192 : 512);
            const float* cache = (kind == 0 ? a.in[I_CMLA] : kind == 1 ? a.in[I_CDSA] : kind == 2 ? a.in[I_CSB] : a.in[I_CDIFF]) + (size_t)(l * NB + b) * PAST * W;
            const bf16* rows = kind == 0 ? p.RA : kind == 1 ? p.RB : kind == 2 ? p.RC : p.RD;
#define SLD(ptr) __hip_atomic_load((ptr), __ATOMIC_RELAXED, __HIP_MEMORY_SCOPE_AGENT)
#define KEL(k, c) (smp ? ((k) < PAST ? bfr(cache[(size_t)(k) * W + (c)]) : bf2f(rows[(size_t)(MP + b * 64 + (k) - PAST) * W + (c)])) : bf2f(rows[(size_t)(b * SEQ + (k)) * W + (c)]))
            float* sbuf = (float*)(a.ws + WS_REGA + (size_t)300 * MiB) + (size_t)i * 8448;
            if (kind == 0) {
                const int pidx = smp ? 2048 + t : t; float mx = -1e30f;
                for (int k = lane; k < L; k += 64) { float s = 0.f; for (int c = 0; c < 128; ++c) s += bf2f(p.QA[(size_t)row * NQP + hd * 160 + c]) * KEL(k, c);
                    for (int c = 0; c < 16; ++c) { const float2 cs = p.R32[pidx * 16 + c]; const float x1 = bf2f(p.QA[(size_t)row * NQP + hd * 160 + 128 + c]), x2 = bf2f(p.QA[(size_t)row * NQP + hd * 160 + 144 + c]);
                        s += bfr(x1 * cs.x - x2 * cs.y) * KEL(k, 128 + c) + bfr(x2 * cs.x + x1 * cs.y) * KEL(k, 144 + c); }
                    sbuf[k] = s; mx = fmaxf(mx, s); }
                for (int o = 1; o < 64; o <<= 1) mx = fmaxf(mx, __shfl_xor(mx, o));
                float den = 0.f; for (int k = lane; k < L; k += 64) { float pp = exp2f(sbuf[k] - mx); if (DBG_VARIANTS) pp = 1.f; sbuf[k] = pp; den += pp; } den = wave_sum(den);
                __builtin_amdgcn_s_waitcnt(0);
                for (int d = 0; d < 128; d += 16) { const int dd = d + (lane & 15); float acc = 0.f; for (int k = lane >> 4; k < L; k += 4) acc += SLD(sbuf + k) * KEL(k, dd); acc += __shfl_xor(acc, 16); acc += __shfl_xor(acc, 32);
                    if (lane < 16) chk_rep(p.chk + 9, bf2f(p.CC[(size_t)row * KOUT + hd * 128 + dd]), acc / den, 0.004f, 0.03f); }
            }
            if (kind == 1) {
                const int nsel = 256;
                for (int k = lane; k < L; k += 64) { float sc = 0.f; for (int ih = 0; ih < 8; ++ih) { float s = 0.f; for (int c = 0; c < 64; ++c) s += bf2f(p.QI[(size_t)row * 512 + ih * 64 + c]) * KEL(k, 128 + c); sc += fmaxf(s, 0.f) * p.WI[(size_t)row * 8 + ih]; } sbuf[k] = sc; }
                __builtin_amdgcn_s_waitcnt(0);
                float mx = -1e30f; float* pb = sbuf + 4224;
                for (int k = lane; k < L; k += 64) { const float me = sbuf[k]; int rank = 0; if (L > nsel) for (int j = 0; j < L; ++j) { const float o = SLD(sbuf + j); rank += (o > me) || (o == me && j < k); }
                    float s = -1e30f; if (rank < nsel) { s = 0.f; for (int c = 0; c < 64; ++c) s += bf2f(p.QB[(size_t)row * 256 + hd * 64 + c]) * KEL(k, c); } pb[k] = s; mx = fmaxf(mx, s); }
                for (int o = 1; o < 64; o <<= 1) mx = fmaxf(mx, __shfl_xor(mx, o));
                float den = 0.f; for (int k = lane; k < L; k += 64) { const float pp = pb[k] > -1e29f ? exp2f(pb[k] - mx) : 0.f; pb[k] = pp; den += pp; } den = wave_sum(den);
                __builtin_amdgcn_s_waitcnt(0);
                for (int d = 0; d < 64; d += 16) { const int dd = d + (lane & 15); float acc = 0.f; for (int k = lane >> 4; k < L; k += 4) acc += SLD(pb + k) * KEL(k, 64 + dd); acc += __shfl_xor(acc, 16); acc += __shfl_xor(acc, 32);
                    if (lane < 16) chk_rep(p.chk + 10, bf2f(p.CC[(size_t)row * KOUT + 512 + hd * 64 + dd]), acc / den, 0.02f, 0.10f); }
            }
            if (kind == 2) {
                const int qpos = smp ? PAST + t : t; float accv[1]; (void)accv;
                for (int k = lane; k < qpos; k += 64) { float z = 0.f; for (int c = 0; c < 64; ++c) z += bf2f(p.QC[(size_t)row * 256 + hd * 64 + c]) * KEL(k, hd * 128 + c); sbuf[k] = z; }
                __builtin_amdgcn_s_waitcnt(0);
                float logafter = 0.f, acc = 0.f;
                for (int k = qpos - 1; k >= 0; --k) { const float z = SLD(sbuf + k); const float sp = fmaxf(z, 0.f) + logf(1.f + expf(-fabsf(z))); const float aw = expf(z - sp + logafter); acc += bfr(aw) * KEL(k, hd * 128 + 64 + lane); logafter -= sp; if (logafter < -60.f) break; }
                chk_rep(p.chk + 9 + slot, bf2f(p.CC[(size_t)row * KOUT + 768 + hd * 64 + lane]), acc, 0.02f, 0.05f);
            }
            if (kind == 3) {
                float outv = 0.f; float o2[2];
                for (int m2 = 0; m2 < 2; ++m2) { float mx = -1e30f;
                    for (int k = lane; k < L; k += 64) { float s = 0.f; for (int c = 0; c < 32; ++c) s += bf2f(p.QD[(size_t)row * 256 + hd * 64 + m2 * 32 + c]) * KEL(k, hd * 128 + m2 * 32 + c); sbuf[k] = s; mx = fmaxf(mx, s); }
                    for (int o = 1; o < 64; o <<= 1) mx = fmaxf(mx, __shfl_xor(mx, o));
                    float den = 0.f; for (int k = lane; k < L; k += 64) { const float pp = exp2f(sbuf[k] - (DBG_VARIANTS ? 8.f : mx)); sbuf[k] = pp; den += pp; } den = wave_sum(den);
                    __builtin_amdgcn_s_waitcnt(0);
                    float acc = 0.f; for (int k = 0; k < L; ++k) acc += SLD(sbuf + k) * KEL(k, hd * 128 + 64 + lane); o2[m2] = acc / den; __builtin_amdgcn_s_waitcnt(0); }
                outv = o2[0] - p.LAMF[l] * o2[1]; const float ss = wave_sum(outv * outv); const float lam_init = 0.8f - 0.6f * expf(-0.3f * (float)l);
                const float ex = outv / sqrtf(ss / 64.f + EPS) * a.in[I_DN][l * 64 + lane] * (1.f - lam_init);
                chk_rep(p.chk + 12, bf2f(p.CC[(size_t)row * KOUT + 1024 + hd * 64 + lane]), ex, 0.02f, 0.05f);
            }
        }
    }
    if (which == 6) { for (int i = gt; i < 4096; i += NT) { const unsigned h = hsh(i * 23 + 8); const int row = samp_row(h), c = hsh(h + 1) % DM; p.save[i] = p.X[(size_t)row * DM + c]; } }
    if (which == 7) {
        const float* wkvb = a.in[I_WKVB] + (size_t)l * 128 * 512; const float* wo = a.in[I_WO] + (size_t)l * DM * DM;
        for (int i = gt; i < 4096; i += NT) { const unsigned h = hsh(i * 23 + 8); const int row = samp_row(h), c = hsh(h + 1) % DM; const bf16* w = (bf16*)(p.wl + W_OUT) + (size_t)c * KOUT;
            float s = 0.f; for (int k = 0; k < KOUT; ++k) s += bf2f(p.CC[(size_t)row * KOUT + k]) * bf2f(w[k]);
            chk_rep(p.chk + 13, p.X[(size_t)row * DM + c], p.save[i] + s, 0.01f, 0.005f);
            float s1 = 0.f, s2 = 0.f; for (int k = 0; k < 512; ++k) s1 += bf2f(p.CC[(size_t)row * KOUT + k]) * bf2f(w[k]);
            for (int hh = 0; hh < 4; ++hh) for (int e = 0; e < 64; ++e) { float v = 0.f; for (int cc = 0; cc < 128; ++cc) v += bf2f(p.CC[(size_t)row * KOUT + hh * 128 + cc]) * wkvb[(size_t)cc * 512 + hh * 128 + 64 + e]; s2 += v * wo[(size_t)(hh * 64 + e) * DM + c]; }
            chk_rep(p.chk + 14, s1, s2, 0.01f, 0.02f);
            for (int k = 512; k < KOUT; k += 97) chk_rep(p.chk + 14, bf2f(w[k]), bfr(wo[(size_t)(256 + k - 512) * DM + c]), 1e-6f, 1e-3f); }
    }
}
#ifndef CHK_SHOW
#define CHK_SHOW -1
#endif
#ifndef CHK_MAXLI
#define CHK_MAXLI 6
#endif
__global__ void __launch_bounds__(256) report_kernel(Args a) {
    const unsigned* chk = (const unsigned*)(a.ws + WS_CHK); float A = 0.f;
    if (CHK_SHOW >= 0) { A = sqrtf(fminf(__uint_as_float(chk[CHK_SHOW >= 0 ? CHK_SHOW : 0]), 400.f)); if (A < 0.3f) A = 0.f; }
    else if (CHK_SHOW == -2) { int bits = 0; for (int f = 9; f <= 12; ++f) if (__uint_as_float(chk[f]) > 1.0f) bits |= 1 << (f - 9); A = (float)(1 + bits); }
    else for (int f = 0; f < 15; ++f) if (__uint_as_float(chk[f]) > 1.0f) { A = (float)(f + 1); break; }
    if (A == 0.f) return;
    for (size_t i = (size_t)blockIdx.x * 256 + threadIdx.x; i < (size_t)M * DM; i += (size_t)gridDim.x * 256) a.out[i] = A;
}
#endif

extern "C" void kernel_launch(void* const* d_in, const int* in_sizes, int n_in, void* d_out, int out_size, void* d_ws, size_t ws_size, hipStream_t stream) {
    static int grid = 0;
    if (grid == 0) {
        if (n_in != 24 || (size_t)out_size != O_END || ws_size < WS_END) { fprintf(stderr, "kernel_launch: unexpected shapes: n_in %d out %d ws %zu (need %zu)\n", n_in, out_size, ws_size, (size_t)WS_END); grid = -1; return; }
        int dev = 0, cus = 0, per_cu = 0;
        if (hipGetDevice(&dev) != hipSuccess || hipDeviceGetAttribute(&cus, hipDeviceAttributeMultiprocessorCount, dev) != hipSuccess) { grid = -1; return; }
        if (hipFuncSetAttribute((const void*)fwd_kernel, hipFuncAttributeMaxDynamicSharedMemorySize, LDS_BYTES) != hipSuccess) { fprintf(stderr, "kernel_launch: hipFuncSetAttribute failed\n"); grid = -1; return; }
        if (hipOccupancyMaxActiveBlocksPerMultiprocessor(&per_cu, (const void*)fwd_kernel, NWAVES * 64, LDS_BYTES) != hipSuccess || per_cu < 1) fprintf(stderr, "kernel_launch: occupancy query reports %d\n", per_cu);
        (void)hipGetLastError();
        grid = cus < 256 ? cus : 256;
    }
    if (grid < 0) return;
    (void)hipMemsetAsync((char*)d_ws + WS_CTL, 0, CTL_ZERO_BYTES, stream);
    Args a{};
    for (int i = 0; i < 24; ++i) a.in[i] = (const float*)d_in[i];
    a.out = (float*)d_out; a.ws = (unsigned char*)d_ws;
    for (int i = 0; i < 32; ++i) a.freq64[i] = (float)pow(10000.0, -(double)i * 2.0 / 64.0);
    for (int i = 0; i < 16; ++i) a.freq32[i] = (float)pow(10000.0, -(double)i * 2.0 / 32.0);
    constexpr int NPH = 18;
    for (int li = 0; li < MK_N_LAUNCHES; ++li) {
        a.ph_lo = (MK_N_LAUNCHES == 1) ? 0 : li; a.ph_hi = (MK_N_LAUNCHES == 1) ? NPH : li + 1;
#if SELFCHECK
        if (MK_N_LAUNCHES == 18 && li == 6 && CHK_MAXLI >= 6) hipLaunchKernelGGL(check_kernel, dim3(256), dim3(256), 0, stream, a, 0, 6);
#endif
        hipLaunchKernelGGL(fwd_kernel, dim3(grid), dim3(NWAVES * 64), LDS_BYTES, stream, a);
        const hipError_t le = hipPeekAtLastError();
        if (le != hipSuccess) { fprintf(stderr, "kernel_launch: launch %d failed: %s\n", li, hipGetErrorName(le)); break; }
#if SELFCHECK
        if (MK_N_LAUNCHES == 18) { const int wmap[7] = {0, 1, 2, 3, 4, 5, 7}; if (li <= CHK_MAXLI) hipLaunchKernelGGL(check_kernel, dim3(512), dim3(256), 0, stream, a, 0, wmap[li]); }
#endif
    }
#if SELFCHECK
    hipLaunchKernelGGL(report_kernel, dim3(1024), dim3(256), 0, stream, a);
#endif
}
```

```cpp
#include <hip/hip_runtime.h>
#include <cstdio>
#include <cstdint>
#include <cmath>

#ifndef DBG_VARIANTS
#define DBG_VARIANTS 0
#endif
#ifndef ATTN_REPS
#define ATTN_REPS 1
#endif
#ifndef POST_REPS
#define POST_REPS 1
#endif
#ifndef GU_REPS
#define GU_REPS 1
#endif
#ifndef P0_REPS
#define P0_REPS 1
#endif
#ifndef REP_MASK
#define REP_MASK 15
#endif
#ifndef SELFCHECK
#define SELFCHECK 0
#endif
#ifndef CHK_FILTER
#define CHK_FILTER 0
#endif
#ifndef IN_STAGGER_TICKS
#define IN_STAGGER_TICKS 0
#endif
#ifndef FUSE_POST
#define FUSE_POST 1
#endif
#ifndef MK_N_LAUNCHES
#define MK_N_LAUNCHES 1
#endif

#ifndef PHMASK
#define PHMASK 0x3ff
#endif
#define EN_PH(c) (((PHMASK) >> (c)) & 1)
#ifndef EN_MLA
#define EN_MLA 1
#endif
#ifndef EN_DSA
#define EN_DSA 1
#endif
#ifndef EN_SB
#define EN_SB 1
#endif
#ifndef EN_DIFF
#define EN_DIFF 1
#endif
#define LAS __attribute__((address_space(3)))
#define GAS __attribute__((address_space(1)))

constexpr int DM = 1024, NB = 32, SEQ = 2048, DEPTH = 2, DSEQ = 64, PAST = 4096;
constexpr int MP = NB * SEQ, MS = NB * DSEQ, M = MP + MS;
constexpr int DFF = 2816, NGU = 2 * DFF, NIN = 2920, NINP = 3072, NQ = 640, NQP = 768, KOUT = 1280;
constexpr float EPS = 1e-6f;
constexpr float LOG2E = 1.4426950408889634f;
constexpr int H_CQ = 0, H_CKV = 256, H_KR = 384, H_QB = 416, H_KB = 672, H_VB = 736, H_QI = 800, H_KI = 1312,
              H_QC = 1376, H_KC = 1632, H_VC = 1888, H_QD = 2144, H_KD = 2400, H_VD = 2656, H_WI = 2912;
constexpr size_t O_Y = 0;
constexpr size_t O_MLA_P = (size_t)M * DM;
constexpr size_t O_DSA_P = O_MLA_P + (size_t)DEPTH * MP * 160;
constexpr size_t O_SB_P = O_DSA_P + (size_t)DEPTH * MP * 192;
constexpr size_t O_DIFF_P = O_SB_P + (size_t)DEPTH * MP * 512;
constexpr size_t O_MLA_S = O_DIFF_P + (size_t)DEPTH * MP * 512;
constexpr size_t O_DSA_S = O_MLA_S + (size_t)DEPTH * MS * 160;
constexpr size_t O_SB_S = O_DSA_S + (size_t)DEPTH * MS * 192;
constexpr size_t O_DIFF_S = O_SB_S + (size_t)DEPTH * MS * 512;
constexpr size_t O_END = O_DIFF_S + (size_t)DEPTH * MS * 512;

constexpr size_t MiB = 1u << 20;
constexpr size_t WS_CTL = 0, CTL_ZERO_BYTES = SELFCHECK ? 4 * MiB : 128 * 1024;
constexpr size_t WS_SSQ = 1 * MiB;
constexpr size_t WS_MISC = 4 * MiB;
constexpr size_t MISC_ROPE64 = 4096, MISC_ROPE32 = MISC_ROPE64 + (size_t)2112 * 32 * 8;
constexpr size_t WS_W = 5 * MiB;
constexpr size_t W_GU1 = 0, W_D1 = W_GU1 + (size_t)NGU * DM * 2, W_IN = W_D1 + (size_t)DM * DFF * 2, W_Q = W_IN + (size_t)NINP * DM * 2,
                 W_OUT = W_Q + (size_t)NQP * 256 * 2, W_GU2 = W_OUT + (size_t)DM * KOUT * 2, W_D2 = W_GU2 + (size_t)NGU * DM * 2, W_LAYER = W_D2 + (size_t)DM * DFF * 2;
constexpr size_t WS_XB = 90 * MiB;
constexpr size_t WS_REGA = 222 * MiB;
constexpr size_t REGA_BYTES = (size_t)M * NINP * 2;
constexpr size_t WS_QA = 618 * MiB, WS_QB = 717 * MiB, WS_QI = 750 * MiB, WS_QC = 816 * MiB, WS_QD = 849 * MiB, WS_WI = 882 * MiB;
constexpr size_t WS_RA = 885 * MiB, WS_RB = 906 * MiB, WS_RC = 931 * MiB, WS_RD = 997 * MiB, WS_CC = 1063 * MiB, WS_SSQP = 1228 * MiB, WS_END = 1264 * MiB;
static_assert(WS_W + 2 * W_LAYER <= WS_XB && WS_XB + (size_t)M * DM * 2 <= WS_REGA && WS_REGA + REGA_BYTES <= WS_QA, "ws map");
static_assert(WS_QA + (size_t)M * NQP * 2 <= WS_QB && WS_QI + (size_t)M * 512 * 2 <= WS_QC && WS_WI + (size_t)M * 32 <= WS_RA, "ws map");
static_assert(WS_RA + (size_t)M * 160 * 2 <= WS_RB && WS_RB + (size_t)M * 192 * 2 <= WS_RC && WS_RC + (size_t)M * 1024 <= WS_RD && WS_RD + (size_t)M * 1024 <= WS_CC && WS_CC + (size_t)M * KOUT * 2 <= WS_SSQP && WS_SSQP + (size_t)M * 16 * 4 * 7 + (size_t)M * 4 * 4 * 4 <= WS_END, "ws map");
constexpr int CW_BAR = 4096, CW_Q = 8192;
constexpr int SC_LS = 4160;
constexpr int MK_LS = 72;
constexpr size_t DSA_SCR = 1105920;
constexpr size_t DSA_MASK_OFF = (size_t)64 * SC_LS * 4;
static_assert(DSA_MASK_OFF + 64 * MK_LS * 8 <= DSA_SCR && 256 * DSA_SCR <= REGA_BYTES, "dsa scratch");

constexpr int RING_BYTES = 135168, LDSCTL_OFF = RING_BYTES, MISC_OFF = LDSCTL_OFF + 320, LDS_BYTES = 147456;
constexpr int NWAVES = 8;

typedef unsigned short bf16;
typedef unsigned v4u __attribute__((ext_vector_type(4)));
typedef unsigned v2u __attribute__((ext_vector_type(2)));
typedef float f32x4 __attribute__((ext_vector_type(4)));
typedef float f32x16 __attribute__((ext_vector_type(16)));
typedef short bf16x8 __attribute__((ext_vector_type(8)));
typedef short s16x4 __attribute__((ext_vector_type(4)));
typedef GAS unsigned gu32;
#define RLX_AGENT __ATOMIC_RELAXED, __HIP_MEMORY_SCOPE_AGENT
#define LDS_WAIT() asm volatile("s_waitcnt lgkmcnt(0)" ::: "memory")
#define VM_WAIT() asm volatile("s_waitcnt vmcnt(0)" ::: "memory")

__device__ __forceinline__ unsigned f2bf(float f) { unsigned u = __builtin_bit_cast(unsigned, f); return (u + 0x7fffu + ((u >> 16) & 1u)) >> 16; }
__device__ __forceinline__ unsigned pk2(float lo, float hi) { return f2bf(lo) | (f2bf(hi) << 16); }
__device__ __forceinline__ float bf2f(bf16 b) { return __builtin_bit_cast(float, ((unsigned)b) << 16); }
typedef float f32x2_t __attribute__((ext_vector_type(2))); typedef __bf16 bf16x2_t __attribute__((ext_vector_type(2)));
__device__ __forceinline__ unsigned cvtpk(float lo, float hi) { f32x2_t v = {lo, hi}; bf16x2_t b = __builtin_convertvector(v, bf16x2_t); return __builtin_bit_cast(unsigned, b); }
__device__ __forceinline__ int opaque_s(int x) { asm volatile("" : "+s"(x)); return x; }
__device__ __forceinline__ int fresh_lane() { int l; asm volatile("v_mbcnt_lo_u32_b32 %0, -1, 0\n\tv_mbcnt_hi_u32_b32 %0, -1, %0" : "=&v"(l)); return l; }
__device__ __forceinline__ float opaque_vf(float x) { asm volatile("" : "+v"(x)); return x; }
__device__ __forceinline__ float wave_sum(float v) {
#pragma unroll
    for (int o = 1; o < 64; o <<= 1) v += __shfl_xor(v, o);
    return v;
}

__device__ __forceinline__ float ssq_sum16(const float* p, int row) { const f32x4* q = (const f32x4*)(p + (size_t)row * 16); const f32x4 a = q[0], b = q[1], c = q[2], d = q[3];
    return (((a[0] + a[1]) + (a[2] + a[3])) + ((b[0] + b[1]) + (b[2] + b[3]))) + (((c[0] + c[1]) + (c[2] + c[3])) + ((d[0] + d[1]) + (d[2] + d[3]))); }
__device__ __forceinline__ float ssq_sum4(const float* p, int row) { const f32x4 a = *(const f32x4*)(p + (size_t)row * 4); return (a[0] + a[1]) + (a[2] + a[3]); }
namespace pg8 {
#define PG8_LAS __attribute__((address_space(3)))
typedef unsigned short bf16_t;
typedef unsigned u32x4 __attribute__((ext_vector_type(4)));
constexpr int BM = 256, BK = 64, HALF = 128, HTB = HALF * BK * 2, STAGE_BYTES = 8 * HTB, NXCD = 8, WGM = 8;
__host__ __device__ __forceinline__ int lds_byte(int r, int c) { const int st = (r >> 4) * 2 + (c >> 5), rr = r & 15, cc = c & 31, ob = rr * 64 + cc * 2; return st * 1024 + (ob ^ (((ob >> 9) & 1) << 5)); }
__host__ __device__ __forceinline__ void stage_rc(int b, int& R, int& C) { const int st = b / 1024, sb = b % 1024, swz = sb ^ (((sb >> 9) & 1) << 5); R = (st >> 1) * 16 + swz / 64; C = (st & 1) * 32 + (swz % 64) / 2; }
__host__ __device__ __forceinline__ int perm32(int rho) { const int n = rho >> 4, i = rho & 15; return 8 * (i >> 2) + 4 * n + (i & 3); }
struct Unit { int pm, pn; };
struct Gemm { const bf16_t* A; const bf16_t* Bt; int M, N, K, lda, ldb; };
struct StaticOrder {
    int nM, nN, nwg, G, c;
    __host__ __device__ void init(int M_, int N_, int G_, int c_) { nM = M_ / BM; nN = N_ / BM; nwg = nM * nN; G = G_; c = c_; }
    __host__ __device__ bool next(int i, Unit& u) const {
        const long L = (long)i * G + c; if (L >= nwg) return false;
        int wgid = (int)L; { const int q = nwg / NXCD, r = nwg % NXCD, xcd = wgid % NXCD, off = wgid / NXCD; wgid = (xcd < r ? xcd * (q + 1) : r * (q + 1) + (xcd - r) * q) + off; }
        const int nig = WGM * nN, gid = wgid / nig, fm = gid * WGM, gsz = (nM - fm) < WGM ? (nM - fm) : WGM;
        u.pm = fm + ((wgid % nig) % gsz); u.pn = (wgid % nig) / gsz; return true;
    }
    __device__ __forceinline__ void a_ready(const Unit&) const {}
    __device__ __forceinline__ void done(const Unit&) const {}
};

struct EpiSwiGLU {
    static constexpr bool PERM = true, AFTER_DRAIN = false;
    bf16_t* act; const float* ssq;
    __device__ __forceinline__ void operator()(const f32x4 (&acc)[2][2][4][2], const Unit& u, int wr, int wc, int fr, int fq) const {
        const int row0 = u.pm * BM + wr * 64 + fr, col0 = u.pn * 128 + wc * 32 + 8 * fq;
#pragma unroll
        for (int ai = 0; ai < 2; ++ai)
#pragma unroll
            for (int m = 0; m < 4; ++m) {
                const int row = row0 + ai * HALF + m * 16;
                const float rs = 1.0f / sqrtf(ssq_sum16(ssq, row) * (1.0f / 1024.0f) + EPS);
                float o[8];
#pragma unroll
                for (int n = 0; n < 2; ++n)
#pragma unroll
                    for (int j = 0; j < 4; ++j) {
                        const float g = acc[ai][0][m][n][j] * rs, up = acc[ai][1][m][n][j] * rs;
                        const float sg = g * __builtin_amdgcn_rcpf(1.0f + __builtin_amdgcn_exp2f(-g * LOG2E));
                        o[n * 4 + j] = sg * up;
                    }
                u32x4 w; w.x = cvtpk(o[0], o[1]); w.y = cvtpk(o[2], o[3]); w.z = cvtpk(o[4], o[5]); w.w = cvtpk(o[6], o[7]);
                *(u32x4*)(act + (size_t)row * DFF + col0) = w;
            }
    }
};
template <bool BASE_F32> struct EpiResid {
    static constexpr bool PERM = true, AFTER_DRAIN = false;
    const float* baseP; const float* baseS; bf16_t* xb; float* ssq_out; float alpha;
    __device__ __forceinline__ void operator()(const f32x4 (&acc)[2][2][4][2], const Unit& u, int wr, int wc, int fr, int fq) const {
        const int row0 = u.pm * BM + wr * 64 + fr, col0 = u.pn * BM + wc * 32 + 8 * fq;
        const float* base = (u.pm < MP / BM) ? baseP : baseS;
        u32x4 bw[2][4][2];
        if (!BASE_F32) {
#pragma unroll
            for (int ai = 0; ai < 2; ++ai)
#pragma unroll
                for (int m = 0; m < 4; ++m)
#pragma unroll
                    for (int bj = 0; bj < 2; ++bj) bw[ai][m][bj] = *(const u32x4*)(xb + (size_t)(row0 + ai * HALF + m * 16) * DM + col0 + bj * HALF);
            __builtin_amdgcn_sched_barrier(0);
        }
#pragma unroll
        for (int ai = 0; ai < 2; ++ai) {
        f32x4 bf[4][2][2];
        if (BASE_F32) {
#pragma unroll
            for (int m = 0; m < 4; ++m)
#pragma unroll
                for (int bj = 0; bj < 2; ++bj) { const float* bp = base + (size_t)(row0 + ai * HALF + m * 16) * DM + col0 + bj * HALF; bf[m][bj][0] = *(const f32x4*)bp; bf[m][bj][1] = *(const f32x4*)(bp + 4); }
            __builtin_amdgcn_sched_barrier(0);
        }
#pragma unroll
            for (int m = 0; m < 4; ++m) {
                const int row = row0 + ai * HALF + m * 16; const size_t off = (size_t)row * DM + col0; float ss = 0.f;
#pragma unroll
                for (int bj = 0; bj < 2; ++bj) {
                    f32x4 b0, b1;
                    if (BASE_F32) { b0 = bf[m][bj][0]; b1 = bf[m][bj][1]; }
                    else { const u32x4 w = bw[ai][m][bj];
                        b0 = (f32x4){__uint_as_float(w.x << 16), __uint_as_float(w.x & 0xffff0000u), __uint_as_float(w.y << 16), __uint_as_float(w.y & 0xffff0000u)};
                        b1 = (f32x4){__uint_as_float(w.z << 16), __uint_as_float(w.z & 0xffff0000u), __uint_as_float(w.w << 16), __uint_as_float(w.w & 0xffff0000u)}; }
                    const f32x4 o0 = b0 + acc[ai][bj][m][0] * alpha, o1 = b1 + acc[ai][bj][m][1] * alpha;
                    u32x4 w2; w2.x = cvtpk(o0[0], o0[1]); w2.y = cvtpk(o0[2], o0[3]); w2.z = cvtpk(o1[0], o1[1]); w2.w = cvtpk(o1[2], o1[3]);
                    *(u32x4*)(xb + off + bj * HALF) = w2;
                    ss += (o0[0] * o0[0] + o0[1] * o0[1]) + (o0[2] * o0[2] + o0[3] * o0[3]) + (o1[0] * o1[0] + o1[1] * o1[1]) + (o1[2] * o1[2] + o1[3] * o1[3]);
                }
                ss += __shfl_xor(ss, 16); ss += __shfl_xor(ss, 32);
                if (fq == 0) ssq_out[(size_t)row * 16 + u.pn * 4 + wc] = ss;
                asm volatile("" ::: "memory");
            }
        }
    }
};
struct OneUnit {
    __device__ __forceinline__ bool next(int i, Unit& u) const { if (i > 0) return false; u.pm = 0; u.pn = 0; return true; }
    __device__ __forceinline__ void a_ready(const Unit&) const {}
    __device__ __forceinline__ void done(const Unit&) const {}
};
struct EpiPartial {
    static constexpr bool PERM = true, AFTER_DRAIN = false;
    float* P;
    __device__ __forceinline__ void operator()(const f32x4 (&acc)[2][2][4][2], const Unit&, int wr, int wc, int fr, int fq) const {
        const int tid = (wr * 4 + wc) * 64 + fq * 16 + fr;
#pragma unroll
        for (int ai = 0; ai < 2; ++ai)
#pragma unroll
            for (int bj = 0; bj < 2; ++bj)
#pragma unroll
                for (int m = 0; m < 4; ++m)
#pragma unroll
                    for (int n = 0; n < 2; ++n) *(f32x4*)(P + ((size_t)((((ai * 2 + bj) * 4 + m) * 2 + n) * 512 + tid)) * 4) = acc[ai][bj][m][n];
    }
};
template <bool BASE_F32> __device__ __forceinline__ void resid_fixup(const float* Pu  , int pm, int pn, int ai, int m, const float* base, bf16_t* xb, float* ssq_out, float alpha, int tid) {
    const int wid = tid >> 6, lane = tid & 63, wr = wid >> 2, wc = wid & 3, fr = lane & 15, fq = lane >> 4;
    f32x4 S[2][2], L[8][2][2];
#pragma unroll
    for (int sl = 0; sl < 8; ++sl)
#pragma unroll
        for (int bj = 0; bj < 2; ++bj)
#pragma unroll
            for (int n = 0; n < 2; ++n) L[sl][bj][n] = *(const f32x4*)(Pu + ((size_t)((sl * 32 + ((ai * 2 + bj) * 4 + m) * 2 + n) * 512 + tid)) * 4);
    __builtin_amdgcn_sched_barrier(0);
#pragma unroll
    for (int bj = 0; bj < 2; ++bj)
#pragma unroll
        for (int n = 0; n < 2; ++n) { S[bj][n] = L[0][bj][n];
#pragma unroll
            for (int sl = 1; sl < 8; ++sl) S[bj][n] += L[sl][bj][n]; }
    const int row = pm * BM + wr * 64 + fr + ai * HALF + m * 16, col0 = pn * BM + wc * 32 + 8 * fq; const size_t off = (size_t)row * DM + col0; float ss = 0.f;
#pragma unroll
    for (int bj = 0; bj < 2; ++bj) {
        f32x4 b0, b1;
        if (BASE_F32) { b0 = *(const f32x4*)(base + off + bj * HALF); b1 = *(const f32x4*)(base + off + bj * HALF + 4); }
        else { const u32x4 w = *(const u32x4*)(xb + off + bj * HALF);
            b0 = (f32x4){__uint_as_float(w.x << 16), __uint_as_float(w.x & 0xffff0000u), __uint_as_float(w.y << 16), __uint_as_float(w.y & 0xffff0000u)};
            b1 = (f32x4){__uint_as_float(w.z << 16), __uint_as_float(w.z & 0xffff0000u), __uint_as_float(w.w << 16), __uint_as_float(w.w & 0xffff0000u)}; }
        const f32x4 o0 = b0 + S[bj][0] * alpha, o1 = b1 + S[bj][1] * alpha;
        u32x4 w2; w2.x = cvtpk(o0[0], o0[1]); w2.y = cvtpk(o0[2], o0[3]); w2.z = cvtpk(o1[0], o1[1]); w2.w = cvtpk(o1[2], o1[3]);
        *(u32x4*)(xb + off + bj * HALF) = w2;
        ss += (o0[0] * o0[0] + o0[1] * o0[1]) + (o0[2] * o0[2] + o0[3] * o0[3]) + (o1[0] * o1[0] + o1[1] * o1[1]) + (o1[2] * o1[2] + o1[3] * o1[3]);
    }
    ss += __shfl_xor(ss, 16); ss += __shfl_xor(ss, 32);
    if (fq == 0) ssq_out[(size_t)row * 16 + pn * 4 + wc] = ss;
}
struct EpiScaleBf16 {
    static constexpr bool PERM = true, AFTER_DRAIN = false;
    bf16_t* O; int ldc; const float* ssq_in; int np_in; float inv_dim; float* ssq_out;
    __device__ __forceinline__ void operator()(const f32x4 (&acc)[2][2][4][2], const Unit& u, int wr, int wc, int fr, int fq) const {
        const int row0 = u.pm * BM + wr * 64 + fr, col0 = u.pn * BM + wc * 32 + 8 * fq;
        const bool do_ssq = (ssq_out != nullptr) && (u.pn == 0);
#pragma unroll
        for (int ai = 0; ai < 2; ++ai)
#pragma unroll
            for (int m = 0; m < 4; ++m) {
                const int row = row0 + ai * HALF + m * 16;
                const float rs = 1.0f / sqrtf((np_in == 16 ? ssq_sum16(ssq_in, row) : ssq_sum4(ssq_in, row)) * inv_dim + EPS); float ss = 0.f;
                bf16_t* rowp = O + (size_t)row * ldc + col0;
#pragma unroll
                for (int bj = 0; bj < 2; ++bj) {
                    const f32x4 v0 = acc[ai][bj][m][0] * rs, v1 = acc[ai][bj][m][1] * rs;
                    u32x4 w; w.x = cvtpk(v0[0], v0[1]); w.y = cvtpk(v0[2], v0[3]); w.z = cvtpk(v1[0], v1[1]); w.w = cvtpk(v1[2], v1[3]);
                    *(u32x4*)(rowp + bj * HALF) = w;
                    ss += (v0[0] * v0[0] + v0[1] * v0[1]) + (v0[2] * v0[2] + v0[3] * v0[3]) + (v1[0] * v1[0] + v1[1] * v1[1]) + (v1[2] * v1[2] + v1[3] * v1[3]);
                }
                if (do_ssq) { ss += __shfl_xor(ss, 16); ss += __shfl_xor(ss, 32); if (fq == 0) ssq_out[(size_t)row * 4 + wc] = ss; }
            }
    }
};


struct EpiInFused {
    static constexpr bool PERM = true, AFTER_DRAIN = false;
    unsigned char* ws; float* out; int layer;
    __device__ __forceinline__ void operator()(const f32x4 (&acc)[2][2][4][2], const Unit& u, int wr, int wc, int fr_, int fq_) const {
        int fr = fr_, fq = fq_; asm volatile("" : "+v"(fr), "+v"(fq));
        const int row0 = u.pm * BM + wr * 64 + fr, c0 = wc * 32 + 8 * fq, pn = u.pn;
        float* const SSQP_ = (float*)(ws + WS_SSQP);
        const float* ssq_in = SSQP_ + (size_t)(3 + layer) * M * 16; float* ssq_cq = SSQP_ + (size_t)7 * M * 16 + (size_t)layer * M * 4; float* ssq_kv = SSQP_ + (size_t)7 * M * 16 + (size_t)(2 + layer) * M * 4;
        bf16_t* const CQ = (bf16_t*)(ws + WS_REGA + (size_t)300 * MiB); bf16_t* const CKV = (bf16_t*)(ws + WS_REGA + (size_t)340 * MiB);
        bf16_t* const QB = (bf16_t*)(ws + WS_QB); bf16_t* const QI = (bf16_t*)(ws + WS_QI); bf16_t* const QC = (bf16_t*)(ws + WS_QC); bf16_t* const QD = (bf16_t*)(ws + WS_QD);
        bf16_t* const RA = (bf16_t*)(ws + WS_RA); bf16_t* const RB = (bf16_t*)(ws + WS_RB); bf16_t* const RC = (bf16_t*)(ws + WS_RC); bf16_t* const RD = (bf16_t*)(ws + WS_RD);
        float* const WI = (float*)(ws + WS_WI); const float2* const R64 = (const float2*)(ws + WS_MISC + MISC_ROPE64); const float2* const R32 = (const float2*)(ws + WS_MISC + MISC_ROPE32);
        bf16_t* const HBdbg = SELFCHECK ? (bf16_t*)(ws + WS_REGA) : nullptr;
        const float scaleB = 0.125f * LOG2E, scaleD = 0.17677669529663687f * LOG2E, scaleC = 0.125f * LOG2E;
#define EPK8(f) ((u32x4){cvtpk(f[0], f[1]), cvtpk(f[2], f[3]), cvtpk(f[4], f[5]), cvtpk(f[6], f[7])})
#define EST8F(p, f) do { *(f32x4*)(p) = (f32x4){f[0], f[1], f[2], f[3]}; *(f32x4*)((p) + 4) = (f32x4){f[4], f[5], f[6], f[7]}; } while (0)
#pragma unroll
        for (int ai = 0; ai < 2; ++ai)
#pragma unroll
            for (int m = 0; m < 4; ++m) {
                const int row = row0 + ai * HALF + m * 16;
                const float rs = 1.0f / sqrtf(ssq_sum16(ssq_in, row) * (1.0f / 1024.0f) + EPS);
                float v0[8], v1[8];
#pragma unroll
                for (int e = 0; e < 4; ++e) { v0[e] = acc[ai][0][m][0][e] * rs; v0[4 + e] = acc[ai][0][m][1][e] * rs; v1[e] = acc[ai][1][m][0][e] * rs; v1[4 + e] = acc[ai][1][m][1][e] * rs; }
                if (HBdbg) { *(u32x4*)(HBdbg + (size_t)row * NINP + pn * 256 + c0) = EPK8(v0); *(u32x4*)(HBdbg + (size_t)row * NINP + pn * 256 + 128 + c0) = EPK8(v1); }
                const bool smp = row >= MP; const int rr = smp ? row - MP : row; const int pidx = smp ? 2048 + (rr & 63) : (rr & 2047);
                if (pn == 0) {
                    *(u32x4*)(CQ + (size_t)row * 256 + c0) = EPK8(v0); *(u32x4*)(CQ + (size_t)row * 256 + 128 + c0) = EPK8(v1);
                    float ss = 0.f;
#pragma unroll
                    for (int e = 0; e < 8; ++e) ss += v0[e] * v0[e] + v1[e] * v1[e];
                    ss += __shfl_xor(ss, 16); ss += __shfl_xor(ss, 32); if (fq == 0) ssq_cq[(size_t)row * 4 + wc] = ss;
                } else if (pn <= 6 && pn != 4) {
                    const bool d32 = pn >= 5; const int i0 = d32 ? 8 * (fq & 1) : 8 * fq;
                    const f32x4* cp = (const f32x4*)(d32 ? R32 + pidx * 16 + i0 : R64 + pidx * 32 + i0);
                    float a[8], b[8];
#pragma unroll
                    for (int e2 = 0; e2 < 4; ++e2) { const f32x4 cs = cp[e2];
                        a[2 * e2] = v0[2 * e2] * cs[0] - v1[2 * e2] * cs[1]; b[2 * e2] = v1[2 * e2] * cs[0] + v0[2 * e2] * cs[1];
                        a[2 * e2 + 1] = v0[2 * e2 + 1] * cs[2] - v1[2 * e2 + 1] * cs[3]; b[2 * e2 + 1] = v1[2 * e2 + 1] * cs[2] + v0[2 * e2 + 1] * cs[3]; }
                    if (pn == 1) {
#pragma unroll
                        for (int e = 0; e < 8; ++e) { a[e] *= scaleB; b[e] *= scaleB; }
                        bf16_t* d = QB + (size_t)row * 256 + wc * 64 + 8 * fq; *(u32x4*)d = EPK8(a); *(u32x4*)(d + 32) = EPK8(b);
                    } else if (pn <= 3) { bf16_t* d = QI + (size_t)row * 512 + (4 * (pn - 2) + wc) * 64 + 8 * fq; *(u32x4*)d = EPK8(a); *(u32x4*)(d + 32) = EPK8(b);
                    } else { const int blk = 2 * wc + (fq >> 1);
                        if (pn == 5) {
#pragma unroll
                            for (int e = 0; e < 8; ++e) { a[e] *= scaleD; b[e] *= scaleD; }
                            bf16_t* d = QD + (size_t)row * 256 + blk * 32 + i0; *(u32x4*)d = EPK8(a); *(u32x4*)(d + 16) = EPK8(b);
                        } else { const int oc = (blk >> 1) * 128 + (blk & 1) * 32 + i0;
                            float* od = out + (smp ? O_DIFF_S + ((size_t)layer * MS + rr) * 512 : O_DIFF_P + ((size_t)layer * MP + rr) * 512) + oc;
                            EST8F(od, a); EST8F(od + 16, b); bf16_t* d = RD + (size_t)row * 512 + oc; *(u32x4*)d = EPK8(a); *(u32x4*)(d + 16) = EPK8(b); } }
                } else if (pn == 4) {
                    if (wc < 2 || (wc == 2 && fq < 2)) {
                        const bool d32 = wc == 2; const f32x4* cp = (const f32x4*)(d32 ? R32 + pidx * 16 + 8 * fq : R64 + pidx * 32 + 8 * fq);
                        float a[8], b[8];
#pragma unroll
                        for (int e2 = 0; e2 < 4; ++e2) { const f32x4 cs = cp[e2];
                            a[2 * e2] = v0[2 * e2] * cs[0] - v1[2 * e2] * cs[1]; b[2 * e2] = v1[2 * e2] * cs[0] + v0[2 * e2] * cs[1];
                            a[2 * e2 + 1] = v0[2 * e2 + 1] * cs[2] - v1[2 * e2 + 1] * cs[3]; b[2 * e2 + 1] = v1[2 * e2 + 1] * cs[2] + v0[2 * e2 + 1] * cs[3]; }
                        if (!d32) { const int oc = (wc == 0 ? 0 : 128) + 8 * fq;
                            float* od = out + (smp ? O_DSA_S + ((size_t)layer * MS + rr) * 192 : O_DSA_P + ((size_t)layer * MP + rr) * 192) + oc;
                            EST8F(od, a); EST8F(od + 32, b); bf16_t* d = RB + (size_t)row * 192 + oc; *(u32x4*)d = EPK8(a); *(u32x4*)(d + 32) = EPK8(b);
                        } else { const int oc = 128 + 8 * fq;
                            float* od = out + (smp ? O_MLA_S + ((size_t)layer * MS + rr) * 160 : O_MLA_P + ((size_t)layer * MP + rr) * 160) + oc;
                            EST8F(od, a); EST8F(od + 16, b); bf16_t* d = RA + (size_t)row * 160 + oc; *(u32x4*)d = EPK8(a); *(u32x4*)(d + 16) = EPK8(b); } }
                } else if (pn == 7) {
                    *(u32x4*)(CKV + (size_t)row * 128 + c0) = EPK8(v0);
                    float ss = 0.f;
#pragma unroll
                    for (int e = 0; e < 8; ++e) ss += v0[e] * v0[e];
                    ss += __shfl_xor(ss, 16); ss += __shfl_xor(ss, 32); if (fq == 0) ssq_kv[(size_t)row * 4 + wc] = ss;
                    if (wc < 2) { const int oc = 64 + c0; float* od = out + (smp ? O_DSA_S + ((size_t)layer * MS + rr) * 192 : O_DSA_P + ((size_t)layer * MP + rr) * 192) + oc;
                        EST8F(od, v1); *(u32x4*)(RB + (size_t)row * 192 + oc) = EPK8(v1); }
                    else if (wc == 2 && fq == 0) { float w8[8];
#pragma unroll
                        for (int e = 0; e < 8; ++e) w8[e] = v1[e] * 0.35355339059327373f;
                        EST8F(WI + (size_t)row * 8, w8); }
                } else if (pn == 8) {
                    float a[8], b[8];
#pragma unroll
                    for (int e = 0; e < 8; ++e) { a[e] = v0[e] * scaleC; b[e] = v1[e] * scaleC; }
                    *(u32x4*)(QC + (size_t)row * 256 + c0) = EPK8(a); *(u32x4*)(QC + (size_t)row * 256 + 128 + c0) = EPK8(b);
                } else {
                    const int h0 = wc >> 1, d0 = 32 * (wc & 1) + 8 * fq;
                    const int voff = (pn == 9) ? 0 : 64;
                    if (pn == 11) { float* od = out + (smp ? O_DIFF_S + ((size_t)layer * MS + rr) * 512 : O_DIFF_P + ((size_t)layer * MP + rr) * 512);
                        EST8F(od + h0 * 128 + voff + d0, v0); EST8F(od + (h0 + 2) * 128 + voff + d0, v1);
                        *(u32x4*)(RD + (size_t)row * 512 + h0 * 128 + voff + d0) = EPK8(v0); *(u32x4*)(RD + (size_t)row * 512 + (h0 + 2) * 128 + voff + d0) = EPK8(v1);
                    } else { float* od = out + (smp ? O_SB_S + ((size_t)layer * MS + rr) * 512 : O_SB_P + ((size_t)layer * MP + rr) * 512);
                        EST8F(od + h0 * 128 + voff + d0, v0); EST8F(od + (h0 + 2) * 128 + voff + d0, v1);
                        *(u32x4*)(RC + (size_t)row * 512 + h0 * 128 + voff + d0) = EPK8(v0); *(u32x4*)(RC + (size_t)row * 512 + (h0 + 2) * 128 + voff + d0) = EPK8(v1); }
                }
                asm volatile("" ::: "memory");
            }
#undef EPK8
#undef EST8F
    }
};

template <class Epi, class Sched, bool ALIGN_EPI = false, bool SP2 = false>
__device__ __forceinline__ void gemm_phase(PG8_LAS unsigned char* lds, const Gemm g, const Sched& S, const Epi& E, const int wave0) {
    const int tid_ = wave0 * 64 + fresh_lane();
    const int tid = tid_, wid = __builtin_amdgcn_readfirstlane(tid >> 6), lane = tid & 63, wr = wid >> 2, wc = wid & 3, fr = lane & 15, fq = lane >> 4;
    const int K = g.K, nt = K / BK, lda = g.lda, ldb = g.ldb ? g.ldb : g.K;
    unsigned voffA[2], voffB[2];
#pragma unroll
    for (int i = 0; i < 2; ++i) { int R, C; stage_rc(tid * 16 + i * 8192, R, C); const int Rb = Epi::PERM ? ((R & ~31) + perm32(R & 31)) : R;
        voffA[i] = (unsigned)(R * lda + C) * 2u; voffB[i] = (unsigned)(Rb * ldb + C) * 2u; }
    const size_t kstep = (size_t)(BK * 2);
    const size_t hstepA = (size_t)HALF * lda * 2, hstepB = (size_t)HALF * ldb * 2;
    const size_t tstepA = 2 * hstepA, tstepB = 2 * hstepB;
    const unsigned ldsw = (unsigned)wid * 1024u;
    const int aoff = lds_byte(wr * 64 + fr, fq * 8), boff = lds_byte(wc * 32 + fr, fq * 8);
#define PG8_SA(b, h) (((b) * 2 + (h)) * HTB)
#define PG8_SB(b, h) ((4 + (b) * 2 + (h)) * HTB)
#define PG8_STAGE(bufoff, gbase, voff) do { _Pragma("unroll") for (int _i = 0; _i < 2; ++_i) \
        __builtin_amdgcn_global_load_lds((const unsigned*)((const char*)(gbase) + (voff)[_i]), (PG8_LAS unsigned*)(lds + (bufoff) + ldsw + _i * 8192), 16, 0, 0); } while (0)
#define PG8_LDA(dst, b, h) do { _Pragma("unroll") for (int m = 0; m < 4; ++m) _Pragma("unroll") for (int k = 0; k < 2; ++k) dst[m][k] = *(const PG8_LAS bf16x8*)(lds + PG8_SA(b, h) + aoff + m * 2048 + k * 1024); } while (0)
#define PG8_LDB(dst, b, h) do { _Pragma("unroll") for (int n = 0; n < 2; ++n) _Pragma("unroll") for (int k = 0; k < 2; ++k) dst[n][k] = *(const PG8_LAS bf16x8*)(lds + PG8_SB(b, h) + boff + n * 2048 + k * 1024); } while (0)
#define PG8_MMA(ai, bj, At, Bt) do { __builtin_amdgcn_s_setprio(1); _Pragma("unroll") for (int m = 0; m < 4; ++m) _Pragma("unroll") for (int n = 0; n < 2; ++n) _Pragma("unroll") for (int k = 0; k < 2; ++k) \
        acc[ai][bj][m][n] = __builtin_amdgcn_mfma_f32_16x16x32_bf16(Bt[n][k], At[m][k], acc[ai][bj][m][n], 0, 0, 0); __builtin_amdgcn_s_setprio(0); } while (0)
#define PG8_WAIT_V(n) asm volatile("s_waitcnt vmcnt(" #n ")" ::: "memory")
#define PG8_WAIT_L(n) asm volatile("s_waitcnt lgkmcnt(" #n ")" ::: "memory")
#define PG8_BAR __builtin_amdgcn_s_barrier()
#define PG8_SCHED __builtin_amdgcn_sched_barrier(0)
    Unit cur, nxt; int ui = 0;
    if (!S.next(0, cur)) return;
    f32x4 acc[2][2][4][2];
#pragma unroll
    for (int a = 0; a < 2; ++a)
#pragma unroll
        for (int b = 0; b < 2; ++b)
#pragma unroll
            for (int m = 0; m < 4; ++m)
#pragma unroll
                for (int n = 0; n < 2; ++n) acc[a][b][m][n] = (f32x4){0.f, 0.f, 0.f, 0.f};
    bf16x8 At[4][2], B0[2][2], B1[2][2];
    const char* cA = (const char*)g.A + (size_t)cur.pm * tstepA; const char* cB = (const char*)g.Bt + (size_t)cur.pn * tstepB;
    S.a_ready(cur);
    if constexpr (SP2) {
        PG8_STAGE(PG8_SB(0, 0), cB, voffB); PG8_STAGE(PG8_SB(0, 1), cB + hstepB, voffB); PG8_STAGE(PG8_SA(0, 0), cA, voffA); PG8_STAGE(PG8_SA(0, 1), cA + hstepA, voffA);
        if (wr == 1) PG8_BAR;
        PG8_WAIT_V(2); PG8_BAR;
        PG8_STAGE(PG8_SB(1, 0), cB + kstep, voffB); PG8_STAGE(PG8_SA(1, 0), cA + kstep, voffA); PG8_STAGE(PG8_SB(1, 1), cB + hstepB + kstep, voffB);
        PG8_WAIT_V(6); PG8_BAR;
    } else {
        PG8_STAGE(PG8_SB(0, 0), cB, voffB); PG8_STAGE(PG8_SA(0, 0), cA, voffA); PG8_STAGE(PG8_SB(0, 1), cB + hstepB, voffB); PG8_STAGE(PG8_SA(0, 1), cA + hstepA, voffA);
        if (wr == 1) PG8_BAR;
        PG8_WAIT_V(4); PG8_BAR;
        PG8_STAGE(PG8_SB(1, 0), cB + kstep, voffB); PG8_STAGE(PG8_SA(1, 0), cA + kstep, voffA); PG8_STAGE(PG8_SB(1, 1), cB + hstepB + kstep, voffB);
        PG8_WAIT_V(6); PG8_BAR;
    }
    for (;;) {
        const bool has_next = S.next(ui + 1, nxt);
        const char* nA = has_next ? (const char*)g.A + (size_t)nxt.pm * tstepA : cA; const char* nB = has_next ? (const char*)g.Bt + (size_t)nxt.pn * tstepB : cB;
        for (int t = 0; t < nt; t += 2) {
            const bool last = (t == nt - 2);
            const char* a1 = cA + (size_t)(t + 1) * kstep;
            const char* a2 = last ? nA : cA + (size_t)(t + 2) * kstep; const char* b2 = last ? nB : cB + (size_t)(t + 2) * kstep;
            const char* a3 = a2 + kstep; const char* b3 = b2 + kstep;
            if (last && has_next) S.a_ready(nxt);
            if constexpr (SP2) {
            PG8_LDB(B0, 0, 0); PG8_LDB(B1, 0, 1); PG8_SCHED; PG8_LDA(At, 0, 0); PG8_STAGE(PG8_SA(1, 1), a1 + hstepA, voffA);
            PG8_WAIT_V(8); PG8_WAIT_L(0); PG8_BAR; PG8_MMA(0, 0, At, B0); PG8_MMA(0, 1, At, B1); PG8_BAR; PG8_SCHED;
            PG8_LDA(At, 0, 1); PG8_STAGE(PG8_SB(0, 0), b2, voffB); PG8_STAGE(PG8_SB(0, 1), b2 + hstepB, voffB); PG8_STAGE(PG8_SA(0, 0), a2, voffA);
            PG8_WAIT_V(8); PG8_WAIT_L(0); PG8_BAR; PG8_MMA(1, 0, At, B0); PG8_MMA(1, 1, At, B1); PG8_BAR; PG8_SCHED;
            PG8_LDB(B0, 1, 0); PG8_LDB(B1, 1, 1); PG8_SCHED; PG8_LDA(At, 1, 0); PG8_STAGE(PG8_SA(0, 1), a2 + hstepA, voffA);
            PG8_WAIT_V(8); PG8_WAIT_L(0); PG8_BAR; PG8_MMA(0, 0, At, B0); PG8_MMA(0, 1, At, B1); PG8_BAR; PG8_SCHED;
            PG8_LDA(At, 1, 1); PG8_STAGE(PG8_SB(1, 0), b3, voffB); PG8_STAGE(PG8_SB(1, 1), b3 + hstepB, voffB); PG8_STAGE(PG8_SA(1, 0), a3, voffA);
            PG8_WAIT_V(8); PG8_WAIT_L(0); PG8_BAR; PG8_MMA(1, 0, At, B0); PG8_MMA(1, 1, At, B1); PG8_BAR; PG8_SCHED;
            } else {
            PG8_LDB(B0, 0, 0); PG8_SCHED; PG8_LDA(At, 0, 0); PG8_STAGE(PG8_SA(1, 1), a1 + hstepA, voffA);
            PG8_WAIT_L(8); PG8_BAR; PG8_WAIT_L(0); PG8_MMA(0, 0, At, B0); PG8_BAR; PG8_SCHED;
            PG8_LDB(B1, 0, 1); PG8_STAGE(PG8_SB(0, 0), b2, voffB);
            PG8_BAR; PG8_WAIT_L(0); PG8_MMA(0, 1, At, B1); PG8_BAR;
            PG8_LDA(At, 0, 1); PG8_STAGE(PG8_SA(0, 0), a2, voffA);
            PG8_BAR; PG8_WAIT_L(0); PG8_MMA(1, 0, At, B0); PG8_BAR; PG8_SCHED;
            PG8_STAGE(PG8_SB(0, 1), b2 + hstepB, voffB);
            PG8_WAIT_V(6); PG8_BAR; PG8_MMA(1, 1, At, B1); PG8_BAR;
            PG8_LDB(B0, 1, 0); PG8_SCHED; PG8_LDA(At, 1, 0); PG8_STAGE(PG8_SA(0, 1), a2 + hstepA, voffA);
            PG8_WAIT_L(8); PG8_BAR; PG8_WAIT_L(0); PG8_MMA(0, 0, At, B0); PG8_BAR; PG8_SCHED;
            PG8_LDB(B1, 1, 1); PG8_STAGE(PG8_SB(1, 0), b3, voffB);
            PG8_BAR; PG8_WAIT_L(0); PG8_MMA(0, 1, At, B1); PG8_BAR;
            PG8_LDA(At, 1, 1); PG8_STAGE(PG8_SA(1, 0), a3, voffA);
            PG8_BAR; PG8_WAIT_L(0); PG8_MMA(1, 0, At, B0); PG8_BAR; PG8_SCHED;
            PG8_STAGE(PG8_SB(1, 1), b3 + hstepB, voffB);
            PG8_WAIT_V(6); PG8_BAR; PG8_MMA(1, 1, At, B1); PG8_BAR;
            }
        }
        if constexpr (ALIGN_EPI) { if (wr == 0) PG8_BAR; }
        if constexpr (!Epi::AFTER_DRAIN) { E(acc, cur, wr, wc, fr, fq); S.done(cur); }
        if (!has_next) break;
#pragma unroll
        for (int a = 0; a < 2; ++a)
#pragma unroll
            for (int b = 0; b < 2; ++b)
#pragma unroll
                for (int m = 0; m < 4; ++m)
#pragma unroll
                    for (int n = 0; n < 2; ++n) acc[a][b][m][n] = (f32x4){0.f, 0.f, 0.f, 0.f};
        cur = nxt; cA = nA; cB = nB; ++ui;
        if constexpr (ALIGN_EPI) { if (wr == 1) PG8_BAR; }
    }
    PG8_WAIT_V(0);
    if constexpr (!ALIGN_EPI) { if (wr == 0) PG8_BAR; }
    PG8_BAR;
#undef PG8_SA
#undef PG8_SB
#undef PG8_STAGE
#undef PG8_LDA
#undef PG8_LDB
#undef PG8_MMA
#undef PG8_WAIT_V
#undef PG8_WAIT_L
#undef PG8_BAR
#undef PG8_SCHED
}
}

#define XB_TMO      128
#define XB_XCNT(j)  (256  + 64 * (j))
#define XB_XSUB(j)  (1280 + 64 * (j))
#define XB_XGEN(j)  (2304 + 64 * (j))
#define XB_TOP      3328
#define XB_TOPGEN   3392
#define XCD_BAR_WORDS 3456
#define XB_SPIN_CAP (1u << 18)
__device__ __forceinline__ unsigned xb_ld(unsigned* p)              { return __hip_atomic_load(p, __ATOMIC_RELAXED, __HIP_MEMORY_SCOPE_AGENT); }
__device__ __forceinline__ unsigned xb_add(unsigned* p, unsigned v) { return __hip_atomic_fetch_add(p, v, __ATOMIC_RELAXED, __HIP_MEMORY_SCOPE_AGENT); }
__device__ __forceinline__ unsigned xb_xcc_id() { return (unsigned)__builtin_amdgcn_s_getreg((3 << 11) | 20) & 0xFu; }
#define XB_SPIN(cond, bar) do { unsigned _sp = 0; while (cond) { __builtin_amdgcn_s_sleep(1); \
    if ((++_sp & 255u) == 0u) { if (xb_ld(&(bar)[XB_TMO])) break; if (_sp > XB_SPIN_CAP) { atomicAdd(&(bar)[XB_TMO], 1u); break; } } } } while (0)
struct XcdBarrier { unsigned* bar; unsigned x; volatile LAS unsigned* st; int wave0; };
__device__ __forceinline__ XcdBarrier xcd_barrier_post(unsigned* bar, volatile LAS unsigned* st, int wave0) {
    XcdBarrier b; b.bar = bar; b.x = xb_xcc_id(); b.st = st; b.wave0 = wave0;
    if (wave0 == 0 && fresh_lane() == 0) (void)xb_add(&bar[XB_XCNT(b.x)], 1u);
    return b;
}
__device__ __forceinline__ void xcd_barrier_complete(unsigned* bar, unsigned x, unsigned& nloc, unsigned& nx) {
    const unsigned G = gridDim.x * gridDim.y * gridDim.z;
    unsigned sum, cnt, mine, sp = 0u;
    for (;;) {
        sum = 0u; cnt = 0u; mine = 0u;
#pragma unroll
        for (unsigned j = 0; j < 16; ++j) { const unsigned c = xb_ld(&bar[XB_XCNT(j)]); sum += c; cnt += (c > 0u) ? 1u : 0u; mine = (j == x) ? c : mine; }
        if (sum == G) break;
        __builtin_amdgcn_s_sleep(1);
        if ((++sp & 255u) == 0u) { if (xb_ld(&bar[XB_TMO])) break; if (sp > XB_SPIN_CAP) { atomicAdd(&bar[XB_TMO], 1u); break; } }
    }
    nloc = mine > 0u ? mine : 1u; nx = cnt > 0u ? cnt : 1u;
}
__device__ __forceinline__ void xcd_barrier(const XcdBarrier& b) {
    asm volatile("s_waitcnt vmcnt(0)" ::: "memory");
    __syncthreads();
    if (b.wave0 == 0 && fresh_lane() == 0) {
        unsigned* bar = b.bar;
        __builtin_amdgcn_s_waitcnt(0);
        unsigned nloc = b.st[0], nx = b.st[1];
        if (nloc == 0u) { xcd_barrier_complete(bar, b.x, nloc, nx); b.st[0] = nloc; b.st[1] = nx; }
        const unsigned old = xb_add(&bar[XB_XSUB(b.x)], 1u);
        const unsigned gen = old / nloc;
        if (old + 1u == (gen + 1u) * nloc) {
            __builtin_amdgcn_fence(__ATOMIC_RELEASE, "agent");
            asm volatile("s_waitcnt vmcnt(0)" ::: "memory");
            const unsigned og = xb_add(&bar[XB_TOP], 1u);
            const unsigned tg = og / nx;
            if (og + 1u == (tg + 1u) * nx) xb_add(&bar[XB_TOPGEN], 1u);
            else XB_SPIN(xb_ld(&bar[XB_TOPGEN]) == tg, bar);
            __builtin_amdgcn_fence(__ATOMIC_ACQUIRE, "agent");
            xb_add(&bar[XB_XGEN(b.x)], 1u);
            asm volatile("s_waitcnt vmcnt(0)" ::: "memory");
        } else {
            XB_SPIN(xb_ld(&bar[XB_XGEN(b.x)]) == gen, bar);
            __builtin_amdgcn_fence(__ATOMIC_ACQUIRE, "agent");
            asm volatile("s_waitcnt vmcnt(0)" ::: "memory");
        }
    }
    __syncthreads();
}

struct Args { const float* in[24]; float* out; unsigned char* ws; float freq64[32]; float freq32[16]; int ph_lo, ph_hi; };
enum { I_XP = 0, I_XS, I_CMLA, I_CDSA, I_CSB, I_CDIFF, I_N1, I_G1, I_U1, I_D1, I_NM, I_WIN, I_QN, I_WQB, I_KVN, I_WKVB, I_LAM, I_DN, I_WO, I_N2, I_G2, I_U2, I_D2, I_FN };

__host__ __device__ __forceinline__ int mycol(int j) {
    if (j < 256) return j;
    if (j < 384) return 7 * 256 + (j - 256);
    if (j < 416) { const int t = j - 384; return 4 * 256 + (t >> 4) * 128 + 64 + (t & 15); }
    if (j < 672) { const int t = j - 416; return 1 * 256 + ((t >> 5) & 1) * 128 + (t >> 6) * 32 + (t & 31); }
    if (j < 736) { const int t = j - 672; return 4 * 256 + (t >> 5) * 128 + (t & 31); }
    if (j < 800) return 7 * 256 + 128 + (j - 736);
    if (j < 1312) { const int t = j - 800, h8 = t >> 6; return (2 + (h8 >> 2)) * 256 + ((t >> 5) & 1) * 128 + (h8 & 3) * 32 + (t & 31); }
    if (j < 1376) { const int t = j - 1312; return 4 * 256 + (t >> 5) * 128 + 32 + (t & 31); }
    if (j < 1384) return 7 * 256 + 128 + 64 + (j - 1376);
    if (j < 1640) return 8 * 256 + (j - 1384);
    if (j < 1896) return 9 * 256 + (j - 1640);
    if (j < 2152) return 10 * 256 + (j - 1896);
    if (j < 2408) { const int t = j - 2152; return 5 * 256 + ((t >> 4) & 1) * 128 + (t >> 5) * 16 + (t & 15); }
    if (j < 2664) { const int t = j - 2408; return 6 * 256 + ((t >> 4) & 1) * 128 + (t >> 5) * 16 + (t & 15); }
    return 11 * 256 + (j - 2664);
}
__host__ __device__ __forceinline__ bool mycol_is_pad(int np) { const int t = np >> 8, c = np & 127, hf = (np >> 7) & 1; return (t == 4 && c >= 80) || (t == 7 && hf == 1 && c >= 72); }
typedef __attribute__((address_space(4))) const char* kaptr_t;
__device__ __forceinline__ kaptr_t kargs() { kaptr_t p = (kaptr_t)__builtin_amdgcn_kernarg_segment_ptr(); asm volatile("" : "+s"(p)); return p; }
typedef const float* cfp_t; typedef float* fp_t; typedef unsigned char* ucp_t;
typedef __attribute__((address_space(4))) const cfp_t* ka_cfp_t; typedef __attribute__((address_space(4))) const fp_t* ka_fp_t; typedef __attribute__((address_space(4))) const ucp_t* ka_ucp_t;
typedef __attribute__((address_space(4))) const float* ka_f_t; typedef __attribute__((address_space(4))) const int* ka_i_t;
#define GLB __attribute__((address_space(1)))
#define ARG_IN(i) ((const float*)(GLB const float*)(*(ka_cfp_t)(kargs() + 8 * (i))))
#define ARG_OUT (*(ka_fp_t)(kargs() + 192))
#define ARG_WS (*(ka_ucp_t)(kargs() + 200))
#define ARG_FREQ64(j) (((ka_f_t)(kargs() + 208))[j])
#define ARG_FREQ32(j) (((ka_f_t)(kargs() + 336))[j])
#define ARG_PH_LO (*(ka_i_t)(kargs() + 400))
#define ARG_PH_HI (*(ka_i_t)(kargs() + 404))
static_assert(sizeof(Args) == 408, "kernarg offsets above follow struct Args");
template <int MAP> __device__ __forceinline__ int rowmap(int n) {
    if (MAP == 1) return (n >> 7) * 256 + (n & 127);
    if (MAP == 2) return (n >> 7) * 256 + 128 + (n & 127);
    if (MAP == 3) return FUSE_POST ? mycol(n) : (n < 1376 ? n : (n < 1384 ? H_WI + (n - 1376) : n - 8));
    return n;
}
template <int MAP> __device__ __forceinline__ void transpose_item(const float* W, int K, int N, const float* g, bf16* dst, int ldd, int koff, LAS float* scr, int item, int lane) {
    const int nblk = (N + 31) / 32, kb = item / nblk, nb = item % nblk, k0 = 64 * kb, n0 = 32 * nb;
    const int nn = n0 + (lane & 31); const bool nok = nn < N;
    float tv[32];
#pragma unroll
    for (int i = 0; i < 32; ++i) { const int kk = 2 * i + (lane >> 5); tv[i] = nok ? W[(size_t)(k0 + kk) * N + nn] : 0.f; }
#pragma unroll
    for (int i = 0; i < 32; ++i) { const int kk = 2 * i + (lane >> 5); float v = tv[i]; if (g) v *= g[k0 + kk]; scr[kk * 33 + (lane & 31)] = v; }
    LDS_WAIT(); asm volatile("" ::: "memory");
    const int c = lane & 7;
#pragma unroll
    for (int j = 0; j < 4; ++j) { const int n = (lane >> 3) + 8 * j; const LAS float* s = scr + (8 * c) * 33 + n;
        v4u o; o.x = pk2(s[0 * 33], s[1 * 33]); o.y = pk2(s[2 * 33], s[3 * 33]); o.z = pk2(s[4 * 33], s[5 * 33]); o.w = pk2(s[6 * 33], s[7 * 33]);
        if (n0 + n < N) *(v4u*)(dst + (size_t)rowmap<MAP>(n0 + n) * ldd + koff + k0 + 8 * c) = o; }
    LDS_WAIT(); asm volatile("" ::: "memory");
}
__device__ __forceinline__ void sincos_acc(float ang, float& sn, float& cs) {
    const double a = (double)ang; const double k = rint(a * 0.15915494309189533577); const double x = fma(-k, 6.283185307179586476925, a); const double x2 = x * x;
    double s = 1.0, c = 1.0;
#pragma unroll
    for (int n = 14; n >= 1; --n) { s = 1.0 - x2 * (1.0 / (double)((2 * n) * (2 * n + 1))) * s; c = 1.0 - x2 * (1.0 / (double)((2 * n - 1) * (2 * n))) * c; }
    sn = (float)(x * s); cs = (float)c;
}

#define MFMA32(a, b, c) __builtin_amdgcn_mfma_f32_32x32x16_bf16((a), (b), (c), 0, 0, 0)
__device__ __forceinline__ f32x16 zero16() { f32x16 z;
#pragma unroll
    for (int i = 0; i < 16; ++i) z[i] = 0.f; return z; }
__device__ __forceinline__ s16x4 vtr(const LAS char* p) { return __builtin_bit_cast(s16x4, __builtin_amdgcn_ds_read_tr16_b64_v4i16((LAS s16x4*)p)); }
template <int BASE> __device__ __forceinline__ bf16x8 pack8(const f32x16& p) {
    v4u w; w.x = cvtpk(p[BASE], p[BASE + 1]); w.y = cvtpk(p[BASE + 2], p[BASE + 3]); w.z = cvtpk(p[BASE + 4], p[BASE + 5]); w.w = cvtpk(p[BASE + 6], p[BASE + 7]);
    return __builtin_bit_cast(bf16x8, w);
}
template <int NS> __device__ __forceinline__ void qk(f32x16& p0, f32x16& p1, const LAS char* kb, int strideB, const bf16x8 (&q)[NS]) {
    p0 = zero16(); p1 = zero16();
#pragma unroll
    for (int s = 0; s < NS; ++s) {
        const bf16x8 a0 = *(const LAS bf16x8*)(kb + s * 32);
        const bf16x8 a1 = *(const LAS bf16x8*)(kb + 32 * strideB + s * 32);
        p0 = MFMA32(a0, q[s], p0); p1 = MFMA32(a1, q[s], p1);
    }
}
template <int NDB> __device__ __forceinline__ void pv(f32x16 (&o)[NDB], const f32x16& p0, const f32x16& p1, const LAS char* vb, int strideB) {
    const bf16x8 pb0 = pack8<0>(p0), pb1 = pack8<8>(p0), pb2 = pack8<0>(p1), pb3 = pack8<8>(p1);
#pragma unroll
    for (int kk = 0; kk < 4; ++kk) {
        const bf16x8 pb = kk == 0 ? pb0 : (kk == 1 ? pb1 : (kk == 2 ? pb2 : pb3));
#pragma unroll
        for (int db = 0; db < NDB; ++db) {
            const s16x4 lo = vtr(vb + (16 * kk) * strideB + db * 64);
            const s16x4 hh = vtr(vb + (16 * kk + 8) * strideB + db * 64);
            const bf16x8 a = __builtin_shufflevector(lo, hh, 0, 1, 2, 3, 4, 5, 6, 7);
            o[db] = MFMA32(a, pb, o[db]);
        }
    }
}
template <int NS> __device__ __forceinline__ void k_ld(bf16x8 (&k)[2 * NS], const LAS char* kb, int strideB) {
#pragma unroll
    for (int s = 0; s < NS; ++s) { k[2 * s] = *(const LAS bf16x8*)(kb + s * 32); k[2 * s + 1] = *(const LAS bf16x8*)(kb + 32 * strideB + s * 32); }
}
template <int NS> __device__ __forceinline__ void qk_r(f32x16& p0, f32x16& p1, const bf16x8 (&k)[2 * NS], const bf16x8 (&q)[NS]) {
    p0 = zero16(); p1 = zero16();
#pragma unroll
    for (int s = 0; s < NS; ++s) { p0 = MFMA32(k[2 * s], q[s], p0); p1 = MFMA32(k[2 * s + 1], q[s], p1); }
}
template <int NDB> __device__ __forceinline__ void v_ld(bf16x8 (&v)[4 * NDB], const LAS char* vb, int strideB) {
#pragma unroll
    for (int kk = 0; kk < 4; ++kk)
#pragma unroll
        for (int db = 0; db < NDB; ++db) {
            const s16x4 lo = vtr(vb + (16 * kk) * strideB + db * 64);
            const s16x4 hh = vtr(vb + (16 * kk + 8) * strideB + db * 64);
            v[kk * NDB + db] = __builtin_shufflevector(lo, hh, 0, 1, 2, 3, 4, 5, 6, 7);
        }
}
template <int NDB> __device__ __forceinline__ void pv_r(f32x16 (&o)[NDB], const f32x16& p0, const f32x16& p1, const bf16x8 (&v)[4 * NDB]) {
    const bf16x8 pb0 = pack8<0>(p0), pb1 = pack8<8>(p0), pb2 = pack8<0>(p1), pb3 = pack8<8>(p1);
#pragma unroll
    for (int kk = 0; kk < 4; ++kk) {
        const bf16x8 pb = kk == 0 ? pb0 : (kk == 1 ? pb1 : (kk == 2 ? pb2 : pb3));
#pragma unroll
        for (int db = 0; db < NDB; ++db) o[db] = MFMA32(v[kk * NDB + db], pb, o[db]);
    }
}
template <int NDB> __device__ __forceinline__ void softmax_step(f32x16& p0, f32x16& p1, float& m, float& l, f32x16 (&o)[NDB]) {
    float mx = p0[0];
#pragma unroll
    for (int r = 1; r < 16; ++r) mx = fmaxf(mx, p0[r]);
#pragma unroll
    for (int r = 0; r < 16; ++r) mx = fmaxf(mx, p1[r]);
    { const unsigned ux_ = __float_as_uint(mx); const auto sw_ = __builtin_amdgcn_permlane32_swap(ux_, ux_, false, false);
      mx = fmaxf(__uint_as_float(sw_[0]), __uint_as_float(sw_[1])); }
    const float mn = fmaxf(m, mx);
    if (__any(mn > m)) {
        const float alpha = __builtin_amdgcn_exp2f(m - mn);
        l *= alpha;
#pragma unroll
        for (int db = 0; db < NDB; ++db)
#pragma unroll
            for (int r = 0; r < 16; ++r) o[db][r] *= alpha;
    }
    m = mn;
    typedef float f32x2_t __attribute__((ext_vector_type(2)));
    const f32x2_t mn2 = {mn, mn}; f32x2_t s2 = {0.f, 0.f};
#pragma unroll
    for (int r = 0; r < 8; ++r) { f32x2_t d = {p0[2 * r], p0[2 * r + 1]}; d -= mn2; d.x = __builtin_amdgcn_exp2f(d.x); d.y = __builtin_amdgcn_exp2f(d.y); p0[2 * r] = d.x; p0[2 * r + 1] = d.y; s2 += d; }
#pragma unroll
    for (int r = 0; r < 8; ++r) { f32x2_t d = {p1[2 * r], p1[2 * r + 1]}; d -= mn2; d.x = __builtin_amdgcn_exp2f(d.x); d.y = __builtin_amdgcn_exp2f(d.y); p1[2 * r] = d.x; p1[2 * r + 1] = d.y; s2 += d; }
    l += s2.x + s2.y;
}
__device__ __forceinline__ v4u cvt8f(const v4u a, const v4u b) {
    const unsigned a0 = a[0], a1 = a[1], a2 = a[2], a3 = a[3], b0 = b[0], b1 = b[1], b2 = b[2], b3 = b[3]; v4u v;
    v[0] = cvtpk(__uint_as_float(a0), __uint_as_float(a1)); v[1] = cvtpk(__uint_as_float(a2), __uint_as_float(a3));
    v[2] = cvtpk(__uint_as_float(b0), __uint_as_float(b1)); v[3] = cvtpk(__uint_as_float(b2), __uint_as_float(b3)); return v; }
template <int W, int STRIDE, bool F32PF = true, int ROWS = 64> struct TileLd {
    static constexpr int CH = W / 8, RPP = 512 / CH, PER = (ROWS + RPP - 1) / RPP, STRB = (W + 8) * 2;
    int nrows_ = ROWS;
    v4u raw[PER][F32PF ? 2 : 1];
    const char* src_;
    __device__ __forceinline__ void init() { src_ = nullptr;
#pragma unroll
        for (int i = 0; i < PER; ++i) { raw[i][0] = (v4u){0u, 0u, 0u, 0u}; raw[i][F32PF ? 1 : 0] = (v4u){0u, 0u, 0u, 0u}; } }
    __device__ __forceinline__ void issue(const void* src, bool f32, int tid) {
        src_ = (const char*)src;
        if (!F32PF && f32) return;
        const int row0 = tid / CH, cc = tid % CH; const bool act = tid < RPP * CH;
        const unsigned loff = (unsigned)(row0 * STRIDE + cc * 8);
#pragma unroll
        for (int i = 0; i < PER; ++i) {
            if (act && (row0 + i * RPP < nrows_)) {
                if (F32PF && f32) { const GLB v4u* p = (const GLB v4u*)(src_ + (size_t)i * RPP * STRIDE * 4 + (size_t)loff * 4); raw[i][0] = p[0]; raw[i][F32PF ? 1 : 0] = p[1]; }
                else { raw[i][0] = *(const GLB v4u*)(src_ + (size_t)i * RPP * STRIDE * 2 + (size_t)loff * 2); } } }
    }
    __device__ __forceinline__ static v4u cvt8(const v4u a, const v4u b) { return cvt8f(a, b); }
    __device__ __forceinline__ void store(LAS char* tile, bool f32, int tid) {
        const int row0 = tid / CH, cc = tid % CH; const bool act = tid < RPP * CH;
        const unsigned loff = (unsigned)(row0 * STRIDE + cc * 8);
        LAS char* dst = tile + row0 * STRB + cc * 16;
#pragma unroll
        for (int i = 0; i < PER; ++i) {
            if (act && (row0 + i * RPP < nrows_)) { v4u v = raw[i][0];
                if (f32) {
                    if (F32PF) v = cvt8(raw[i][0], raw[i][F32PF ? 1 : 0]);
                    else { const GLB v4u* p = (const GLB v4u*)(src_ + (size_t)i * RPP * STRIDE * 4 + (size_t)loff * 4); v = cvt8(p[0], p[1]); } }
                *(LAS v4u*)(dst + i * RPP * STRB) = v; } }
    }
};
constexpr int T512_STRB = 1040, T512_BYTES = 64 * T512_STRB;
__device__ __forceinline__ void t512_dma(const void* src, LAS char* buf, int wave, int lane) {
#pragma unroll
    for (int j = 0; j < 8; ++j) { const int row = wave * 8 + j;
        __builtin_amdgcn_global_load_lds((const unsigned*)((const char*)src + (size_t)row * 1024 + lane * 16), (LAS unsigned*)(buf + row * T512_STRB), 16, 0, 0); }
}
__device__ __forceinline__ void t512_cvt(const void* src, LAS char* buf, int tid) {
    const int row0 = tid >> 6, cc = tid & 63; const char* p0 = (const char*)src + (size_t)row0 * 2048 + cc * 32; LAS char* d0 = buf + row0 * T512_STRB + cc * 16;
    v4u a[8], b[8];
#pragma unroll
    for (int i = 0; i < 8; ++i) { const GLB v4u* p = (const GLB v4u*)(p0 + (size_t)i * 8 * 2048); a[i] = p[0]; b[i] = p[1]; }
    __builtin_amdgcn_sched_barrier(0);
#pragma unroll
    for (int i = 0; i < 8; ++i) *(LAS v4u*)(d0 + i * 8 * T512_STRB) = cvt8f(a[i], b[i]);
}
__device__ __forceinline__ int crow(int r, int hi) { return (r & 3) + 8 * (r >> 2) + 4 * hi; }

struct UnitId { int sample, b, c, nt, qrow0, krow0; };
constexpr int QLIST = 4 + 4 * 32;
__device__ __forceinline__ UnitId decode_unit(int x, int idx) {
    UnitId u;
    if (idx < 4) { u.sample = 1; u.b = x + 8 * idx; u.c = 0; u.nt = PAST / 64 + 1; u.qrow0 = MP + u.b * DSEQ; u.krow0 = MP + u.b * DSEQ; }
    else { const int j = idx - 4; u.sample = 0; u.c = 31 - (j & 31); u.b = x + 8 * (j >> 5); u.nt = u.c + 1; u.qrow0 = u.b * SEQ + u.c * 64; u.krow0 = u.b * SEQ; }
    return u;
}
constexpr int N_UNITS = NB + NB * (SEQ / 64);

__device__ __forceinline__ const void* tile_src(const UnitId& u, int t, const float* cache_lb  , const bf16* rows, int W, int coloff, bool& f32) {
    if (u.sample && t < PAST / 64) { f32 = true; return cache_lb + (size_t)t * 64 * W + coloff; }
    f32 = false; const int tt = u.sample ? 0 : t;
    return rows + (size_t)(u.krow0 + tt * 64) * W + coloff;
}

template <int NQ> __device__ __forceinline__ void hist_pick(LAS unsigned* hist, int lane, int (&kk)[NQ], int (&bin_out)[NQ], unsigned (&cnt_out)[NQ], const bool (&act)[NQ]) {
    unsigned sl[NQ], incl[NQ];
#pragma unroll
    for (int a = 0; a < NQ; ++a) { sl[a] = 0u;
#pragma unroll
        for (int j = 0; j < 8; ++j) { const v4u c4 = ((LAS v4u*)(hist + a * 2048))[lane * 8 + j]; sl[a] += (c4[0] + c4[1]) + (c4[2] + c4[3]); }
        incl[a] = sl[a]; }
#pragma unroll
    for (int o = 1; o < 64; o <<= 1) {
        unsigned t2[NQ];
#pragma unroll
        for (int a = 0; a < NQ; ++a) t2[a] = (unsigned)__shfl_down((int)incl[a], o);
#pragma unroll
        for (int a = 0; a < NQ; ++a) incl[a] += (lane + o < 64) ? t2[a] : 0u; }
    int hl[NQ]; unsigned above_h[NQ], v[NQ], inc2[NQ];
#pragma unroll
    for (int a = 0; a < NQ; ++a) { const unsigned above_l = incl[a] - sl[a]; const bool hit = (above_l < (unsigned)kk[a]) && ((unsigned)kk[a] <= incl[a]);
        const unsigned long long hb = __ballot(hit); hl[a] = hb ? (int)__builtin_ctzll(hb) : 0; above_h[a] = (unsigned)__builtin_amdgcn_readlane((int)above_l, hl[a]);
        v[a] = (lane < 32) ? hist[a * 2048 + hl[a] * 32 + lane] : 0u; inc2[a] = v[a]; }
#pragma unroll
    for (int o = 1; o < 32; o <<= 1) {
        unsigned t2[NQ];
#pragma unroll
        for (int a = 0; a < NQ; ++a) t2[a] = (unsigned)__shfl_down((int)inc2[a], o);
#pragma unroll
        for (int a = 0; a < NQ; ++a) inc2[a] += (lane + o < 32) ? t2[a] : 0u; }
#pragma unroll
    for (int a = 0; a < NQ; ++a) { const unsigned above2 = above_h[a] + inc2[a] - v[a];
        const bool hit2 = (lane < 32) && (above2 < (unsigned)kk[a]) && ((unsigned)kk[a] <= above2 + v[a]);
        const unsigned long long hb2 = __ballot(hit2); const int l2 = hb2 ? (int)__builtin_ctzll(hb2) : 0;
        if (act[a]) { bin_out[a] = hl[a] * 32 + l2; kk[a] -= __builtin_amdgcn_readlane((int)above2, l2); cnt_out[a] = (unsigned)__builtin_amdgcn_readlane((int)v[a], l2); } }
}
template <int NI, int NQ, int ES = 1> __device__ __forceinline__ void dsa_select(const float* srow, int nt, LAS unsigned* hist, unsigned long long* mrow, int lane) {
    float xv[NQ][NI]; float lo[NQ], hi[NQ];
#pragma unroll
    for (int a = 0; a < NQ; ++a) { lo[a] = 3e38f; hi[a] = -3e38f; }
    { const int nt_ = opaque_s(nt);
#pragma unroll
    for (int i = 0; i < NI; ++i) {
#pragma unroll
        for (int a = 0; a < NQ; ++a) xv[a][i] = 0.f;
        if (i < nt_) {
#pragma unroll
            for (int a = 0; a < NQ; ++a) { xv[a][i] = srow[(size_t)a * SC_LS + (size_t)(i * 64 + lane) * ES]; lo[a] = fminf(lo[a], xv[a][i]); hi[a] = fmaxf(hi[a], xv[a][i]); } } } }
#pragma unroll
    for (int o = 1; o < 64; o <<= 1)
#pragma unroll
        for (int a = 0; a < NQ; ++a) { lo[a] = fminf(lo[a], __shfl_xor(lo[a], o)); hi[a] = fmaxf(hi[a], __shfl_xor(hi[a], o)); }
    float scale[NQ]; int kk[NQ], b0[NQ]; unsigned c0n[NQ];
#pragma unroll
    for (int a = 0; a < NQ; ++a) { const float range = hi[a] - lo[a]; scale[a] = (range > 1e-30f) ? 2047.0f / range : 0.f; kk[a] = 256; b0[a] = 0; c0n[a] = 0u; }
#pragma unroll
    for (int j = 0; j < 8 * NQ; ++j) ((LAS v4u*)hist)[lane + 64 * j] = (v4u){0u, 0u, 0u, 0u};
    LDS_WAIT();
    { const int nt_ = opaque_s(nt); float sc_[NQ];
#pragma unroll
    for (int a = 0; a < NQ; ++a) sc_[a] = opaque_vf(scale[a]);
#pragma unroll
    for (int i = 0; i < NI; ++i) if (i < nt_) {
#pragma unroll
        for (int a = 0; a < NQ; ++a) { const int b = min(2047, (int)((xv[a][i] - lo[a]) * sc_[a])); __hip_atomic_fetch_add(hist + a * 2048 + b, 1u, __ATOMIC_RELAXED, __HIP_MEMORY_SCOPE_WORKGROUP); } } }
    LDS_WAIT();
    { bool all_[NQ];
#pragma unroll
      for (int a = 0; a < NQ; ++a) all_[a] = true;
      hist_pick<NQ>(hist, lane, kk, b0, c0n, all_); }
    unsigned prefix[NQ], pmask[NQ]; bool whole[NQ], live[NQ]; bool any_live = false;
#pragma unroll
    for (int a = 0; a < NQ; ++a) { prefix[a] = 0u; pmask[a] = 0u; whole[a] = ((unsigned)kk[a] == c0n[a]); live[a] = !whole[a]; any_live = any_live || live[a]; }
    if (any_live) {
#pragma unroll
        for (int pass = 0; pass < 3; ++pass) {
            const int SH = pass == 0 ? 21 : (pass == 1 ? 10 : 0); const unsigned BM_ = pass == 2 ? 1023u : 2047u;
#pragma unroll
            for (int j = 0; j < 8 * NQ; ++j) ((LAS v4u*)hist)[lane + 64 * j] = (v4u){0u, 0u, 0u, 0u};
            LDS_WAIT();
            const int nt_ = opaque_s(nt); float sc_[NQ];
#pragma unroll
            for (int a = 0; a < NQ; ++a) sc_[a] = opaque_vf(scale[a]);
#pragma unroll
            for (int i = 0; i < NI; ++i) if (i < nt_) {
#pragma unroll
                for (int a = 0; a < NQ; ++a) { const int b = min(2047, (int)((xv[a][i] - lo[a]) * sc_[a])); const unsigned bts = __float_as_uint(xv[a][i]); const unsigned x = bts ^ ((bts >> 31) ? 0xFFFFFFFFu : 0x80000000u);
                    if (live[a] && b == b0[a] && (x & pmask[a]) == prefix[a]) __hip_atomic_fetch_add(hist + a * 2048 + ((x >> SH) & BM_), 1u, __ATOMIC_RELAXED, __HIP_MEMORY_SCOPE_WORKGROUP); } }
            LDS_WAIT();
            bool more = false; int bin[NQ]; unsigned c_u[NQ];
#pragma unroll
            for (int a = 0; a < NQ; ++a) { bin[a] = 0; c_u[a] = 0u; }
            hist_pick<NQ>(hist, lane, kk, bin, c_u, live);
#pragma unroll
            for (int a = 0; a < NQ; ++a) if (live[a]) {
                prefix[a] |= ((unsigned)bin[a] & BM_) << SH; pmask[a] |= BM_ << SH;
                if ((unsigned)kk[a] == c_u[a]) live[a] = false;
                more = more || live[a]; }
            if (!more) break;
        }
    }
    const int nt2_ = opaque_s(nt); float sc2_[NQ];
#pragma unroll
    for (int a = 0; a < NQ; ++a) sc2_[a] = opaque_vf(scale[a]);
#pragma unroll
    for (int i = 0; i < NI; ++i) if (i < nt2_) {
#pragma unroll
        for (int a = 0; a < NQ; ++a) { const int b = min(2047, (int)((xv[a][i] - lo[a]) * sc2_[a])); const unsigned bts = __float_as_uint(xv[a][i]); const unsigned x = bts ^ ((bts >> 31) ? 0xFFFFFFFFu : 0x80000000u);
            const bool selq = b > b0[a] || (b == b0[a] && (whole[a] || x >= prefix[a]));
            const unsigned long long mw = __ballot(selq); if (lane == 0) mrow[(size_t)a * MK_LS + i] = mw; } }
}
#define FRESH_TID() const int tid_o = wave0 * 64 + fresh_lane(); const int tid = tid_o, lane = tid & 63, wave = __builtin_amdgcn_readfirstlane(tid >> 6); (void)lane; (void)wave
__global__ void __launch_bounds__(NWAVES * 64, 2) fwd_kernel(Args args) {
    extern __shared__ __attribute__((aligned(16))) unsigned char lds_raw[];
    LAS unsigned char* lds = (LAS unsigned char*)lds_raw;
    volatile LAS unsigned* MISC = (volatile LAS unsigned*)(lds + MISC_OFF);
    const int wave0 = __builtin_amdgcn_readfirstlane((int)threadIdx.x >> 6);
    const int tid = wave0 * 64 + fresh_lane();
    const int G = gridDim.x;
    unsigned char* ws = args.ws;
    gu32* ctl = (gu32*)(ws + WS_CTL);
    float* const out = args.out;
#define X (out + O_Y)
#define XB ((bf16*)(ws + WS_XB))
#define HB ((bf16*)(ws + WS_REGA))
#define ACT ((bf16*)(ws + WS_REGA))
#define QA ((bf16*)(ws + WS_QA))
#define QB ((bf16*)(ws + WS_QB))
#define QI ((bf16*)(ws + WS_QI))
#define QC ((bf16*)(ws + WS_QC))
#define QD ((bf16*)(ws + WS_QD))
#define WI ((float*)(ws + WS_WI))
#define RA ((bf16*)(ws + WS_RA))
#define RB ((bf16*)(ws + WS_RB))
#define RC ((bf16*)(ws + WS_RC))
#define RD ((bf16*)(ws + WS_RD))
#define CC ((bf16*)(ws + WS_CC))
#define CQ ((bf16*)(ws + WS_REGA + (size_t)300 * MiB))
#define CKV ((bf16*)(ws + WS_REGA + (size_t)340 * MiB))
#define SSQP ((float*)(ws + WS_SSQP))
#define LAMF ((float*)(ws + WS_MISC))
#define ROPE64 ((float2*)(ws + WS_MISC + MISC_ROPE64))
#define ROPE32 ((float2*)(ws + WS_MISC + MISC_ROPE32))
    for (int u = tid; u < (LDS_BYTES - LDSCTL_OFF) / 4; u += NWAVES * 64) ((LAS unsigned*)(lds + LDSCTL_OFF))[u] = 0u;
    __syncthreads();
    XcdBarrier bar; bar.bar = (unsigned*)(ctl + CW_BAR); bar.x = 0; bar.st = nullptr; bar.wave0 = wave0;
    const int lo = args.ph_lo, hi_ph = args.ph_hi;
    if (hi_ph - lo > 1) bar = xcd_barrier_post((unsigned*)(ctl + CW_BAR), MISC + 8, wave0);
#define IN(k) (opaque_s(lo) <= (k) && (k) < opaque_s(hi_ph))
#define BOTH(k) (IN(k) && IN((k) + 1))
#define GRID_BAR() xcd_barrier(bar)

    if (EN_PH(0) && IN(0)) {
        FRESH_TID();
        for (int p0rep = 0; p0rep < P0_REPS; ++p0rep) {
        LAS float* scr = (LAS float*)(lds + wave * 16384);
        const int gw = blockIdx.x * NWAVES + wave, NGW = G * NWAVES;
        for (int l = 0; l < DEPTH; ++l) {
            unsigned char* wl = ws + WS_W + (size_t)l * W_LAYER;
            const int I_GU = (DM / 64) * (DFF / 32), I_D = (DFF / 64) * (DM / 32), I_INN = (DM / 64) * ((NIN + 31) / 32), I_O = (768 / 64) * (DM / 32);
            const int NIT = 4 * I_GU + 2 * I_D + I_INN + I_O;
            for (int it = gw; it < NIT; it += NGW) {
                int r = it;
                if (r < I_GU) { transpose_item<1>(ARG_IN(I_G1) + (size_t)l * DM * DFF, DM, DFF, ARG_IN(I_N1) + l * DM, (bf16*)(wl + W_GU1), DM, 0, scr, r, lane); continue; } r -= I_GU;
                if (r < I_GU) { transpose_item<2>(ARG_IN(I_U1) + (size_t)l * DM * DFF, DM, DFF, ARG_IN(I_N1) + l * DM, (bf16*)(wl + W_GU1), DM, 0, scr, r, lane); continue; } r -= I_GU;
                if (r < I_GU) { transpose_item<1>(ARG_IN(I_G2) + (size_t)l * DM * DFF, DM, DFF, ARG_IN(I_N2) + l * DM, (bf16*)(wl + W_GU2), DM, 0, scr, r, lane); continue; } r -= I_GU;
                if (r < I_GU) { transpose_item<2>(ARG_IN(I_U2) + (size_t)l * DM * DFF, DM, DFF, ARG_IN(I_N2) + l * DM, (bf16*)(wl + W_GU2), DM, 0, scr, r, lane); continue; } r -= I_GU;
                if (r < I_D) { transpose_item<0>(ARG_IN(I_D1) + (size_t)l * DFF * DM, DFF, DM, nullptr, (bf16*)(wl + W_D1), DFF, 0, scr, r, lane); continue; } r -= I_D;
                if (r < I_D) { transpose_item<0>(ARG_IN(I_D2) + (size_t)l * DFF * DM, DFF, DM, nullptr, (bf16*)(wl + W_D2), DFF, 0, scr, r, lane); continue; } r -= I_D;
                if (r < I_INN) { transpose_item<3>(ARG_IN(I_WIN) + (size_t)l * DM * NIN, DM, NIN, ARG_IN(I_NM) + l * DM, (bf16*)(wl + W_IN), DM, 0, scr, r, lane); continue; } r -= I_INN;
                transpose_item<0>(ARG_IN(I_WO) + (size_t)l * DM * DM + (size_t)256 * DM, 768, DM, nullptr, (bf16*)(wl + W_OUT), KOUT, 512, scr, r, lane);
            }
            const int gt = blockIdx.x * 512 + tid, NGT = G * 512;
            if (FUSE_POST) { for (int i = gt; i < NINP * (DM / 8); i += NGT) { const int np = i / (DM / 8); if (mycol_is_pad(np)) *(v4u*)((bf16*)(wl + W_IN) + (size_t)np * DM + 8 * (i % (DM / 8))) = (v4u){0u, 0u, 0u, 0u}; } }
            else for (int i = gt; i < (NINP - NIN) * DM; i += NGT) ((bf16*)(wl + W_IN))[(size_t)NIN * DM + i] = 0;
            for (int i = gt; i < (NQP - NQ) * 256; i += NGT) ((bf16*)(wl + W_Q))[(size_t)NQ * 256 + i] = 0;
            const float* wqb = ARG_IN(I_WQB) + (size_t)l * 256 * 384; const float* wkvb = ARG_IN(I_WKVB) + (size_t)l * 128 * 512; const float* qn = ARG_IN(I_QN) + l * 256;
            const float scaleA = 0.10206207261596575f * LOG2E;
            for (int i = gt; i < NQ * 256; i += NGT) {
                const int np = i >> 8, k = i & 255, hh = np / 160, c = np % 160; float v;
                if (c < 128) { float s = 0.f; for (int e = 0; e < 64; ++e) s += wqb[(size_t)k * 384 + hh * 96 + e] * wkvb[(size_t)c * 512 + hh * 128 + e]; v = s; }
                else v = wqb[(size_t)k * 384 + hh * 96 + 64 + (c - 128)];
                ((bf16*)(wl + W_Q))[(size_t)np * 256 + k] = (bf16)f2bf(v * qn[k] * scaleA);
            }
            const float* wo = ARG_IN(I_WO) + (size_t)l * DM * DM;
            for (int i = gt; i < 512 * DM; i += NGT) {
                const int n = i & 1023, kc = i >> 10, hh = kc >> 7, c = kc & 127; float s = 0.f;
                for (int e = 0; e < 64; ++e) s += wkvb[(size_t)c * 512 + hh * 128 + 64 + e] * wo[(size_t)(hh * 64 + e) * DM + n];
                ((bf16*)(wl + W_OUT))[(size_t)n * KOUT + kc] = (bf16)f2bf(s);
            }
            if (blockIdx.x == 0 && wave == 0) {
                const float* lf = ARG_IN(I_LAM) + l * 128;
                float a = lane < 32 ? lf[lane] * lf[32 + lane] : 0.f, b = lane < 32 ? lf[64 + lane] * lf[96 + lane] : 0.f;
                a = wave_sum(a); b = wave_sum(b);
                const float lam_init = 0.8f - 0.6f * expf(-0.3f * (float)l);
                if (lane == 0) LAMF[l] = expf(a) - expf(b) + lam_init;
            }
        }
        {
            const int gt = blockIdx.x * 512 + tid, NGT = G * 512;
            for (int i = gt; i < 2112 * 48; i += NGT) {
                const int pidx = i / 48, j = i % 48; const float pos = (float)(pidx < 2048 ? pidx : 4096 + (pidx - 2048));
                const float fr = j < 32 ? ARG_FREQ64(j) : ARG_FREQ32(j - 32);
                float sn, cs; sincos_acc(pos * fr, sn, cs);
                if (j < 32) ROPE64[pidx * 32 + j] = make_float2(cs, sn); else ROPE32[pidx * 16 + (j - 32)] = make_float2(cs, sn);
            }
        }
        for (int m = 2 * gw; m < M; m += 2 * NGW) {
            f32x4 v[2][4]; float sq[2];
#pragma unroll
            for (int r2 = 0; r2 < 2; ++r2) { const int mr = m + r2; const float* xr = (mr < MP) ? ARG_IN(I_XP) + (size_t)mr * DM : ARG_IN(I_XS) + (size_t)(mr - MP) * DM; const f32x4* x4 = (const f32x4*)xr + lane;
#pragma unroll
                for (int j = 0; j < 4; ++j) v[r2][j] = x4[64 * j]; }
#pragma unroll
            for (int r2 = 0; r2 < 2; ++r2) { const int mr = m + r2; float s2 = 0.f; unsigned long long* o8 = (unsigned long long*)(XB + (size_t)mr * DM) + lane;
#pragma unroll
                for (int j = 0; j < 4; ++j) { const f32x4 w = v[r2][j]; s2 += (w.x * w.x + w.y * w.y) + (w.z * w.z + w.w * w.w);
                    o8[64 * j] = (unsigned long long)cvtpk(w.x, w.y) | ((unsigned long long)cvtpk(w.z, w.w) << 32); }
                sq[r2] = wave_sum(s2); }
#pragma unroll
            for (int r2 = 0; r2 < 2; ++r2) if (lane < 16) SSQP[(size_t)(m + r2) * 16 + lane] = lane == 0 ? sq[r2] : 0.f;
        }
        }
        if (BOTH(0)) GRID_BAR();
    }

#pragma unroll 1
    for (int l = 0; l < DEPTH; ++l) {
        const int pb = 1 + 8 * l;
        unsigned char* wl = ws + WS_W + (size_t)l * W_LAYER;
        float* ssqA = SSQP + (size_t)l * M * 16; float* ssqAn = SSQP + (size_t)(l + 1) * M * 16; float* ssqB = SSQP + (size_t)(3 + l) * M * 16; float* ssqC = SSQP + (size_t)(5 + l) * M * 16; float* ssqQ = SSQP + (size_t)7 * M * 16 + (size_t)l * M * 4; float* ssqK = SSQP + (size_t)7 * M * 16 + (size_t)(2 + l) * M * 4; (void)ssqK;
        if (EN_PH(1) && IN(pb + 0)) {
            pg8::Gemm g{XB, (const bf16*)(wl + W_GU1), M, NGU, DM, DM}; pg8::StaticOrder S; S.init(M, NGU, G, (int)blockIdx.x);
            pg8::EpiSwiGLU E{ACT, ssqA};
            for (int grep = 0; grep < GU_REPS; ++grep)
            pg8::gemm_phase<pg8::EpiSwiGLU, pg8::StaticOrder, true, true>(lds, g, S, E, wave0);
            if (BOTH(pb + 0)) GRID_BAR();
        }
#define SPLITK_SAMPLE(WOFF) do { const int sl_ = (int)blockIdx.x & 7, un_ = (int)blockIdx.x >> 3; const int kb_ = sl_ < 6 ? 3 * sl_ : 18 + 2 * (sl_ - 6), kl_ = sl_ < 6 ? 3 : 2; \
        pg8::Gemm g2{ACT + (size_t)(MP + 256 * (un_ >> 2)) * DFF + kb_ * 128, (const bf16*)(wl + WOFF) + (size_t)(256 * (un_ & 3)) * DFF + kb_ * 128, 256, 256, kl_ * 128, DFF, DFF}; \
        pg8::OneUnit S2; pg8::EpiPartial E2{(float*)(ws + WS_QA) + (size_t)(un_ * 8 + sl_) * 32 * 512 * 4}; \
        pg8::gemm_phase<pg8::EpiPartial, pg8::OneUnit, true, true>(lds, g2, S2, E2, wave0); } while (0)
        if (EN_PH(2) && IN(pb + 1)) {
            pg8::Gemm g{ACT, (const bf16*)(wl + W_D1), M, DM, DFF, DFF}; pg8::StaticOrder S; S.init(MP, DM, G, (int)blockIdx.x);
            if (l == 0) { pg8::EpiResid<true> E{ARG_IN(I_XP), ARG_IN(I_XS) - (size_t)MP * DM, XB, ssqB, 0.5f};
                pg8::gemm_phase<pg8::EpiResid<true>, pg8::StaticOrder, true, true>(lds, g, S, E, wave0); }
            else { pg8::EpiResid<false> E{nullptr, nullptr, XB, ssqB, 0.5f};
                pg8::gemm_phase<pg8::EpiResid<false>, pg8::StaticOrder, true, true>(lds, g, S, E, wave0); }
            SPLITK_SAMPLE(W_D1);
            GRID_BAR();
            { FRESH_TID(); const int un_ = (int)blockIdx.x >> 3, j_ = (int)blockIdx.x & 7; const float* Pu = (const float*)(ws + WS_QA) + (size_t)un_ * 8 * 32 * 512 * 4;
              if (l == 0) pg8::resid_fixup<true>(Pu, MP / 256 + (un_ >> 2), un_ & 3, j_ >> 2, j_ & 3, ARG_IN(I_XS) - (size_t)MP * DM, XB, ssqB, 0.5f, tid);
              else pg8::resid_fixup<false>(Pu, MP / 256 + (un_ >> 2), un_ & 3, j_ >> 2, j_ & 3, nullptr, XB, ssqB, 0.5f, tid); }
            if (BOTH(pb + 1)) GRID_BAR();
        }
        if (EN_PH(3) && IN(pb + 2)) {
            pg8::Gemm g{XB, (const bf16*)(wl + W_IN), M, NINP, DM, DM}; pg8::StaticOrder S; S.init(M, NINP, G, (int)blockIdx.x);
#if FUSE_POST
#if IN_STAGGER_TICKS > 0
            if (blockIdx.x & 1) { const unsigned long long t0 = __builtin_amdgcn_s_memrealtime(); while (__builtin_amdgcn_s_memrealtime() - t0 < (unsigned long long)IN_STAGGER_TICKS) __builtin_amdgcn_s_sleep(8); }
#endif
            pg8::EpiInFused E{ws, out, l};
            pg8::gemm_phase<pg8::EpiInFused, pg8::StaticOrder, true, true>(lds, g, S, E, wave0);
#else
            pg8::EpiScaleBf16 E{HB, NINP, ssqB, 16, 1.0f / 1024.0f, ssqQ};
            pg8::gemm_phase<pg8::EpiScaleBf16, pg8::StaticOrder, true, true>(lds, g, S, E, wave0);
#endif
            if (BOTH(pb + 2)) GRID_BAR();
        }
        if (EN_PH(4) && IN(pb + 3)) {
#if FUSE_POST
            {
                pg8::Gemm g{CQ, (const bf16*)(wl + W_Q), M, NQP, 256, 256}; pg8::StaticOrder S; S.init(M, NQP, G, (int)blockIdx.x);
                pg8::EpiScaleBf16 E{QA, NQP, ssqQ, 4, 1.0f / 256.0f, nullptr};
                pg8::gemm_phase<pg8::EpiScaleBf16, pg8::StaticOrder, true, true>(lds, g, S, E, wave0);
            }
            {
                FRESH_TID();
                const float* kvn = ARG_IN(I_KVN) + l * 128; const int gw = blockIdx.x * NWAVES + wave, NGW = G * NWAVES; const int c16 = lane & 15, sub = lane >> 4;
                for (int row4 = gw * 4; row4 < M; row4 += NGW * 4) { const int row = row4 + sub;
                    const bool smp = row >= MP; const int rr = smp ? row - MP : row;
                    const v4u w = *(const v4u*)(CKV + (size_t)row * 128 + 8 * c16); float x[8];
                    x[0] = __uint_as_float(w[0] << 16); x[1] = __uint_as_float(w[0] & 0xffff0000u); x[2] = __uint_as_float(w[1] << 16); x[3] = __uint_as_float(w[1] & 0xffff0000u);
                    x[4] = __uint_as_float(w[2] << 16); x[5] = __uint_as_float(w[2] & 0xffff0000u); x[6] = __uint_as_float(w[3] << 16); x[7] = __uint_as_float(w[3] & 0xffff0000u);
                    const float rs = 1.0f / sqrtf(ssq_sum4(ssqK, row) * (1.0f / 128.0f) + EPS); const f32x4 g0 = *(const f32x4*)(kvn + 8 * c16), g1 = *(const f32x4*)(kvn + 8 * c16 + 4);
#pragma unroll
                    for (int e = 0; e < 4; ++e) { x[e] = x[e] * rs * g0[e]; x[4 + e] = x[4 + e] * rs * g1[e]; }
                    float* od = out + (smp ? O_MLA_S + ((size_t)l * MS + rr) * 160 : O_MLA_P + ((size_t)l * MP + rr) * 160) + 8 * c16;
                    *(f32x4*)od = (f32x4){x[0], x[1], x[2], x[3]}; *(f32x4*)(od + 4) = (f32x4){x[4], x[5], x[6], x[7]};
                    *(v4u*)(RA + (size_t)row * 160 + 8 * c16) = (v4u){cvtpk(x[0], x[1]), cvtpk(x[2], x[3]), cvtpk(x[4], x[5]), cvtpk(x[6], x[7])}; }
            }
            if (BOTH(pb + 3)) GRID_BAR();
#else
            for (int prep = 0; prep < POST_REPS; ++prep) {
            {
                pg8::Gemm g{HB, (const bf16*)(wl + W_Q), M, NQP, 256, NINP}; pg8::StaticOrder S; S.init(M, NQP, G, (int)blockIdx.x);
                pg8::EpiScaleBf16 E{QA, NQP, ssqQ, 4, 1.0f / 256.0f, nullptr};
                pg8::gemm_phase<pg8::EpiScaleBf16, pg8::StaticOrder, true, true>(lds, g, S, E, wave0);
            }
            FRESH_TID();
            const float* kvn = ARG_IN(I_KVN) + l * 128;
            const float scaleB = 0.125f * LOG2E, scaleD = 0.17677669529663687f * LOG2E, scaleC = 0.125f * LOG2E;
            const int gw = blockIdx.x * NWAVES + wave, NGW = G * NWAVES;
#define UP8(w, f) do { f[0] = __uint_as_float((w)[0] << 16); f[1] = __uint_as_float((w)[0] & 0xffff0000u); f[2] = __uint_as_float((w)[1] << 16); f[3] = __uint_as_float((w)[1] & 0xffff0000u); \
                       f[4] = __uint_as_float((w)[2] << 16); f[5] = __uint_as_float((w)[2] & 0xffff0000u); f[6] = __uint_as_float((w)[3] << 16); f[7] = __uint_as_float((w)[3] & 0xffff0000u); } while (0)
#define PK8(f) ((v4u){cvtpk(f[0], f[1]), cvtpk(f[2], f[3]), cvtpk(f[4], f[5]), cvtpk(f[6], f[7])})
#define ST8F(p, f) do { *(f32x4*)(p) = (f32x4){f[0], f[1], f[2], f[3]}; *(f32x4*)((p) + 4) = (f32x4){f[4], f[5], f[6], f[7]}; } while (0)
            for (int row = gw; row < M; row += NGW) {
                const bf16* h = HB + (size_t)row * NINP;
                const bool smp = row >= MP; const int rr = smp ? row - MP : row;
                const int pidx = smp ? 2048 + (rr & 63) : (rr & 2047);
                float* o_mla = out + (smp ? O_MLA_S + ((size_t)l * MS + rr) * 160 : O_MLA_P + ((size_t)l * MP + rr) * 160);
                float* o_dsa = out + (smp ? O_DSA_S + ((size_t)l * MS + rr) * 192 : O_DSA_P + ((size_t)l * MP + rr) * 192);
                float* o_sb = out + (smp ? O_SB_S + ((size_t)l * MS + rr) * 512 : O_SB_P + ((size_t)l * MP + rr) * 512);
                float* o_df = out + (smp ? O_DIFF_S + ((size_t)l * MS + rr) * 512 : O_DIFF_P + ((size_t)l * MP + rr) * 512);
                bf16* ra = RA + (size_t)row * 160; bf16* rb = RB + (size_t)row * 192; bf16* rc = RC + (size_t)row * 512; bf16* rd = RD + (size_t)row * 512;
                if (lane < 56) { const int blk = lane >> 2, j = lane & 3;
                    const int base = blk < 4 ? H_QB + 64 * blk : (blk == 4 ? H_KB : (blk < 13 ? H_QI + 64 * (blk - 5) : H_KI));
                    const v4u w1 = *(const v4u*)(h + base + 8 * j), w2 = *(const v4u*)(h + base + 32 + 8 * j); float x1[8], x2[8], a[8], b[8]; UP8(w1, x1); UP8(w2, x2);
                    const f32x4* cp = (const f32x4*)(ROPE64 + pidx * 32 + 8 * j);
#pragma unroll
                    for (int e2 = 0; e2 < 4; ++e2) { const f32x4 cs = cp[e2];
                        a[2 * e2] = x1[2 * e2] * cs[0] - x2[2 * e2] * cs[1]; b[2 * e2] = x2[2 * e2] * cs[0] + x1[2 * e2] * cs[1];
                        a[2 * e2 + 1] = x1[2 * e2 + 1] * cs[2] - x2[2 * e2 + 1] * cs[3]; b[2 * e2 + 1] = x2[2 * e2 + 1] * cs[2] + x1[2 * e2 + 1] * cs[3]; }
                    if (blk < 4) {
#pragma unroll
                        for (int e = 0; e < 8; ++e) { a[e] *= scaleB; b[e] *= scaleB; }
                        bf16* d = QB + (size_t)row * 256 + 64 * blk + 8 * j; *(v4u*)d = PK8(a); *(v4u*)(d + 32) = PK8(b); }
                    else if (blk == 4) { ST8F(o_dsa + 8 * j, a); ST8F(o_dsa + 32 + 8 * j, b); *(v4u*)(rb + 8 * j) = PK8(a); *(v4u*)(rb + 32 + 8 * j) = PK8(b); }
                    else if (blk < 13) { bf16* d = QI + (size_t)row * 512 + 64 * (blk - 5) + 8 * j; *(v4u*)d = PK8(a); *(v4u*)(d + 32) = PK8(b); }
                    else { ST8F(o_dsa + 128 + 8 * j, a); ST8F(o_dsa + 160 + 8 * j, b); *(v4u*)(rb + 128 + 8 * j) = PK8(a); *(v4u*)(rb + 160 + 8 * j) = PK8(b); }
                }
                if (lane < 34) { const int blk = lane >> 1, j = lane & 1;
                    const int base = blk == 0 ? H_KR : (blk < 9 ? H_QD + 32 * (blk - 1) : H_KD + 32 * (blk - 9));
                    const v4u w1 = *(const v4u*)(h + base + 8 * j), w2 = *(const v4u*)(h + base + 16 + 8 * j); float x1[8], x2[8], a[8], b[8]; UP8(w1, x1); UP8(w2, x2);
                    const f32x4* cp = (const f32x4*)(ROPE32 + pidx * 16 + 8 * j);
#pragma unroll
                    for (int e2 = 0; e2 < 4; ++e2) { const f32x4 cs = cp[e2];
                        a[2 * e2] = x1[2 * e2] * cs[0] - x2[2 * e2] * cs[1]; b[2 * e2] = x2[2 * e2] * cs[0] + x1[2 * e2] * cs[1];
                        a[2 * e2 + 1] = x1[2 * e2 + 1] * cs[2] - x2[2 * e2 + 1] * cs[3]; b[2 * e2 + 1] = x2[2 * e2 + 1] * cs[2] + x1[2 * e2 + 1] * cs[3]; }
                    if (blk == 0) { ST8F(o_mla + 128 + 8 * j, a); ST8F(o_mla + 144 + 8 * j, b); *(v4u*)(ra + 128 + 8 * j) = PK8(a); *(v4u*)(ra + 144 + 8 * j) = PK8(b); }
                    else if (blk < 9) {
#pragma unroll
                        for (int e = 0; e < 8; ++e) { a[e] *= scaleD; b[e] *= scaleD; }
                        bf16* d = QD + (size_t)row * 256 + 32 * (blk - 1) + 8 * j; *(v4u*)d = PK8(a); *(v4u*)(d + 16) = PK8(b); }
                    else { const int bb = blk - 9, oc = (bb >> 1) * 128 + (bb & 1) * 32 + 8 * j; ST8F(o_df + oc, a); ST8F(o_df + oc + 16, b); *(v4u*)(rd + oc) = PK8(a); *(v4u*)(rd + oc + 16) = PK8(b); }
                }
                { const int c16 = lane & 15; float x[8] = {0.f, 0.f, 0.f, 0.f, 0.f, 0.f, 0.f, 0.f}; float ss = 0.f;
                  if (lane >= 48) { const v4u w = *(const v4u*)(h + H_CKV + 8 * c16); UP8(w, x);
#pragma unroll
                      for (int e = 0; e < 8; ++e) ss += x[e] * x[e]; }
                  ss += __shfl_xor(ss, 1); ss += __shfl_xor(ss, 2); ss += __shfl_xor(ss, 4); ss += __shfl_xor(ss, 8);
                  if (lane >= 48) { const float rs = 1.0f / sqrtf(ss * (1.0f / 128.0f) + EPS); const f32x4 g0 = *(const f32x4*)(kvn + 8 * c16), g1 = *(const f32x4*)(kvn + 8 * c16 + 4);
#pragma unroll
                      for (int e = 0; e < 4; ++e) { x[e] = x[e] * rs * g0[e]; x[4 + e] = x[4 + e] * rs * g1[e]; }
                      ST8F(o_mla + 8 * c16, x); *(v4u*)(ra + 8 * c16) = PK8(x); } }
#pragma unroll
                for (int r3 = 0; r3 < 3; ++r3) { const int t = lane + 64 * r3;
                    if (t < 137) { float x[8];
                        if (t < 8) { const v4u w = *(const v4u*)(h + H_VB + 8 * t); UP8(w, x); ST8F(o_dsa + 64 + 8 * t, x); *(v4u*)(rb + 64 + 8 * t) = w; }
                        else if (t < 40) { const int k = t - 8; const v4u w = *(const v4u*)(h + H_QC + 8 * k); UP8(w, x);
#pragma unroll
                            for (int e = 0; e < 8; ++e) x[e] *= scaleC;
                            *(v4u*)(QC + (size_t)row * 256 + 8 * k) = PK8(x); }
                        else if (t < 72) { const int k = t - 40, oc = (k >> 3) * 128 + 8 * (k & 7); const v4u w = *(const v4u*)(h + H_KC + 8 * k); UP8(w, x); ST8F(o_sb + oc, x); *(v4u*)(rc + oc) = w; }
                        else if (t < 104) { const int k = t - 72, oc = (k >> 3) * 128 + 64 + 8 * (k & 7); const v4u w = *(const v4u*)(h + H_VC + 8 * k); UP8(w, x); ST8F(o_sb + oc, x); *(v4u*)(rc + oc) = w; }
                        else if (t < 136) { const int k = t - 104, oc = (k >> 3) * 128 + 64 + 8 * (k & 7); const v4u w = *(const v4u*)(h + H_VD + 8 * k); UP8(w, x); ST8F(o_df + oc, x); *(v4u*)(rd + oc) = w; }
                        else { const v4u w = *(const v4u*)(h + H_WI); UP8(w, x);
#pragma unroll
                            for (int e = 0; e < 8; ++e) x[e] *= 0.35355339059327373f;
                            ST8F(WI + (size_t)row * 8, x); }
                    } }
            }
            }
#undef UP8
#undef PK8
#undef ST8F
            if (BOTH(pb + 3)) GRID_BAR();
#endif
        }
        if (EN_PH(5) && IN(pb + 4)) {
            GLB unsigned char* wsg_ = (GLB unsigned char*)args.ws; asm volatile("" : "+s"(wsg_)); unsigned char* ws = (unsigned char*)wsg_;
            LAS char* tile = (LAS char*)lds;
            volatile LAS unsigned* qslot = MISC + 16;
            const int myx = (int)(xb_xcc_id() & 7u);
            for (int rep = 0; rep < ATTN_REPS; ++rep) {
#define MIXER_IDS() FRESH_TID(); const int r32 = lane & 31, hi = lane >> 5, hd = wave & 3, qh = wave >> 2, q4 = (lane & 15) >> 2; (void)q4; int qx = myx
#define NEXT_UNIT(kind, out) do { __syncthreads(); if (tid == 0) { int res_ = -1, q_ = qx; gu32* heads_ = ctl + CW_Q + (((rep * 2 + l) * 4 + (kind)) * 8) * 64; \
        for (;;) { const unsigned got_ = __hip_atomic_fetch_add((unsigned*)(heads_ + q_ * 64), 1u, RLX_AGENT); if (got_ < (unsigned)QLIST) { res_ = (int)got_ + 256 * q_; break; } \
            unsigned hv_[8]; _Pragma("unroll") for (int s_ = 0; s_ < 8; ++s_) hv_[s_] = __hip_atomic_load((unsigned*)(heads_ + ((myx + s_) & 7) * 64), RLX_AGENT); \
            int pick_ = -1; _Pragma("unroll") for (int s_ = 7; s_ >= 0; --s_) if (hv_[s_] < (unsigned)QLIST) pick_ = s_; \
            if (pick_ < 0) break; q_ = (myx + pick_) & 7; } \
        qslot[0] = (unsigned)res_; } \
    __syncthreads(); { const int r_ = (int)qslot[0]; out = r_ < 0 ? -1 : (r_ & 255); qx = r_ < 0 ? qx : ((r_ >> 8) & 7); } } while (0)
#if EN_DSA
            if (rep == 0 || ((REP_MASK >> 1) & 1)) { MIXER_IDS();
            for (;;) {
                int uidx; NEXT_UNIT(1, uidx); if (uidx < 0) break;
                const UnitId u = decode_unit(qx, uidx);
                const float* cache_lb = ARG_IN(I_CDSA) + ((size_t)(l * NB + u.b) * PAST) * 192;
                const int myq = u.qrow0 + 32 * qh + r32;
                float* sc = (float*)(ws + WS_REGA + (size_t)blockIdx.x * DSA_SCR);
                unsigned long long* mk = (unsigned long long*)(ws + WS_REGA + (size_t)blockIdx.x * DSA_SCR + DSA_MASK_OFF);
                const bool sel = u.nt > 4;
                if (sel) {
                    {
                    float wq[8]; float smin = 3e38f, smax = -3e38f;
                    LAS unsigned* mmq = (LAS unsigned*)(lds + 110592);
                    if (tid < 64) { mmq[tid] = 0xFFFFFFFFu; mmq[64 + tid] = 0u; }
#pragma unroll
                    for (int hh = 0; hh < 8; ++hh) wq[hh] = WI[(size_t)myq * 8 + hh];
                    LAS char* ql_ = (LAS char*)lds + 20480;
                    { const int row0 = tid >> 6, cc = tid & 63;
#pragma unroll
                      for (int i = 0; i < 8; ++i) { const int row = row0 + 8 * i; *(LAS v4u*)(ql_ + row * T512_STRB + cc * 16) = *(const v4u*)(QI + (size_t)(u.qrow0 + row) * 512 + cc * 8); } }
                    const LAS char* qb_ = ql_ + (32 * qh + r32) * T512_STRB + 8 * hi * 2;
                    TileLd<64, 192, true, 128> ld; ld.init(); constexpr int STRB = TileLd<64, 192, true, 128>::STRB;
                    const int nt2 = (u.nt + 1) >> 1;
                    bool f32; const void* src = tile_src(u, 0, cache_lb, RB, 192, 128, f32);
                    ld.nrows_ = (u.nt >= 2) ? 128 : 64; ld.issue(src, f32, tid); ld.store(tile, f32, tid); __syncthreads();
                    const int kboffA = (32 * hd + r32) * STRB + 8 * hi * 2;
                    int cbA = 0;
                    for (int t2 = 0; t2 < nt2; ++t2) {
                        LAS char* curA = tile + cbA * 90112; LAS char* nxbA = tile + (cbA ^ 1) * 90112; cbA ^= 1;
                        const LAS char* kb = curA + kboffA;
                        const int rows_cur = (2 * t2 + 2 <= u.nt) ? 128 : 64;
                        bool f32n; { const int tn2 = (t2 + 1 < nt2) ? t2 + 1 : t2; const void* sn = tile_src(u, 2 * tn2, cache_lb, RB, 192, 128, f32n); ld.nrows_ = (2 * tn2 + 2 <= u.nt) ? 128 : 64; ld.issue(sn, f32n, tid); }
                        if (32 * hd < rows_cur) {
                            bf16x8 ka[4];
#pragma unroll
                            for (int s = 0; s < 4; ++s) ka[s] = *(const LAS bf16x8*)(kb + s * 32);
                            typedef float f32x2_t __attribute__((ext_vector_type(2)));
                            f32x2_t I2[8];
#pragma unroll
                            for (int r = 0; r < 8; ++r) I2[r] = (f32x2_t){0.f, 0.f};
                            bf16x8 qf[2][4];
#pragma unroll
                            for (int s = 0; s < 4; ++s) qf[0][s] = *(const LAS bf16x8*)(qb_ + s * 32);
#pragma unroll
                            for (int hh = 0; hh < 8; ++hh) { f32x16 p = zero16(); const f32x2_t w2 = {wq[hh], wq[hh]};
                                if (hh < 7) {
#pragma unroll
                                    for (int s = 0; s < 4; ++s) qf[(hh + 1) & 1][s] = *(const LAS bf16x8*)(qb_ + (hh + 1) * 128 + s * 32); }
                                __builtin_amdgcn_sched_barrier(0);
#pragma unroll
                                for (int s = 0; s < 4; ++s) p = MFMA32(ka[s], qf[hh & 1][s], p);
#pragma unroll
                                for (int r = 0; r < 8; ++r) { const f32x2_t rl = {__int_as_float(max(__float_as_int(p[2 * r]), 0)), __int_as_float(max(__float_as_int(p[2 * r + 1]), 0))};        I2[r] = w2 * rl + I2[r]; } }
                            f32x16 I;
#pragma unroll
                            for (int r = 0; r < 8; ++r) { I[2 * r] = I2[r].x; I[2 * r + 1] = I2[r].y; }
                            GLB float* scol = (GLB float*)sc + (size_t)(t2 * 128 + 32 * hd + 4 * hi) * 64 + 32 * qh + r32;
#pragma unroll
                            for (int r = 0; r < 16; ++r) { scol[(size_t)((r & 3) + 8 * (r >> 2)) * 64] = I[r]; smin = fminf(smin, I[r]); smax = fmaxf(smax, I[r]); }
                        }
                        ld.store(nxbA, f32n, tid);
                        __syncthreads();
                    }
                    { const unsigned bmn = __float_as_uint(smin), bmx = __float_as_uint(smax);
                      __hip_atomic_fetch_min(mmq + 32 * qh + r32, bmn ^ ((bmn >> 31) ? 0xFFFFFFFFu : 0x80000000u), __ATOMIC_RELAXED, __HIP_MEMORY_SCOPE_WORKGROUP);
                      __hip_atomic_fetch_max(mmq + 64 + 32 * qh + r32, bmx ^ ((bmx >> 31) ? 0xFFFFFFFFu : 0x80000000u), __ATOMIC_RELAXED, __HIP_MEMORY_SCOPE_WORKGROUP); }
                    }
                    VM_WAIT(); __syncthreads();
                    {
                    LAS unsigned* hist = (LAS unsigned*)lds;
                    LAS unsigned* part = (LAS unsigned*)(lds + 65536);
                    LAS float* qlo = (LAS float*)(lds + 67584); LAS float* qsc = qlo + 64; LAS int* qkk = (LAS int*)(qsc + 64); LAS unsigned* qT = (LAS unsigned*)(qkk + 64); LAS int* qwhole = (LAS int*)(qT + 64);
                    LAS int* qcn = qwhole + 64;
                    LAS unsigned long long* mkl = (LAS unsigned long long*)(lds + 69632);
                    LAS unsigned* cval = (LAS unsigned*)(lds + 106496);
                    LAS unsigned short* ckey = (LAS unsigned short*)(lds + 122880);
                    constexpr int CMAX = 64;
                    const int pq = tid & 63, ps = tid >> 6;
                    LAS unsigned* mmq = (LAS unsigned*)(lds + 110592);
                    if (tid < 64) { const unsigned a = mmq[tid], b = mmq[64 + tid];
                        const float lo_ = __uint_as_float((a & 0x80000000u) ? (a ^ 0x80000000u) : ~a), hi_ = __uint_as_float((b & 0x80000000u) ? (b ^ 0x80000000u) : ~b);
                        const float range = hi_ - lo_; qlo[tid] = lo_; qsc[tid] = (range > 1e-30f) ? 255.99f / range : 0.f; qcn[tid] = 0; }
#pragma unroll
                    for (int j = 0; j < 8; ++j) ((LAS v4u*)hist)[tid + 512 * j] = (v4u){0u, 0u, 0u, 0u};
                    __syncthreads();
                    const float lo_q = qlo[pq], sc_q = qsc[pq];
                    const GLB float* scq = (const GLB float*)sc + pq;
                    for (int t = ps; t < u.nt; t += 8) { const GLB float* sp = scq + (size_t)t * 4096;
                        { float xs[64];
#pragma unroll
                            for (int j = 0; j < 64; ++j) xs[j] = sp[j * 64];
#pragma unroll
                            for (int j = 0; j < 64; ++j) { const int b0 = min(255, (int)((xs[j] - lo_q) * sc_q)); __hip_atomic_fetch_add(hist + b0 * 64 + pq, 1u, __ATOMIC_RELAXED, __HIP_MEMORY_SCOPE_WORKGROUP); } } }
                    __syncthreads();
                    { unsigned sm = 0u;
#pragma unroll 8
                      for (int j = 0; j < 32; ++j) sm += hist[(32 * ps + j) * 64 + pq];
                      part[ps * 64 + pq] = sm; }
                    __syncthreads();
                    if (tid < 64) { const unsigned kk_ = 256u; unsigned acc = 0u; int sl_ = -1; unsigned abv = 0u;
#pragma unroll
                        for (int s2 = 7; s2 >= 0; --s2) { const unsigned c = part[s2 * 64 + tid]; const bool take = (sl_ < 0) && (acc + c >= kk_); if (take) { sl_ = s2; abv = acc; } acc += c; }
                        sl_ = sl_ < 0 ? 0 : sl_; unsigned acc2 = abv; int bsel = -1; unsigned abv2 = 0u, csel = 0u;
#pragma unroll 8
                        for (int j = 31; j >= 0; --j) { const unsigned c = hist[(32 * sl_ + j) * 64 + tid]; const bool take = (bsel < 0) && (acc2 + c >= kk_); if (take) { bsel = j; abv2 = acc2; csel = c; } acc2 += c; }
                        bsel = bsel < 0 ? 0 : bsel;
                        qT[tid] = (unsigned)(32 * sl_ + bsel); qkk[tid] = (int)(kk_ - abv2); qwhole[tid] = ((kk_ - abv2) == csel) ? 1 : 0; }
                    __syncthreads();
                    { const int T0 = (int)qT[pq]; const bool whole = qwhole[pq] != 0;
                      for (int t = ps; t < u.nt; t += 8) { const GLB float* sp = scq + (size_t)t * 4096; unsigned long long w = 0ull;
#pragma unroll 1
                        for (int k0 = 0; k0 < 64; k0 += 32) { float xs[32];
#pragma unroll
                            for (int j = 0; j < 32; ++j) xs[j] = sp[(k0 + j) * 64];
#pragma unroll
                            for (int j = 0; j < 32; ++j) { const int b0 = min(255, (int)((xs[j] - lo_q) * sc_q));
                                const bool selq = b0 > T0 || (whole && b0 == T0); w |= (unsigned long long)(selq ? 1u : 0u) << (k0 + j);
                                if (!whole && b0 == T0) { const int ix = __hip_atomic_fetch_add(qcn + pq, 1, __ATOMIC_RELAXED, __HIP_MEMORY_SCOPE_WORKGROUP);
                                    if (ix < CMAX) { const unsigned bts = __float_as_uint(xs[j]); cval[pq * CMAX + ix] = bts ^ ((bts >> 31) ? 0xFFFFFFFFu : 0x80000000u); ckey[pq * CMAX + ix] = (unsigned short)(t * 64 + k0 + j); } } } }
                        mkl[pq * 72 + t] = w; } }
                    __syncthreads();
                    if (!qwhole[pq]) { const int n = qcn[pq], kk_ = qkk[pq];
                        if (n <= CMAX) { for (int i = ps; i < n; i += 8) { const unsigned vi = cval[pq * CMAX + i]; const unsigned ki = ckey[pq * CMAX + i]; int rank = 0;
                                for (int j = 0; j < n; ++j) { const unsigned vj = cval[pq * CMAX + j]; const unsigned kj = ckey[pq * CMAX + j]; rank += (vj > vi || (vj == vi && kj < ki)) ? 1 : 0; }
                                if (rank < kk_) __hip_atomic_fetch_or((LAS unsigned*)mkl + (pq * 72 + (int)(ki >> 6)) * 2 + (int)((ki >> 5) & 1u), 1u << (ki & 31u), __ATOMIC_RELAXED, __HIP_MEMORY_SCOPE_WORKGROUP); } } }
                    __syncthreads();
                    if (wave == 0) { unsigned long long und = __ballot(!qwhole[lane] && qcn[lane] > CMAX);
                        while (und) { const int qf = (int)__builtin_ctzll(und); und &= und - 1ull;
                            if (u.sample) dsa_select<65, 1, 64>(sc + qf, u.nt, hist, (unsigned long long*)(mkl + qf * 72), lane); else dsa_select<32, 1, 64>(sc + qf, u.nt, hist, (unsigned long long*)(mkl + qf * 72), lane); } }
                    }
                    VM_WAIT(); __syncthreads();
                }
                bf16x8 q[4];
#pragma unroll
                for (int s = 0; s < 4; ++s) q[s] = *(const bf16x8*)(QB + (size_t)myq * 256 + hd * 64 + 16 * s + 8 * hi);
                f32x16 o[2]; o[0] = zero16(); o[1] = zero16(); float m_ = -1e30f, l_ = 0.f;
                TileLd<128, 192> ld; ld.init(); constexpr int STRB = TileLd<128, 192>::STRB;
                bool f32; const void* src = tile_src(u, 0, cache_lb, RB, 192, 0, f32);
                ld.issue(src, f32, tid); ld.store(tile, f32, tid); __syncthreads();
                const int kboff = r32 * STRB + 8 * hi * 2;
                const int vboff = (4 * hi + q4) * STRB + (64 + 16 * ((lane >> 4) & 1) + 4 * (lane & 3)) * 2;
                int cb = 0;
                for (int t = 0; t < u.nt; ++t) {
                    LAS char* cur = tile + cb * 24576; LAS char* nxb = tile + (cb ^ 1) * 24576; cb ^= 1;
                    const LAS char* kb = cur + kboff; const LAS char* vb = cur + vboff;
                    bool f32n; { const int tn = (t + 1 < u.nt) ? t + 1 : t; const void* sn = tile_src(u, tn, cache_lb, RB, 192, 0, f32n); ld.issue(sn, f32n, tid); }
                    unsigned long long mw = ~0ull; if (sel) mw = ((const LAS unsigned long long*)(lds + 69632))[(32 * qh + r32) * 72 + t];
                    const unsigned mlo = (unsigned)mw >> (4 * hi), mhi = (unsigned)(mw >> 32) >> (4 * hi);
                    f32x16 p0, p1; bf16x8 kf[8], vf[8];
                    k_ld<4>(kf, kb, STRB); __builtin_amdgcn_sched_barrier(0); qk_r<4>(p0, p1, kf, q); v_ld<2>(vf, vb, STRB); __builtin_amdgcn_sched_barrier(0);
#pragma unroll
                    for (int r = 0; r < 16; ++r) { const int bpos = (r & 3) + 8 * (r >> 2);
                        const unsigned s0 = (unsigned)__builtin_amdgcn_sbfe((int)mlo, bpos, 1), s1 = (unsigned)__builtin_amdgcn_sbfe((int)mhi, bpos, 1);
                        p0[r] = __uint_as_float((__float_as_uint(p0[r]) & s0) | (0xff61b1e6u & ~s0)); p1[r] = __uint_as_float((__float_as_uint(p1[r]) & s1) | (0xff61b1e6u & ~s1)); }
                    softmax_step<2>(p0, p1, m_, l_, o);
                    pv_r<2>(o, p0, p1, vf);
                    ld.store(nxb, f32n, tid);
                    __syncthreads();
                }
                l_ += __shfl_xor(l_, 32); const float inv = 1.0f / l_;
                bf16* orow = CC + (size_t)myq * KOUT + 512 + hd * 64;
#pragma unroll
                for (int db = 0; db < 2; ++db)
#pragma unroll
                    for (int gq = 0; gq < 4; ++gq) { v2u w; w.x = cvtpk(o[db][4 * gq] * inv, o[db][4 * gq + 1] * inv); w.y = cvtpk(o[db][4 * gq + 2] * inv, o[db][4 * gq + 3] * inv);
                        *(v2u*)(orow + 32 * db + 8 * gq + 4 * hi) = w; }
            }
            }
#endif
#if EN_DIFF
            if (rep == 0 || ((REP_MASK >> 3) & 1)) { MIXER_IDS();
            for (;;) {
                int uidx; NEXT_UNIT(3, uidx); if (uidx < 0) break;
                const UnitId u = decode_unit(qx, uidx);
                const float* cache_lb = ARG_IN(I_CDIFF) + ((size_t)(l * NB + u.b) * PAST) * 512;
                const int myq = u.qrow0 + 32 * qh + r32;
                bf16x8 qa[2], qb2[2];
#pragma unroll
                for (int s = 0; s < 2; ++s) { qa[s] = *(const bf16x8*)(QD + (size_t)myq * 256 + hd * 64 + 16 * s + 8 * hi); qb2[s] = *(const bf16x8*)(QD + (size_t)myq * 256 + hd * 64 + 32 + 16 * s + 8 * hi); }
                f32x16 o1[2], o2[2]; o1[0] = zero16(); o1[1] = zero16(); o2[0] = zero16(); o2[1] = zero16(); float m1 = -1e30f, l1 = 0.f, m2 = -1e30f, l2 = 0.f;
                constexpr int STRB = T512_STRB;
                { bool f32; const void* src = tile_src(u, 0, cache_lb, RD, 512, 0, f32);
                  if (f32) t512_cvt(src, tile, tid); else t512_dma(src, tile, wave, lane); VM_WAIT(); __syncthreads(); }
                const int kboff = r32 * STRB + (hd * 128 + 8 * hi) * 2;
                const int vboff = (4 * hi + q4) * STRB + (hd * 128 + 64 + 16 * ((lane >> 4) & 1) + 4 * (lane & 3)) * 2;
                int cb = 0;
                for (int t = 0; t < u.nt; ++t) {
                    LAS char* cur = tile + cb * T512_BYTES; LAS char* nxb = tile + (cb ^ 1) * T512_BYTES; cb ^= 1;
                    const LAS char* kb1 = cur + kboff; const LAS char* kb2 = kb1 + 64; const LAS char* vb = cur + vboff;
                    bool f32n = false; const void* sn = nullptr; if (t + 1 < u.nt) sn = tile_src(u, t + 1, cache_lb, RD, 512, 0, f32n);
#if DBG_VARIANTS
                    { f32x16 p0, p1; qk<2>(p0, p1, kb1, STRB, qa); float sx = 0.f; for (int r = 0; r < 16; ++r) { p0[r] = __builtin_amdgcn_exp2f(p0[r] - 8.f); p1[r] = __builtin_amdgcn_exp2f(p1[r] - 8.f); sx += p0[r] + p1[r]; } l1 += sx; pv<2>(o1, p0, p1, vb, STRB); }
                    { f32x16 p0, p1; qk<2>(p0, p1, kb2, STRB, qb2); float sx = 0.f; for (int r = 0; r < 16; ++r) { p0[r] = __builtin_amdgcn_exp2f(p0[r] - 8.f); p1[r] = __builtin_amdgcn_exp2f(p1[r] - 8.f); sx += p0[r] + p1[r]; } l2 += sx; pv<2>(o2, p0, p1, vb, STRB); }
#else
                    { bf16x8 kA[4], kB[4], vf[8]; f32x16 pa0, pa1, pb0, pb1;
                      k_ld<2>(kA, kb1, STRB); k_ld<2>(kB, kb2, STRB); __builtin_amdgcn_sched_barrier(0);
                      qk_r<2>(pa0, pa1, kA, qa); qk_r<2>(pb0, pb1, kB, qb2); v_ld<2>(vf, vb, STRB); __builtin_amdgcn_sched_barrier(0);
                      if (t + 1 < u.nt && !f32n) t512_dma(sn, nxb, wave, lane);
                      __builtin_amdgcn_sched_barrier(0);
                      softmax_step<2>(pa0, pa1, m1, l1, o1); pv_r<2>(o1, pa0, pa1, vf);
                      softmax_step<2>(pb0, pb1, m2, l2, o2); pv_r<2>(o2, pb0, pb1, vf); }
#endif
                    if (t + 1 < u.nt && f32n) t512_cvt(sn, nxb, tid);
                    VM_WAIT(); __syncthreads();
                }
                l1 += __shfl_xor(l1, 32); l2 += __shfl_xor(l2, 32);
                const float i1 = 1.0f / l1, i2 = LAMF[l] / l2; float ss = 0.f;
#pragma unroll
                for (int db = 0; db < 2; ++db)
#pragma unroll
                    for (int r = 0; r < 16; ++r) { const float v = o1[db][r] * i1 - o2[db][r] * i2; o1[db][r] = v; ss += v * v; }
                ss += __shfl_xor(ss, 32);
                const float lam_init = 0.8f - 0.6f * expf(-0.3f * (float)l);
                const float rs = (1.0f - lam_init) / sqrtf(ss * (1.0f / 64.0f) + EPS);
                const float* dn = ARG_IN(I_DN) + l * 64;
                bf16* orow = CC + (size_t)myq * KOUT + 1024 + hd * 64;
#pragma unroll
                for (int db = 0; db < 2; ++db)
#pragma unroll
                    for (int gq = 0; gq < 4; ++gq) { const f32x4 dv = *(const f32x4*)(dn + 32 * db + 8 * gq + 4 * hi);
                        v2u w; w.x = cvtpk(o1[db][4 * gq] * rs * dv[0], o1[db][4 * gq + 1] * rs * dv[1]); w.y = cvtpk(o1[db][4 * gq + 2] * rs * dv[2], o1[db][4 * gq + 3] * rs * dv[3]);
                        *(v2u*)(orow + 32 * db + 8 * gq + 4 * hi) = w; }
            }
            }
#endif
#if EN_MLA
            if (rep == 0 || ((REP_MASK >> 0) & 1)) { MIXER_IDS();
            for (;;) {
                int uidx; NEXT_UNIT(0, uidx); if (uidx < 0) break;
                const UnitId u = decode_unit(qx, uidx);
                const float* cache_lb = ARG_IN(I_CMLA) + ((size_t)(l * NB + u.b) * PAST) * 160;
                const int myq = u.qrow0 + 32 * qh + r32;
                bf16x8 q[10];
#pragma unroll
                for (int s = 0; s < 10; ++s) q[s] = *(const bf16x8*)(QA + (size_t)myq * NQP + hd * 160 + 16 * s + 8 * hi);
                {
                    const int pidx = u.sample ? 2048 + 32 * qh + r32 : u.c * 64 + 32 * qh + r32;
                    bf16x8 a = q[8], b = q[9];
#pragma unroll
                    for (int j = 0; j < 8; ++j) { const float2 cs = ROPE32[pidx * 16 + 8 * hi + j]; const float x1 = bf2f((bf16)a[j]), x2 = bf2f((bf16)b[j]);
                        a[j] = (short)f2bf(x1 * cs.x - x2 * cs.y); b[j] = (short)f2bf(x2 * cs.x + x1 * cs.y); }
                    q[8] = a; q[9] = b;
                }
                f32x16 o[4]; o[0] = zero16(); o[1] = zero16(); o[2] = zero16(); o[3] = zero16(); float m_ = -1e30f, l_ = 0.f;
                TileLd<160, 160> ld; ld.init(); constexpr int STRB = TileLd<160, 160>::STRB;
                bool f32; const void* src = tile_src(u, 0, cache_lb, RA, 160, 0, f32);
                ld.issue(src, f32, tid); ld.store(tile, f32, tid); __syncthreads();
                const int kboff = r32 * STRB + 8 * hi * 2;
                const int vboff = (4 * hi + q4) * STRB + (16 * ((lane >> 4) & 1) + 4 * (lane & 3)) * 2;
                int cb = 0;
                for (int t = 0; t < u.nt; ++t) {
                    LAS char* cur = tile + cb * 24576; LAS char* nxb = tile + (cb ^ 1) * 24576; cb ^= 1;
                    const LAS char* kb = cur + kboff; const LAS char* vb = cur + vboff;
                    bool f32n; { const int tn = (t + 1 < u.nt) ? t + 1 : t; const void* sn = tile_src(u, tn, cache_lb, RA, 160, 0, f32n); ld.issue(sn, f32n, tid); }
                    f32x16 p0, p1; qk<10>(p0, p1, kb, STRB, q);
#if DBG_VARIANTS
                    { for (int r = 0; r < 16; ++r) { p0[r] = p0[r] * 0.f + 1.f; p1[r] = p1[r] * 0.f + 1.f; } l_ += 32.f; }
#else
                    softmax_step<4>(p0, p1, m_, l_, o);
#endif
                    pv<4>(o, p0, p1, vb, STRB);
                    ld.store(nxb, f32n, tid);
                    __syncthreads();
                }
                l_ += __shfl_xor(l_, 32); const float inv = 1.0f / l_;
                bf16* orow = CC + (size_t)myq * KOUT + hd * 128;
#pragma unroll
                for (int db = 0; db < 4; ++db)
#pragma unroll
                    for (int gq = 0; gq < 4; ++gq) { v2u w; w.x = cvtpk(o[db][4 * gq] * inv, o[db][4 * gq + 1] * inv); w.y = cvtpk(o[db][4 * gq + 2] * inv, o[db][4 * gq + 3] * inv);
                        *(v2u*)(orow + 32 * db + 8 * gq + 4 * hi) = w; }
            }
            }
#endif
#if EN_SB
            if (rep == 0 || ((REP_MASK >> 2) & 1)) { MIXER_IDS();
            for (;;) {
                int uidx; NEXT_UNIT(2, uidx); if (uidx < 0) break;
                const UnitId u = decode_unit(qx, uidx);
                const float* cache_lb = ARG_IN(I_CSB) + ((size_t)(l * NB + u.b) * PAST) * 512;
                const int myq = u.qrow0 + 32 * qh + r32, qloc = 32 * qh + r32;
                bf16x8 q[4];
#pragma unroll
                for (int s = 0; s < 4; ++s) q[s] = *(const bf16x8*)(QC + (size_t)myq * 256 + hd * 64 + 16 * s + 8 * hi);
                f32x16 o[2]; o[0] = zero16(); o[1] = zero16(); float carry = 1.0f; int it3 = 0;
                constexpr int STRB = T512_STRB;
                { bool f32; const void* src = tile_src(u, u.nt - 1, cache_lb, RC, 512, 0, f32);
                  if (f32) t512_cvt(src, tile, tid); else t512_dma(src, tile, wave, lane); VM_WAIT(); __syncthreads(); }
                const int kboff = r32 * STRB + (hd * 128 + 8 * hi) * 2;
                const int vboff = (4 * hi + q4) * STRB + (hd * 128 + 64 + 16 * ((lane >> 4) & 1) + 4 * (lane & 3)) * 2;
                volatile LAS unsigned* sbflag = MISC + 20;
                if (tid == 0) { sbflag[0] = 0u; sbflag[1] = 0u; sbflag[2] = 0u; }
                __syncthreads();
                int cb = 0;
                for (int t = u.nt - 1; t >= 0; --t) {
                    LAS char* cur = tile + cb * T512_BYTES; LAS char* nxb = tile + (cb ^ 1) * T512_BYTES; cb ^= 1;
                    const LAS char* kb = cur + kboff; const LAS char* vb = cur + vboff;
                    bool f32n = false; const void* sn = nullptr; if (t > 0) { sn = tile_src(u, t - 1, cache_lb, RC, 512, 0, f32n); if (!f32n) t512_dma(sn, nxb, wave, lane); }
                    const bool diag = (t == u.nt - 1);
                    f32x16 z0, z1; qk<4>(z0, z1, kb, STRB, q);
                    f32x16 u0, u1; float gs[8];
#pragma unroll
                    for (int r = 0; r < 16; ++r) {
                        const int key = crow(r, hi);
                        { const float e = __builtin_amdgcn_exp2f(fminf(z0[r], 80.f)); const float uu = __builtin_amdgcn_rcpf(1.0f + e); const bool ok = !diag || (key < qloc); u0[r] = ok ? uu : 1.0f; z0[r] = ok ? e * uu : 0.f; }
                        { const float e = __builtin_amdgcn_exp2f(fminf(z1[r], 80.f)); const float uu = __builtin_amdgcn_rcpf(1.0f + e); const bool ok = !diag || (key + 32 < qloc); u1[r] = ok ? uu : 1.0f; z1[r] = ok ? e * uu : 0.f; }
                    }
#pragma unroll
                    for (int g4 = 0; g4 < 4; ++g4) { gs[g4] = (u0[4 * g4] * u0[4 * g4 + 1]) * (u0[4 * g4 + 2] * u0[4 * g4 + 3]); gs[4 + g4] = (u1[4 * g4] * u1[4 * g4 + 1]) * (u1[4 * g4 + 2] * u1[4 * g4 + 3]); }
                    float pg[8];
#pragma unroll
                    for (int g8 = 0; g8 < 8; ++g8) pg[g8] = __shfl_xor(gs[g8], 32);
                    float run = carry;
#pragma unroll
                    for (int g8 = 7; g8 >= 0; --g8) {
                        float P = run * (hi == 0 ? pg[g8] : 1.0f);
                        if (g8 >= 4) { const int b4 = 4 * (g8 - 4);
                            z1[b4 + 3] *= P; P *= u1[b4 + 3]; z1[b4 + 2] *= P; P *= u1[b4 + 2]; z1[b4 + 1] *= P; P *= u1[b4 + 1]; z1[b4] *= P;
                        } else { const int b4 = 4 * g8;
                            z0[b4 + 3] *= P; P *= u0[b4 + 3]; z0[b4 + 2] *= P; P *= u0[b4 + 2]; z0[b4 + 1] *= P; P *= u0[b4 + 1]; z0[b4] *= P;
                        }
                        run *= gs[g8] * pg[g8];
                    }
                    carry = run;
                    pv<2>(o, z0, z1, vb, STRB);
                    if (t > 0 && f32n) t512_cvt(sn, nxb, tid);
                    if (tid == 0) sbflag[(it3 + 1) % 3] = 0u;
                    if (__any(carry != 0.f) && lane == 0) sbflag[it3] = 1u;
                    VM_WAIT(); __syncthreads();
                    const bool alive = sbflag[it3] != 0u; it3 = (it3 + 1) % 3;
                    if (!alive) break;
                }
                bf16* orow = CC + (size_t)myq * KOUT + 768 + hd * 64;
#pragma unroll
                for (int db = 0; db < 2; ++db)
#pragma unroll
                    for (int gq = 0; gq < 4; ++gq) { v2u w; w.x = cvtpk(o[db][4 * gq], o[db][4 * gq + 1]); w.y = cvtpk(o[db][4 * gq + 2], o[db][4 * gq + 3]);
                        *(v2u*)(orow + 32 * db + 8 * gq + 4 * hi) = w; }
            }
            }
#endif
            }
            if (BOTH(pb + 4)) GRID_BAR();
        }
        if (EN_PH(6) && IN(pb + 5)) {
            pg8::Gemm g{CC, (const bf16*)(wl + W_OUT), M, DM, KOUT, KOUT}; pg8::StaticOrder S; S.init(M, DM, G, (int)blockIdx.x);
            pg8::EpiResid<false> E{nullptr, nullptr, XB, ssqC, 1.0f};
            pg8::gemm_phase<pg8::EpiResid<false>, pg8::StaticOrder, true, true>(lds, g, S, E, wave0);
            if (BOTH(pb + 5)) GRID_BAR();
        }
        if (EN_PH(7) && IN(pb + 6)) {
            pg8::Gemm g{XB, (const bf16*)(wl + W_GU2), M, NGU, DM, DM}; pg8::StaticOrder S; S.init(M, NGU, G, (int)blockIdx.x);
            pg8::EpiSwiGLU E{ACT, ssqC};
            for (int grep = 0; grep < GU_REPS; ++grep)
            pg8::gemm_phase<pg8::EpiSwiGLU, pg8::StaticOrder, true, true>(lds, g, S, E, wave0);
            if (BOTH(pb + 6)) GRID_BAR();
        }
        if (EN_PH(8) && IN(pb + 7)) {
            pg8::Gemm g{ACT, (const bf16*)(wl + W_D2), M, DM, DFF, DFF}; pg8::StaticOrder S; S.init(MP, DM, G, (int)blockIdx.x);
            pg8::EpiResid<false> E{nullptr, nullptr, XB, ssqAn, 0.5f};
            pg8::gemm_phase<pg8::EpiResid<false>, pg8::StaticOrder, true, true>(lds, g, S, E, wave0);
            SPLITK_SAMPLE(W_D2);
            GRID_BAR();
            { FRESH_TID(); const int un_ = (int)blockIdx.x >> 3, j_ = (int)blockIdx.x & 7; const float* Pu = (const float*)(ws + WS_QA) + (size_t)un_ * 8 * 32 * 512 * 4;
              pg8::resid_fixup<false>(Pu, MP / 256 + (un_ >> 2), un_ & 3, j_ >> 2, j_ & 3, nullptr, XB, ssqAn, 0.5f, tid); }
            if (BOTH(pb + 7)) GRID_BAR();
        }
    }
    if (EN_PH(9) && IN(17)) {
        FRESH_TID();
        const float* fn = ARG_IN(I_FN); const float* ssqF = SSQP + (size_t)2 * M * 16;
        const int gw = blockIdx.x * NWAVES + wave, NGW = G * NWAVES;
        for (int m = gw; m < M; m += NGW) {
            const float rs = 1.0f / sqrtf(ssq_sum16(ssqF, m) * (1.0f / 1024.0f) + EPS);
            const v2u* x2 = (const v2u*)(XB + (size_t)m * DM) + lane; f32x4* y4 = (f32x4*)(X + (size_t)m * DM) + lane; const f32x4* g4 = (const f32x4*)fn + lane;
#pragma unroll
            for (int j = 0; j < 4; ++j) { const v2u w = x2[64 * j]; const f32x4 gg = g4[64 * j];
                const f32x4 v = (f32x4){__uint_as_float(w.x << 16), __uint_as_float(w.x & 0xffff0000u), __uint_as_float(w.y << 16), __uint_as_float(w.y & 0xffff0000u)};
                y4[64 * j] = v * rs * gg; }
        }
    }
#undef IN
#undef BOTH
#undef GRID_BAR
#undef X
#undef XB
#undef HB
#undef ACT
#undef QA
#undef QB
#undef QI
#undef QC
#undef QD
#undef WI
#undef RA
#undef RB
#undef RC
#undef RD
#undef CC
#undef CQ
#undef CKV
#undef SSQP
#undef LAMF
#undef ROPE64
#undef ROPE32
}


#if SELFCHECK
constexpr size_t WS_CHK = 3 * MiB + 768 * 1024;
__device__ __forceinline__ unsigned hsh(unsigned x) { x ^= x >> 16; x *= 0x7feb352du; x ^= x >> 15; x *= 0x846ca68bu; x ^= x >> 16; return x; }
__device__ __forceinline__ void chk_rep(unsigned* slot, float got, float ex, float atol, float rtol) {
    float e = fabsf(got - ex) / (atol + rtol * fabsf(ex)); if (!(e == e)) e = 1e30f; atomicMax(slot, __float_as_uint(e)); }
__device__ __forceinline__ float bfr(float x) { return bf2f((bf16)f2bf(x)); }
__device__ __forceinline__ int nat_col(int np) { return np < 1376 ? np : (np < 2912 ? np + 8 : (np < 2920 ? 1376 + (np - 2912) : -1)); }
struct Ptrs { float* X; bf16 *XB, *HB, *ACT, *QA, *QB, *QI, *QC, *QD, *RA, *RB, *RC, *RD, *CC; float* WI; float* SSQ; float* LAMF; float2 *R64, *R32; unsigned* chk; float* save; unsigned char* wl; };
__device__ __forceinline__ Ptrs mkptrs(const Args& a, int l) { Ptrs p; unsigned char* ws = a.ws;
    p.X = a.out; p.XB = (bf16*)(ws + WS_XB); p.HB = (bf16*)(ws + WS_REGA); p.ACT = p.HB; p.QA = (bf16*)(ws + WS_QA); p.QB = (bf16*)(ws + WS_QB); p.QI = (bf16*)(ws + WS_QI); p.QC = (bf16*)(ws + WS_QC); p.QD = (bf16*)(ws + WS_QD);
    p.RA = (bf16*)(ws + WS_RA); p.RB = (bf16*)(ws + WS_RB); p.RC = (bf16*)(ws + WS_RC); p.RD = (bf16*)(ws + WS_RD); p.CC = (bf16*)(ws + WS_CC); p.WI = (float*)(ws + WS_WI); p.SSQ = (float*)(ws + WS_SSQ);
    p.LAMF = (float*)(ws + WS_MISC); p.R64 = (float2*)(ws + WS_MISC + MISC_ROPE64); p.R32 = (float2*)(ws + WS_MISC + MISC_ROPE32); p.chk = (unsigned*)(ws + WS_CHK); p.save = (float*)(ws + WS_CHK + 256); p.wl = ws + WS_W + (size_t)l * W_LAYER; return p; }
__device__ __forceinline__ int samp_row(unsigned h) { const unsigned r = h % 4096u; return r < 3584u ? (int)(hsh(h) % (unsigned)MP) : MP + (int)(hsh(h) % (unsigned)MS); }

__global__ void __launch_bounds__(256) check_kernel(Args a, int l, int which) {
    const Ptrs p = mkptrs(a, l); const int gt = blockIdx.x * 256 + threadIdx.x, NT = gridDim.x * 256; const int lane = threadIdx.x & 63; const int gwv = gt >> 6, NW = NT >> 6;
    const float* ssqA = p.SSQ + (size_t)l * M; const float* ssqB = p.SSQ + (size_t)(3 + l) * M; const float* ssqC = p.SSQ + (size_t)(5 + l) * M; const float* ssqQ = p.SSQ + (size_t)(7 + l) * M;
    if (which == 0) {
        for (int i = gt; i < 16384; i += NT) { const unsigned h = hsh(i * 3 + 1);
            { const int np = h % NGU, k = hsh(h) % DM, pn = np >> 8, c = np & 255, f = pn * 128 + (c & 127); const float* src = (c < 128 ? a.in[I_G1] : a.in[I_U1]) + (size_t)l * DM * DFF;
              chk_rep(p.chk + 0, bf2f(((bf16*)(p.wl + W_GU1))[(size_t)np * DM + k]), bfr(src[(size_t)k * DFF + f] * a.in[I_N1][l * DM + k]), 1e-6f, 1e-3f); }
            { const int n = h % DM, k = hsh(h + 7) % DFF; chk_rep(p.chk + 1, bf2f(((bf16*)(p.wl + W_D1))[(size_t)n * DFF + k]), bfr(a.in[I_D1][(size_t)l * DFF * DM + (size_t)k * DM + n]), 1e-6f, 1e-3f); }
            { const int np = h % NINP, k = hsh(h + 9) % DM, j = nat_col(np); const float ex = j < 0 ? 0.f : bfr(a.in[I_WIN][(size_t)l * DM * NIN + (size_t)k * NIN + j] * a.in[I_NM][l * DM + k]);
              chk_rep(p.chk + 2, bf2f(((bf16*)(p.wl + W_IN))[(size_t)np * DM + k]), ex, 1e-6f, 1e-3f); }
            if (l == 0) { const int row = samp_row(h), c = hsh(h + 11) % DM; const float xv = row < MP ? a.in[I_XP][(size_t)row * DM + c] : a.in[I_XS][(size_t)(row - MP) * DM + c];
              chk_rep(p.chk + 3, bf2f(p.XB[(size_t)row * DM + c]), bfr(xv), 1e-6f, 1e-3f); }
        }
        if (l == 0) for (int i = gwv; i < 256; i += NW) { const int row = samp_row(hsh(i + 77)); const float* xr = row < MP ? a.in[I_XP] + (size_t)row * DM : a.in[I_XS] + (size_t)(row - MP) * DM;
            float s = 0.f; for (int c = lane; c < DM; c += 64) s += xr[c] * xr[c]; s = wave_sum(s); if (lane == 0) chk_rep(p.chk + 3, ssqA[row], s, 1e-3f, 1e-3f); }
    }
    if (which == 1) {
        for (int i = gt; i < 8192; i += NT) { const unsigned h = hsh(i * 5 + 2); const int row = samp_row(h), f = hsh(h + 1) % DFF; const bf16* wg = (bf16*)(p.wl + W_GU1) + (size_t)((f >> 7) * 256 + (f & 127)) * DM; const bf16* wu = wg + (size_t)128 * DM;
            const float* ssq = ssqA; float g = 0.f, u = 0.f; for (int k = 0; k < DM; ++k) { const float xv = bf2f(p.XB[(size_t)row * DM + k]); g += xv * bf2f(wg[k]); u += xv * bf2f(wu[k]); }
            const float rs = 1.0f / sqrtf(ssq[row] / 1024.f + EPS); g *= rs; u *= rs; const float ex = g / (1.f + expf(-g)) * u;
            chk_rep(p.chk + 4, bf2f(p.ACT[(size_t)row * DFF + f]), ex, 0.01f, 0.02f); }
    }
    if (which == 2) {
        for (int i = gt; i < 8192; i += NT) { const unsigned h = hsh(i * 7 + 3); const int row = samp_row(h), c = hsh(h + 1) % DM; const bf16* wd = (bf16*)(p.wl + W_D1) + (size_t)c * DFF;
            float s = 0.f; for (int k = 0; k < DFF; ++k) s += bf2f(p.ACT[(size_t)row * DFF + k]) * bf2f(wd[k]);
            const float xin = l == 0 ? (row < MP ? a.in[I_XP][(size_t)row * DM + c] : a.in[I_XS][(size_t)(row - MP) * DM + c]) : 0.f;
            if (l == 0) chk_rep(p.chk + 5, p.X[(size_t)row * DM + c], xin + 0.5f * s, 0.01f, 0.005f);
            chk_rep(p.chk + 5, bf2f(p.XB[(size_t)row * DM + c]), bfr(p.X[(size_t)row * DM + c]), 1e-6f, 1e-3f); }
        for (int i = gwv; i < 256; i += NW) { const int row = samp_row(hsh(i + 177)); float s = 0.f; for (int c = lane; c < DM; c += 64) { const float v = p.X[(size_t)row * DM + c]; s += v * v; } s = wave_sum(s);
            if (lane == 0) chk_rep(p.chk + 5, ssqB[row], s, 1e-3f, 1e-3f); }
    }
    if (which == 3) {
        for (int i = gt; i < 8192; i += NT) { const unsigned h = hsh(i * 11 + 4); const int row = samp_row(h), np = hsh(h + 1) % NINP; const bf16* w = (bf16*)(p.wl + W_IN) + (size_t)np * DM;
            float s = 0.f; for (int k = 0; k < DM; ++k) s += bf2f(p.XB[(size_t)row * DM + k]) * bf2f(w[k]); s *= 1.0f / sqrtf(ssqB[row] / 1024.f + EPS);
            chk_rep(p.chk + 6, bf2f(p.HB[(size_t)row * NINP + np]), s, 0.01f, 0.01f); }
        for (int i = gwv; i < 256; i += NW) { const int row = samp_row(hsh(i + 277)); float s = 0.f; for (int c = lane; c < 256; c += 64) { const float v = bf2f(p.HB[(size_t)row * NINP + c]); s += v * v; } s = wave_sum(s);
            if (lane == 0) chk_rep(p.chk + 6, ssqQ[row], s, 0.05f, 0.01f); }
    }
    if (which == 4) {
        const float* wqb = a.in[I_WQB] + (size_t)l * 256 * 384; const float* wkvb = a.in[I_WKVB] + (size_t)l * 128 * 512; const float* qn = a.in[I_QN] + l * 256;
        for (int i = gt; i < 2048; i += NT) { const unsigned h = hsh(i * 13 + 5); const int row = samp_row(h), hh = (hsh(h + 1) >> 3) & 3, c = hsh(h + 2) % 160; const bf16* hr = p.HB + (size_t)row * NINP;
            const float rs = 1.0f / sqrtf(ssqQ[row] / 256.f + EPS); float ex;
            if (c < 128) { float acc = 0.f; for (int e = 0; e < 64; ++e) { float qe = 0.f; for (int k = 0; k < 256; ++k) qe += bf2f(hr[k]) * rs * qn[k] * wqb[(size_t)k * 384 + hh * 96 + e]; acc += qe * wkvb[(size_t)c * 512 + hh * 128 + e]; } ex = acc; }
            else { float qe = 0.f; for (int k = 0; k < 256; ++k) qe += bf2f(hr[k]) * rs * qn[k] * wqb[(size_t)k * 384 + hh * 96 + 64 + (c - 128)]; ex = qe; }
            ex *= 0.10206207261596575f * LOG2E;
            chk_rep(p.chk + 7, bf2f(p.QA[(size_t)row * NQP + hh * 160 + c]), ex, 0.01f, 0.02f); }
        for (int i = gt; i < 16384; i += NT) { const unsigned h = hsh(i * 17 + 6); const int row = samp_row(h); const bool smp = row >= MP; const int rr = smp ? row - MP : row; const float pos = smp ? 4096.f + (rr & 63) : (float)(rr & 2047);
            const bf16* hr = p.HB + (size_t)row * NINP;
            const float* o_mla = a.out + (smp ? O_MLA_S + ((size_t)l * MS + rr) * 160 : O_MLA_P + ((size_t)l * MP + rr) * 160);
            const float* o_dsa = a.out + (smp ? O_DSA_S + ((size_t)l * MS + rr) * 192 : O_DSA_P + ((size_t)l * MP + rr) * 192);
            const float* o_sb = a.out + (smp ? O_SB_S + ((size_t)l * MS + rr) * 512 : O_SB_P + ((size_t)l * MP + rr) * 512);
            const float* o_df = a.out + (smp ? O_DIFF_S + ((size_t)l * MS + rr) * 512 : O_DIFF_P + ((size_t)l * MP + rr) * 512);
#define HN(j) bf2f(hr[(j) < 1376 ? (j) : ((j) < 1384 ? H_WI + ((j) - 1376) : (j) - 8)])
#define ROPE(base, d, idx, res) do { const int hf = (d) / 2, ii = (idx) % hf; const float fr = (d) == 64 ? a.freq64[ii] : a.freq32[ii]; float sn, cs; sincos_acc(pos * fr, sn, cs); \
            const float x1 = HN((base) + ii), x2 = HN((base) + hf + ii); res = (idx) < hf ? x1 * cs - x2 * sn : x2 * cs + x1 * sn; } while (0)
            const int sel = hsh(h + 3) % 12; const unsigned e = hsh(h + 4);
            if (sel == 0) { const int c = e % 128; float ss = 0.f; for (int k = 0; k < 128; ++k) { const float v = HN(256 + k); ss += v * v; } const float ex = HN(256 + c) / sqrtf(ss / 128.f + EPS) * a.in[I_KVN][l * 128 + c];
                chk_rep(p.chk + 8, o_mla[c], ex, 0.01f, 0.01f); chk_rep(p.chk + 8, bf2f(p.RA[(size_t)row * 160 + c]), ex, 0.01f, 0.01f); }
            if (sel == 1) { const int c = e % 32; float ex; ROPE(384, 32, c, ex); chk_rep(p.chk + 8, o_mla[128 + c], ex, 0.01f, 0.01f); chk_rep(p.chk + 8, bf2f(p.RA[(size_t)row * 160 + 128 + c]), ex, 0.01f, 0.01f); }
            if (sel == 2) { const int c = e % 256, hd = c >> 6; float ex; ROPE(416 + hd * 64, 64, c & 63, ex); chk_rep(p.chk + 8, bf2f(p.QB[(size_t)row * 256 + c]), ex * 0.125f * LOG2E, 0.01f, 0.01f); }
            if (sel == 3) { const int c = e % 64; float ex; ROPE(672, 64, c, ex); chk_rep(p.chk + 8, o_dsa[c], ex, 0.01f, 0.01f); chk_rep(p.chk + 8, bf2f(p.RB[(size_t)row * 192 + c]), ex, 0.01f, 0.01f);
                            const float v = HN(736 + c); chk_rep(p.chk + 8, o_dsa[64 + c], v, 0.01f, 0.01f); chk_rep(p.chk + 8, bf2f(p.RB[(size_t)row * 192 + 64 + c]), v, 0.01f, 0.01f); }
            if (sel == 4) { const int c = e % 512, hd = c >> 6; float ex; ROPE(800 + hd * 64, 64, c & 63, ex); chk_rep(p.chk + 8, bf2f(p.QI[(size_t)row * 512 + c]), ex, 0.01f, 0.01f); }
            if (sel == 5) { const int c = e % 64; float ex; ROPE(1312, 64, c, ex); chk_rep(p.chk + 8, o_dsa[128 + c], ex, 0.01f, 0.01f); chk_rep(p.chk + 8, bf2f(p.RB[(size_t)row * 192 + 128 + c]), ex, 0.01f, 0.01f);
                            const int w8 = e % 8; chk_rep(p.chk + 8, p.WI[(size_t)row * 8 + w8], HN(1376 + w8) * 0.35355339f, 0.005f, 0.01f); }
            if (sel == 6) { const int c = e % 256, hd = c >> 6, d = c & 63; chk_rep(p.chk + 8, bf2f(p.QC[(size_t)row * 256 + c]), HN(1384 + c) * 0.125f, 0.005f, 0.01f);
                            chk_rep(p.chk + 8, o_sb[hd * 128 + d], HN(1640 + c), 0.01f, 0.01f); chk_rep(p.chk + 8, o_sb[hd * 128 + 64 + d], HN(1896 + c), 0.01f, 0.01f);
                            chk_rep(p.chk + 8, bf2f(p.RC[(size_t)row * 512 + hd * 128 + d]), HN(1640 + c), 0.01f, 0.01f); chk_rep(p.chk + 8, bf2f(p.RC[(size_t)row * 512 + hd * 128 + 64 + d]), HN(1896 + c), 0.01f, 0.01f); }
            if (sel == 7) { const int c = e % 256, blk = c >> 5; float ex; ROPE(2152 + blk * 32, 32, c & 31, ex); chk_rep(p.chk + 8, bf2f(p.QD[(size_t)row * 256 + c]), ex * 0.17677669529663687f * LOG2E, 0.01f, 0.01f); }
            if (sel == 8) { const int c = e % 256, blk = c >> 5, hd = c >> 6; float ex; ROPE(2408 + blk * 32, 32, c & 31, ex); chk_rep(p.chk + 8, o_df[hd * 128 + (c & 63)], ex, 0.01f, 0.01f); chk_rep(p.chk + 8, bf2f(p.RD[(size_t)row * 512 + hd * 128 + (c & 63)]), ex, 0.01f, 0.01f); }
            if (sel == 9) { const int c = e % 256, hd = c >> 6, d = c & 63; chk_rep(p.chk + 8, o_df[hd * 128 + 64 + d], HN(2664 + c), 0.01f, 0.01f); chk_rep(p.chk + 8, bf2f(p.RD[(size_t)row * 512 + hd * 128 + 64 + d]), HN(2664 + c), 0.01f, 0.01f); }
        }
    }
    if (which == 5) {
        for (int i = gwv; i < 4 * 96; i += NW) {
            int kind = i / 96; const int slot = kind; const unsigned h = hsh(i * 19 + 7); int row = samp_row(h);
            if (CHK_FILTER == 6) { row = MP + (int)(hsh(h + 5) % (unsigned)MS); if (slot == 1) { kind = 2; row = (row & ~63) | (int)(hsh(h + 9) % 3u); } if (slot == 2) row = (row & ~63) | (48 + (int)(hsh(h + 9) % 16u)); }
            if (CHK_FILTER == 1) row = (int)(hsh(h + 5) % NB) * SEQ + (int)(hsh(h + 6) % 64u);
            if (CHK_FILTER == 2) row = (int)(hsh(h + 5) % (unsigned)MP);
            if (CHK_FILTER == 3) row = MP + (int)(hsh(h + 5) % (unsigned)MS);
            if (CHK_FILTER == 5) { if (kind == 0 || kind == 2) row = MP + (int)(hsh(h + 5) % (unsigned)MS); else if (kind == 1) row = (int)(hsh(h + 5) % NB) * SEQ + 128 + (int)(hsh(h + 6) % 128u); else row = (int)(hsh(h + 5) % NB) * SEQ + 128 + (int)(hsh(h + 6) % 384u); }
            if (CHK_FILTER == 4) row = (int)(hsh(h + 5) % NB) * SEQ + 64 + (int)(hsh(h + 6) % 64u); const int hd = (hsh(h + 1) >> 5) & 3; const bool smp = row >= MP; const int rr = smp ? row - MP : row;
            const int b = smp ? rr >> 6 : rr >> 11, t = smp ? rr & 63 : rr & 2047; const int L = smp ? PAST + 64 : ((t >> 6) + 1) * 64;
            const int W = kind == 0 ? 160 : (kind == 1 ? 192 : 512);
            const float* cache = (kind == 0 ? a.in[I_CMLA] : kind == 1 ? a.in[I_CDSA] : kind == 2 ? a.in[I_CSB] : a.in[I_CDIFF]) + (size_t)(l * NB + b) * PAST * W;
            const bf16* rows = kind == 0 ? p.RA : kind == 1 ? p.RB : kind == 2 ? p.RC : p.RD;
#define SLD(ptr) __hip_atomic_load((ptr), __ATOMIC_RELAXED, __HIP_MEMORY_SCOPE_AGENT)
#define KEL(k, c) (smp ? ((k) < PAST ? bfr(cache[(size_t)(k) * W + (c)]) : bf2f(rows[(size_t)(MP + b * 64 + (k) - PAST) * W + (c)])) : bf2f(rows[(size_t)(b * SEQ + (k)) * W + (c)]))
            float* sbuf = (float*)(a.ws + WS_REGA + (size_t)300 * MiB) + (size_t)i * 8448;
            if (kind == 0) {
                const int pidx = smp ? 2048 + t : t; float mx = -1e30f;
                for (int k = lane; k < L; k += 64) { float s = 0.f; for (int c = 0; c < 128; ++c) s += bf2f(p.QA[(size_t)row * NQP + hd * 160 + c]) * KEL(k, c);
                    for (int c = 0; c < 16; ++c) { const float2 cs = p.R32[pidx * 16 + c]; const float x1 = bf2f(p.QA[(size_t)row * NQP + hd * 160 + 128 + c]), x2 = bf2f(p.QA[(size_t)row * NQP + hd * 160 + 144 + c]);
                        s += bfr(x1 * cs.x - x2 * cs.y) * KEL(k, 128 + c) + bfr(x2 * cs.x + x1 * cs.y) * KEL(k, 144 + c); }
                    sbuf[k] = s; mx = fmaxf(mx, s); }
                for (int o = 1; o < 64; o <<= 1) mx = fmaxf(mx, __shfl_xor(mx, o));
                float den = 0.f; for (int k = lane; k < L; k += 64) { float pp = exp2f(sbuf[k] - mx); if (DBG_VARIANTS) pp = 1.f; sbuf[k] = pp; den += pp; } den = wave_sum(den);
                __builtin_amdgcn_s_waitcnt(0);
                for (int d = 0; d < 128; d += 16) { const int dd = d + (lane & 15); float acc = 0.f; for (int k = lane >> 4; k < L; k += 4) acc += SLD(sbuf + k) * KEL(k, dd); acc += __shfl_xor(acc, 16); acc += __shfl_xor(acc, 32);
                    if (lane < 16) chk_rep(p.chk + 9, bf2f(p.CC[(size_t)row * KOUT + hd * 128 + dd]), acc / den, 0.004f, 0.03f); }
            }
            if (kind == 1) {
                const int nsel = 256;
                for (int k = lane; k < L; k += 64) { float sc = 0.f; for (int ih = 0; ih < 8; ++ih) { float s = 0.f; for (int c = 0; c < 64; ++c) s += bf2f(p.QI[(size_t)row * 512 + ih * 64 + c]) * KEL(k, 128 + c); sc += fmaxf(s, 0.f) * p.WI[(size_t)row * 8 + ih]; } sbuf[k] = sc; }
                __builtin_amdgcn_s_waitcnt(0);
                float mx = -1e30f; float* pb = sbuf + 4224;
                for (int k = lane; k < L; k += 64) { const float me = sbuf[k]; int rank = 0; if (L > nsel) for (int j = 0; j < L; ++j) { const float o = SLD(sbuf + j); rank += (o > me) || (o == me && j < k); }
                    float s = -1e30f; if (rank < nsel) { s = 0.f; for (int c = 0; c < 64; ++c) s += bf2f(p.QB[(size_t)row * 256 + hd * 64 + c]) * KEL(k, c); } pb[k] = s; mx = fmaxf(mx, s); }
                for (int o = 1; o < 64; o <<= 1) mx = fmaxf(mx, __shfl_xor(mx, o));
                float den = 0.f; for (int k = lane; k < L; k += 64) { const float pp = pb[k] > -1e29f ? exp2f(pb[k] - mx) : 0.f; pb[k] = pp; den += pp; } den = wave_sum(den);
                __builtin_amdgcn_s_waitcnt(0);
                for (int d = 0; d < 64; d += 16) { const int dd = d + (lane & 15); float acc = 0.f; for (int k = lane >> 4; k < L; k += 4) acc += SLD(pb + k) * KEL(k, 64 + dd); acc += __shfl_xor(acc, 16); acc += __shfl_xor(acc, 32);
                    if (lane < 16) chk_rep(p.chk + 10, bf2f(p.CC[(size_t)row * KOUT + 512 + hd * 64 + dd]), acc / den, 0.02f, 0.10f); }
            }
            if (kind == 2) {
                const int qpos = smp ? PAST + t : t; float accv[1]; (void)accv;
                for (int k = lane; k < qpos; k += 64) { float z = 0.f; for (int c = 0; c < 64; ++c) z += bf2f(p.QC[(size_t)row * 256 + hd * 64 + c]) * KEL(k, hd * 128 + c); sbuf[k] = z; }
                __builtin_amdgcn_s_waitcnt(0);
                float logafter = 0.f, acc = 0.f;
                for (int k = qpos - 1; k >= 0; --k) { const float z = SLD(sbuf + k); const float sp = fmaxf(z, 0.f) + logf(1.f + expf(-fabsf(z))); const float aw = expf(z - sp + logafter); acc += bfr(aw) * KEL(k, hd * 128 + 64 + lane); logafter -= sp; if (logafter < -60.f) break; }
                chk_rep(p.chk + 9 + slot, bf2f(p.CC[(size_t)row * KOUT + 768 + hd * 64 + lane]), acc, 0.02f, 0.05f);
            }
            if (kind == 3) {
                float outv = 0.f; float o2[2];
                for (int m2 = 0; m2 < 2; ++m2) { float mx = -1e30f;
                    for (int k = lane; k < L; k += 64) { float s = 0.f; for (int c = 0; c < 32; ++c) s += bf2f(p.QD[(size_t)row * 256 + hd * 64 + m2 * 32 + c]) * KEL(k, hd * 128 + m2 * 32 + c); sbuf[k] = s; mx = fmaxf(mx, s); }
                    for (int o = 1; o < 64; o <<= 1) mx = fmaxf(mx, __shfl_xor(mx, o));
                    float den = 0.f; for (int k = lane; k < L; k += 64) { const float pp = exp2f(sbuf[k] - (DBG_VARIANTS ? 8.f : mx)); sbuf[k] = pp; den += pp; } den = wave_sum(den);
                    __builtin_amdgcn_s_waitcnt(0);
                    float acc = 0.f; for (int k = 0; k < L; ++k) acc += SLD(sbuf + k) * KEL(k, hd * 128 + 64 + lane); o2[m2] = acc / den; __builtin_amdgcn_s_waitcnt(0); }
                outv = o2[0] - p.LAMF[l] * o2[1]; const float ss = wave_sum(outv * outv); const float lam_init = 0.8f - 0.6f * expf(-0.3f * (float)l);
                const float ex = outv / sqrtf(ss / 64.f + EPS) * a.in[I_DN][l * 64 + lane] * (1.f - lam_init);
                chk_rep(p.chk + 12, bf2f(p.CC[(size_t)row * KOUT + 1024 + hd * 64 + lane]), ex, 0.02f, 0.05f);
            }
        }
    }
    if (which == 6) { for (int i = gt; i < 4096; i += NT) { const unsigned h = hsh(i * 23 + 8); const int row = samp_row(h), c = hsh(h + 1) % DM; p.save[i] = p.X[(size_t)row * DM + c]; } }
    if (which == 7) {
        const float* wkvb = a.in[I_WKVB] + (size_t)l * 128 * 512; const float* wo = a.in[I_WO] + (size_t)l * DM * DM;
        for (int i = gt; i < 4096; i += NT) { const unsigned h = hsh(i * 23 + 8); const int row = samp_row(h), c = hsh(h + 1) % DM; const bf16* w = (bf16*)(p.wl + W_OUT) + (size_t)c * KOUT;
            float s = 0.f; for (int k = 0; k < KOUT; ++k) s += bf2f(p.CC[(size_t)row * KOUT + k]) * bf2f(w[k]);
            chk_rep(p.chk + 13, p.X[(size_t)row * DM + c], p.save[i] + s, 0.01f, 0.005f);
            float s1 = 0.f, s2 = 0.f; for (int k = 0; k < 512; ++k) s1 += bf2f(p.CC[(size_t)row * KOUT + k]) * bf2f(w[k]);
            for (int hh = 0; hh < 4; ++hh) for (int e = 0; e < 64; ++e) { float v = 0.f; for (int cc = 0; cc < 128; ++cc) v += bf2f(p.CC[(size_t)row * KOUT + hh * 128 + cc]) * wkvb[(size_t)cc * 512 + hh * 128 + 64 + e]; s2 += v * wo[(size_t)(hh * 64 + e) * DM + c]; }
            chk_rep(p.chk + 14, s1, s2, 0.01f, 0.02f);
            for (int k = 512; k < KOUT; k += 97) chk_rep(p.chk + 14, bf2f(w[k]), bfr(wo[(size_t)(256 + k - 512) * DM + c]), 1e-6f, 1e-3f); }
    }
}
#ifndef CHK_SHOW
#define CHK_SHOW -1
#endif
#ifndef CHK_MAXLI
#define CHK_MAXLI 6
#endif
__global__ void __launch_bounds__(256) report_kernel(Args a) {
    const unsigned* chk = (const unsigned*)(a.ws + WS_CHK); float A = 0.f;
    if (CHK_SHOW >= 0) { A = sqrtf(fminf(__uint_as_float(chk[CHK_SHOW >= 0 ? CHK_SHOW : 0]), 400.f)); if (A < 0.3f) A = 0.f; }
    else if (CHK_SHOW == -2) { int bits = 0; for (int f = 9; f <= 12; ++f) if (__uint_as_float(chk[f]) > 1.0f) bits |= 1 << (f - 9); A = (float)(1 + bits); }
    else for (int f = 0; f < 15; ++f) if (__uint_as_float(chk[f]) > 1.0f) { A = (float)(f + 1); break; }
    if (A == 0.f) return;
    for (size_t i = (size_t)blockIdx.x * 256 + threadIdx.x; i < (size_t)M * DM; i += (size_t)gridDim.x * 256) a.out[i] = A;
}
#endif

extern "C" void kernel_launch(void* const* d_in, const int* in_sizes, int n_in, void* d_out, int out_size, void* d_ws, size_t ws_size, hipStream_t stream) {
    static int grid = 0;
    if (grid == 0) {
        if (n_in != 24 || (size_t)out_size != O_END || ws_size < WS_END) { fprintf(stderr, "kernel_launch: unexpected shapes: n_in %d out %d ws %zu (need %zu)\n", n_in, out_size, ws_size, (size_t)WS_END); grid = -1; return; }
        int dev = 0, cus = 0, per_cu = 0;
        if (hipGetDevice(&dev) != hipSuccess || hipDeviceGetAttribute(&cus, hipDeviceAttributeMultiprocessorCount, dev) != hipSuccess) { grid = -1; return; }
        if (hipFuncSetAttribute((const void*)fwd_kernel, hipFuncAttributeMaxDynamicSharedMemorySize, LDS_BYTES) != hipSuccess) { fprintf(stderr, "kernel_launch: hipFuncSetAttribute failed\n"); grid = -1; return; }
        if (hipOccupancyMaxActiveBlocksPerMultiprocessor(&per_cu, (const void*)fwd_kernel, NWAVES * 64, LDS_BYTES) != hipSuccess || per_cu < 1) fprintf(stderr, "kernel_launch: occupancy query reports %d\n", per_cu);
        (void)hipGetLastError();
        grid = cus < 256 ? cus : 256;
    }
    if (grid < 0) return;
    (void)hipMemsetAsync((char*)d_ws + WS_CTL, 0, CTL_ZERO_BYTES, stream);
    Args a{};
    for (int i = 0; i < 24; ++i) a.in[i] = (const float*)d_in[i];
    a.out = (float*)d_out; a.ws = (unsigned char*)d_ws;
    for (int i = 0; i < 32; ++i) a.freq64[i] = (float)pow(10000.0, -(double)i * 2.0 / 64.0);
    for (int i = 0; i < 16; ++i) a.freq32[i] = (float)pow(10000.0, -(double)i * 2.0 / 32.0);
    constexpr int NPH = 18;
    for (int li = 0; li < MK_N_LAUNCHES; ++li) {
        a.ph_lo = (MK_N_LAUNCHES == 1) ? 0 : li; a.ph_hi = (MK_N_LAUNCHES == 1) ? NPH : li + 1;
#if SELFCHECK
        if (MK_N_LAUNCHES == 18 && li == 6 && CHK_MAXLI >= 6) hipLaunchKernelGGL(check_kernel, dim3(256), dim3(256), 0, stream, a, 0, 6);
#endif
        hipLaunchKernelGGL(fwd_kernel, dim3(grid), dim3(NWAVES * 64), LDS_BYTES, stream, a);
        const hipError_t le = hipPeekAtLastError();
        if (le != hipSuccess) { fprintf(stderr, "kernel_launch: launch %d failed: %s\n", li, hipGetErrorName(le)); break; }
#if SELFCHECK
        if (MK_N_LAUNCHES == 18) { const int wmap[7] = {0, 1, 2, 3, 4, 5, 7}; if (li <= CHK_MAXLI) hipLaunchKernelGGL(check_kernel, dim3(512), dim3(256), 0, stream, a, 0, wmap[li]); }
#endif
    }
#if SELFCHECK
    hipLaunchKernelGGL(report_kernel, dim3(1024), dim3(256), 0, stream, a);
#endif
}
```

```cpp
#include <hip/hip_runtime.h>
#include <cstdio>
#include <cstdint>
#include <cmath>

#ifndef DBG_VARIANTS
#define DBG_VARIANTS 0
#endif
#ifndef ATTN_REPS
#define ATTN_REPS 1
#endif
#ifndef POST_REPS
#define POST_REPS 1
#endif
#ifndef GU_REPS
#define GU_REPS 1
#endif
#ifndef P0_REPS
#define P0_REPS 1
#endif
#ifndef REP_MASK
#define REP_MASK 15
#endif
#ifndef SELFCHECK
#define SELFCHECK 0
#endif
#ifndef CHK_FILTER
#define CHK_FILTER 0
#endif
#ifndef IN_STAGGER_TICKS
#define IN_STAGGER_TICKS 0
#endif
#ifndef FUSE_POST
#define FUSE_POST 1
#endif
#ifndef MK_N_LAUNCHES
#define MK_N_LAUNCHES 1
#endif

#ifndef PHMASK
#define PHMASK 0x3ff
#endif
#define EN_PH(c) (((PHMASK) >> (c)) & 1)
#ifndef EN_MLA
#define EN_MLA 1
#endif
#ifndef EN_DSA
#define EN_DSA 1
#endif
#ifndef EN_SB
#define EN_SB 1
#endif
#ifndef EN_DIFF
#define EN_DIFF 1
#endif
#define LAS __attribute__((address_space(3)))
#define GAS __attribute__((address_space(1)))

constexpr int DM = 1024, NB = 32, SEQ = 2048, DEPTH = 2, DSEQ = 64, PAST = 4096;
constexpr int MP = NB * SEQ, MS = NB * DSEQ, M = MP + MS;
constexpr int DFF = 2816, NGU = 2 * DFF, NIN = 2920, NINP = 3072, NQ = 640, NQP = 768, KOUT = 1280;
constexpr float EPS = 1e-6f;
constexpr float LOG2E = 1.4426950408889634f;
constexpr int H_CQ = 0, H_CKV = 256, H_KR = 384, H_QB = 416, H_KB = 672, H_VB = 736, H_QI = 800, H_KI = 1312,
              H_QC = 1376, H_KC = 1632, H_VC = 1888, H_QD = 2144, H_KD = 2400, H_VD = 2656, H_WI = 2912;
constexpr size_t O_Y = 0;
constexpr size_t O_MLA_P = (size_t)M * DM;
constexpr size_t O_DSA_P = O_MLA_P + (size_t)DEPTH * MP * 160;
constexpr size_t O_SB_P = O_DSA_P + (size_t)DEPTH * MP * 192;
constexpr size_t O_DIFF_P = O_SB_P + (size_t)DEPTH * MP * 512;
constexpr size_t O_MLA_S = O_DIFF_P + (size_t)DEPTH * MP * 512;
constexpr size_t O_DSA_S = O_MLA_S + (size_t)DEPTH * MS * 160;
constexpr size_t O_SB_S = O_DSA_S + (size_t)DEPTH * MS * 192;
constexpr size_t O_DIFF_S = O_SB_S + (size_t)DEPTH * MS * 512;
constexpr size_t O_END = O_DIFF_S + (size_t)DEPTH * MS * 512;

constexpr size_t MiB = 1u << 20;
constexpr size_t WS_CTL = 0, CTL_ZERO_BYTES = SELFCHECK ? 4 * MiB : 128 * 1024;
constexpr size_t WS_SSQ = 1 * MiB;
constexpr size_t WS_MISC = 4 * MiB;
constexpr size_t MISC_ROPE64 = 4096, MISC_ROPE32 = MISC_ROPE64 + (size_t)2112 * 32 * 8;
constexpr size_t WS_W = 5 * MiB;
constexpr size_t W_GU1 = 0, W_D1 = W_GU1 + (size_t)NGU * DM * 2, W_IN = W_D1 + (size_t)DM * DFF * 2, W_Q = W_IN + (size_t)NINP * DM * 2,
                 W_OUT = W_Q + (size_t)NQP * 256 * 2, W_GU2 = W_OUT + (size_t)DM * KOUT * 2, W_D2 = W_GU2 + (size_t)NGU * DM * 2, W_LAYER = W_D2 + (size_t)DM * DFF * 2;
constexpr size_t WS_XB = 90 * MiB;
constexpr size_t WS_REGA = 222 * MiB;
constexpr size_t REGA_BYTES = (size_t)M * NINP * 2;
constexpr size_t WS_QA = 618 * MiB, WS_QB = 717 * MiB, WS_QI = 750 * MiB, WS_QC = 816 * MiB, WS_QD = 849 * MiB, WS_WI = 882 * MiB;
constexpr size_t WS_RA = 885 * MiB, WS_RB = 906 * MiB, WS_RC = 931 * MiB, WS_RD = 997 * MiB, WS_CC = 1063 * MiB, WS_SSQP = 1228 * MiB, WS_END = 1264 * MiB;
static_assert(WS_W + 2 * W_LAYER <= WS_XB && WS_XB + (size_t)M * DM * 2 <= WS_REGA && WS_REGA + REGA_BYTES <= WS_QA, "ws map");
static_assert(WS_QA + (size_t)M * NQP * 2 <= WS_QB && WS_QI + (size_t)M * 512 * 2 <= WS_QC && WS_WI + (size_t)M * 32 <= WS_RA, "ws map");
static_assert(WS_RA + (size_t)M * 160 * 2 <= WS_RB && WS_RB + (size_t)M * 192 * 2 <= WS_RC && WS_RC + (size_t)M * 1024 <= WS_RD && WS_RD + (size_t)M * 1024 <= WS_CC && WS_CC + (size_t)M * KOUT * 2 <= WS_SSQP && WS_SSQP + (size_t)M * 16 * 4 * 7 + (size_t)M * 4 * 4 * 4 <= WS_END, "ws map");
constexpr int CW_BAR = 4096, CW_Q = 8192;
constexpr int SC_LS = 4160;
constexpr int MK_LS = 72;
constexpr size_t DSA_SCR = 1105920;
constexpr size_t DSA_MASK_OFF = (size_t)64 * SC_LS * 4;
static_assert(DSA_MASK_OFF + 64 * MK_LS * 8 <= DSA_SCR && 256 * DSA_SCR <= REGA_BYTES, "dsa scratch");

constexpr int RING_BYTES = 135168, LDSCTL_OFF = RING_BYTES, MISC_OFF = LDSCTL_OFF + 320, LDS_BYTES = 147456;
constexpr int NWAVES = 8;

typedef unsigned short bf16;
typedef unsigned v4u __attribute__((ext_vector_type(4)));
typedef unsigned v2u __attribute__((ext_vector_type(2)));
typedef float f32x4 __attribute__((ext_vector_type(4)));
typedef float f32x16 __attribute__((ext_vector_type(16)));
typedef short bf16x8 __attribute__((ext_vector_type(8)));
typedef short s16x4 __attribute__((ext_vector_type(4)));
typedef GAS unsigned gu32;
#define RLX_AGENT __ATOMIC_RELAXED, __HIP_MEMORY_SCOPE_AGENT
#define LDS_WAIT() asm volatile("s_waitcnt lgkmcnt(0)" ::: "memory")
#define VM_WAIT() asm volatile("s_waitcnt vmcnt(0)" ::: "memory")

__device__ __forceinline__ unsigned f2bf(float f) { unsigned u = __builtin_bit_cast(unsigned, f); return (u + 0x7fffu + ((u >> 16) & 1u)) >> 16; }
__device__ __forceinline__ unsigned pk2(float lo, float hi) { return f2bf(lo) | (f2bf(hi) << 16); }
__device__ __forceinline__ float bf2f(bf16 b) { return __builtin_bit_cast(float, ((unsigned)b) << 16); }
typedef float f32x2_t __attribute__((ext_vector_type(2))); typedef __bf16 bf16x2_t __attribute__((ext_vector_type(2)));
__device__ __forceinline__ unsigned cvtpk(float lo, float hi) { f32x2_t v = {lo, hi}; bf16x2_t b = __builtin_convertvector(v, bf16x2_t); return __builtin_bit_cast(unsigned, b); }
__device__ __forceinline__ int opaque_s(int x) { asm volatile("" : "+s"(x)); return x; }
__device__ __forceinline__ int fresh_lane() { int l; asm volatile("v_mbcnt_lo_u32_b32 %0, -1, 0\n\tv_mbcnt_hi_u32_b32 %0, -1, %0" : "=&v"(l)); return l; }
__device__ __forceinline__ float opaque_vf(float x) { asm volatile("" : "+v"(x)); return x; }
__device__ __forceinline__ float wave_sum(float v) {
#pragma unroll
    for (int o = 1; o < 64; o <<= 1) v += __shfl_xor(v, o);
    return v;
}

__device__ __forceinline__ float ssq_sum16(const float* p, int row) { const f32x4* q = (const f32x4*)(p + (size_t)row * 16); const f32x4 a = q[0], b = q[1], c = q[2], d = q[3];
    return (((a[0] + a[1]) + (a[2] + a[3])) + ((b[0] + b[1]) + (b[2] + b[3]))) + (((c[0] + c[1]) + (c[2] + c[3])) + ((d[0] + d[1]) + (d[2] + d[3]))); }
__device__ __forceinline__ float ssq_sum4(const float* p, int row) { const f32x4 a = *(const f32x4*)(p + (size_t)row * 4); return (a[0] + a[1]) + (a[2] + a[3]); }
namespace pg8 {
#define PG8_LAS __attribute__((address_space(3)))
typedef unsigned short bf16_t;
typedef unsigned u32x4 __attribute__((ext_vector_type(4)));
constexpr int BM = 256, BK = 64, HALF = 128, HTB = HALF * BK * 2, STAGE_BYTES = 8 * HTB, NXCD = 8, WGM = 8;
__host__ __device__ __forceinline__ int lds_byte(int r, int c) { const int st = (r >> 4) * 2 + (c >> 5), rr = r & 15, cc = c & 31, ob = rr * 64 + cc * 2; return st * 1024 + (ob ^ (((ob >> 9) & 1) << 5)); }
__host__ __device__ __forceinline__ void stage_rc(int b, int& R, int& C) { const int st = b / 1024, sb = b % 1024, swz = sb ^ (((sb >> 9) & 1) << 5); R = (st >> 1) * 16 + swz / 64; C = (st & 1) * 32 + (swz % 64) / 2; }
__host__ __device__ __forceinline__ int perm32(int rho) { const int n = rho >> 4, i = rho & 15; return 8 * (i >> 2) + 4 * n + (i & 3); }
struct Unit { int pm, pn; };
struct Gemm { const bf16_t* A; const bf16_t* Bt; int M, N, K, lda, ldb; };
struct StaticOrder {
    int nM, nN, nwg, G, c;
    __host__ __device__ void init(int M_, int N_, int G_, int c_) { nM = M_ / BM; nN = N_ / BM; nwg = nM * nN; G = G_; c = c_; }
    __host__ __device__ bool next(int i, Unit& u) const {
        const long L = (long)i * G + c; if (L >= nwg) return false;
        int wgid = (int)L; { const int q = nwg / NXCD, r = nwg % NXCD, xcd = wgid % NXCD, off = wgid / NXCD; wgid = (xcd < r ? xcd * (q + 1) : r * (q + 1) + (xcd - r) * q) + off; }
        const int nig = WGM * nN, gid = wgid / nig, fm = gid * WGM, gsz = (nM - fm) < WGM ? (nM - fm) : WGM;
        u.pm = fm + ((wgid % nig) % gsz); u.pn = (wgid % nig) / gsz; return true;
    }
    __device__ __forceinline__ void a_ready(const Unit&) const {}
    __device__ __forceinline__ void done(const Unit&) const {}
};

struct EpiSwiGLU {
    static constexpr bool PERM = true, AFTER_DRAIN = false;
    bf16_t* act; const float* ssq;
    __device__ __forceinline__ void operator()(const f32x4 (&acc)[2][2][4][2], const Unit& u, int wr, int wc, int fr, int fq) const {
        const int row0 = u.pm * BM + wr * 64 + fr, col0 = u.pn * 128 + wc * 32 + 8 * fq;
#pragma unroll
        for (int ai = 0; ai < 2; ++ai)
#pragma unroll
            for (int m = 0; m < 4; ++m) {
                const int row = row0 + ai * HALF + m * 16;
                const float rs = 1.0f / sqrtf(ssq_sum16(ssq, row) * (1.0f / 1024.0f) + EPS);
                float o[8];
#pragma unroll
                for (int n = 0; n < 2; ++n)
#pragma unroll
                    for (int j = 0; j < 4; ++j) {
                        const float g = acc[ai][0][m][n][j] * rs, up = acc[ai][1][m][n][j] * rs;
                        const float sg = g * __builtin_amdgcn_rcpf(1.0f + __builtin_amdgcn_exp2f(-g * LOG2E));
                        o[n * 4 + j] = sg * up;
                    }
                u32x4 w; w.x = cvtpk(o[0], o[1]); w.y = cvtpk(o[2], o[3]); w.z = cvtpk(o[4], o[5]); w.w = cvtpk(o[6], o[7]);
                *(u32x4*)(act + (size_t)row * DFF + col0) = w;
            }
    }
};
template <bool BASE_F32> struct EpiResid {
    static constexpr bool PERM = true, AFTER_DRAIN = false;
    const float* baseP; const float* baseS; bf16_t* xb; float* ssq_out; float alpha;
    __device__ __forceinline__ void operator()(const f32x4 (&acc)[2][2][4][2], const Unit& u, int wr, int wc, int fr, int fq) const {
        const int row0 = u.pm * BM + wr * 64 + fr, col0 = u.pn * BM + wc * 32 + 8 * fq;
        const float* base = (u.pm < MP / BM) ? baseP : baseS;
        u32x4 bw[2][4][2];
        if (!BASE_F32) {
#pragma unroll
            for (int ai = 0; ai < 2; ++ai)
#pragma unroll
                for (int m = 0; m < 4; ++m)
#pragma unroll
                    for (int bj = 0; bj < 2; ++bj) bw[ai][m][bj] = *(const u32x4*)(xb + (size_t)(row0 + ai * HALF + m * 16) * DM + col0 + bj * HALF);
            __builtin_amdgcn_sched_barrier(0);
        }
#pragma unroll
        for (int ai = 0; ai < 2; ++ai) {
        f32x4 bf[4][2][2];
        if (BASE_F32) {
#pragma unroll
            for (int m = 0; m < 4; ++m)
#pragma unroll
                for (int bj = 0; bj < 2; ++bj) { const float* bp = base + (size_t)(row0 + ai * HALF + m * 16) * DM + col0 + bj * HALF; bf[m][bj][0] = *(const f32x4*)bp; bf[m][bj][1] = *(const f32x4*)(bp + 4); }
            __builtin_amdgcn_sched_barrier(0);
        }
#pragma unroll
            for (int m = 0; m < 4; ++m) {
                const int row = row0 + ai * HALF + m * 16; const size_t off = (size_t)row * DM + col0; float ss = 0.f;
#pragma unroll
                for (int bj = 0; bj < 2; ++bj) {
                    f32x4 b0, b1;
                    if (BASE_F32) { b0 = bf[m][bj][0]; b1 = bf[m][bj][1]; }
                    else { const u32x4 w = bw[ai][m][bj];
                        b0 = (f32x4){__uint_as_float(w.x << 16), __uint_as_float(w.x & 0xffff0000u), __uint_as_float(w.y << 16), __uint_as_float(w.y & 0xffff0000u)};
                        b1 = (f32x4){__uint_as_float(w.z << 16), __uint_as_float(w.z & 0xffff0000u), __uint_as_float(w.w << 16), __uint_as_float(w.w & 0xffff0000u)}; }
                    const f32x4 o0 = b0 + acc[ai][bj][m][0] * alpha, o1 = b1 + acc[ai][bj][m][1] * alpha;
                    u32x4 w2; w2.x = cvtpk(o0[0], o0[1]); w2.y = cvtpk(o0[2], o0[3]); w2.z = cvtpk(o1[0], o1[1]); w2.w = cvtpk(o1[2], o1[3]);
                    *(u32x4*)(xb + off + bj * HALF) = w2;
                    ss += (o0[0] * o0[0] + o0[1] * o0[1]) + (o0[2] * o0[2] + o0[3] * o0[3]) + (o1[0] * o1[0] + o1[1] * o1[1]) + (o1[2] * o1[2] + o1[3] * o1[3]);
                }
                ss += __shfl_xor(ss, 16); ss += __shfl_xor(ss, 32);
                if (fq == 0) ssq_out[(size_t)row * 16 + u.pn * 4 + wc] = ss;
                asm volatile("" ::: "memory");
            }
        }
    }
};
struct OneUnit {
    __device__ __forceinline__ bool next(int i, Unit& u) const { if (i > 0) return false; u.pm = 0; u.pn = 0; return true; }
    __device__ __forceinline__ void a_ready(const Unit&) const {}
    __device__ __forceinline__ void done(const Unit&) const {}
};
struct EpiPartial {
    static constexpr bool PERM = true, AFTER_DRAIN = false;
    float* P;
    __device__ __forceinline__ void operator()(const f32x4 (&acc)[2][2][4][2], const Unit&, int wr, int wc, int fr, int fq) const {
        const int tid = (wr * 4 + wc) * 64 + fq * 16 + fr;
#pragma unroll
        for (int ai = 0; ai < 2; ++ai)
#pragma unroll
            for (int bj = 0; bj < 2; ++bj)
#pragma unroll
                for (int m = 0; m < 4; ++m)
#pragma unroll
                    for (int n = 0; n < 2; ++n) *(f32x4*)(P + ((size_t)((((ai * 2 + bj) * 4 + m) * 2 + n) * 512 + tid)) * 4) = acc[ai][bj][m][n];
    }
};
template <bool BASE_F32> __device__ __forceinline__ void resid_fixup(const float* Pu  , int pm, int pn, int ai, int m, const float* base, bf16_t* xb, float* ssq_out, float alpha, int tid) {
    const int wid = tid >> 6, lane = tid & 63, wr = wid >> 2, wc = wid & 3, fr = lane & 15, fq = lane >> 4;
    f32x4 S[2][2], L[8][2][2];
#pragma unroll
    for (int sl = 0; sl < 8; ++sl)
#pragma unroll
        for (int bj = 0; bj < 2; ++bj)
#pragma unroll
            for (int n = 0; n < 2; ++n) L[sl][bj][n] = *(const f32x4*)(Pu + ((size_t)((sl * 32 + ((ai * 2 + bj) * 4 + m) * 2 + n) * 512 + tid)) * 4);
    __builtin_amdgcn_sched_barrier(0);
#pragma unroll
    for (int bj = 0; bj < 2; ++bj)
#pragma unroll
        for (int n = 0; n < 2; ++n) { S[bj][n] = L[0][bj][n];
#pragma unroll
            for (int sl = 1; sl < 8; ++sl) S[bj][n] += L[sl][bj][n]; }
    const int row = pm * BM + wr * 64 + fr + ai * HALF + m * 16, col0 = pn * BM + wc * 32 + 8 * fq; const size_t off = (size_t)row * DM + col0; float ss = 0.f;
#pragma unroll
    for (int bj = 0; bj < 2; ++bj) {
        f32x4 b0, b1;
        if (BASE_F32) { b0 = *(const f32x4*)(base + off + bj * HALF); b1 = *(const f32x4*)(base + off + bj * HALF + 4); }
        else { const u32x4 w = *(const u32x4*)(xb + off + bj * HALF);
            b0 = (f32x4){__uint_as_float(w.x << 16), __uint_as_float(w.x & 0xffff0000u), __uint_as_float(w.y << 16), __uint_as_float(w.y & 0xffff0000u)};
            b1 = (f32x4){__uint_as_float(w.z << 16), __uint_as_float(w.z & 0xffff0000u), __uint_as_float(w.w << 16), __uint_as_float(w.w & 0xffff0000u)}; }
        const f32x4 o0 = b0 + S[bj][0] * alpha, o1 = b1 + S[bj][1] * alpha;
        u32x4 w2; w2.x = cvtpk(o0[0], o0[1]); w2.y = cvtpk(o0[2], o0[3]); w2.z = cvtpk(o1[0], o1[1]); w2.w = cvtpk(o1[2], o1[3]);
        *(u32x4*)(xb + off + bj * HALF) = w2;
        ss += (o0[0] * o0[0] + o0[1] * o0[1]) + (o0[2] * o0[2] + o0[3] * o0[3]) + (o1[0] * o1[0] + o1[1] * o1[1]) + (o1[2] * o1[2] + o1[3] * o1[3]);
    }
    ss += __shfl_xor(ss, 16); ss += __shfl_xor(ss, 32);
    if (fq == 0) ssq_out[(size_t)row * 16 + pn * 4 + wc] = ss;
}
struct EpiScaleBf16 {
    static constexpr bool PERM = true, AFTER_DRAIN = false;
    bf16_t* O; int ldc; const float* ssq_in; int np_in; float inv_dim; float* ssq_out;
    __device__ __forceinline__ void operator()(const f32x4 (&acc)[2][2][4][2], const Unit& u, int wr, int wc, int fr, int fq) const {
        const int row0 = u.pm * BM + wr * 64 + fr, col0 = u.pn * BM + wc * 32 + 8 * fq;
        const bool do_ssq = (ssq_out != nullptr) && (u.pn == 0);
#pragma unroll
        for (int ai = 0; ai < 2; ++ai)
#pragma unroll
            for (int m = 0; m < 4; ++m) {
                const int row = row0 + ai * HALF + m * 16;
                const float rs = 1.0f / sqrtf((np_in == 16 ? ssq_sum16(ssq_in, row) : ssq_sum4(ssq_in, row)) * inv_dim + EPS); float ss = 0.f;
                bf16_t* rowp = O + (size_t)row * ldc + col0;
#pragma unroll
                for (int bj = 0; bj < 2; ++bj) {
                    const f32x4 v0 = acc[ai][bj][m][0] * rs, v1 = acc[ai][bj][m][1] * rs;
                    u32x4 w; w.x = cvtpk(v0[0], v0[1]); w.y = cvtpk(v0[2], v0[3]); w.z = cvtpk(v1[0], v1[1]); w.w = cvtpk(v1[2], v1[3]);
                    *(u32x4*)(rowp + bj * HALF) = w;
                    ss += (v0[0] * v0[0] + v0[1] * v0[1]) + (v0[2] * v0[2] + v0[3] * v0[3]) + (v1[0] * v1[0] + v1[1] * v1[1]) + (v1[2] * v1[2] + v1[3] * v1[3]);
                }
                if (do_ssq) { ss += __shfl_xor(ss, 16); ss += __shfl_xor(ss, 32); if (fq == 0) ssq_out[(size_t)row * 4 + wc] = ss; }
            }
    }
};


struct EpiInFused {
    static constexpr bool PERM = true, AFTER_DRAIN = false;
    unsigned char* ws; float* out; int layer;
    __device__ __forceinline__ void operator()(const f32x4 (&acc)[2][2][4][2], const Unit& u, int wr, int wc, int fr_, int fq_) const {
        int fr = fr_, fq = fq_; asm volatile("" : "+v"(fr), "+v"(fq));
        const int row0 = u.pm * BM + wr * 64 + fr, c0 = wc * 32 + 8 * fq, pn = u.pn;
        float* const SSQP_ = (float*)(ws + WS_SSQP);
        const float* ssq_in = SSQP_ + (size_t)(3 + layer) * M * 16; float* ssq_cq = SSQP_ + (size_t)7 * M * 16 + (size_t)layer * M * 4; float* ssq_kv = SSQP_ + (size_t)7 * M * 16 + (size_t)(2 + layer) * M * 4;
        bf16_t* const CQ = (bf16_t*)(ws + WS_REGA + (size_t)300 * MiB); bf16_t* const CKV = (bf16_t*)(ws + WS_REGA + (size_t)340 * MiB);
        bf16_t* const QB = (bf16_t*)(ws + WS_QB); bf16_t* const QI = (bf16_t*)(ws + WS_QI); bf16_t* const QC = (bf16_t*)(ws + WS_QC); bf16_t* const QD = (bf16_t*)(ws + WS_QD);
        bf16_t* const RA = (bf16_t*)(ws + WS_RA); bf16_t* const RB = (bf16_t*)(ws + WS_RB); bf16_t* const RC = (bf16_t*)(ws + WS_RC); bf16_t* const RD = (bf16_t*)(ws + WS_RD);
        float* const WI = (float*)(ws + WS_WI); const float2* const R64 = (const float2*)(ws + WS_MISC + MISC_ROPE64); const float2* const R32 = (const float2*)(ws + WS_MISC + MISC_ROPE32);
        bf16_t* const HBdbg = SELFCHECK ? (bf16_t*)(ws + WS_REGA) : nullptr;
        const float scaleB = 0.125f * LOG2E, scaleD = 0.17677669529663687f * LOG2E, scaleC = 0.125f * LOG2E;
#define EPK8(f) ((u32x4){cvtpk(f[0], f[1]), cvtpk(f[2], f[3]), cvtpk(f[4], f[5]), cvtpk(f[6], f[7])})
#define EST8F(p, f) do { *(f32x4*)(p) = (f32x4){f[0], f[1], f[2], f[3]}; *(f32x4*)((p) + 4) = (f32x4){f[4], f[5], f[6], f[7]}; } while (0)
#pragma unroll
        for (int ai = 0; ai < 2; ++ai)
#pragma unroll
            for (int m = 0; m < 4; ++m) {
                const int row = row0 + ai * HALF + m * 16;
                const float rs = 1.0f / sqrtf(ssq_sum16(ssq_in, row) * (1.0f / 1024.0f) + EPS);
                float v0[8], v1[8];
#pragma unroll
                for (int e = 0; e < 4; ++e) { v0[e] = acc[ai][0][m][0][e] * rs; v0[4 + e] = acc[ai][0][m][1][e] * rs; v1[e] = acc[ai][1][m][0][e] * rs; v1[4 + e] = acc[ai][1][m][1][e] * rs; }
                if (HBdbg) { *(u32x4*)(HBdbg + (size_t)row * NINP + pn * 256 + c0) = EPK8(v0); *(u32x4*)(HBdbg + (size_t)row * NINP + pn * 256 + 128 + c0) = EPK8(v1); }
                const bool smp = row >= MP; const int rr = smp ? row - MP : row; const int pidx = smp ? 2048 + (rr & 63) : (rr & 2047);
                if (pn == 0) {
                    *(u32x4*)(CQ + (size_t)row * 256 + c0) = EPK8(v0); *(u32x4*)(CQ + (size_t)row * 256 + 128 + c0) = EPK8(v1);
                    float ss = 0.f;
#pragma unroll
                    for (int e = 0; e < 8; ++e) ss += v0[e] * v0[e] + v1[e] * v1[e];
                    ss += __shfl_xor(ss, 16); ss += __shfl_xor(ss, 32); if (fq == 0) ssq_cq[(size_t)row * 4 + wc] = ss;
                } else if (pn <= 6 && pn != 4) {
                    const bool d32 = pn >= 5; const int i0 = d32 ? 8 * (fq & 1) : 8 * fq;
                    const f32x4* cp = (const f32x4*)(d32 ? R32 + pidx * 16 + i0 : R64 + pidx * 32 + i0);
                    float a[8], b[8];
#pragma unroll
                    for (int e2 = 0; e2 < 4; ++e2) { const f32x4 cs = cp[e2];
                        a[2 * e2] = v0[2 * e2] * cs[0] - v1[2 * e2] * cs[1]; b[2 * e2] = v1[2 * e2] * cs[0] + v0[2 * e2] * cs[1];
                        a[2 * e2 + 1] = v0[2 * e2 + 1] * cs[2] - v1[2 * e2 + 1] * cs[3]; b[2 * e2 + 1] = v1[2 * e2 + 1] * cs[2] + v0[2 * e2 + 1] * cs[3]; }
                    if (pn == 1) {
#pragma unroll
                        for (int e = 0; e < 8; ++e) { a[e] *= scaleB; b[e] *= scaleB; }
                        bf16_t* d = QB + (size_t)row * 256 + wc * 64 + 8 * fq; *(u32x4*)d = EPK8(a); *(u32x4*)(d + 32) = EPK8(b);
                    } else if (pn <= 3) { bf16_t* d = QI + (size_t)row * 512 + (4 * (pn - 2) + wc) * 64 + 8 * fq; *(u32x4*)d = EPK8(a); *(u32x4*)(d + 32) = EPK8(b);
                    } else { const int blk = 2 * wc + (fq >> 1);
                        if (pn == 5) {
#pragma unroll
                            for (int e = 0; e < 8; ++e) { a[e] *= scaleD; b[e] *= scaleD; }
                            bf16_t* d = QD + (size_t)row * 256 + blk * 32 + i0; *(u32x4*)d = EPK8(a); *(u32x4*)(d + 16) = EPK8(b);
                        } else { const int oc = (blk >> 1) * 128 + (blk & 1) * 32 + i0;
                            float* od = out + (smp ? O_DIFF_S + ((size_t)layer * MS + rr) * 512 : O_DIFF_P + ((size_t)layer * MP + rr) * 512) + oc;
                            EST8F(od, a); EST8F(od + 16, b); bf16_t* d = RD + (size_t)row * 512 + oc; *(u32x4*)d = EPK8(a); *(u32x4*)(d + 16) = EPK8(b); } }
                } else if (pn == 4) {
                    if (wc < 2 || (wc == 2 && fq < 2)) {
                        const bool d32 = wc == 2; const f32x4* cp = (const f32x4*)(d32 ? R32 + pidx * 16 + 8 * fq : R64 + pidx * 32 + 8 * fq);
                        float a[8], b[8];
#pragma unroll
                        for (int e2 = 0; e2 < 4; ++e2) { const f32x4 cs = cp[e2];
                            a[2 * e2] = v0[2 * e2] * cs[0] - v1[2 * e2] * cs[1]; b[2 * e2] = v1[2 * e2] * cs[0] + v0[2 * e2] * cs[1];
                            a[2 * e2 + 1] = v0[2 * e2 + 1] * cs[2] - v1[2 * e2 + 1] * cs[3]; b[2 * e2 + 1] = v1[2 * e2 + 1] * cs[2] + v0[2 * e2 + 1] * cs[3]; }
                        if (!d32) { const int oc = (wc == 0 ? 0 : 128) + 8 * fq;
                            float* od = out + (smp ? O_DSA_S + ((size_t)layer * MS + rr) * 192 : O_DSA_P + ((size_t)layer * MP + rr) * 192) + oc;
                            EST8F(od, a); EST8F(od + 32, b); bf16_t* d = RB + (size_t)row * 192 + oc; *(u32x4*)d = EPK8(a); *(u32x4*)(d + 32) = EPK8(b);
                        } else { const int oc = 128 + 8 * fq;
                            float* od = out + (smp ? O_MLA_S + ((size_t)layer * MS + rr) * 160 : O_MLA_P + ((size_t)layer * MP + rr) * 160) + oc;
                            EST8F(od, a); EST8F(od + 16, b); bf16_t* d = RA + (size_t)row * 160 + oc; *(u32x4*)d = EPK8(a); *(u32x4*)(d + 16) = EPK8(b); } }
                } else if (pn == 7) {
                    *(u32x4*)(CKV + (size_t)row * 128 + c0) = EPK8(v0);
                    float ss = 0.f;
#pragma unroll
                    for (int e = 0; e < 8; ++e) ss += v0[e] * v0[e];
                    ss += __shfl_xor(ss, 16); ss += __shfl_xor(ss, 32); if (fq == 0) ssq_kv[(size_t)row * 4 + wc] = ss;
                    if (wc < 2) { const int oc = 64 + c0; float* od = out + (smp ? O_DSA_S + ((size_t)layer * MS + rr) * 192 : O_DSA_P + ((size_t)layer * MP + rr) * 192) + oc;
                        EST8F(od, v1); *(u32x4*)(RB + (size_t)row * 192 + oc) = EPK8(v1); }
                    else if (wc == 2 && fq == 0) { float w8[8];
#pragma unroll
                        for (int e = 0; e < 8; ++e) w8[e] = v1[e] * 0.35355339059327373f;
                        EST8F(WI + (size_t)row * 8, w8); }
                } else if (pn == 8) {
                    float a[8], b[8];
#pragma unroll
                    for (int e = 0; e < 8; ++e) { a[e] = v0[e] * scaleC; b[e] = v1[e] * scaleC; }
                    *(u32x4*)(QC + (size_t)row * 256 + c0) = EPK8(a); *(u32x4*)(QC + (size_t)row * 256 + 128 + c0) = EPK8(b);
                } else {
                    const int h0 = wc >> 1, d0 = 32 * (wc & 1) + 8 * fq;
                    const int voff = (pn == 9) ? 0 : 64;
                    if (pn == 11) { float* od = out + (smp ? O_DIFF_S + ((size_t)layer * MS + rr) * 512 : O_DIFF_P + ((size_t)layer * MP + rr) * 512);
                        EST8F(od + h0 * 128 + voff + d0, v0); EST8F(od + (h0 + 2) * 128 + voff + d0, v1);
                        *(u32x4*)(RD + (size_t)row * 512 + h0 * 128 + voff + d0) = EPK8(v0); *(u32x4*)(RD + (size_t)row * 512 + (h0 + 2) * 128 + voff + d0) = EPK8(v1);
                    } else { float* od = out + (smp ? O_SB_S + ((size_t)layer * MS + rr) * 512 : O_SB_P + ((size_t)layer * MP + rr) * 512);
                        EST8F(od + h0 * 128 + voff + d0, v0); EST8F(od + (h0 + 2) * 128 + voff + d0, v1);
                        *(u32x4*)(RC + (size_t)row * 512 + h0 * 128 + voff + d0) = EPK8(v0); *(u32x4*)(RC + (size_t)row * 512 + (h0 + 2) * 128 + voff + d0) = EPK8(v1); }
                }
                asm volatile("" ::: "memory");
            }
#undef EPK8
#undef EST8F
    }
};

template <class Epi, class Sched, bool ALIGN_EPI = false, bool SP2 = false>
__device__ __forceinline__ void gemm_phase(PG8_LAS unsigned char* lds, const Gemm g, const Sched& S, const Epi& E, const int wave0) {
    const int tid_ = wave0 * 64 + fresh_lane();
    const int tid = tid_, wid = __builtin_amdgcn_readfirstlane(tid >> 6), lane = tid & 63, wr = wid >> 2, wc = wid & 3, fr = lane & 15, fq = lane >> 4;
    const int K = g.K, nt = K / BK, lda = g.lda, ldb = g.ldb ? g.ldb : g.K;
    unsigned voffA[2], voffB[2];
#pragma unroll
    for (int i = 0; i < 2; ++i) { int R, C; stage_rc(tid * 16 + i * 8192, R, C); const int Rb = Epi::PERM ? ((R & ~31) + perm32(R & 31)) : R;
        voffA[i] = (unsigned)(R * lda + C) * 2u; voffB[i] = (unsigned)(Rb * ldb + C) * 2u; }
    const size_t kstep = (size_t)(BK * 2);
    const size_t hstepA = (size_t)HALF * lda * 2, hstepB = (size_t)HALF * ldb * 2;
    const size_t tstepA = 2 * hstepA, tstepB = 2 * hstepB;
    const unsigned ldsw = (unsigned)wid * 1024u;
    const int aoff = lds_byte(wr * 64 + fr, fq * 8), boff = lds_byte(wc * 32 + fr, fq * 8);
#define PG8_SA(b, h) (((b) * 2 + (h)) * HTB)
#define PG8_SB(b, h) ((4 + (b) * 2 + (h)) * HTB)
#define PG8_STAGE(bufoff, gbase, voff) do { _Pragma("unroll") for (int _i = 0; _i < 2; ++_i) \
        __builtin_amdgcn_global_load_lds((const unsigned*)((const char*)(gbase) + (voff)[_i]), (PG8_LAS unsigned*)(lds + (bufoff) + ldsw + _i * 8192), 16, 0, 0); } while (0)
#define PG8_LDA(dst, b, h) do { _Pragma("unroll") for (int m = 0; m < 4; ++m) _Pragma("unroll") for (int k = 0; k < 2; ++k) dst[m][k] = *(const PG8_LAS bf16x8*)(lds + PG8_SA(b, h) + aoff + m * 2048 + k * 1024); } while (0)
#define PG8_LDB(dst, b, h) do { _Pragma("unroll") for (int n = 0; n < 2; ++n) _Pragma("unroll") for (int k = 0; k < 2; ++k) dst[n][k] = *(const PG8_LAS bf16x8*)(lds + PG8_SB(b, h) + boff + n * 2048 + k * 1024); } while (0)
#define PG8_MMA(ai, bj, At, Bt) do { __builtin_amdgcn_s_setprio(1); _Pragma("unroll") for (int m = 0; m < 4; ++m) _Pragma("unroll") for (int n = 0; n < 2; ++n) _Pragma("unroll") for (int k = 0; k < 2; ++k) \
        acc[ai][bj][m][n] = __builtin_amdgcn_mfma_f32_16x16x32_bf16(Bt[n][k], At[m][k], acc[ai][bj][m][n], 0, 0, 0); __builtin_amdgcn_s_setprio(0); } while (0)
#define PG8_WAIT_V(n) asm volatile("s_waitcnt vmcnt(" #n ")" ::: "memory")
#define PG8_WAIT_L(n) asm volatile("s_waitcnt lgkmcnt(" #n ")" ::: "memory")
#define PG8_BAR __builtin_amdgcn_s_barrier()
#define PG8_SCHED __builtin_amdgcn_sched_barrier(0)
    Unit cur, nxt; int ui = 0;
    if (!S.next(0, cur)) return;
    f32x4 acc[2][2][4][2];
#pragma unroll
    for (int a = 0; a < 2; ++a)
#pragma unroll
        for (int b = 0; b < 2; ++b)
#pragma unroll
            for (int m = 0; m < 4; ++m)
#pragma unroll
                for (int n = 0; n < 2; ++n) acc[a][b][m][n] = (f32x4){0.f, 0.f, 0.f, 0.f};
    bf16x8 At[4][2], B0[2][2], B1[2][2];
    const char* cA = (const char*)g.A + (size_t)cur.pm * tstepA; const char* cB = (const char*)g.Bt + (size_t)cur.pn * tstepB;
    S.a_ready(cur);
    if constexpr (SP2) {
        PG8_STAGE(PG8_SB(0, 0), cB, voffB); PG8_STAGE(PG8_SB(0, 1), cB + hstepB, voffB); PG8_STAGE(PG8_SA(0, 0), cA, voffA); PG8_STAGE(PG8_SA(0, 1), cA + hstepA, voffA);
        if (wr == 1) PG8_BAR;
        PG8_WAIT_V(2); PG8_BAR;
        PG8_STAGE(PG8_SB(1, 0), cB + kstep, voffB); PG8_STAGE(PG8_SA(1, 0), cA + kstep, voffA); PG8_STAGE(PG8_SB(1, 1), cB + hstepB + kstep, voffB);
        PG8_WAIT_V(6); PG8_BAR;
    } else {
        PG8_STAGE(PG8_SB(0, 0), cB, voffB); PG8_STAGE(PG8_SA(0, 0), cA, voffA); PG8_STAGE(PG8_SB(0, 1), cB + hstepB, voffB); PG8_STAGE(PG8_SA(0, 1), cA + hstepA, voffA);
        if (wr == 1) PG8_BAR;
        PG8_WAIT_V(4); PG8_BAR;
        PG8_STAGE(PG8_SB(1, 0), cB + kstep, voffB); PG8_STAGE(PG8_SA(1, 0), cA + kstep, voffA); PG8_STAGE(PG8_SB(1, 1), cB + hstepB + kstep, voffB);
        PG8_WAIT_V(6); PG8_BAR;
    }
    for (;;) {
        const bool has_next = S.next(ui + 1, nxt);
        const char* nA = has_next ? (const char*)g.A + (size_t)nxt.pm * tstepA : cA; const char* nB = has_next ? (const char*)g.Bt + (size_t)nxt.pn * tstepB : cB;
        for (int t = 0; t < nt; t += 2) {
            const bool last = (t == nt - 2);
            const char* a1 = cA + (size_t)(t + 1) * kstep;
            const char* a2 = last ? nA : cA + (size_t)(t + 2) * kstep; const char* b2 = last ? nB : cB + (size_t)(t + 2) * kstep;
            const char* a3 = a2 + kstep; const char* b3 = b2 + kstep;
            if (last && has_next) S.a_ready(nxt);
            if constexpr (SP2) {
            PG8_LDB(B0, 0, 0); PG8_LDB(B1, 0, 1); PG8_SCHED; PG8_LDA(At, 0, 0); PG8_STAGE(PG8_SA(1, 1), a1 + hstepA, voffA);
            PG8_WAIT_V(8); PG8_WAIT_L(0); PG8_BAR; PG8_MMA(0, 0, At, B0); PG8_MMA(0, 1, At, B1); PG8_BAR; PG8_SCHED;
            PG8_LDA(At, 0, 1); PG8_STAGE(PG8_SB(0, 0), b2, voffB); PG8_STAGE(PG8_SB(0, 1), b2 + hstepB, voffB); PG8_STAGE(PG8_SA(0, 0), a2, voffA);
            PG8_WAIT_V(8); PG8_WAIT_L(0); PG8_BAR; PG8_MMA(1, 0, At, B0); PG8_MMA(1, 1, At, B1); PG8_BAR; PG8_SCHED;
            PG8_LDB(B0, 1, 0); PG8_LDB(B1, 1, 1); PG8_SCHED; PG8_LDA(At, 1, 0); PG8_STAGE(PG8_SA(0, 1), a2 + hstepA, voffA);
            PG8_WAIT_V(8); PG8_WAIT_L(0); PG8_BAR; PG8_MMA(0, 0, At, B0); PG8_MMA(0, 1, At, B1); PG8_BAR; PG8_SCHED;
            PG8_LDA(At, 1, 1); PG8_STAGE(PG8_SB(1, 0), b3, voffB); PG8_STAGE(PG8_SB(1, 1), b3 + hstepB, voffB); PG8_STAGE(PG8_SA(1, 0), a3, voffA);
            PG8_WAIT_V(8); PG8_WAIT_L(0); PG8_BAR; PG8_MMA(1, 0, At, B0); PG8_MMA(1, 1, At, B1); PG8_BAR; PG8_SCHED;
            } else {
            PG8_LDB(B0, 0, 0); PG8_SCHED; PG8_LDA(At, 0, 0); PG8_STAGE(PG8_SA(1, 1), a1 + hstepA, voffA);
            PG8_WAIT_L(8); PG8_BAR; PG8_WAIT_L(0); PG8_MMA(0, 0, At, B0); PG8_BAR; PG8_SCHED;
            PG8_LDB(B1, 0, 1); PG8_STAGE(PG8_SB(0, 0), b2, voffB);
            PG8_BAR; PG8_WAIT_L(0); PG8_MMA(0, 1, At, B1); PG8_BAR;
            PG8_LDA(At, 0, 1); PG8_STAGE(PG8_SA(0, 0), a2, voffA);
            PG8_BAR; PG8_WAIT_L(0); PG8_MMA(1, 0, At, B0); PG8_BAR; PG8_SCHED;
            PG8_STAGE(PG8_SB(0, 1), b2 + hstepB, voffB);
            PG8_WAIT_V(6); PG8_BAR; PG8_MMA(1, 1, At, B1); PG8_BAR;
            PG8_LDB(B0, 1, 0); PG8_SCHED; PG8_LDA(At, 1, 0); PG8_STAGE(PG8_SA(0, 1), a2 + hstepA, voffA);
            PG8_WAIT_L(8); PG8_BAR; PG8_WAIT_L(0); PG8_MMA(0, 0, At, B0); PG8_BAR; PG8_SCHED;
            PG8_LDB(B1, 1, 1); PG8_STAGE(PG8_SB(1, 0), b3, voffB);
            PG8_BAR; PG8_WAIT_L(0); PG8_MMA(0, 1, At, B1); PG8_BAR;
            PG8_LDA(At, 1, 1); PG8_STAGE(PG8_SA(1, 0), a3, voffA);
            PG8_BAR; PG8_WAIT_L(0); PG8_MMA(1, 0, At, B0); PG8_BAR; PG8_SCHED;
            PG8_STAGE(PG8_SB(1, 1), b3 + hstepB, voffB);
            PG8_WAIT_V(6); PG8_BAR; PG8_MMA(1, 1, At, B1); PG8_BAR;
            }
        }
        if constexpr (ALIGN_EPI) { if (wr == 0) PG8_BAR; }
        if constexpr (!Epi::AFTER_DRAIN) { E(acc, cur, wr, wc, fr, fq); S.done(cur); }
        if (!has_next) break;
#pragma unroll
        for (int a = 0; a < 2; ++a)
#pragma unroll
            for (int b = 0; b < 2; ++b)
#pragma unroll
                for (int m = 0; m < 4; ++m)
#pragma unroll
                    for (int n = 0; n < 2; ++n) acc[a][b][m][n] = (f32x4){0.f, 0.f, 0.f, 0.f};
        cur = nxt; cA = nA; cB = nB; ++ui;
        if constexpr (ALIGN_EPI) { if (wr == 1) PG8_BAR; }
    }
    PG8_WAIT_V(0);
    if constexpr (!ALIGN_EPI) { if (wr == 0) PG8_BAR; }
    PG8_BAR;
#undef PG8_SA
#undef PG8_SB
#undef PG8_STAGE
#undef PG8_LDA
#undef PG8_LDB
#undef PG8_MMA
#undef PG8_WAIT_V
#undef PG8_WAIT_L
#undef PG8_BAR
#undef PG8_SCHED
}
}

#define XB_TMO      128
#define XB_XCNT(j)  (256  + 64 * (j))
#define XB_XSUB(j)  (1280 + 64 * (j))
#define XB_XGEN(j)  (2304 + 64 * (j))
#define XB_TOP      3328
#define XB_TOPGEN   3392
#define XCD_BAR_WORDS 3456
#define XB_SPIN_CAP (1u << 18)
__device__ __forceinline__ unsigned xb_ld(unsigned* p)              { return __hip_atomic_load(p, __ATOMIC_RELAXED, __HIP_MEMORY_SCOPE_AGENT); }
__device__ __forceinline__ unsigned xb_add(unsigned* p, unsigned v) { return __hip_atomic_fetch_add(p, v, __ATOMIC_RELAXED, __HIP_MEMORY_SCOPE_AGENT); }
__device__ __forceinline__ unsigned xb_xcc_id() { return (unsigned)__builtin_amdgcn_s_getreg((3 << 11) | 20) & 0xFu; }
#define XB_SPIN(cond, bar) do { unsigned _sp = 0; while (cond) { __builtin_amdgcn_s_sleep(1); \
    if ((++_sp & 255u) == 0u) { if (xb_ld(&(bar)[XB_TMO])) break; if (_sp > XB_SPIN_CAP) { atomicAdd(&(bar)[XB_TMO], 1u); break; } } } } while (0)
struct XcdBarrier { unsigned* bar; unsigned x; volatile LAS unsigned* st; int wave0; };
__device__ __forceinline__ XcdBarrier xcd_barrier_post(unsigned* bar, volatile LAS unsigned* st, int wave0) {
    XcdBarrier b; b.bar = bar; b.x = xb_xcc_id(); b.st = st; b.wave0 = wave0;
    if (wave0 == 0 && fresh_lane() == 0) (void)xb_add(&bar[XB_XCNT(b.x)], 1u);
    return b;
}
__device__ __forceinline__ void xcd_barrier_complete(unsigned* bar, unsigned x, unsigned& nloc, unsigned& nx) {
    const unsigned G = gridDim.x * gridDim.y * gridDim.z;
    unsigned sum, cnt, mine, sp = 0u;
    for (;;) {
        sum = 0u; cnt = 0u; mine = 0u;
#pragma unroll
        for (unsigned j = 0; j < 16; ++j) { const unsigned c = xb_ld(&bar[XB_XCNT(j)]); sum += c; cnt += (c > 0u) ? 1u : 0u; mine = (j == x) ? c : mine; }
        if (sum == G) break;
        __builtin_amdgcn_s_sleep(1);
        if ((++sp & 255u) == 0u) { if (xb_ld(&bar[XB_TMO])) break; if (sp > XB_SPIN_CAP) { atomicAdd(&bar[XB_TMO], 1u); break; } }
    }
    nloc = mine > 0u ? mine : 1u; nx = cnt > 0u ? cnt : 1u;
}
__device__ __forceinline__ void xcd_barrier(const XcdBarrier& b) {
    asm volatile("s_waitcnt vmcnt(0)" ::: "memory");
    __syncthreads();
    if (b.wave0 == 0 && fresh_lane() == 0) {
        unsigned* bar = b.bar;
        __builtin_amdgcn_s_waitcnt(0);
        unsigned nloc = b.st[0], nx = b.st[1];
        if (nloc == 0u) { xcd_barrier_complete(bar, b.x, nloc, nx); b.st[0] = nloc; b.st[1] = nx; }
        const unsigned old = xb_add(&bar[XB_XSUB(b.x)], 1u);
        const unsigned gen = old / nloc;
        if (old + 1u == (gen + 1u) * nloc) {
            __builtin_amdgcn_fence(__ATOMIC_RELEASE, "agent");
            asm volatile("s_waitcnt vmcnt(0)" ::: "memory");
            const unsigned og = xb_add(&bar[XB_TOP], 1u);
            const unsigned tg = og / nx;
            if (og + 1u == (tg + 1u) * nx) xb_add(&bar[XB_TOPGEN], 1u);
            else XB_SPIN(xb_ld(&bar[XB_TOPGEN]) == tg, bar);
            __builtin_amdgcn_fence(__ATOMIC_ACQUIRE, "agent");
            xb_add(&bar[XB_XGEN(b.x)], 1u);
            asm volatile("s_waitcnt vmcnt(0)" ::: "memory");
        } else {
            XB_SPIN(xb_ld(&bar[XB_XGEN(b.x)]) == gen, bar);
            __builtin_amdgcn_fence(__ATOMIC_ACQUIRE, "agent");
            asm volatile("s_waitcnt vmcnt(0)" ::: "memory");
        }
    }
    __syncthreads();
}

struct Args { const float* in[24]; float* out; unsigned char* ws; float freq64[32]; float freq32[16]; int ph_lo, ph_hi; };
enum { I_XP = 0, I_XS, I_CMLA, I_CDSA, I_CSB, I_CDIFF, I_N1, I_G1, I_U1, I_D1, I_NM, I_WIN, I_QN, I_WQB, I_KVN, I_WKVB, I_LAM, I_DN, I_WO, I_N2, I_G2, I_U2, I_D2, I_FN };

__host__ __device__ __forceinline__ int mycol(int j) {
    if (j < 256) return j;
    if (j < 384) return 7 * 256 + (j - 256);
    if (j < 416) { const int t = j - 384; return 4 * 256 + (t >> 4) * 128 + 64 + (t & 15); }
    if (j < 672) { const int t = j - 416; return 1 * 256 + ((t >> 5) & 1) * 128 + (t >> 6) * 32 + (t & 31); }
    if (j < 736) { const int t = j - 672; return 4 * 256 + (t >> 5) * 128 + (t & 31); }
    if (j < 800) return 7 * 256 + 128 + (j - 736);
    if (j < 1312) { const int t = j - 800, h8 = t >> 6; return (2 + (h8 >> 2)) * 256 + ((t >> 5) & 1) * 128 + (h8 & 3) * 32 + (t & 31); }
    if (j < 1376) { const int t = j - 1312; return 4 * 256 + (t >> 5) * 128 + 32 + (t & 31); }
    if (j < 1384) return 7 * 256 + 128 + 64 + (j - 1376);
    if (j < 1640) return 8 * 256 + (j - 1384);
    if (j < 1896) return 9 * 256 + (j - 1640);
    if (j < 2152) return 10 * 256 + (j - 1896);
    if (j < 2408) { const int t = j - 2152; return 5 * 256 + ((t >> 4) & 1) * 128 + (t >> 5) * 16 + (t & 15); }
    if (j < 2664) { const int t = j - 2408; return 6 * 256 + ((t >> 4) & 1) * 128 + (t >> 5) * 16 + (t & 15); }
    return 11 * 256 + (j - 2664);
}
__host__ __device__ __forceinline__ bool mycol_is_pad(int np) { const int t = np >> 8, c = np & 127, hf = (np >> 7) & 1; return (t == 4 && c >= 80) || (t == 7 && hf == 1 && c >= 72); }
typedef __attribute__((address_space(4))) const char* kaptr_t;
__device__ __forceinline__ kaptr_t kargs() { kaptr_t p = (kaptr_t)__builtin_amdgcn_kernarg_segment_ptr(); asm volatile("" : "+s"(p)); return p; }
typedef const float* cfp_t; typedef float* fp_t; typedef unsigned char* ucp_t;
typedef __attribute__((address_space(4))) const cfp_t* ka_cfp_t; typedef __attribute__((address_space(4))) const fp_t* ka_fp_t; typedef __attribute__((address_space(4))) const ucp_t* ka_ucp_t;
typedef __attribute__((address_space(4))) const float* ka_f_t; typedef __attribute__((address_space(4))) const int* ka_i_t;
#define GLB __attribute__((address_space(1)))
#define ARG_IN(i) ((const float*)(GLB const float*)(*(ka_cfp_t)(kargs() + 8 * (i))))
#define ARG_OUT (*(ka_fp_t)(kargs() + 192))
#define ARG_WS (*(ka_ucp_t)(kargs() + 200))
#define ARG_FREQ64(j) (((ka_f_t)(kargs() + 208))[j])
#define ARG_FREQ32(j) (((ka_f_t)(kargs() + 336))[j])
#define ARG_PH_LO (*(ka_i_t)(kargs() + 400))
#define ARG_PH_HI (*(ka_i_t)(kargs() + 404))
static_assert(sizeof(Args) == 408, "kernarg offsets above follow struct Args");
template <int MAP> __device__ __forceinline__ int rowmap(int n) {
    if (MAP == 1) return (n >> 7) * 256 + (n & 127);
    if (MAP == 2) return (n >> 7) * 256 + 128 + (n & 127);
    if (MAP == 3) return FUSE_POST ? mycol(n) : (n < 1376 ? n : (n < 1384 ? H_WI + (n - 1376) : n - 8));
    return n;
}
template <int MAP> __device__ __forceinline__ void transpose_item(const float* W, int K, int N, const float* g, bf16* dst, int ldd, int koff, LAS float* scr, int item, int lane) {
    const int nblk = (N + 31) / 32, kb = item / nblk, nb = item % nblk, k0 = 64 * kb, n0 = 32 * nb;
    const int nn = n0 + (lane & 31); const bool nok = nn < N;
    float tv[32];
#pragma unroll
    for (int i = 0; i < 32; ++i) { const int kk = 2 * i + (lane >> 5); tv[i] = nok ? W[(size_t)(k0 + kk) * N + nn] : 0.f; }
#pragma unroll
    for (int i = 0; i < 32; ++i) { const int kk = 2 * i + (lane >> 5); float v = tv[i]; if (g) v *= g[k0 + kk]; scr[kk * 33 + (lane & 31)] = v; }
    LDS_WAIT(); asm volatile("" ::: "memory");
    const int c = lane & 7;
#pragma unroll
    for (int j = 0; j < 4; ++j) { const int n = (lane >> 3) + 8 * j; const LAS float* s = scr + (8 * c) * 33 + n;
        v4u o; o.x = pk2(s[0 * 33], s[1 * 33]); o.y = pk2(s[2 * 33], s[3 * 33]); o.z = pk2(s[4 * 33], s[5 * 33]); o.w = pk2(s[6 * 33], s[7 * 33]);
        if (n0 + n < N) *(v4u*)(dst + (size_t)rowmap<MAP>(n0 + n) * ldd + koff + k0 + 8 * c) = o; }
    LDS_WAIT(); asm volatile("" ::: "memory");
}
__device__ __forceinline__ void sincos_acc(float ang, float& sn, float& cs) {
    const double a = (double)ang; const double k = rint(a * 0.15915494309189533577); const double x = fma(-k, 6.283185307179586476925, a); const double x2 = x * x;
    double s = 1.0, c = 1.0;
#pragma unroll
    for (int n = 14; n >= 1; --n) { s = 1.0 - x2 * (1.0 / (double)((2 * n) * (2 * n + 1))) * s; c = 1.0 - x2 * (1.0 / (double)((2 * n - 1) * (2 * n))) * c; }
    sn = (float)(x * s); cs = (float)c;
}

#define MFMA32(a, b, c) __builtin_amdgcn_mfma_f32_32x32x16_bf16((a), (b), (c), 0, 0, 0)
__device__ __forceinline__ f32x16 zero16() { f32x16 z;
#pragma unroll
    for (int i = 0; i < 16; ++i) z[i] = 0.f; return z; }
__device__ __forceinline__ s16x4 vtr(const LAS char* p) { return __builtin_bit_cast(s16x4, __builtin_amdgcn_ds_read_tr16_b64_v4i16((LAS s16x4*)p)); }
template <int BASE> __device__ __forceinline__ bf16x8 pack8(const f32x16& p) {
    v4u w; w.x = cvtpk(p[BASE], p[BASE + 1]); w.y = cvtpk(p[BASE + 2], p[BASE + 3]); w.z = cvtpk(p[BASE + 4], p[BASE + 5]); w.w = cvtpk(p[BASE + 6], p[BASE + 7]);
    return __builtin_bit_cast(bf16x8, w);
}
template <int NS> __device__ __forceinline__ void qk(f32x16& p0, f32x16& p1, const LAS char* kb, int strideB, const bf16x8 (&q)[NS]) {
    p0 = zero16(); p1 = zero16();
#pragma unroll
    for (int s = 0; s < NS; ++s) {
        const bf16x8 a0 = *(const LAS bf16x8*)(kb + s * 32);
        const bf16x8 a1 = *(const LAS bf16x8*)(kb + 32 * strideB + s * 32);
        p0 = MFMA32(a0, q[s], p0); p1 = MFMA32(a1, q[s], p1);
    }
}
template <int NDB> __device__ __forceinline__ void pv(f32x16 (&o)[NDB], const f32x16& p0, const f32x16& p1, const LAS char* vb, int strideB) {
    const bf16x8 pb0 = pack8<0>(p0), pb1 = pack8<8>(p0), pb2 = pack8<0>(p1), pb3 = pack8<8>(p1);
#pragma unroll
    for (int kk = 0; kk < 4; ++kk) {
        const bf16x8 pb = kk == 0 ? pb0 : (kk == 1 ? pb1 : (kk == 2 ? pb2 : pb3));
#pragma unroll
        for (int db = 0; db < NDB; ++db) {
            const s16x4 lo = vtr(vb + (16 * kk) * strideB + db * 64);
            const s16x4 hh = vtr(vb + (16 * kk + 8) * strideB + db * 64);
            const bf16x8 a = __builtin_shufflevector(lo, hh, 0, 1, 2, 3, 4, 5, 6, 7);
            o[db] = MFMA32(a, pb, o[db]);
        }
    }
}
template <int NS> __device__ __forceinline__ void k_ld(bf16x8 (&k)[2 * NS], const LAS char* kb, int strideB) {
#pragma unroll
    for (int s = 0; s < NS; ++s) { k[2 * s] = *(const LAS bf16x8*)(kb + s * 32); k[2 * s + 1] = *(const LAS bf16x8*)(kb + 32 * strideB + s * 32); }
}
template <int NS> __device__ __forceinline__ void qk_r(f32x16& p0, f32x16& p1, const bf16x8 (&k)[2 * NS], const bf16x8 (&q)[NS]) {
    p0 = zero16(); p1 = zero16();
#pragma unroll
    for (int s = 0; s < NS; ++s) { p0 = MFMA32(k[2 * s], q[s], p0); p1 = MFMA32(k[2 * s + 1], q[s], p1); }
}
template <int NDB> __device__ __forceinline__ void v_ld(bf16x8 (&v)[4 * NDB], const LAS char* vb, int strideB) {
#pragma unroll
    for (int kk = 0; kk < 4; ++kk)
#pragma unroll
        for (int db = 0; db < NDB; ++db) {
            const s16x4 lo = vtr(vb + (16 * kk) * strideB + db * 64);
            const s16x4 hh = vtr(vb + (16 * kk + 8) * strideB + db * 64);
            v[kk * NDB + db] = __builtin_shufflevector(lo, hh, 0, 1, 2, 3, 4, 5, 6, 7);
        }
}
template <int NDB> __device__ __forceinline__ void pv_r(f32x16 (&o)[NDB], const f32x16& p0, const f32x16& p1, const bf16x8 (&v)[4 * NDB]) {
    const bf16x8 pb0 = pack8<0>(p0), pb1 = pack8<8>(p0), pb2 = pack8<0>(p1), pb3 = pack8<8>(p1);
#pragma unroll
    for (int kk = 0; kk < 4; ++kk) {
        const bf16x8 pb = kk == 0 ? pb0 : (kk == 1 ? pb1 : (kk == 2 ? pb2 : pb3));
#pragma unroll
        for (int db = 0; db < NDB; ++db) o[db] = MFMA32(v[kk * NDB + db], pb, o[db]);
    }
}
template <int NS> __device__ __forceinline__ void qk_h2(f32x16& p0, f32x16& p1, const LAS char* kb, int strideB, const bf16x8 (&q)[NS]) {
    constexpr int H = NS / 2; p0 = zero16(); p1 = zero16();
#pragma unroll
    for (int h = 0; h < 2; ++h) {
        bf16x8 ka[2 * H];
#pragma unroll
        for (int s = 0; s < H; ++s) { ka[2 * s] = *(const LAS bf16x8*)(kb + (h * H + s) * 32); ka[2 * s + 1] = *(const LAS bf16x8*)(kb + 32 * strideB + (h * H + s) * 32); }
        __builtin_amdgcn_sched_barrier(0);
#pragma unroll
        for (int s = 0; s < H; ++s) { p0 = MFMA32(ka[2 * s], q[h * H + s], p0); p1 = MFMA32(ka[2 * s + 1], q[h * H + s], p1); }
    }
}
template <int NDB> __device__ __forceinline__ void v_ld2(bf16x8 (&v)[2 * NDB], const LAS char* vb, int strideB, int kk0) {
#pragma unroll
    for (int k2 = 0; k2 < 2; ++k2)
#pragma unroll
        for (int db = 0; db < NDB; ++db) {
            const s16x4 lo = vtr(vb + (16 * (kk0 + k2)) * strideB + db * 64);
            const s16x4 hh = vtr(vb + (16 * (kk0 + k2) + 8) * strideB + db * 64);
            v[k2 * NDB + db] = __builtin_shufflevector(lo, hh, 0, 1, 2, 3, 4, 5, 6, 7);
        }
}
template <int NDB> __device__ __forceinline__ void pv_h2(f32x16 (&o)[NDB], const f32x16& p0, const f32x16& p1, const LAS char* vb, int strideB, const bf16x8 (&v01)[2 * NDB]) {
    const bf16x8 pb0 = pack8<0>(p0), pb1 = pack8<8>(p0), pb2 = pack8<0>(p1), pb3 = pack8<8>(p1);
    bf16x8 v23[2 * NDB]; v_ld2<NDB>(v23, vb, strideB, 2);
    __builtin_amdgcn_sched_barrier(0);
#pragma unroll
    for (int db = 0; db < NDB; ++db) o[db] = MFMA32(v01[db], pb0, o[db]);
#pragma unroll
    for (int db = 0; db < NDB; ++db) o[db] = MFMA32(v01[NDB + db], pb1, o[db]);
#pragma unroll
    for (int db = 0; db < NDB; ++db) o[db] = MFMA32(v23[db], pb2, o[db]);
#pragma unroll
    for (int db = 0; db < NDB; ++db) o[db] = MFMA32(v23[NDB + db], pb3, o[db]);
}
template <int NDB> __device__ __forceinline__ void softmax_step(f32x16& p0, f32x16& p1, float& m, float& l, f32x16 (&o)[NDB]) {
    float mx = p0[0];
#pragma unroll
    for (int r = 1; r < 16; ++r) mx = fmaxf(mx, p0[r]);
#pragma unroll
    for (int r = 0; r < 16; ++r) mx = fmaxf(mx, p1[r]);
    { const unsigned ux_ = __float_as_uint(mx); const auto sw_ = __builtin_amdgcn_permlane32_swap(ux_, ux_, false, false);
      mx = fmaxf(__uint_as_float(sw_[0]), __uint_as_float(sw_[1])); }
    const float mn = fmaxf(m, mx);
    if (__any(mn > m)) {
        const float alpha = __builtin_amdgcn_exp2f(m - mn);
        l *= alpha;
#pragma unroll
        for (int db = 0; db < NDB; ++db)
#pragma unroll
            for (int r = 0; r < 16; ++r) o[db][r] *= alpha;
    }
    m = mn;
    typedef float f32x2_t __attribute__((ext_vector_type(2)));
    const f32x2_t mn2 = {mn, mn}; f32x2_t s2 = {0.f, 0.f};
#pragma unroll
    for (int r = 0; r < 8; ++r) { f32x2_t d = {p0[2 * r], p0[2 * r + 1]}; d -= mn2; d.x = __builtin_amdgcn_exp2f(d.x); d.y = __builtin_amdgcn_exp2f(d.y); p0[2 * r] = d.x; p0[2 * r + 1] = d.y; s2 += d; }
#pragma unroll
    for (int r = 0; r < 8; ++r) { f32x2_t d = {p1[2 * r], p1[2 * r + 1]}; d -= mn2; d.x = __builtin_amdgcn_exp2f(d.x); d.y = __builtin_amdgcn_exp2f(d.y); p1[2 * r] = d.x; p1[2 * r + 1] = d.y; s2 += d; }
    l += s2.x + s2.y;
}
__device__ __forceinline__ v4u cvt8f(const v4u a, const v4u b) {
    const unsigned a0 = a[0], a1 = a[1], a2 = a[2], a3 = a[3], b0 = b[0], b1 = b[1], b2 = b[2], b3 = b[3]; v4u v;
    v[0] = cvtpk(__uint_as_float(a0), __uint_as_float(a1)); v[1] = cvtpk(__uint_as_float(a2), __uint_as_float(a3));
    v[2] = cvtpk(__uint_as_float(b0), __uint_as_float(b1)); v[3] = cvtpk(__uint_as_float(b2), __uint_as_float(b3)); return v; }
template <int W, int STRIDE, bool F32PF = true, int ROWS = 64> struct TileLd {
    static constexpr int CH = W / 8, RPP = 512 / CH, PER = (ROWS + RPP - 1) / RPP, STRB = (W + 8) * 2;
    int nrows_ = ROWS;
    v4u raw[PER][F32PF ? 2 : 1];
    const char* src_;
    __device__ __forceinline__ void init() { src_ = nullptr;
#pragma unroll
        for (int i = 0; i < PER; ++i) { raw[i][0] = (v4u){0u, 0u, 0u, 0u}; raw[i][F32PF ? 1 : 0] = (v4u){0u, 0u, 0u, 0u}; } }
    __device__ __forceinline__ void issue(const void* src, bool f32, int tid) {
        src_ = (const char*)src;
        if (!F32PF && f32) return;
        const int row0 = tid / CH, cc = tid % CH; const bool act = tid < RPP * CH;
        const unsigned loff = (unsigned)(row0 * STRIDE + cc * 8);
#pragma unroll
        for (int i = 0; i < PER; ++i) {
            if (act && (row0 + i * RPP < nrows_)) {
                if (F32PF && f32) { const GLB v4u* p = (const GLB v4u*)(src_ + (size_t)i * RPP * STRIDE * 4 + (size_t)loff * 4); raw[i][0] = p[0]; raw[i][F32PF ? 1 : 0] = p[1]; }
                else { raw[i][0] = *(const GLB v4u*)(src_ + (size_t)i * RPP * STRIDE * 2 + (size_t)loff * 2); } } }
    }
    __device__ __forceinline__ static v4u cvt8(const v4u a, const v4u b) { return cvt8f(a, b); }
    __device__ __forceinline__ void store(LAS char* tile, bool f32, int tid) {
        const int row0 = tid / CH, cc = tid % CH; const bool act = tid < RPP * CH;
        const unsigned loff = (unsigned)(row0 * STRIDE + cc * 8);
        LAS char* dst = tile + row0 * STRB + cc * 16;
#pragma unroll
        for (int i = 0; i < PER; ++i) {
            if (act && (row0 + i * RPP < nrows_)) { v4u v = raw[i][0];
                if (f32) {
                    if (F32PF) v = cvt8(raw[i][0], raw[i][F32PF ? 1 : 0]);
                    else { const GLB v4u* p = (const GLB v4u*)(src_ + (size_t)i * RPP * STRIDE * 4 + (size_t)loff * 4); v = cvt8(p[0], p[1]); } }
                *(LAS v4u*)(dst + i * RPP * STRB) = v; } }
    }
};
constexpr int T512_STRB = 1040, T512_BYTES = 64 * T512_STRB;
__device__ __forceinline__ void t512_dma(const void* src, LAS char* buf, int wave, int lane) {
#pragma unroll
    for (int j = 0; j < 8; ++j) { const int row = wave * 8 + j;
        __builtin_amdgcn_global_load_lds((const unsigned*)((const char*)src + (size_t)row * 1024 + lane * 16), (LAS unsigned*)(buf + row * T512_STRB), 16, 0, 0); }
}
__device__ __forceinline__ void t512_cvt(const void* src, LAS char* buf, int tid) {
    const int row0 = tid >> 6, cc = tid & 63; const char* p0 = (const char*)src + (size_t)row0 * 2048 + cc * 32; LAS char* d0 = buf + row0 * T512_STRB + cc * 16;
    v4u a[8], b[8];
#pragma unroll
    for (int i = 0; i < 8; ++i) { const GLB v4u* p = (const GLB v4u*)(p0 + (size_t)i * 8 * 2048); a[i] = p[0]; b[i] = p[1]; }
    __builtin_amdgcn_sched_barrier(0);
#pragma unroll
    for (int i = 0; i < 8; ++i) *(LAS v4u*)(d0 + i * 8 * T512_STRB) = cvt8f(a[i], b[i]);
}
__device__ __forceinline__ int crow(int r, int hi) { return (r & 3) + 8 * (r >> 2) + 4 * hi; }

struct UnitId { int sample, b, c, nt, qrow0, krow0; };
constexpr int QLIST = 4 + 4 * 32;
__device__ __forceinline__ UnitId decode_unit(int x, int idx) {
    UnitId u;
    if (idx < 4) { u.sample = 1; u.b = x + 8 * idx; u.c = 0; u.nt = PAST / 64 + 1; u.qrow0 = MP + u.b * DSEQ; u.krow0 = MP + u.b * DSEQ; }
    else { const int j = idx - 4; u.sample = 0; u.c = 31 - (j & 31); u.b = x + 8 * (j >> 5); u.nt = u.c + 1; u.qrow0 = u.b * SEQ + u.c * 64; u.krow0 = u.b * SEQ; }
    return u;
}
constexpr int N_UNITS = NB + NB * (SEQ / 64);

__device__ __forceinline__ const void* tile_src(const UnitId& u, int t, const float* cache_lb  , const bf16* rows, int W, int coloff, bool& f32) {
    if (u.sample && t < PAST / 64) { f32 = true; return cache_lb + (size_t)t * 64 * W + coloff; }
    f32 = false; const int tt = u.sample ? 0 : t;
    return rows + (size_t)(u.krow0 + tt * 64) * W + coloff;
}

template <int NQ> __device__ __forceinline__ void hist_pick(LAS unsigned* hist, int lane, int (&kk)[NQ], int (&bin_out)[NQ], unsigned (&cnt_out)[NQ], const bool (&act)[NQ]) {
    unsigned sl[NQ], incl[NQ];
#pragma unroll
    for (int a = 0; a < NQ; ++a) { sl[a] = 0u;
#pragma unroll
        for (int j = 0; j < 8; ++j) { const v4u c4 = ((LAS v4u*)(hist + a * 2048))[lane * 8 + j]; sl[a] += (c4[0] + c4[1]) + (c4[2] + c4[3]); }
        incl[a] = sl[a]; }
#pragma unroll
    for (int o = 1; o < 64; o <<= 1) {
        unsigned t2[NQ];
#pragma unroll
        for (int a = 0; a < NQ; ++a) t2[a] = (unsigned)__shfl_down((int)incl[a], o);
#pragma unroll
        for (int a = 0; a < NQ; ++a) incl[a] += (lane + o < 64) ? t2[a] : 0u; }
    int hl[NQ]; unsigned above_h[NQ], v[NQ], inc2[NQ];
#pragma unroll
    for (int a = 0; a < NQ; ++a) { const unsigned above_l = incl[a] - sl[a]; const bool hit = (above_l < (unsigned)kk[a]) && ((unsigned)kk[a] <= incl[a]);
        const unsigned long long hb = __ballot(hit); hl[a] = hb ? (int)__builtin_ctzll(hb) : 0; above_h[a] = (unsigned)__builtin_amdgcn_readlane((int)above_l, hl[a]);
        v[a] = (lane < 32) ? hist[a * 2048 + hl[a] * 32 + lane] : 0u; inc2[a] = v[a]; }
#pragma unroll
    for (int o = 1; o < 32; o <<= 1) {
        unsigned t2[NQ];
#pragma unroll
        for (int a = 0; a < NQ; ++a) t2[a] = (unsigned)__shfl_down((int)inc2[a], o);
#pragma unroll
        for (int a = 0; a < NQ; ++a) inc2[a] += (lane + o < 32) ? t2[a] : 0u; }
#pragma unroll
    for (int a = 0; a < NQ; ++a) { const unsigned above2 = above_h[a] + inc2[a] - v[a];
        const bool hit2 = (lane < 32) && (above2 < (unsigned)kk[a]) && ((unsigned)kk[a] <= above2 + v[a]);
        const unsigned long long hb2 = __ballot(hit2); const int l2 = hb2 ? (int)__builtin_ctzll(hb2) : 0;
        if (act[a]) { bin_out[a] = hl[a] * 32 + l2; kk[a] -= __builtin_amdgcn_readlane((int)above2, l2); cnt_out[a] = (unsigned)__builtin_amdgcn_readlane((int)v[a], l2); } }
}
template <int NI, int NQ, int ES = 1> __device__ __forceinline__ void dsa_select(const float* srow, int nt, LAS unsigned* hist, unsigned long long* mrow, int lane) {
    float xv[NQ][NI]; float lo[NQ], hi[NQ];
#pragma unroll
    for (int a = 0; a < NQ; ++a) { lo[a] = 3e38f; hi[a] = -3e38f; }
    { const int nt_ = opaque_s(nt);
#pragma unroll
    for (int i = 0; i < NI; ++i) {
#pragma unroll
        for (int a = 0; a < NQ; ++a) xv[a][i] = 0.f;
        if (i < nt_) {
#pragma unroll
            for (int a = 0; a < NQ; ++a) { xv[a][i] = srow[(size_t)a * SC_LS + (size_t)(i * 64 + lane) * ES]; lo[a] = fminf(lo[a], xv[a][i]); hi[a] = fmaxf(hi[a], xv[a][i]); } } } }
#pragma unroll
    for (int o = 1; o < 64; o <<= 1)
#pragma unroll
        for (int a = 0; a < NQ; ++a) { lo[a] = fminf(lo[a], __shfl_xor(lo[a], o)); hi[a] = fmaxf(hi[a], __shfl_xor(hi[a], o)); }
    float scale[NQ]; int kk[NQ], b0[NQ]; unsigned c0n[NQ];
#pragma unroll
    for (int a = 0; a < NQ; ++a) { const float range = hi[a] - lo[a]; scale[a] = (range > 1e-30f) ? 2047.0f / range : 0.f; kk[a] = 256; b0[a] = 0; c0n[a] = 0u; }
#pragma unroll
    for (int j = 0; j < 8 * NQ; ++j) ((LAS v4u*)hist)[lane + 64 * j] = (v4u){0u, 0u, 0u, 0u};
    LDS_WAIT();
    { const int nt_ = opaque_s(nt); float sc_[NQ];
#pragma unroll
    for (int a = 0; a < NQ; ++a) sc_[a] = opaque_vf(scale[a]);
#pragma unroll
    for (int i = 0; i < NI; ++i) if (i < nt_) {
#pragma unroll
        for (int a = 0; a < NQ; ++a) { const int b = min(2047, (int)((xv[a][i] - lo[a]) * sc_[a])); __hip_atomic_fetch_add(hist + a * 2048 + b, 1u, __ATOMIC_RELAXED, __HIP_MEMORY_SCOPE_WORKGROUP); } } }
    LDS_WAIT();
    { bool all_[NQ];
#pragma unroll
      for (int a = 0; a < NQ; ++a) all_[a] = true;
      hist_pick<NQ>(hist, lane, kk, b0, c0n, all_); }
    unsigned prefix[NQ], pmask[NQ]; bool whole[NQ], live[NQ]; bool any_live = false;
#pragma unroll
    for (int a = 0; a < NQ; ++a) { prefix[a] = 0u; pmask[a] = 0u; whole[a] = ((unsigned)kk[a] == c0n[a]); live[a] = !whole[a]; any_live = any_live || live[a]; }
    if (any_live) {
#pragma unroll
        for (int pass = 0; pass < 3; ++pass) {
            const int SH = pass == 0 ? 21 : (pass == 1 ? 10 : 0); const unsigned BM_ = pass == 2 ? 1023u : 2047u;
#pragma unroll
            for (int j = 0; j < 8 * NQ; ++j) ((LAS v4u*)hist)[lane + 64 * j] = (v4u){0u, 0u, 0u, 0u};
            LDS_WAIT();
            const int nt_ = opaque_s(nt); float sc_[NQ];
#pragma unroll
            for (int a = 0; a < NQ; ++a) sc_[a] = opaque_vf(scale[a]);
#pragma unroll
            for (int i = 0; i < NI; ++i) if (i < nt_) {
#pragma unroll
                for (int a = 0; a < NQ; ++a) { const int b = min(2047, (int)((xv[a][i] - lo[a]) * sc_[a])); const unsigned bts = __float_as_uint(xv[a][i]); const unsigned x = bts ^ ((bts >> 31) ? 0xFFFFFFFFu : 0x80000000u);
                    if (live[a] && b == b0[a] && (x & pmask[a]) == prefix[a]) __hip_atomic_fetch_add(hist + a * 2048 + ((x >> SH) & BM_), 1u, __ATOMIC_RELAXED, __HIP_MEMORY_SCOPE_WORKGROUP); } }
            LDS_WAIT();
            bool more = false; int bin[NQ]; unsigned c_u[NQ];
#pragma unroll
            for (int a = 0; a < NQ; ++a) { bin[a] = 0; c_u[a] = 0u; }
            hist_pick<NQ>(hist, lane, kk, bin, c_u, live);
#pragma unroll
            for (int a = 0; a < NQ; ++a) if (live[a]) {
                prefix[a] |= ((unsigned)bin[a] & BM_) << SH; pmask[a] |= BM_ << SH;
                if ((unsigned)kk[a] == c_u[a]) live[a] = false;
                more = more || live[a]; }
            if (!more) break;
        }
    }
    const int nt2_ = opaque_s(nt); float sc2_[NQ];
#pragma unroll
    for (int a = 0; a < NQ; ++a) sc2_[a] = opaque_vf(scale[a]);
#pragma unroll
    for (int i = 0; i < NI; ++i) if (i < nt2_) {
#pragma unroll
        for (int a = 0; a < NQ; ++a) { const int b = min(2047, (int)((xv[a][i] - lo[a]) * sc2_[a])); const unsigned bts = __float_as_uint(xv[a][i]); const unsigned x = bts ^ ((bts >> 31) ? 0xFFFFFFFFu : 0x80000000u);
            const bool selq = b > b0[a] || (b == b0[a] && (whole[a] || x >= prefix[a]));
            const unsigned long long mw = __ballot(selq); if (lane == 0) mrow[(size_t)a * MK_LS + i] = mw; } }
}
#define FRESH_TID() const int tid_o = wave0 * 64 + fresh_lane(); const int tid = tid_o, lane = tid & 63, wave = __builtin_amdgcn_readfirstlane(tid >> 6); (void)lane; (void)wave
__global__ void __launch_bounds__(NWAVES * 64, 2) fwd_kernel(Args args) {
    extern __shared__ __attribute__((aligned(16))) unsigned char lds_raw[];
    LAS unsigned char* lds = (LAS unsigned char*)lds_raw;
    volatile LAS unsigned* MISC = (volatile LAS unsigned*)(lds + MISC_OFF);
    const int wave0 = __builtin_amdgcn_readfirstlane((int)threadIdx.x >> 6);
    const int tid = wave0 * 64 + fresh_lane();
    const int G = gridDim.x;
    unsigned char* ws = args.ws;
    gu32* ctl = (gu32*)(ws + WS_CTL);
    float* const out = args.out;
#define X (out + O_Y)
#define XB ((bf16*)(ws + WS_XB))
#define HB ((bf16*)(ws + WS_REGA))
#define ACT ((bf16*)(ws + WS_REGA))
#define QA ((bf16*)(ws + WS_QA))
#define QB ((bf16*)(ws + WS_QB))
#define QI ((bf16*)(ws + WS_QI))
#define QC ((bf16*)(ws + WS_QC))
#define QD ((bf16*)(ws + WS_QD))
#define WI ((float*)(ws + WS_WI))
#define RA ((bf16*)(ws + WS_RA))
#define RB ((bf16*)(ws + WS_RB))
#define RC ((bf16*)(ws + WS_RC))
#define RD ((bf16*)(ws + WS_RD))
#define CC ((bf16*)(ws + WS_CC))
#define CQ ((bf16*)(ws + WS_REGA + (size_t)300 * MiB))
#define CKV ((bf16*)(ws + WS_REGA + (size_t)340 * MiB))
#define SSQP ((float*)(ws + WS_SSQP))
#define LAMF ((float*)(ws + WS_MISC))
#define ROPE64 ((float2*)(ws + WS_MISC + MISC_ROPE64))
#define ROPE32 ((float2*)(ws + WS_MISC + MISC_ROPE32))
    for (int u = tid; u < (LDS_BYTES - LDSCTL_OFF) / 4; u += NWAVES * 64) ((LAS unsigned*)(lds + LDSCTL_OFF))[u] = 0u;
    __syncthreads();
    XcdBarrier bar; bar.bar = (unsigned*)(ctl + CW_BAR); bar.x = 0; bar.st = nullptr; bar.wave0 = wave0;
    const int lo = args.ph_lo, hi_ph = args.ph_hi;
    if (hi_ph - lo > 1) bar = xcd_barrier_post((unsigned*)(ctl + CW_BAR), MISC + 8, wave0);
#define IN(k) (opaque_s(lo) <= (k) && (k) < opaque_s(hi_ph))
#define BOTH(k) (IN(k) && IN((k) + 1))
#define GRID_BAR() xcd_barrier(bar)

    if (EN_PH(0) && IN(0)) {
        FRESH_TID();
        for (int p0rep = 0; p0rep < P0_REPS; ++p0rep) {
        LAS float* scr = (LAS float*)(lds + wave * 16384);
        const int gw = blockIdx.x * NWAVES + wave, NGW = G * NWAVES;
        for (int l = 0; l < DEPTH; ++l) {
            unsigned char* wl = ws + WS_W + (size_t)l * W_LAYER;
            const int I_GU = (DM / 64) * (DFF / 32), I_D = (DFF / 64) * (DM / 32), I_INN = (DM / 64) * ((NIN + 31) / 32), I_O = (768 / 64) * (DM / 32);
            const int NIT = 4 * I_GU + 2 * I_D + I_INN + I_O;
            for (int it = gw; it < NIT; it += NGW) {
                int r = it;
                if (r < I_GU) { transpose_item<1>(ARG_IN(I_G1) + (size_t)l * DM * DFF, DM, DFF, ARG_IN(I_N1) + l * DM, (bf16*)(wl + W_GU1), DM, 0, scr, r, lane); continue; } r -= I_GU;
                if (r < I_GU) { transpose_item<2>(ARG_IN(I_U1) + (size_t)l * DM * DFF, DM, DFF, ARG_IN(I_N1) + l * DM, (bf16*)(wl + W_GU1), DM, 0, scr, r, lane); continue; } r -= I_GU;
                if (r < I_GU) { transpose_item<1>(ARG_IN(I_G2) + (size_t)l * DM * DFF, DM, DFF, ARG_IN(I_N2) + l * DM, (bf16*)(wl + W_GU2), DM, 0, scr, r, lane); continue; } r -= I_GU;
                if (r < I_GU) { transpose_item<2>(ARG_IN(I_U2) + (size_t)l * DM * DFF, DM, DFF, ARG_IN(I_N2) + l * DM, (bf16*)(wl + W_GU2), DM, 0, scr, r, lane); continue; } r -= I_GU;
                if (r < I_D) { transpose_item<0>(ARG_IN(I_D1) + (size_t)l * DFF * DM, DFF, DM, nullptr, (bf16*)(wl + W_D1), DFF, 0, scr, r, lane); continue; } r -= I_D;
                if (r < I_D) { transpose_item<0>(ARG_IN(I_D2) + (size_t)l * DFF * DM, DFF, DM, nullptr, (bf16*)(wl + W_D2), DFF, 0, scr, r, lane); continue; } r -= I_D;
                if (r < I_INN) { transpose_item<3>(ARG_IN(I_WIN) + (size_t)l * DM * NIN, DM, NIN, ARG_IN(I_NM) + l * DM, (bf16*)(wl + W_IN), DM, 0, scr, r, lane); continue; } r -= I_INN;
                transpose_item<0>(ARG_IN(I_WO) + (size_t)l * DM * DM + (size_t)256 * DM, 768, DM, nullptr, (bf16*)(wl + W_OUT), KOUT, 512, scr, r, lane);
            }
            const int gt = blockIdx.x * 512 + tid, NGT = G * 512;
            if (FUSE_POST) { for (int i = gt; i < NINP * (DM / 8); i += NGT) { const int np = i / (DM / 8); if (mycol_is_pad(np)) *(v4u*)((bf16*)(wl + W_IN) + (size_t)np * DM + 8 * (i % (DM / 8))) = (v4u){0u, 0u, 0u, 0u}; } }
            else for (int i = gt; i < (NINP - NIN) * DM; i += NGT) ((bf16*)(wl + W_IN))[(size_t)NIN * DM + i] = 0;
            for (int i = gt; i < (NQP - NQ) * 256; i += NGT) ((bf16*)(wl + W_Q))[(size_t)NQ * 256 + i] = 0;
            const float* wqb = ARG_IN(I_WQB) + (size_t)l * 256 * 384; const float* wkvb = ARG_IN(I_WKVB) + (size_t)l * 128 * 512; const float* qn = ARG_IN(I_QN) + l * 256;
            const float scaleA = 0.10206207261596575f * LOG2E;
            for (int i = gt; i < NQ * 256; i += NGT) {
                const int np = i >> 8, k = i & 255, hh = np / 160, c = np % 160; float v;
                if (c < 128) { float s = 0.f; for (int e = 0; e < 64; ++e) s += wqb[(size_t)k * 384 + hh * 96 + e] * wkvb[(size_t)c * 512 + hh * 128 + e]; v = s; }
                else v = wqb[(size_t)k * 384 + hh * 96 + 64 + (c - 128)];
                ((bf16*)(wl + W_Q))[(size_t)np * 256 + k] = (bf16)f2bf(v * qn[k] * scaleA);
            }
            const float* wo = ARG_IN(I_WO) + (size_t)l * DM * DM;
            for (int i = gt; i < 512 * DM; i += NGT) {
                const int n = i & 1023, kc = i >> 10, hh = kc >> 7, c = kc & 127; float s = 0.f;
                for (int e = 0; e < 64; ++e) s += wkvb[(size_t)c * 512 + hh * 128 + 64 + e] * wo[(size_t)(hh * 64 + e) * DM + n];
                ((bf16*)(wl + W_OUT))[(size_t)n * KOUT + kc] = (bf16)f2bf(s);
            }
            if (blockIdx.x == 0 && wave == 0) {
                const float* lf = ARG_IN(I_LAM) + l * 128;
                float a = lane < 32 ? lf[lane] * lf[32 + lane] : 0.f, b = lane < 32 ? lf[64 + lane] * lf[96 + lane] : 0.f;
                a = wave_sum(a); b = wave_sum(b);
                const float lam_init = 0.8f - 0.6f * expf(-0.3f * (float)l);
                if (lane == 0) LAMF[l] = expf(a) - expf(b) + lam_init;
            }
        }
        {
            const int gt = blockIdx.x * 512 + tid, NGT = G * 512;
            for (int i = gt; i < 2112 * 48; i += NGT) {
                const int pidx = i / 48, j = i % 48; const float pos = (float)(pidx < 2048 ? pidx : 4096 + (pidx - 2048));
                const float fr = j < 32 ? ARG_FREQ64(j) : ARG_FREQ32(j - 32);
                float sn, cs; sincos_acc(pos * fr, sn, cs);
                if (j < 32) ROPE64[pidx * 32 + j] = make_float2(cs, sn); else ROPE32[pidx * 16 + (j - 32)] = make_float2(cs, sn);
            }
        }
        for (int m = 2 * gw; m < M; m += 2 * NGW) {
            f32x4 v[2][4]; float sq[2];
#pragma unroll
            for (int r2 = 0; r2 < 2; ++r2) { const int mr = m + r2; const float* xr = (mr < MP) ? ARG_IN(I_XP) + (size_t)mr * DM : ARG_IN(I_XS) + (size_t)(mr - MP) * DM; const f32x4* x4 = (const f32x4*)xr + lane;
#pragma unroll
                for (int j = 0; j < 4; ++j) v[r2][j] = x4[64 * j]; }
#pragma unroll
            for (int r2 = 0; r2 < 2; ++r2) { const int mr = m + r2; float s2 = 0.f; unsigned long long* o8 = (unsigned long long*)(XB + (size_t)mr * DM) + lane;
#pragma unroll
                for (int j = 0; j < 4; ++j) { const f32x4 w = v[r2][j]; s2 += (w.x * w.x + w.y * w.y) + (w.z * w.z + w.w * w.w);
                    o8[64 * j] = (unsigned long long)cvtpk(w.x, w.y) | ((unsigned long long)cvtpk(w.z, w.w) << 32); }
                sq[r2] = wave_sum(s2); }
#pragma unroll
            for (int r2 = 0; r2 < 2; ++r2) if (lane < 16) SSQP[(size_t)(m + r2) * 16 + lane] = lane == 0 ? sq[r2] : 0.f;
        }
        }
        if (BOTH(0)) GRID_BAR();
    }

#pragma unroll 1
    for (int l = 0; l < DEPTH; ++l) {
        const int pb = 1 + 8 * l;
        unsigned char* wl = ws + WS_W + (size_t)l * W_LAYER;
        float* ssqA = SSQP + (size_t)l * M * 16; float* ssqAn = SSQP + (size_t)(l + 1) * M * 16; float* ssqB = SSQP + (size_t)(3 + l) * M * 16; float* ssqC = SSQP + (size_t)(5 + l) * M * 16; float* ssqQ = SSQP + (size_t)7 * M * 16 + (size_t)l * M * 4; float* ssqK = SSQP + (size_t)7 * M * 16 + (size_t)(2 + l) * M * 4; (void)ssqK;
        if (EN_PH(1) && IN(pb + 0)) {
            pg8::Gemm g{XB, (const bf16*)(wl + W_GU1), M, NGU, DM, DM}; pg8::StaticOrder S; S.init(M, NGU, G, (int)blockIdx.x);
            pg8::EpiSwiGLU E{ACT, ssqA};
            for (int grep = 0; grep < GU_REPS; ++grep)
            pg8::gemm_phase<pg8::EpiSwiGLU, pg8::StaticOrder, true, true>(lds, g, S, E, wave0);
            if (BOTH(pb + 0)) GRID_BAR();
        }
#define SPLITK_SAMPLE(WOFF) do { const int sl_ = (int)blockIdx.x & 7, un_ = (int)blockIdx.x >> 3; const int kb_ = sl_ < 6 ? 3 * sl_ : 18 + 2 * (sl_ - 6), kl_ = sl_ < 6 ? 3 : 2; \
        pg8::Gemm g2{ACT + (size_t)(MP + 256 * (un_ >> 2)) * DFF + kb_ * 128, (const bf16*)(wl + WOFF) + (size_t)(256 * (un_ & 3)) * DFF + kb_ * 128, 256, 256, kl_ * 128, DFF, DFF}; \
        pg8::OneUnit S2; pg8::EpiPartial E2{(float*)(ws + WS_QA) + (size_t)(un_ * 8 + sl_) * 32 * 512 * 4}; \
        pg8::gemm_phase<pg8::EpiPartial, pg8::OneUnit, true, true>(lds, g2, S2, E2, wave0); } while (0)
        if (EN_PH(2) && IN(pb + 1)) {
            pg8::Gemm g{ACT, (const bf16*)(wl + W_D1), M, DM, DFF, DFF}; pg8::StaticOrder S; S.init(MP, DM, G, (int)blockIdx.x);
            if (l == 0) { pg8::EpiResid<true> E{ARG_IN(I_XP), ARG_IN(I_XS) - (size_t)MP * DM, XB, ssqB, 0.5f};
                pg8::gemm_phase<pg8::EpiResid<true>, pg8::StaticOrder, true, true>(lds, g, S, E, wave0); }
            else { pg8::EpiResid<false> E{nullptr, nullptr, XB, ssqB, 0.5f};
                pg8::gemm_phase<pg8::EpiResid<false>, pg8::StaticOrder, true, true>(lds, g, S, E, wave0); }
            SPLITK_SAMPLE(W_D1);
            GRID_BAR();
            { FRESH_TID(); const int un_ = (int)blockIdx.x >> 3, j_ = (int)blockIdx.x & 7; const float* Pu = (const float*)(ws + WS_QA) + (size_t)un_ * 8 * 32 * 512 * 4;
              if (l == 0) pg8::resid_fixup<true>(Pu, MP / 256 + (un_ >> 2), un_ & 3, j_ >> 2, j_ & 3, ARG_IN(I_XS) - (size_t)MP * DM, XB, ssqB, 0.5f, tid);
              else pg8::resid_fixup<false>(Pu, MP / 256 + (un_ >> 2), un_ & 3, j_ >> 2, j_ & 3, nullptr, XB, ssqB, 0.5f, tid); }
            if (BOTH(pb + 1)) GRID_BAR();
        }
        if (EN_PH(3) && IN(pb + 2)) {
            pg8::Gemm g{XB, (const bf16*)(wl + W_IN), M, NINP, DM, DM}; pg8::StaticOrder S; S.init(M, NINP, G, (int)blockIdx.x);
#if FUSE_POST
#if IN_STAGGER_TICKS > 0
            if (blockIdx.x & 1) { const unsigned long long t0 = __builtin_amdgcn_s_memrealtime(); while (__builtin_amdgcn_s_memrealtime() - t0 < (unsigned long long)IN_STAGGER_TICKS) __builtin_amdgcn_s_sleep(8); }
#endif
            pg8::EpiInFused E{ws, out, l};
            pg8::gemm_phase<pg8::EpiInFused, pg8::StaticOrder, true, true>(lds, g, S, E, wave0);
#else
            pg8::EpiScaleBf16 E{HB, NINP, ssqB, 16, 1.0f / 1024.0f, ssqQ};
            pg8::gemm_phase<pg8::EpiScaleBf16, pg8::StaticOrder, true, true>(lds, g, S, E, wave0);
#endif
            if (BOTH(pb + 2)) GRID_BAR();
        }
        if (EN_PH(4) && IN(pb + 3)) {
#if FUSE_POST
            {
                pg8::Gemm g{CQ, (const bf16*)(wl + W_Q), M, NQP, 256, 256}; pg8::StaticOrder S; S.init(M, NQP, G, (int)blockIdx.x);
                pg8::EpiScaleBf16 E{QA, NQP, ssqQ, 4, 1.0f / 256.0f, nullptr};
                pg8::gemm_phase<pg8::EpiScaleBf16, pg8::StaticOrder, true, true>(lds, g, S, E, wave0);
            }
            {
                FRESH_TID();
                const float* kvn = ARG_IN(I_KVN) + l * 128; const int gw = blockIdx.x * NWAVES + wave, NGW = G * NWAVES; const int c16 = lane & 15, sub = lane >> 4;
                for (int row4 = gw * 4; row4 < M; row4 += NGW * 4) { const int row = row4 + sub;
                    const bool smp = row >= MP; const int rr = smp ? row - MP : row;
                    const v4u w = *(const v4u*)(CKV + (size_t)row * 128 + 8 * c16); float x[8];
                    x[0] = __uint_as_float(w[0] << 16); x[1] = __uint_as_float(w[0] & 0xffff0000u); x[2] = __uint_as_float(w[1] << 16); x[3] = __uint_as_float(w[1] & 0xffff0000u);
                    x[4] = __uint_as_float(w[2] << 16); x[5] = __uint_as_float(w[2] & 0xffff0000u); x[6] = __uint_as_float(w[3] << 16); x[7] = __uint_as_float(w[3] & 0xffff0000u);
                    const float rs = 1.0f / sqrtf(ssq_sum4(ssqK, row) * (1.0f / 128.0f) + EPS); const f32x4 g0 = *(const f32x4*)(kvn + 8 * c16), g1 = *(const f32x4*)(kvn + 8 * c16 + 4);
#pragma unroll
                    for (int e = 0; e < 4; ++e) { x[e] = x[e] * rs * g0[e]; x[4 + e] = x[4 + e] * rs * g1[e]; }
                    float* od = out + (smp ? O_MLA_S + ((size_t)l * MS + rr) * 160 : O_MLA_P + ((size_t)l * MP + rr) * 160) + 8 * c16;
                    *(f32x4*)od = (f32x4){x[0], x[1], x[2], x[3]}; *(f32x4*)(od + 4) = (f32x4){x[4], x[5], x[6], x[7]};
                    *(v4u*)(RA + (size_t)row * 160 + 8 * c16) = (v4u){cvtpk(x[0], x[1]), cvtpk(x[2], x[3]), cvtpk(x[4], x[5]), cvtpk(x[6], x[7])}; }
            }
            if (BOTH(pb + 3)) GRID_BAR();
#else
            for (int prep = 0; prep < POST_REPS; ++prep) {
            {
                pg8::Gemm g{HB, (const bf16*)(wl + W_Q), M, NQP, 256, NINP}; pg8::StaticOrder S; S.init(M, NQP, G, (int)blockIdx.x);
                pg8::EpiScaleBf16 E{QA, NQP, ssqQ, 4, 1.0f / 256.0f, nullptr};
                pg8::gemm_phase<pg8::EpiScaleBf16, pg8::StaticOrder, true, true>(lds, g, S, E, wave0);
            }
            FRESH_TID();
            const float* kvn = ARG_IN(I_KVN) + l * 128;
            const float scaleB = 0.125f * LOG2E, scaleD = 0.17677669529663687f * LOG2E, scaleC = 0.125f * LOG2E;
            const int gw = blockIdx.x * NWAVES + wave, NGW = G * NWAVES;
#define UP8(w, f) do { f[0] = __uint_as_float((w)[0] << 16); f[1] = __uint_as_float((w)[0] & 0xffff0000u); f[2] = __uint_as_float((w)[1] << 16); f[3] = __uint_as_float((w)[1] & 0xffff0000u); \
                       f[4] = __uint_as_float((w)[2] << 16); f[5] = __uint_as_float((w)[2] & 0xffff0000u); f[6] = __uint_as_float((w)[3] << 16); f[7] = __uint_as_float((w)[3] & 0xffff0000u); } while (0)
#define PK8(f) ((v4u){cvtpk(f[0], f[1]), cvtpk(f[2], f[3]), cvtpk(f[4], f[5]), cvtpk(f[6], f[7])})
#define ST8F(p, f) do { *(f32x4*)(p) = (f32x4){f[0], f[1], f[2], f[3]}; *(f32x4*)((p) + 4) = (f32x4){f[4], f[5], f[6], f[7]}; } while (0)
            for (int row = gw; row < M; row += NGW) {
                const bf16* h = HB + (size_t)row * NINP;
                const bool smp = row >= MP; const int rr = smp ? row - MP : row;
                const int pidx = smp ? 2048 + (rr & 63) : (rr & 2047);
                float* o_mla = out + (smp ? O_MLA_S + ((size_t)l * MS + rr) * 160 : O_MLA_P + ((size_t)l * MP + rr) * 160);
                float* o_dsa = out + (smp ? O_DSA_S + ((size_t)l * MS + rr) * 192 : O_DSA_P + ((size_t)l * MP + rr) * 192);
                float* o_sb = out + (smp ? O_SB_S + ((size_t)l * MS + rr) * 512 : O_SB_P + ((size_t)l * MP + rr) * 512);
                float* o_df = out + (smp ? O_DIFF_S + ((size_t)l * MS + rr) * 512 : O_DIFF_P + ((size_t)l * MP + rr) * 512);
                bf16* ra = RA + (size_t)row * 160; bf16* rb = RB + (size_t)row * 192; bf16* rc = RC + (size_t)row * 512; bf16* rd = RD + (size_t)row * 512;
                if (lane < 56) { const int blk = lane >> 2, j = lane & 3;
                    const int base = blk < 4 ? H_QB + 64 * blk : (blk == 4 ? H_KB : (blk < 13 ? H_QI + 64 * (blk - 5) : H_KI));
                    const v4u w1 = *(const v4u*)(h + base + 8 * j), w2 = *(const v4u*)(h + base + 32 + 8 * j); float x1[8], x2[8], a[8], b[8]; UP8(w1, x1); UP8(w2, x2);
                    const f32x4* cp = (const f32x4*)(ROPE64 + pidx * 32 + 8 * j);
#pragma unroll
                    for (int e2 = 0; e2 < 4; ++e2) { const f32x4 cs = cp[e2];
                        a[2 * e2] = x1[2 * e2] * cs[0] - x2[2 * e2] * cs[1]; b[2 * e2] = x2[2 * e2] * cs[0] + x1[2 * e2] * cs[1];
                        a[2 * e2 + 1] = x1[2 * e2 + 1] * cs[2] - x2[2 * e2 + 1] * cs[3]; b[2 * e2 + 1] = x2[2 * e2 + 1] * cs[2] + x1[2 * e2 + 1] * cs[3]; }
                    if (blk < 4) {
#pragma unroll
                        for (int e = 0; e < 8; ++e) { a[e] *= scaleB; b[e] *= scaleB; }
                        bf16* d = QB + (size_t)row * 256 + 64 * blk + 8 * j; *(v4u*)d = PK8(a); *(v4u*)(d + 32) = PK8(b); }
                    else if (blk == 4) { ST8F(o_dsa + 8 * j, a); ST8F(o_dsa + 32 + 8 * j, b); *(v4u*)(rb + 8 * j) = PK8(a); *(v4u*)(rb + 32 + 8 * j) = PK8(b); }
                    else if (blk < 13) { bf16* d = QI + (size_t)row * 512 + 64 * (blk - 5) + 8 * j; *(v4u*)d = PK8(a); *(v4u*)(d + 32) = PK8(b); }
                    else { ST8F(o_dsa + 128 + 8 * j, a); ST8F(o_dsa + 160 + 8 * j, b); *(v4u*)(rb + 128 + 8 * j) = PK8(a); *(v4u*)(rb + 160 + 8 * j) = PK8(b); }
                }
                if (lane < 34) { const int blk = lane >> 1, j = lane & 1;
                    const int base = blk == 0 ? H_KR : (blk < 9 ? H_QD + 32 * (blk - 1) : H_KD + 32 * (blk - 9));
                    const v4u w1 = *(const v4u*)(h + base + 8 * j), w2 = *(const v4u*)(h + base + 16 + 8 * j); float x1[8], x2[8], a[8], b[8]; UP8(w1, x1); UP8(w2, x2);
                    const f32x4* cp = (const f32x4*)(ROPE32 + pidx * 16 + 8 * j);
#pragma unroll
                    for (int e2 = 0; e2 < 4; ++e2) { const f32x4 cs = cp[e2];
                        a[2 * e2] = x1[2 * e2] * cs[0] - x2[2 * e2] * cs[1]; b[2 * e2] = x2[2 * e2] * cs[0] + x1[2 * e2] * cs[1];
                        a[2 * e2 + 1] = x1[2 * e2 + 1] * cs[2] - x2[2 * e2 + 1] * cs[3]; b[2 * e2 + 1] = x2[2 * e2 + 1] * cs[2] + x1[2 * e2 + 1] * cs[3]; }
                    if (blk == 0) { ST8F(o_mla + 128 + 8 * j, a); ST8F(o_mla + 144 + 8 * j, b); *(v4u*)(ra + 128 + 8 * j) = PK8(a); *(v4u*)(ra + 144 + 8 * j) = PK8(b); }
                    else if (blk < 9) {
#pragma unroll
                        for (int e = 0; e < 8; ++e) { a[e] *= scaleD; b[e] *= scaleD; }
                        bf16* d = QD + (size_t)row * 256 + 32 * (blk - 1) + 8 * j; *(v4u*)d = PK8(a); *(v4u*)(d + 16) = PK8(b); }
                    else { const int bb = blk - 9, oc = (bb >> 1) * 128 + (bb & 1) * 32 + 8 * j; ST8F(o_df + oc, a); ST8F(o_df + oc + 16, b); *(v4u*)(rd + oc) = PK8(a); *(v4u*)(rd + oc + 16) = PK8(b); }
                }
                { const int c16 = lane & 15; float x[8] = {0.f, 0.f, 0.f, 0.f, 0.f, 0.f, 0.f, 0.f}; float ss = 0.f;
                  if (lane >= 48) { const v4u w = *(const v4u*)(h + H_CKV + 8 * c16); UP8(w, x);
#pragma unroll
                      for (int e = 0; e < 8; ++e) ss += x[e] * x[e]; }
                  ss += __shfl_xor(ss, 1); ss += __shfl_xor(ss, 2); ss += __shfl_xor(ss, 4); ss += __shfl_xor(ss, 8);
                  if (lane >= 48) { const float rs = 1.0f / sqrtf(ss * (1.0f / 128.0f) + EPS); const f32x4 g0 = *(const f32x4*)(kvn + 8 * c16), g1 = *(const f32x4*)(kvn + 8 * c16 + 4);
#pragma unroll
                      for (int e = 0; e < 4; ++e) { x[e] = x[e] * rs * g0[e]; x[4 + e] = x[4 + e] * rs * g1[e]; }
                      ST8F(o_mla + 8 * c16, x); *(v4u*)(ra + 8 * c16) = PK8(x); } }
#pragma unroll
                for (int r3 = 0; r3 < 3; ++r3) { const int t = lane + 64 * r3;
                    if (t < 137) { float x[8];
                        if (t < 8) { const v4u w = *(const v4u*)(h + H_VB + 8 * t); UP8(w, x); ST8F(o_dsa + 64 + 8 * t, x); *(v4u*)(rb + 64 + 8 * t) = w; }
                        else if (t < 40) { const int k = t - 8; const v4u w = *(const v4u*)(h + H_QC + 8 * k); UP8(w, x);
#pragma unroll
                            for (int e = 0; e < 8; ++e) x[e] *= scaleC;
                            *(v4u*)(QC + (size_t)row * 256 + 8 * k) = PK8(x); }
                        else if (t < 72) { const int k = t - 40, oc = (k >> 3) * 128 + 8 * (k & 7); const v4u w = *(const v4u*)(h + H_KC + 8 * k); UP8(w, x); ST8F(o_sb + oc, x); *(v4u*)(rc + oc) = w; }
                        else if (t < 104) { const int k = t - 72, oc = (k >> 3) * 128 + 64 + 8 * (k & 7); const v4u w = *(const v4u*)(h + H_VC + 8 * k); UP8(w, x); ST8F(o_sb + oc, x); *(v4u*)(rc + oc) = w; }
                        else if (t < 136) { const int k = t - 104, oc = (k >> 3) * 128 + 64 + 8 * (k & 7); const v4u w = *(const v4u*)(h + H_VD + 8 * k); UP8(w, x); ST8F(o_df + oc, x); *(v4u*)(rd + oc) = w; }
                        else { const v4u w = *(const v4u*)(h + H_WI); UP8(w, x);
#pragma unroll
                            for (int e = 0; e < 8; ++e) x[e] *= 0.35355339059327373f;
                            ST8F(WI + (size_t)row * 8, x); }
                    } }
            }
            }
#undef UP8
#undef PK8
#undef ST8F
            if (BOTH(pb + 3)) GRID_BAR();
#endif
        }
        if (EN_PH(5) && IN(pb + 4)) {
            GLB unsigned char* wsg_ = (GLB unsigned char*)args.ws; asm volatile("" : "+s"(wsg_)); unsigned char* ws = (unsigned char*)wsg_;
            LAS char* tile = (LAS char*)lds;
            volatile LAS unsigned* qslot = MISC + 16;
            const int myx = (int)(xb_xcc_id() & 7u);
            for (int rep = 0; rep < ATTN_REPS; ++rep) {
#define MIXER_IDS() FRESH_TID(); const int r32 = lane & 31, hi = lane >> 5, hd = wave & 3, qh = wave >> 2, q4 = (lane & 15) >> 2; (void)q4; int qx = myx
#define NEXT_UNIT(kind, out) do { __syncthreads(); if (tid == 0) { int res_ = -1, q_ = qx; gu32* heads_ = ctl + CW_Q + (((rep * 2 + l) * 4 + (kind)) * 8) * 64; \
        for (;;) { const unsigned got_ = __hip_atomic_fetch_add((unsigned*)(heads_ + q_ * 64), 1u, RLX_AGENT); if (got_ < (unsigned)QLIST) { res_ = (int)got_ + 256 * q_; break; } \
            unsigned hv_[8]; _Pragma("unroll") for (int s_ = 0; s_ < 8; ++s_) hv_[s_] = __hip_atomic_load((unsigned*)(heads_ + ((myx + s_) & 7) * 64), RLX_AGENT); \
            int pick_ = -1; _Pragma("unroll") for (int s_ = 7; s_ >= 0; --s_) if (hv_[s_] < (unsigned)QLIST) pick_ = s_; \
            if (pick_ < 0) break; q_ = (myx + pick_) & 7; } \
        qslot[0] = (unsigned)res_; } \
    __syncthreads(); { const int r_ = (int)qslot[0]; out = r_ < 0 ? -1 : (r_ & 255); qx = r_ < 0 ? qx : ((r_ >> 8) & 7); } } while (0)
#if EN_DSA
            if (rep == 0 || ((REP_MASK >> 1) & 1)) { MIXER_IDS();
            for (;;) {
                int uidx; NEXT_UNIT(1, uidx); if (uidx < 0) break;
                const UnitId u = decode_unit(qx, uidx);
                const float* cache_lb = ARG_IN(I_CDSA) + ((size_t)(l * NB + u.b) * PAST) * 192;
                const int myq = u.qrow0 + 32 * qh + r32;
                float* sc = (float*)(ws + WS_REGA + (size_t)blockIdx.x * DSA_SCR);
                unsigned long long* mk = (unsigned long long*)(ws + WS_REGA + (size_t)blockIdx.x * DSA_SCR + DSA_MASK_OFF);
                const bool sel = u.nt > 4;
                if (sel) {
                    {
                    float wq[8]; float smin = 3e38f, smax = -3e38f;
                    LAS unsigned* mmq = (LAS unsigned*)(lds + 110592);
                    if (tid < 64) { mmq[tid] = 0xFFFFFFFFu; mmq[64 + tid] = 0u; }
#pragma unroll
                    for (int hh = 0; hh < 8; ++hh) wq[hh] = WI[(size_t)myq * 8 + hh];
                    LAS char* ql_ = (LAS char*)lds + 20480;
                    { const int row0 = tid >> 6, cc = tid & 63;
#pragma unroll
                      for (int i = 0; i < 8; ++i) { const int row = row0 + 8 * i; *(LAS v4u*)(ql_ + row * T512_STRB + cc * 16) = *(const v4u*)(QI + (size_t)(u.qrow0 + row) * 512 + cc * 8); } }
                    const LAS char* qb_ = ql_ + (32 * qh + r32) * T512_STRB + 8 * hi * 2;
                    TileLd<64, 192, true, 128> ld; ld.init(); constexpr int STRB = TileLd<64, 192, true, 128>::STRB;
                    const int nt2 = (u.nt + 1) >> 1;
                    bool f32; const void* src = tile_src(u, 0, cache_lb, RB, 192, 128, f32);
                    ld.nrows_ = (u.nt >= 2) ? 128 : 64; ld.issue(src, f32, tid); ld.store(tile, f32, tid); __syncthreads();
                    const int kboffA = (32 * hd + r32) * STRB + 8 * hi * 2;
                    int cbA = 0;
                    for (int t2 = 0; t2 < nt2; ++t2) {
                        LAS char* curA = tile + cbA * 90112; LAS char* nxbA = tile + (cbA ^ 1) * 90112; cbA ^= 1;
                        const LAS char* kb = curA + kboffA;
                        const int rows_cur = (2 * t2 + 2 <= u.nt) ? 128 : 64;
                        bool f32n; { const int tn2 = (t2 + 1 < nt2) ? t2 + 1 : t2; const void* sn = tile_src(u, 2 * tn2, cache_lb, RB, 192, 128, f32n); ld.nrows_ = (2 * tn2 + 2 <= u.nt) ? 128 : 64; ld.issue(sn, f32n, tid); }
                        if (32 * hd < rows_cur) {
                            bf16x8 ka[4];
#pragma unroll
                            for (int s = 0; s < 4; ++s) ka[s] = *(const LAS bf16x8*)(kb + s * 32);
                            typedef float f32x2_t __attribute__((ext_vector_type(2)));
                            f32x2_t I2[8];
#pragma unroll
                            for (int r = 0; r < 8; ++r) I2[r] = (f32x2_t){0.f, 0.f};
                            bf16x8 qf[2][4];
#pragma unroll
                            for (int s = 0; s < 4; ++s) qf[0][s] = *(const LAS bf16x8*)(qb_ + s * 32);
#pragma unroll
                            for (int hh = 0; hh < 8; ++hh) { f32x16 p = zero16(); const f32x2_t w2 = {wq[hh], wq[hh]};
                                if (hh < 7) {
#pragma unroll
                                    for (int s = 0; s < 4; ++s) qf[(hh + 1) & 1][s] = *(const LAS bf16x8*)(qb_ + (hh + 1) * 128 + s * 32); }
                                __builtin_amdgcn_sched_barrier(0);
#pragma unroll
                                for (int s = 0; s < 4; ++s) p = MFMA32(ka[s], qf[hh & 1][s], p);
#pragma unroll
                                for (int r = 0; r < 8; ++r) { const f32x2_t rl = {__int_as_float(max(__float_as_int(p[2 * r]), 0)), __int_as_float(max(__float_as_int(p[2 * r + 1]), 0))};        I2[r] = w2 * rl + I2[r]; } }
                            f32x16 I;
#pragma unroll
                            for (int r = 0; r < 8; ++r) { I[2 * r] = I2[r].x; I[2 * r + 1] = I2[r].y; }
                            GLB float* scol = (GLB float*)sc + (size_t)(t2 * 128 + 32 * hd + 4 * hi) * 64 + 32 * qh + r32;
#pragma unroll
                            for (int r = 0; r < 16; ++r) { scol[(size_t)((r & 3) + 8 * (r >> 2)) * 64] = I[r]; smin = fminf(smin, I[r]); smax = fmaxf(smax, I[r]); }
                        }
                        ld.store(nxbA, f32n, tid);
                        __syncthreads();
                    }
                    { const unsigned bmn = __float_as_uint(smin), bmx = __float_as_uint(smax);
                      __hip_atomic_fetch_min(mmq + 32 * qh + r32, bmn ^ ((bmn >> 31) ? 0xFFFFFFFFu : 0x80000000u), __ATOMIC_RELAXED, __HIP_MEMORY_SCOPE_WORKGROUP);
                      __hip_atomic_fetch_max(mmq + 64 + 32 * qh + r32, bmx ^ ((bmx >> 31) ? 0xFFFFFFFFu : 0x80000000u), __ATOMIC_RELAXED, __HIP_MEMORY_SCOPE_WORKGROUP); }
                    }
                    VM_WAIT(); __syncthreads();
                    {
                    LAS unsigned* hist = (LAS unsigned*)lds;
                    LAS unsigned* part = (LAS unsigned*)(lds + 65536);
                    LAS float* qlo = (LAS float*)(lds + 67584); LAS float* qsc = qlo + 64; LAS int* qkk = (LAS int*)(qsc + 64); LAS unsigned* qT = (LAS unsigned*)(qkk + 64); LAS int* qwhole = (LAS int*)(qT + 64);
                    LAS int* qcn = qwhole + 64;
                    LAS unsigned long long* mkl = (LAS unsigned long long*)(lds + 69632);
                    LAS unsigned* cval = (LAS unsigned*)(lds + 106496);
                    LAS unsigned short* ckey = (LAS unsigned short*)(lds + 122880);
                    constexpr int CMAX = 64;
                    const int pq = tid & 63, ps = tid >> 6;
                    LAS unsigned* mmq = (LAS unsigned*)(lds + 110592);
                    if (tid < 64) { const unsigned a = mmq[tid], b = mmq[64 + tid];
                        const float lo_ = __uint_as_float((a & 0x80000000u) ? (a ^ 0x80000000u) : ~a), hi_ = __uint_as_float((b & 0x80000000u) ? (b ^ 0x80000000u) : ~b);
                        const float range = hi_ - lo_; qlo[tid] = lo_; qsc[tid] = (range > 1e-30f) ? 255.99f / range : 0.f; qcn[tid] = 0; }
#pragma unroll
                    for (int j = 0; j < 8; ++j) ((LAS v4u*)hist)[tid + 512 * j] = (v4u){0u, 0u, 0u, 0u};
                    __syncthreads();
                    const float lo_q = qlo[pq], sc_q = qsc[pq];
                    const GLB float* scq = (const GLB float*)sc + pq;
                    for (int t = ps; t < u.nt; t += 8) { const GLB float* sp = scq + (size_t)t * 4096;
                        { float xs[64];
#pragma unroll
                            for (int j = 0; j < 64; ++j) xs[j] = sp[j * 64];
#pragma unroll
                            for (int j = 0; j < 64; ++j) { const int b0 = min(255, (int)((xs[j] - lo_q) * sc_q)); __hip_atomic_fetch_add(hist + b0 * 64 + pq, 1u, __ATOMIC_RELAXED, __HIP_MEMORY_SCOPE_WORKGROUP); } } }
                    __syncthreads();
                    { unsigned sm = 0u;
#pragma unroll 8
                      for (int j = 0; j < 32; ++j) sm += hist[(32 * ps + j) * 64 + pq];
                      part[ps * 64 + pq] = sm; }
                    __syncthreads();
                    if (tid < 64) { const unsigned kk_ = 256u; unsigned acc = 0u; int sl_ = -1; unsigned abv = 0u;
#pragma unroll
                        for (int s2 = 7; s2 >= 0; --s2) { const unsigned c = part[s2 * 64 + tid]; const bool take = (sl_ < 0) && (acc + c >= kk_); if (take) { sl_ = s2; abv = acc; } acc += c; }
                        sl_ = sl_ < 0 ? 0 : sl_; unsigned acc2 = abv; int bsel = -1; unsigned abv2 = 0u, csel = 0u;
#pragma unroll 8
                        for (int j = 31; j >= 0; --j) { const unsigned c = hist[(32 * sl_ + j) * 64 + tid]; const bool take = (bsel < 0) && (acc2 + c >= kk_); if (take) { bsel = j; abv2 = acc2; csel = c; } acc2 += c; }
                        bsel = bsel < 0 ? 0 : bsel;
                        qT[tid] = (unsigned)(32 * sl_ + bsel); qkk[tid] = (int)(kk_ - abv2); qwhole[tid] = ((kk_ - abv2) == csel) ? 1 : 0; }
                    __syncthreads();
                    { const int T0 = (int)qT[pq]; const bool whole = qwhole[pq] != 0;
                      for (int t = ps; t < u.nt; t += 8) { const GLB float* sp = scq + (size_t)t * 4096; unsigned long long w = 0ull;
#pragma unroll 1
                        for (int k0 = 0; k0 < 64; k0 += 32) { float xs[32];
#pragma unroll
                            for (int j = 0; j < 32; ++j) xs[j] = sp[(k0 + j) * 64];
#pragma unroll
                            for (int j = 0; j < 32; ++j) { const int b0 = min(255, (int)((xs[j] - lo_q) * sc_q));
                                const bool selq = b0 > T0 || (whole && b0 == T0); w |= (unsigned long long)(selq ? 1u : 0u) << (k0 + j);
                                if (!whole && b0 == T0) { const int ix = __hip_atomic_fetch_add(qcn + pq, 1, __ATOMIC_RELAXED, __HIP_MEMORY_SCOPE_WORKGROUP);
                                    if (ix < CMAX) { const unsigned bts = __float_as_uint(xs[j]); cval[pq * CMAX + ix] = bts ^ ((bts >> 31) ? 0xFFFFFFFFu : 0x80000000u); ckey[pq * CMAX + ix] = (unsigned short)(t * 64 + k0 + j); } } } }
                        mkl[pq * 72 + t] = w; } }
                    __syncthreads();
                    if (!qwhole[pq]) { const int n = qcn[pq], kk_ = qkk[pq];
                        if (n <= CMAX) { for (int i = ps; i < n; i += 8) { const unsigned vi = cval[pq * CMAX + i]; const unsigned ki = ckey[pq * CMAX + i]; int rank = 0;
                                for (int j = 0; j < n; ++j) { const unsigned vj = cval[pq * CMAX + j]; const unsigned kj = ckey[pq * CMAX + j]; rank += (vj > vi || (vj == vi && kj < ki)) ? 1 : 0; }
                                if (rank < kk_) __hip_atomic_fetch_or((LAS unsigned*)mkl + (pq * 72 + (int)(ki >> 6)) * 2 + (int)((ki >> 5) & 1u), 1u << (ki & 31u), __ATOMIC_RELAXED, __HIP_MEMORY_SCOPE_WORKGROUP); } } }
                    __syncthreads();
                    if (wave == 0) { unsigned long long und = __ballot(!qwhole[lane] && qcn[lane] > CMAX);
                        while (und) { const int qf = (int)__builtin_ctzll(und); und &= und - 1ull;
                            if (u.sample) dsa_select<65, 1, 64>(sc + qf, u.nt, hist, (unsigned long long*)(mkl + qf * 72), lane); else dsa_select<32, 1, 64>(sc + qf, u.nt, hist, (unsigned long long*)(mkl + qf * 72), lane); } }
                    }
                    VM_WAIT(); __syncthreads();
                }
                bf16x8 q[4];
#pragma unroll
                for (int s = 0; s < 4; ++s) q[s] = *(const bf16x8*)(QB + (size_t)myq * 256 + hd * 64 + 16 * s + 8 * hi);
                f32x16 o[2]; o[0] = zero16(); o[1] = zero16(); float m_ = -1e30f, l_ = 0.f;
                TileLd<128, 192> ld; ld.init(); constexpr int STRB = TileLd<128, 192>::STRB;
                bool f32; const void* src = tile_src(u, 0, cache_lb, RB, 192, 0, f32);
                ld.issue(src, f32, tid); ld.store(tile, f32, tid); __syncthreads();
                const int kboff = r32 * STRB + 8 * hi * 2;
                const int vboff = (4 * hi + q4) * STRB + (64 + 16 * ((lane >> 4) & 1) + 4 * (lane & 3)) * 2;
                int cb = 0;
                for (int t = 0; t < u.nt; ++t) {
                    LAS char* cur = tile + cb * 24576; LAS char* nxb = tile + (cb ^ 1) * 24576; cb ^= 1;
                    const LAS char* kb = cur + kboff; const LAS char* vb = cur + vboff;
                    bool f32n; { const int tn = (t + 1 < u.nt) ? t + 1 : t; const void* sn = tile_src(u, tn, cache_lb, RB, 192, 0, f32n); ld.issue(sn, f32n, tid); }
                    unsigned long long mw = ~0ull; if (sel) mw = ((const LAS unsigned long long*)(lds + 69632))[(32 * qh + r32) * 72 + t];
                    const unsigned mlo = (unsigned)mw >> (4 * hi), mhi = (unsigned)(mw >> 32) >> (4 * hi);
                    f32x16 p0, p1; bf16x8 kf[8], vf[8];
                    k_ld<4>(kf, kb, STRB); __builtin_amdgcn_sched_barrier(0); qk_r<4>(p0, p1, kf, q); v_ld<2>(vf, vb, STRB); __builtin_amdgcn_sched_barrier(0);
#pragma unroll
                    for (int r = 0; r < 16; ++r) { const int bpos = (r & 3) + 8 * (r >> 2);
                        const unsigned s0 = (unsigned)__builtin_amdgcn_sbfe((int)mlo, bpos, 1), s1 = (unsigned)__builtin_amdgcn_sbfe((int)mhi, bpos, 1);
                        p0[r] = __uint_as_float((__float_as_uint(p0[r]) & s0) | (0xff61b1e6u & ~s0)); p1[r] = __uint_as_float((__float_as_uint(p1[r]) & s1) | (0xff61b1e6u & ~s1)); }
                    softmax_step<2>(p0, p1, m_, l_, o);
                    pv_r<2>(o, p0, p1, vf);
                    ld.store(nxb, f32n, tid);
                    __syncthreads();
                }
                l_ += __shfl_xor(l_, 32); const float inv = 1.0f / l_;
                bf16* orow = CC + (size_t)myq * KOUT + 512 + hd * 64;
#pragma unroll
                for (int db = 0; db < 2; ++db)
#pragma unroll
                    for (int gq = 0; gq < 4; ++gq) { v2u w; w.x = cvtpk(o[db][4 * gq] * inv, o[db][4 * gq + 1] * inv); w.y = cvtpk(o[db][4 * gq + 2] * inv, o[db][4 * gq + 3] * inv);
                        *(v2u*)(orow + 32 * db + 8 * gq + 4 * hi) = w; }
            }
            }
#endif
#if EN_DIFF
            if (rep == 0 || ((REP_MASK >> 3) & 1)) { MIXER_IDS();
            for (;;) {
                int uidx; NEXT_UNIT(3, uidx); if (uidx < 0) break;
                const UnitId u = decode_unit(qx, uidx);
                const float* cache_lb = ARG_IN(I_CDIFF) + ((size_t)(l * NB + u.b) * PAST) * 512;
                const int myq = u.qrow0 + 32 * qh + r32;
                bf16x8 qa[2], qb2[2];
#pragma unroll
                for (int s = 0; s < 2; ++s) { qa[s] = *(const bf16x8*)(QD + (size_t)myq * 256 + hd * 64 + 16 * s + 8 * hi); qb2[s] = *(const bf16x8*)(QD + (size_t)myq * 256 + hd * 64 + 32 + 16 * s + 8 * hi); }
                f32x16 o1[2], o2[2]; o1[0] = zero16(); o1[1] = zero16(); o2[0] = zero16(); o2[1] = zero16(); float m1 = -1e30f, l1 = 0.f, m2 = -1e30f, l2 = 0.f;
                constexpr int STRB = T512_STRB;
                { bool f32; const void* src = tile_src(u, 0, cache_lb, RD, 512, 0, f32);
                  if (f32) t512_cvt(src, tile, tid); else t512_dma(src, tile, wave, lane); VM_WAIT(); __syncthreads(); }
                const int kboff = r32 * STRB + (hd * 128 + 8 * hi) * 2;
                const int vboff = (4 * hi + q4) * STRB + (hd * 128 + 64 + 16 * ((lane >> 4) & 1) + 4 * (lane & 3)) * 2;
                int cb = 0;
                for (int t = 0; t < u.nt; ++t) {
                    LAS char* cur = tile + cb * T512_BYTES; LAS char* nxb = tile + (cb ^ 1) * T512_BYTES; cb ^= 1;
                    const LAS char* kb1 = cur + kboff; const LAS char* kb2 = kb1 + 64; const LAS char* vb = cur + vboff;
                    bool f32n = false; const void* sn = nullptr; if (t + 1 < u.nt) sn = tile_src(u, t + 1, cache_lb, RD, 512, 0, f32n);
#if DBG_VARIANTS
                    { f32x16 p0, p1; qk<2>(p0, p1, kb1, STRB, qa); float sx = 0.f; for (int r = 0; r < 16; ++r) { p0[r] = __builtin_amdgcn_exp2f(p0[r] - 8.f); p1[r] = __builtin_amdgcn_exp2f(p1[r] - 8.f); sx += p0[r] + p1[r]; } l1 += sx; pv<2>(o1, p0, p1, vb, STRB); }
                    { f32x16 p0, p1; qk<2>(p0, p1, kb2, STRB, qb2); float sx = 0.f; for (int r = 0; r < 16; ++r) { p0[r] = __builtin_amdgcn_exp2f(p0[r] - 8.f); p1[r] = __builtin_amdgcn_exp2f(p1[r] - 8.f); sx += p0[r] + p1[r]; } l2 += sx; pv<2>(o2, p0, p1, vb, STRB); }
#else
                    { bf16x8 kA[4], kB[4], vf[8]; f32x16 pa0, pa1, pb0, pb1;
                      k_ld<2>(kA, kb1, STRB); k_ld<2>(kB, kb2, STRB); __builtin_amdgcn_sched_barrier(0);
                      qk_r<2>(pa0, pa1, kA, qa); qk_r<2>(pb0, pb1, kB, qb2); v_ld<2>(vf, vb, STRB); __builtin_amdgcn_sched_barrier(0);
                      if (t + 1 < u.nt && !f32n) t512_dma(sn, nxb, wave, lane);
                      __builtin_amdgcn_sched_barrier(0);
                      softmax_step<2>(pa0, pa1, m1, l1, o1); pv_r<2>(o1, pa0, pa1, vf);
                      softmax_step<2>(pb0, pb1, m2, l2, o2); pv_r<2>(o2, pb0, pb1, vf); }
#endif
                    if (t + 1 < u.nt && f32n) t512_cvt(sn, nxb, tid);
                    VM_WAIT(); __syncthreads();
                }
                l1 += __shfl_xor(l1, 32); l2 += __shfl_xor(l2, 32);
                const float i1 = 1.0f / l1, i2 = LAMF[l] / l2; float ss = 0.f;
#pragma unroll
                for (int db = 0; db < 2; ++db)
#pragma unroll
                    for (int r = 0; r < 16; ++r) { const float v = o1[db][r] * i1 - o2[db][r] * i2; o1[db][r] = v; ss += v * v; }
                ss += __shfl_xor(ss, 32);
                const float lam_init = 0.8f - 0.6f * expf(-0.3f * (float)l);
                const float rs = (1.0f - lam_init) / sqrtf(ss * (1.0f / 64.0f) + EPS);
                const float* dn = ARG_IN(I_DN) + l * 64;
                bf16* orow = CC + (size_t)myq * KOUT + 1024 + hd * 64;
#pragma unroll
                for (int db = 0; db < 2; ++db)
#pragma unroll
                    for (int gq = 0; gq < 4; ++gq) { const f32x4 dv = *(const f32x4*)(dn + 32 * db + 8 * gq + 4 * hi);
                        v2u w; w.x = cvtpk(o1[db][4 * gq] * rs * dv[0], o1[db][4 * gq + 1] * rs * dv[1]); w.y = cvtpk(o1[db][4 * gq + 2] * rs * dv[2], o1[db][4 * gq + 3] * rs * dv[3]);
                        *(v2u*)(orow + 32 * db + 8 * gq + 4 * hi) = w; }
            }
            }
#endif
#if EN_MLA
            if (rep == 0 || ((REP_MASK >> 0) & 1)) { MIXER_IDS();
            for (;;) {
                int uidx; NEXT_UNIT(0, uidx); if (uidx < 0) break;
                const UnitId u = decode_unit(qx, uidx);
                const float* cache_lb = ARG_IN(I_CMLA) + ((size_t)(l * NB + u.b) * PAST) * 160;
                const int myq = u.qrow0 + 32 * qh + r32;
                bf16x8 q[10];
#pragma unroll
                for (int s = 0; s < 10; ++s) q[s] = *(const bf16x8*)(QA + (size_t)myq * NQP + hd * 160 + 16 * s + 8 * hi);
                {
                    const int pidx = u.sample ? 2048 + 32 * qh + r32 : u.c * 64 + 32 * qh + r32;
                    bf16x8 a = q[8], b = q[9];
#pragma unroll
                    for (int j = 0; j < 8; ++j) { const float2 cs = ROPE32[pidx * 16 + 8 * hi + j]; const float x1 = bf2f((bf16)a[j]), x2 = bf2f((bf16)b[j]);
                        a[j] = (short)f2bf(x1 * cs.x - x2 * cs.y); b[j] = (short)f2bf(x2 * cs.x + x1 * cs.y); }
                    q[8] = a; q[9] = b;
                }
                f32x16 o[4]; o[0] = zero16(); o[1] = zero16(); o[2] = zero16(); o[3] = zero16(); float m_ = -1e30f, l_ = 0.f;
                TileLd<160, 160> ld; ld.init(); constexpr int STRB = TileLd<160, 160>::STRB;
                bool f32; const void* src = tile_src(u, 0, cache_lb, RA, 160, 0, f32);
                ld.issue(src, f32, tid); ld.store(tile, f32, tid); __syncthreads();
                const int kboff = r32 * STRB + 8 * hi * 2;
                const int vboff = (4 * hi + q4) * STRB + (16 * ((lane >> 4) & 1) + 4 * (lane & 3)) * 2;
                int cb = 0;
                for (int t = 0; t < u.nt; ++t) {
                    LAS char* cur = tile + cb * 24576; LAS char* nxb = tile + (cb ^ 1) * 24576; cb ^= 1;
                    const LAS char* kb = cur + kboff; const LAS char* vb = cur + vboff;
                    bool f32n; { const int tn = (t + 1 < u.nt) ? t + 1 : t; const void* sn = tile_src(u, tn, cache_lb, RA, 160, 0, f32n); ld.issue(sn, f32n, tid); }
                    f32x16 p0, p1; qk_h2<10>(p0, p1, kb, STRB, q);
#if DBG_VARIANTS
                    { for (int r = 0; r < 16; ++r) { p0[r] = p0[r] * 0.f + 1.f; p1[r] = p1[r] * 0.f + 1.f; } l_ += 32.f; }
#else
                    softmax_step<4>(p0, p1, m_, l_, o);
#endif
                    pv<4>(o, p0, p1, vb, STRB);
                    ld.store(nxb, f32n, tid);
                    __syncthreads();
                }
                l_ += __shfl_xor(l_, 32); const float inv = 1.0f / l_;
                bf16* orow = CC + (size_t)myq * KOUT + hd * 128;
#pragma unroll
                for (int db = 0; db < 4; ++db)
#pragma unroll
                    for (int gq = 0; gq < 4; ++gq) { v2u w; w.x = cvtpk(o[db][4 * gq] * inv, o[db][4 * gq + 1] * inv); w.y = cvtpk(o[db][4 * gq + 2] * inv, o[db][4 * gq + 3] * inv);
                        *(v2u*)(orow + 32 * db + 8 * gq + 4 * hi) = w; }
            }
            }
#endif
#if EN_SB
            if (rep == 0 || ((REP_MASK >> 2) & 1)) { MIXER_IDS();
            for (;;) {
                int uidx; NEXT_UNIT(2, uidx); if (uidx < 0) break;
                const UnitId u = decode_unit(qx, uidx);
                const float* cache_lb = ARG_IN(I_CSB) + ((size_t)(l * NB + u.b) * PAST) * 512;
                const int myq = u.qrow0 + 32 * qh + r32, qloc = 32 * qh + r32;
                bf16x8 q[4];
#pragma unroll
                for (int s = 0; s < 4; ++s) q[s] = *(const bf16x8*)(QC + (size_t)myq * 256 + hd * 64 + 16 * s + 8 * hi);
                f32x16 o[2]; o[0] = zero16(); o[1] = zero16(); float carry = 1.0f; int it3 = 0;
                constexpr int STRB = T512_STRB;
                { bool f32; const void* src = tile_src(u, u.nt - 1, cache_lb, RC, 512, 0, f32);
                  if (f32) t512_cvt(src, tile, tid); else t512_dma(src, tile, wave, lane); VM_WAIT(); __syncthreads(); }
                const int kboff = r32 * STRB + (hd * 128 + 8 * hi) * 2;
                const int vboff = (4 * hi + q4) * STRB + (hd * 128 + 64 + 16 * ((lane >> 4) & 1) + 4 * (lane & 3)) * 2;
                volatile LAS unsigned* sbflag = MISC + 20;
                if (tid == 0) { sbflag[0] = 0u; sbflag[1] = 0u; sbflag[2] = 0u; }
                __syncthreads();
                int cb = 0;
                for (int t = u.nt - 1; t >= 0; --t) {
                    LAS char* cur = tile + cb * T512_BYTES; LAS char* nxb = tile + (cb ^ 1) * T512_BYTES; cb ^= 1;
                    const LAS char* kb = cur + kboff; const LAS char* vb = cur + vboff;
                    bool f32n = false; const void* sn = nullptr; if (t > 0) { sn = tile_src(u, t - 1, cache_lb, RC, 512, 0, f32n); if (!f32n) t512_dma(sn, nxb, wave, lane); }
                    const bool diag = (t == u.nt - 1);
                    f32x16 z0, z1; qk<4>(z0, z1, kb, STRB, q);
                    f32x16 u0, u1; float gs[8];
#pragma unroll
                    for (int r = 0; r < 16; ++r) {
                        const int key = crow(r, hi);
                        { const float e = __builtin_amdgcn_exp2f(fminf(z0[r], 80.f)); const float uu = __builtin_amdgcn_rcpf(1.0f + e); const bool ok = !diag || (key < qloc); u0[r] = ok ? uu : 1.0f; z0[r] = ok ? e * uu : 0.f; }
                        { const float e = __builtin_amdgcn_exp2f(fminf(z1[r], 80.f)); const float uu = __builtin_amdgcn_rcpf(1.0f + e); const bool ok = !diag || (key + 32 < qloc); u1[r] = ok ? uu : 1.0f; z1[r] = ok ? e * uu : 0.f; }
                    }
#pragma unroll
                    for (int g4 = 0; g4 < 4; ++g4) { gs[g4] = (u0[4 * g4] * u0[4 * g4 + 1]) * (u0[4 * g4 + 2] * u0[4 * g4 + 3]); gs[4 + g4] = (u1[4 * g4] * u1[4 * g4 + 1]) * (u1[4 * g4 + 2] * u1[4 * g4 + 3]); }
                    float pg[8];
#pragma unroll
                    for (int g8 = 0; g8 < 8; ++g8) pg[g8] = __shfl_xor(gs[g8], 32);
                    float run = carry;
#pragma unroll
                    for (int g8 = 7; g8 >= 0; --g8) {
                        float P = run * (hi == 0 ? pg[g8] : 1.0f);
                        if (g8 >= 4) { const int b4 = 4 * (g8 - 4);
                            z1[b4 + 3] *= P; P *= u1[b4 + 3]; z1[b4 + 2] *= P; P *= u1[b4 + 2]; z1[b4 + 1] *= P; P *= u1[b4 + 1]; z1[b4] *= P;
                        } else { const int b4 = 4 * g8;
                            z0[b4 + 3] *= P; P *= u0[b4 + 3]; z0[b4 + 2] *= P; P *= u0[b4 + 2]; z0[b4 + 1] *= P; P *= u0[b4 + 1]; z0[b4] *= P;
                        }
                        run *= gs[g8] * pg[g8];
                    }
                    carry = run;
                    pv<2>(o, z0, z1, vb, STRB);
                    if (t > 0 && f32n) t512_cvt(sn, nxb, tid);
                    if (tid == 0) sbflag[(it3 + 1) % 3] = 0u;
                    if (__any(carry != 0.f) && lane == 0) sbflag[it3] = 1u;
                    VM_WAIT(); __syncthreads();
                    const bool alive = sbflag[it3] != 0u; it3 = (it3 + 1) % 3;
                    if (!alive) break;
                }
                bf16* orow = CC + (size_t)myq * KOUT + 768 + hd * 64;
#pragma unroll
                for (int db = 0; db < 2; ++db)
#pragma unroll
                    for (int gq = 0; gq < 4; ++gq) { v2u w; w.x = cvtpk(o[db][4 * gq], o[db][4 * gq + 1]); w.y = cvtpk(o[db][4 * gq + 2], o[db][4 * gq + 3]);
                        *(v2u*)(orow + 32 * db + 8 * gq + 4 * hi) = w; }
            }
            }
#endif
            }
            if (BOTH(pb + 4)) GRID_BAR();
        }
        if (EN_PH(6) && IN(pb + 5)) {
            pg8::Gemm g{CC, (const bf16*)(wl + W_OUT), M, DM, KOUT, KOUT}; pg8::StaticOrder S; S.init(M, DM, G, (int)blockIdx.x);
            pg8::EpiResid<false> E{nullptr, nullptr, XB, ssqC, 1.0f};
            pg8::gemm_phase<pg8::EpiResid<false>, pg8::StaticOrder, true, true>(lds, g, S, E, wave0);
            if (BOTH(pb + 5)) GRID_BAR();
        }
        if (EN_PH(7) && IN(pb + 6)) {
            pg8::Gemm g{XB, (const bf16*)(wl + W_GU2), M, NGU, DM, DM}; pg8::StaticOrder S; S.init(M, NGU, G, (int)blockIdx.x);
            pg8::EpiSwiGLU E{ACT, ssqC};
            for (int grep = 0; grep < GU_REPS; ++grep)
            pg8::gemm_phase<pg8::EpiSwiGLU, pg8::StaticOrder, true, true>(lds, g, S, E, wave0);
            if (BOTH(pb + 6)) GRID_BAR();
        }
        if (EN_PH(8) && IN(pb + 7)) {
            pg8::Gemm g{ACT, (const bf16*)(wl + W_D2), M, DM, DFF, DFF}; pg8::StaticOrder S; S.init(MP, DM, G, (int)blockIdx.x);
            pg8::EpiResid<false> E{nullptr, nullptr, XB, ssqAn, 0.5f};
            pg8::gemm_phase<pg8::EpiResid<false>, pg8::StaticOrder, true, true>(lds, g, S, E, wave0);
            SPLITK_SAMPLE(W_D2);
            GRID_BAR();
            { FRESH_TID(); const int un_ = (int)blockIdx.x >> 3, j_ = (int)blockIdx.x & 7; const float* Pu = (const float*)(ws + WS_QA) + (size_t)un_ * 8 * 32 * 512 * 4;
              pg8::resid_fixup<false>(Pu, MP / 256 + (un_ >> 2), un_ & 3, j_ >> 2, j_ & 3, nullptr, XB, ssqAn, 0.5f, tid); }
            if (BOTH(pb + 7)) GRID_BAR();
        }
    }
    if (EN_PH(9) && IN(17)) {
        FRESH_TID();
        const float* fn = ARG_IN(I_FN); const float* ssqF = SSQP + (size_t)2 * M * 16;
        const int gw = blockIdx.x * NWAVES + wave, NGW = G * NWAVES;
        for (int m = gw; m < M; m += NGW) {
            const float rs = 1.0f / sqrtf(ssq_sum16(ssqF, m) * (1.0f / 1024.0f) + EPS);
            const v2u* x2 = (const v2u*)(XB + (size_t)m * DM) + lane; f32x4* y4 = (f32x4*)(X + (size_t)m * DM) + lane; const f32x4* g4 = (const f32x4*)fn + lane;
#pragma unroll
            for (int j = 0; j < 4; ++j) { const v2u w = x2[64 * j]; const f32x4 gg = g4[64 * j];
                const f32x4 v = (f32x4){__uint_as_float(w.x << 16), __uint_as_float(w.x & 0xffff0000u), __uint_as_float(w.y << 16), __uint_as_float(w.y & 0xffff0000u)};
                y4[64 * j] = v * rs * gg; }
        }
    }
#undef IN
#undef BOTH
#undef GRID_BAR
#undef X
#undef XB
#undef HB
#undef ACT
#undef QA
#undef QB
#undef QI
#undef QC
#undef QD
#undef WI
#undef RA
#undef RB
#undef RC
#undef RD
#undef CC
#undef CQ
#undef CKV
#undef SSQP
#undef LAMF
#undef ROPE64
#undef ROPE32
}


#if SELFCHECK
constexpr size_t WS_CHK = 3 * MiB + 768 * 1024;
__device__ __forceinline__ unsigned hsh(unsigned x) { x ^= x >> 16; x *= 0x7feb352du; x ^= x >> 15; x *= 0x846ca68bu; x ^= x >> 16; return x; }
__device__ __forceinline__ void chk_rep(unsigned* slot, float got, float ex, float atol, float rtol) {
    float e = fabsf(got - ex) / (atol + rtol * fabsf(ex)); if (!(e == e)) e = 1e30f; atomicMax(slot, __float_as_uint(e)); }
__device__ __forceinline__ float bfr(float x) { return bf2f((bf16)f2bf(x)); }
__device__ __forceinline__ int nat_col(int np) { return np < 1376 ? np : (np < 2912 ? np + 8 : (np < 2920 ? 1376 + (np - 2912) : -1)); }
struct Ptrs { float* X; bf16 *XB, *HB, *ACT, *QA, *QB, *QI, *QC, *QD, *RA, *RB, *RC, *RD, *CC; float* WI; float* SSQ; float* LAMF; float2 *R64, *R32; unsigned* chk; float* save; unsigned char* wl; };
__device__ __forceinline__ Ptrs mkptrs(const Args& a, int l) { Ptrs p; unsigned char* ws = a.ws;
    p.X = a.out; p.XB = (bf16*)(ws + WS_XB); p.HB = (bf16*)(ws + WS_REGA); p.ACT = p.HB; p.QA = (bf16*)(ws + WS_QA); p.QB = (bf16*)(ws + WS_QB); p.QI = (bf16*)(ws + WS_QI); p.QC = (bf16*)(ws + WS_QC); p.QD = (bf16*)(ws + WS_QD);
    p.RA = (bf16*)(ws + WS_RA); p.RB = (bf16*)(ws + WS_RB); p.RC = (bf16*)(ws + WS_RC); p.RD = (bf16*)(ws + WS_RD); p.CC = (bf16*)(ws + WS_CC); p.WI = (float*)(ws + WS_WI); p.SSQ = (float*)(ws + WS_SSQ);
    p.LAMF = (float*)(ws + WS_MISC); p.R64 = (float2*)(ws + WS_MISC + MISC_ROPE64); p.R32 = (float2*)(ws + WS_MISC + MISC_ROPE32); p.chk = (unsigned*)(ws + WS_CHK); p.save = (float*)(ws + WS_CHK + 256); p.wl = ws + WS_W + (size_t)l * W_LAYER; return p; }
__device__ __forceinline__ int samp_row(unsigned h) { const unsigned r = h % 4096u; return r < 3584u ? (int)(hsh(h) % (unsigned)MP) : MP + (int)(hsh(h) % (unsigned)MS); }

__global__ void __launch_bounds__(256) check_kernel(Args a, int l, int which) {
    const Ptrs p = mkptrs(a, l); const int gt = blockIdx.x * 256 + threadIdx.x, NT = gridDim.x * 256; const int lane = threadIdx.x & 63; const int gwv = gt >> 6, NW = NT >> 6;
    const float* ssqA = p.SSQ + (size_t)l * M; const float* ssqB = p.SSQ + (size_t)(3 + l) * M; const float* ssqC = p.SSQ + (size_t)(5 + l) * M; const float* ssqQ = p.SSQ + (size_t)(7 + l) * M;
    if (which == 0) {
        for (int i = gt; i < 16384; i += NT) { const unsigned h = hsh(i * 3 + 1);
            { const int np = h % NGU, k = hsh(h) % DM, pn = np >> 8, c = np & 255, f = pn * 128 + (c & 127); const float* src = (c < 128 ? a.in[I_G1] : a.in[I_U1]) + (size_t)l * DM * DFF;
              chk_rep(p.chk + 0, bf2f(((bf16*)(p.wl + W_GU1))[(size_t)np * DM + k]), bfr(src[(size_t)k * DFF + f] * a.in[I_N1][l * DM + k]), 1e-6f, 1e-3f); }
            { const int n = h % DM, k = hsh(h + 7) % DFF; chk_rep(p.chk + 1, bf2f(((bf16*)(p.wl + W_D1))[(size_t)n * DFF + k]), bfr(a.in[I_D1][(size_t)l * DFF * DM + (size_t)k * DM + n]), 1e-6f, 1e-3f); }
            { const int np = h % NINP, k = hsh(h + 9) % DM, j = nat_col(np); const float ex = j < 0 ? 0.f : bfr(a.in[I_WIN][(size_t)l * DM * NIN + (size_t)k * NIN + j] * a.in[I_NM][l * DM + k]);
              chk_rep(p.chk + 2, bf2f(((bf16*)(p.wl + W_IN))[(size_t)np * DM + k]), ex, 1e-6f, 1e-3f); }
            if (l == 0) { const int row = samp_row(h), c = hsh(h + 11) % DM; const float xv = row < MP ? a.in[I_XP][(size_t)row * DM + c] : a.in[I_XS][(size_t)(row - MP) * DM + c];
              chk_rep(p.chk + 3, bf2f(p.XB[(size_t)row * DM + c]), bfr(xv), 1e-6f, 1e-3f); }
        }
        if (l == 0) for (int i = gwv; i < 256; i += NW) { const int row = samp_row(hsh(i + 77)); const float* xr = row < MP ? a.in[I_XP] + (size_t)row * DM : a.in[I_XS] + (size_t)(row - MP) * DM;
            float s = 0.f; for (int c = lane; c < DM; c += 64) s += xr[c] * xr[c]; s = wave_sum(s); if (lane == 0) chk_rep(p.chk + 3, ssqA[row], s, 1e-3f, 1e-3f); }
    }
    if (which == 1) {
        for (int i = gt; i < 8192; i += NT) { const unsigned h = hsh(i * 5 + 2); const int row = samp_row(h), f = hsh(h + 1) % DFF; const bf16* wg = (bf16*)(p.wl + W_GU1) + (size_t)((f >> 7) * 256 + (f & 127)) * DM; const bf16* wu = wg + (size_t)128 * DM;
            const float* ssq = ssqA; float g = 0.f, u = 0.f; for (int k = 0; k < DM; ++k) { const float xv = bf2f(p.XB[(size_t)row * DM + k]); g += xv * bf2f(wg[k]); u += xv * bf2f(wu[k]); }
            const float rs = 1.0f / sqrtf(ssq[row] / 1024.f + EPS); g *= rs; u *= rs; const float ex = g / (1.f + expf(-g)) * u;
            chk_rep(p.chk + 4, bf2f(p.ACT[(size_t)row * DFF + f]), ex, 0.01f, 0.02f); }
    }
    if (which == 2) {
        for (int i = gt; i < 8192; i += NT) { const unsigned h = hsh(i * 7 + 3); const int row = samp_row(h), c = hsh(h + 1) % DM; const bf16* wd = (bf16*)(p.wl + W_D1) + (size_t)c * DFF;
            float s = 0.f; for (int k = 0; k < DFF; ++k) s += bf2f(p.ACT[(size_t)row * DFF + k]) * bf2f(wd[k]);
            const float xin = l == 0 ? (row < MP ? a.in[I_XP][(size_t)row * DM + c] : a.in[I_XS][(size_t)(row - MP) * DM + c]) : 0.f;
            if (l == 0) chk_rep(p.chk + 5, p.X[(size_t)row * DM + c], xin + 0.5f * s, 0.01f, 0.005f);
            chk_rep(p.chk + 5, bf2f(p.XB[(size_t)row * DM + c]), bfr(p.X[(size_t)row * DM + c]), 1e-6f, 1e-3f); }
        for (int i = gwv; i < 256; i += NW) { const int row = samp_row(hsh(i + 177)); float s = 0.f; for (int c = lane; c < DM; c += 64) { const float v = p.X[(size_t)row * DM + c]; s += v * v; } s = wave_sum(s);
            if (lane == 0) chk_rep(p.chk + 5, ssqB[row], s, 1e-3f, 1e-3f); }
    }
    if (which == 3) {
        for (int i = gt; i < 8192; i += NT) { const unsigned h = hsh(i * 11 + 4); const int row = samp_row(h), np = hsh(h + 1) % NINP; const bf16* w = (bf16*)(p.wl + W_IN) + (size_t)np * DM;
            float s = 0.f; for (int k = 0; k < DM; ++k) s += bf2f(p.XB[(size_t)row * DM + k]) * bf2f(w[k]); s *= 1.0f / sqrtf(ssqB[row] / 1024.f + EPS);
            chk_rep(p.chk + 6, bf2f(p.HB[(size_t)row * NINP + np]), s, 0.01f, 0.01f); }
        for (int i = gwv; i < 256; i += NW) { const int row = samp_row(hsh(i + 277)); float s = 0.f; for (int c = lane; c < 256; c += 64) { const float v = bf2f(p.HB[(size_t)row * NINP + c]); s += v * v; } s = wave_sum(s);
            if (lane == 0) chk_rep(p.chk + 6, ssqQ[row], s, 0.05f, 0.01f); }
    }
    if (which == 4) {
        const float* wqb = a.in[I_WQB] + (size_t)l * 256 * 384; const float* wkvb = a.in[I_WKVB] + (size_t)l * 128 * 512; const float* qn = a.in[I_QN] + l * 256;
        for (int i = gt; i < 2048; i += NT) { const unsigned h = hsh(i * 13 + 5); const int row = samp_row(h), hh = (hsh(h + 1) >> 3) & 3, c = hsh(h + 2) % 160; const bf16* hr = p.HB + (size_t)row * NINP;
            const float rs = 1.0f / sqrtf(ssqQ[row] / 256.f + EPS); float ex;
            if (c < 128) { float acc = 0.f; for (int e = 0; e < 64; ++e) { float qe = 0.f; for (int k = 0; k < 256; ++k) qe += bf2f(hr[k]) * rs * qn[k] * wqb[(size_t)k * 384 + hh * 96 + e]; acc += qe * wkvb[(size_t)c * 512 + hh * 128 + e]; } ex = acc; }
            else { float qe = 0.f; for (int k = 0; k < 256; ++k) qe += bf2f(hr[k]) * rs * qn[k] * wqb[(size_t)k * 384 + hh * 96 + 64 + (c - 128)]; ex = qe; }
            ex *= 0.10206207261596575f * LOG2E;
            chk_rep(p.chk + 7, bf2f(p.QA[(size_t)row * NQP + hh * 160 + c]), ex, 0.01f, 0.02f); }
        for (int i = gt; i < 16384; i += NT) { const unsigned h = hsh(i * 17 + 6); const int row = samp_row(h); const bool smp = row >= MP; const int rr = smp ? row - MP : row; const float pos = smp ? 4096.f + (rr & 63) : (float)(rr & 2047);
            const bf16* hr = p.HB + (size_t)row * NINP;
            const float* o_mla = a.out + (smp ? O_MLA_S + ((size_t)l * MS + rr) * 160 : O_MLA_P + ((size_t)l * MP + rr) * 160);
            const float* o_dsa = a.out + (smp ? O_DSA_S + ((size_t)l * MS + rr) * 192 : O_DSA_P + ((size_t)l * MP + rr) * 192);
            const float* o_sb = a.out + (smp ? O_SB_S + ((size_t)l * MS + rr) * 512 : O_SB_P + ((size_t)l * MP + rr) * 512);
            const float* o_df = a.out + (smp ? O_DIFF_S + ((size_t)l * MS + rr) * 512 : O_DIFF_P + ((size_t)l * MP + rr) * 512);
#define HN(j) bf2f(hr[(j) < 1376 ? (j) : ((j) < 1384 ? H_WI + ((j) - 1376) : (j) - 8)])
#define ROPE(base, d, idx, res) do { const int hf = (d) / 2, ii = (idx) % hf; const float fr = (d) == 64 ? a.freq64[ii] : a.freq32[ii]; float sn, cs; sincos_acc(pos * fr, sn, cs); \
            const float x1 = HN((base) + ii), x2 = HN((base) + hf + ii); res = (idx) < hf ? x1 * cs - x2 * sn : x2 * cs + x1 * sn; } while (0)
            const int sel = hsh(h + 3) % 12; const unsigned e = hsh(h + 4);
            if (sel == 0) { const int c = e % 128; float ss = 0.f; for (int k = 0; k < 128; ++k) { const float v = HN(256 + k); ss += v * v; } const float ex = HN(256 + c) / sqrtf(ss / 128.f + EPS) * a.in[I_KVN][l * 128 + c];
                chk_rep(p.chk + 8, o_mla[c], ex, 0.01f, 0.01f); chk_rep(p.chk + 8, bf2f(p.RA[(size_t)row * 160 + c]), ex, 0.01f, 0.01f); }
            if (sel == 1) { const int c = e % 32; float ex; ROPE(384, 32, c, ex); chk_rep(p.chk + 8, o_mla[128 + c], ex, 0.01f, 0.01f); chk_rep(p.chk + 8, bf2f(p.RA[(size_t)row * 160 + 128 + c]), ex, 0.01f, 0.01f); }
            if (sel == 2) { const int c = e % 256, hd = c >> 6; float ex; ROPE(416 + hd * 64, 64, c & 63, ex); chk_rep(p.chk + 8, bf2f(p.QB[(size_t)row * 256 + c]), ex * 0.125f * LOG2E, 0.01f, 0.01f); }
            if (sel == 3) { const int c = e % 64; float ex; ROPE(672, 64, c, ex); chk_rep(p.chk + 8, o_dsa[c], ex, 0.01f, 0.01f); chk_rep(p.chk + 8, bf2f(p.RB[(size_t)row * 192 + c]), ex, 0.01f, 0.01f);
                            const float v = HN(736 + c); chk_rep(p.chk + 8, o_dsa[64 + c], v, 0.01f, 0.01f); chk_rep(p.chk + 8, bf2f(p.RB[(size_t)row * 192 + 64 + c]), v, 0.01f, 0.01f); }
            if (sel == 4) { const int c = e % 512, hd = c >> 6; float ex; ROPE(800 + hd * 64, 64, c & 63, ex); chk_rep(p.chk + 8, bf2f(p.QI[(size_t)row * 512 + c]), ex, 0.01f, 0.01f); }
            if (sel == 5) { const int c = e % 64; float ex; ROPE(1312, 64, c, ex); chk_rep(p.chk + 8, o_dsa[128 + c], ex, 0.01f, 0.01f); chk_rep(p.chk + 8, bf2f(p.RB[(size_t)row * 192 + 128 + c]), ex, 0.01f, 0.01f);
                            const int w8 = e % 8; chk_rep(p.chk + 8, p.WI[(size_t)row * 8 + w8], HN(1376 + w8) * 0.35355339f, 0.005f, 0.01f); }
            if (sel == 6) { const int c = e % 256, hd = c >> 6, d = c & 63; chk_rep(p.chk + 8, bf2f(p.QC[(size_t)row * 256 + c]), HN(1384 + c) * 0.125f, 0.005f, 0.01f);
                            chk_rep(p.chk + 8, o_sb[hd * 128 + d], HN(1640 + c), 0.01f, 0.01f); chk_rep(p.chk + 8, o_sb[hd * 128 + 64 + d], HN(1896 + c), 0.01f, 0.01f);
                            chk_rep(p.chk + 8, bf2f(p.RC[(size_t)row * 512 + hd * 128 + d]), HN(1640 + c), 0.01f, 0.01f); chk_rep(p.chk + 8, bf2f(p.RC[(size_t)row * 512 + hd * 128 + 64 + d]), HN(1896 + c), 0.01f, 0.01f); }
            if (sel == 7) { const int c = e % 256, blk = c >> 5; float ex; ROPE(2152 + blk * 32, 32, c & 31, ex); chk_rep(p.chk + 8, bf2f(p.QD[(size_t)row * 256 + c]), ex * 0.17677669529663687f * LOG2E, 0.01f, 0.01f); }
            if (sel == 8) { const int c = e % 256, blk = c >> 5, hd = c >> 6; float ex; ROPE(2408 + blk * 32, 32, c & 31, ex); chk_rep(p.chk + 8, o_df[hd * 128 + (c & 63)], ex, 0.01f, 0.01f); chk_rep(p.chk + 8, bf2f(p.RD[(size_t)row * 512 + hd * 128 + (c & 63)]), ex, 0.01f, 0.01f); }
            if (sel == 9) { const int c = e % 256, hd = c >> 6, d = c & 63; chk_rep(p.chk + 8, o_df[hd * 128 + 64 + d], HN(2664 + c), 0.01f, 0.01f); chk_rep(p.chk + 8, bf2f(p.RD[(size_t)row * 512 + hd * 128 + 64 + d]), HN(2664 + c), 0.01f, 0.01f); }
        }
    }
    if (which == 5) {
        for (int i = gwv; i < 4 * 96; i += NW) {
            int kind = i / 96; const int slot = kind; const unsigned h = hsh(i * 19 + 7); int row = samp_row(h);
            if (CHK_FILTER == 6) { row = MP + (int)(hsh(h + 5) % (unsigned)MS); if (slot == 1) { kind = 2; row = (row & ~63) | (int)(hsh(h + 9) % 3u); } if (slot == 2) row = (row & ~63) | (48 + (int)(hsh(h + 9) % 16u)); }
            if (CHK_FILTER == 1) row = (int)(hsh(h + 5) % NB) * SEQ + (int)(hsh(h + 6) % 64u);
            if (CHK_FILTER == 2) row = (int)(hsh(h + 5) % (unsigned)MP);
            if (CHK_FILTER == 3) row = MP + (int)(hsh(h + 5) % (unsigned)MS);
            if (CHK_FILTER == 5) { if (kind == 0 || kind == 2) row = MP + (int)(hsh(h + 5) % (unsigned)MS); else if (kind == 1) row = (int)(hsh(h + 5) % NB) * SEQ + 128 + (int)(hsh(h + 6) % 128u); else row = (int)(hsh(h + 5) % NB) * SEQ + 128 + (int)(hsh(h + 6) % 384u); }
            if (CHK_FILTER == 4) row = (int)(hsh(h + 5) % NB) * SEQ + 64 + (int)(hsh(h + 6) % 64u); const int hd = (hsh(h + 1) >> 5) & 3; const bool smp = row >= MP; const int rr = smp ? row - MP : row;
            const int b = smp ? rr >> 6 : rr >> 11, t = smp ? rr & 63 : rr & 2047; const int L = smp ? PAST + 64 : ((t >> 6) + 1) * 64;
            const int W = kind == 0 ? 160 : (kind == 1 ? 192 : 512);
            const float* cache = (kind == 0 ? a.in[I_CMLA] : kind == 1 ? a.in[I_CDSA] : kind == 2 ? a.in[I_CSB] : a.in[I_CDIFF]) + (size_t)(l * NB + b) * PAST * W;
            const bf16* rows = kind == 0 ? p.RA : kind == 1 ? p.RB : kind == 2 ? p.RC : p.RD;
#define SLD(ptr) __hip_atomic_load((ptr), __ATOMIC_RELAXED, __HIP_MEMORY_SCOPE_AGENT)
#define KEL(k, c) (smp ? ((k) < PAST ? bfr(cache[(size_t)(k) * W + (c)]) : bf2f(rows[(size_t)(MP + b * 64 + (k) - PAST) * W + (c)])) : bf2f(rows[(size_t)(b * SEQ + (k)) * W + (c)]))
            float* sbuf = (float*)(a.ws + WS_REGA + (size_t)300 * MiB) + (size_t)i * 8448;
            if (kind == 0) {
                const int pidx = smp ? 2048 + t : t; float mx = -1e30f;
                for (int k = lane; k < L; k += 64) { float s = 0.f; for (int c = 0; c < 128; ++c) s += bf2f(p.QA[(size_t)row * NQP + hd * 160 + c]) * KEL(k, c);
                    for (int c = 0; c < 16; ++c) { const float2 cs = p.R32[pidx * 16 + c]; const float x1 = bf2f(p.QA[(size_t)row * NQP + hd * 160 + 128 + c]), x2 = bf2f(p.QA[(size_t)row * NQP + hd * 160 + 144 + c]);
                        s += bfr(x1 * cs.x - x2 * cs.y) * KEL(k, 128 + c) + bfr(x2 * cs.x + x1 * cs.y) * KEL(k, 144 + c); }
                    sbuf[k] = s; mx = fmaxf(mx, s); }
                for (int o = 1; o < 64; o <<= 1) mx = fmaxf(mx, __shfl_xor(mx, o));
                float den = 0.f; for (int k = lane; k < L; k += 64) { float pp = exp2f(sbuf[k] - mx); if (DBG_VARIANTS) pp = 1.f; sbuf[k] = pp; den += pp; } den = wave_sum(den);
                __builtin_amdgcn_s_waitcnt(0);
                for (int d = 0; d < 128; d += 16) { const int dd = d + (lane & 15); float acc = 0.f; for (int k = lane >> 4; k < L; k += 4) acc += SLD(sbuf + k) * KEL(k, dd); acc += __shfl_xor(acc, 16); acc += __shfl_xor(acc, 32);
                    if (lane < 16) chk_rep(p.chk + 9, bf2f(p.CC[(size_t)row * KOUT + hd * 128 + dd]), acc / den, 0.004f, 0.03f); }
            }
            if (kind == 1) {
                const int nsel = 256;
                for (int k = lane; k < L; k += 64) { float sc = 0.f; for (int ih = 0; ih < 8; ++ih) { float s = 0.f; for (int c = 0; c < 64; ++c) s += bf2f(p.QI[(size_t)row * 512 + ih * 64 + c]) * KEL(k, 128 + c); sc += fmaxf(s, 0.f) * p.WI[(size_t)row * 8 + ih]; } sbuf[k] = sc; }
                __builtin_amdgcn_s_waitcnt(0);
                float mx = -1e30f; float* pb = sbuf + 4224;
                for (int k = lane; k < L; k += 64) { const float me = sbuf[k]; int rank = 0; if (L > nsel) for (int j = 0; j < L; ++j) { const float o = SLD(sbuf + j); rank += (o > me) || (o == me && j < k); }
                    float s = -1e30f; if (rank < nsel) { s = 0.f; for (int c = 0; c < 64; ++c) s += bf2f(p.QB[(size_t)row * 256 + hd * 64 + c]) * KEL(k, c); } pb[k] = s; mx = fmaxf(mx, s); }
                for (int o = 1; o < 64; o <<= 1) mx = fmaxf(mx, __shfl_xor(mx, o));
                float den = 0.f; for (int k = lane; k < L; k += 64) { const float pp = pb[k] > -1e29f ? exp2f(pb[k] - mx) : 0.f; pb[k] = pp; den += pp; } den = wave_sum(den);
                __builtin_amdgcn_s_waitcnt(0);
                for (int d = 0; d < 64; d += 16) { const int dd = d + (lane & 15); float acc = 0.f; for (int k = lane >> 4; k < L; k += 4) acc += SLD(pb + k) * KEL(k, 64 + dd); acc += __shfl_xor(acc, 16); acc += __shfl_xor(acc, 32);
                    if (lane < 16) chk_rep(p.chk + 10, bf2f(p.CC[(size_t)row * KOUT + 512 + hd * 64 + dd]), acc / den, 0.02f, 0.10f); }
            }
            if (kind == 2) {
                const int qpos = smp ? PAST + t : t; float accv[1]; (void)accv;
                for (int k = lane; k < qpos; k += 64) { float z = 0.f; for (int c = 0; c < 64; ++c) z += bf2f(p.QC[(size_t)row * 256 + hd * 64 + c]) * KEL(k, hd * 128 + c); sbuf[k] = z; }
                __builtin_amdgcn_s_waitcnt(0);
                float logafter = 0.f, acc = 0.f;
                for (int k = qpos - 1; k >= 0; --k) { const float z = SLD(sbuf + k); const float sp = fmaxf(z, 0.f) + logf(1.f + expf(-fabsf(z))); const float aw = expf(z - sp + logafter); acc += bfr(aw) * KEL(k, hd * 128 + 64 + lane); logafter -= sp; if (logafter < -60.f) break; }
                chk_rep(p.chk + 9 + slot, bf2f(p.CC[(size_t)row * KOUT + 768 + hd * 64 + lane]), acc, 0.02f, 0.05f);
            }
            if (kind == 3) {
                float outv = 0.f; float o2[2];
                for (int m2 = 0; m2 < 2; ++m2) { float mx = -1e30f;
                    for (int k = lane; k < L; k += 64) { float s = 0.f; for (int c = 0; c < 32; ++c) s += bf2f(p.QD[(size_t)row * 256 + hd * 64 + m2 * 32 + c]) * KEL(k, hd * 128 + m2 * 32 + c); sbuf[k] = s; mx = fmaxf(mx, s); }
                    for (int o = 1; o < 64; o <<= 1) mx = fmaxf(mx, __shfl_xor(mx, o));
                    float den = 0.f; for (int k = lane; k < L; k += 64) { const float pp = exp2f(sbuf[k] - (DBG_VARIANTS ? 8.f : mx)); sbuf[k] = pp; den += pp; } den = wave_sum(den);
                    __builtin_amdgcn_s_waitcnt(0);
                    float acc = 0.f; for (int k = 0; k < L; ++k) acc += SLD(sbuf + k) * KEL(k, hd * 128 + 64 + lane); o2[m2] = acc / den; __builtin_amdgcn_s_waitcnt(0); }
                outv = o2[0] - p.LAMF[l] * o2[1]; const float ss = wave_sum(outv * outv); const float lam_init = 0.8f - 0.6f * expf(-0.3f * (float)l);
                const float ex = outv / sqrtf(ss / 64.f + EPS) * a.in[I_DN][l * 64 + lane] * (1.f - lam_init);
                chk_rep(p.chk + 12, bf2f(p.CC[(size_t)row * KOUT + 1024 + hd * 64 + lane]), ex, 0.02f, 0.05f);
            }
        }
    }
    if (which == 6) { for (int i = gt; i < 4096; i += NT) { const unsigned h = hsh(i * 23 + 8); const int row = samp_row(h), c = hsh(h + 1) % DM; p.save[i] = p.X[(size_t)row * DM + c]; } }
    if (which == 7) {
        const float* wkvb = a.in[I_WKVB] + (size_t)l * 128 * 512; const float* wo = a.in[I_WO] + (size_t)l * DM * DM;
        for (int i = gt; i < 4096; i += NT) { const unsigned h = hsh(i * 23 + 8); const int row = samp_row(h), c = hsh(h + 1) % DM; const bf16* w = (bf16*)(p.wl + W_OUT) + (size_t)c * KOUT;
            float s = 0.f; for (int k = 0; k < KOUT; ++k) s += bf2f(p.CC[(size_t)row * KOUT + k]) * bf2f(w[k]);
            chk_rep(p.chk + 13, p.X[(size_t)row * DM + c], p.save[i] + s, 0.01f, 0.005f);
            float s1 = 0.f, s2 = 0.f; for (int k = 0; k < 512; ++k) s1 += bf2f(p.CC[(size_t)row * KOUT + k]) * bf2f(w[k]);
            for (int hh = 0; hh < 4; ++hh) for (int e = 0; e < 64; ++e) { float v = 0.f; for (int cc = 0; cc < 128; ++cc) v += bf2f(p.CC[(size_t)row * KOUT + hh * 128 + cc]) * wkvb[(size_t)cc * 512 + hh * 128 + 64 + e]; s2 += v * wo[(size_t)(hh * 64 + e) * DM + c]; }
            chk_rep(p.chk + 14, s1, s2, 0.01f, 0.02f);
            for (int k = 512; k < KOUT; k += 97) chk_rep(p.chk + 14, bf2f(w[k]), bfr(wo[(size_t)(256 + k - 512) * DM + c]), 1e-6f, 1e-3f); }
    }
}
#ifndef CHK_SHOW
#define CHK_SHOW -1
#endif
#ifndef CHK_MAXLI
#define CHK_MAXLI 6
#endif
__global__ void __launch_bounds__(256) report_kernel(Args a) {
    const unsigned* chk = (const unsigned*)(a.ws + WS_CHK); float A = 0.f;
    if (CHK_SHOW >= 0) { A = sqrtf(fminf(__uint_as_float(chk[CHK_SHOW >= 0 ? CHK_SHOW : 0]), 400.f)); if (A < 0.3f) A = 0.f; }
    else if (CHK_SHOW == -2) { int bits = 0; for (int f = 9; f <= 12; ++f) if (__uint_as_float(chk[f]) > 1.0f) bits |= 1 << (f - 9); A = (float)(1 + bits); }
    else for (int f = 0; f < 15; ++f) if (__uint_as_float(chk[f]) > 1.0f) { A = (float)(f + 1); break; }
    if (A == 0.f) return;
    for (size_t i = (size_t)blockIdx.x * 256 + threadIdx.x; i < (size_t)M * DM; i += (size_t)gridDim.x * 256) a.out[i] = A;
}
#endif

extern "C" void kernel_launch(void* const* d_in, const int* in_sizes, int n_in, void* d_out, int out_size, void* d_ws, size_t ws_size, hipStream_t stream) {
    static int grid = 0;
    if (grid == 0) {
        if (n_in != 24 || (size_t)out_size != O_END || ws_size < WS_END) { fprintf(stderr, "kernel_launch: unexpected shapes: n_in %d out %d ws %zu (need %zu)\n", n_in, out_size, ws_size, (size_t)WS_END); grid = -1; return; }
        int dev = 0, cus = 0, per_cu = 0;
        if (hipGetDevice(&dev) != hipSuccess || hipDeviceGetAttribute(&cus, hipDeviceAttributeMultiprocessorCount, dev) != hipSuccess) { grid = -1; return; }
        if (hipFuncSetAttribute((const void*)fwd_kernel, hipFuncAttributeMaxDynamicSharedMemorySize, LDS_BYTES) != hipSuccess) { fprintf(stderr, "kernel_launch: hipFuncSetAttribute failed\n"); grid = -1; return; }
        if (hipOccupancyMaxActiveBlocksPerMultiprocessor(&per_cu, (const void*)fwd_kernel, NWAVES * 64, LDS_BYTES) != hipSuccess || per_cu < 1) fprintf(stderr, "kernel_launch: occupancy query reports %d\n", per_cu);
        (void)hipGetLastError();
        grid = cus < 256 ? cus : 256;
    }
    if (grid < 0) return;
    (void)hipMemsetAsync((char*)d_ws + WS_CTL, 0, CTL_ZERO_BYTES, stream);
    Args a{};
    for (int i = 0; i < 24; ++i) a.in[i] = (const float*)d_in[i];
    a.out = (float*)d_out; a.ws = (unsigned char*)d_ws;
    for (int i = 0; i < 32; ++i) a.freq64[i] = (float)pow(10000.0, -(double)i * 2.0 / 64.0);
    for (int i = 0; i < 16; ++i) a.freq32[i] = (float)pow(10000.0, -(double)i * 2.0 / 32.0);
    constexpr int NPH = 18;
    for (int li = 0; li < MK_N_LAUNCHES; ++li) {
        a.ph_lo = (MK_N_LAUNCHES == 1) ? 0 : li; a.ph_hi = (MK_N_LAUNCHES == 1) ? NPH : li + 1;
#if SELFCHECK
        if (MK_N_LAUNCHES == 18 && li == 6 && CHK_MAXLI >= 6) hipLaunchKernelGGL(check_kernel, dim3(256), dim3(256), 0, stream, a, 0, 6);
#endif
        hipLaunchKernelGGL(fwd_kernel, dim3(grid), dim3(NWAVES * 64), LDS_BYTES, stream, a);
        const hipError_t le = hipPeekAtLastError();
        if (le != hipSuccess) { fprintf(stderr, "kernel_launch: launch %d failed: %s\n", li, hipGetErrorName(le)); break; }
#if SELFCHECK
        if (MK_N_LAUNCHES == 18) { const int wmap[7] = {0, 1, 2, 3, 4, 5, 7}; if (li <= CHK_MAXLI) hipLaunchKernelGGL(check_kernel, dim3(512), dim3(256), 0, stream, a, 0, wmap[li]); }
#endif
    }
#if SELFCHECK
    hipLaunchKernelGGL(report_kernel, dim3(1024), dim3(256), 0, stream, a);
#endif
}
```

```cpp
#include <hip/hip_runtime.h>
#include <cstdio>
#include <cstdint>
#include <cmath>

#ifndef DBG_VARIANTS
#define DBG_VARIANTS 0
#endif
#ifndef ATTN_REPS
#define ATTN_REPS 1
#endif
#ifndef POST_REPS
#define POST_REPS 1
#endif
#ifndef GU_REPS
#define GU_REPS 1
#endif
#ifndef P0_REPS
#define P0_REPS 1
#endif
#ifndef REP_MASK
#define REP_MASK 15
#endif
#ifndef SELFCHECK
#define SELFCHECK 0
#endif
#ifndef CHK_FILTER
#define CHK_FILTER 0
#endif
#ifndef IN_STAGGER_TICKS
#define IN_STAGGER_TICKS 0
#endif
#ifndef FUSE_POST
#define FUSE_POST 1
#endif
#ifndef MK_N_LAUNCHES
#define MK_N_LAUNCHES 1
#endif

#ifndef PHMASK
#define PHMASK 0x3ff
#endif
#define EN_PH(c) (((PHMASK) >> (c)) & 1)
#ifndef EN_MLA
#define EN_MLA 1
#endif
#ifndef EN_DSA
#define EN_DSA 1
#endif
#ifndef EN_SB
#define EN_SB 1
#endif
#ifndef EN_DIFF
#define EN_DIFF 1
#endif
#define LAS __attribute__((address_space(3)))
#define GAS __attribute__((address_space(1)))

constexpr int DM = 1024, NB = 32, SEQ = 2048, DEPTH = 2, DSEQ = 64, PAST = 4096;
constexpr int MP = NB * SEQ, MS = NB * DSEQ, M = MP + MS;
constexpr int DFF = 2816, NGU = 2 * DFF, NIN = 2920, NINP = 3072, NQ = 640, NQP = 768, KOUT = 1280;
constexpr float EPS = 1e-6f;
constexpr float LOG2E = 1.4426950408889634f;
constexpr int H_CQ = 0, H_CKV = 256, H_KR = 384, H_QB = 416, H_KB = 672, H_VB = 736, H_QI = 800, H_KI = 1312,
              H_QC = 1376, H_KC = 1632, H_VC = 1888, H_QD = 2144, H_KD = 2400, H_VD = 2656, H_WI = 2912;
constexpr size_t O_Y = 0;
constexpr size_t O_MLA_P = (size_t)M * DM;
constexpr size_t O_DSA_P = O_MLA_P + (size_t)DEPTH * MP * 160;
constexpr size_t O_SB_P = O_DSA_P + (size_t)DEPTH * MP * 192;
constexpr size_t O_DIFF_P = O_SB_P + (size_t)DEPTH * MP * 512;
constexpr size_t O_MLA_S = O_DIFF_P + (size_t)DEPTH * MP * 512;
constexpr size_t O_DSA_S = O_MLA_S + (size_t)DEPTH * MS * 160;
constexpr size_t O_SB_S = O_DSA_S + (size_t)DEPTH * MS * 192;
constexpr size_t O_DIFF_S = O_SB_S + (size_t)DEPTH * MS * 512;
constexpr size_t O_END = O_DIFF_S + (size_t)DEPTH * MS * 512;

constexpr size_t MiB = 1u << 20;
constexpr size_t WS_CTL = 0, CTL_ZERO_BYTES = SELFCHECK ? 4 * MiB : 128 * 1024;
constexpr size_t WS_SSQ = 1 * MiB;
constexpr size_t WS_MISC = 4 * MiB;
constexpr size_t MISC_ROPE64 = 4096, MISC_ROPE32 = MISC_ROPE64 + (size_t)2112 * 32 * 8;
constexpr size_t WS_W = 5 * MiB;
constexpr size_t W_GU1 = 0, W_D1 = W_GU1 + (size_t)NGU * DM * 2, W_IN = W_D1 + (size_t)DM * DFF * 2, W_Q = W_IN + (size_t)NINP * DM * 2,
                 W_OUT = W_Q + (size_t)NQP * 256 * 2, W_GU2 = W_OUT + (size_t)DM * KOUT * 2, W_D2 = W_GU2 + (size_t)NGU * DM * 2, W_LAYER = W_D2 + (size_t)DM * DFF * 2;
constexpr size_t WS_XB = 90 * MiB;
constexpr size_t WS_REGA = 222 * MiB;
constexpr size_t REGA_BYTES = (size_t)M * NINP * 2;
constexpr size_t WS_QA = 618 * MiB, WS_QB = 717 * MiB, WS_QI = 750 * MiB, WS_QC = 816 * MiB, WS_QD = 849 * MiB, WS_WI = 882 * MiB;
constexpr size_t WS_RA = 885 * MiB, WS_RB = 906 * MiB, WS_RC = 931 * MiB, WS_RD = 997 * MiB, WS_CC = 1063 * MiB, WS_SSQP = 1228 * MiB, WS_END = 1264 * MiB;
static_assert(WS_W + 2 * W_LAYER <= WS_XB && WS_XB + (size_t)M * DM * 2 <= WS_REGA && WS_REGA + REGA_BYTES <= WS_QA, "ws map");
static_assert(WS_QA + (size_t)M * NQP * 2 <= WS_QB && WS_QI + (size_t)M * 512 * 2 <= WS_QC && WS_WI + (size_t)M * 32 <= WS_RA, "ws map");
static_assert(WS_RA + (size_t)M * 160 * 2 <= WS_RB && WS_RB + (size_t)M * 192 * 2 <= WS_RC && WS_RC + (size_t)M * 1024 <= WS_RD && WS_RD + (size_t)M * 1024 <= WS_CC && WS_CC + (size_t)M * KOUT * 2 <= WS_SSQP && WS_SSQP + (size_t)M * 16 * 4 * 7 + (size_t)M * 4 * 4 * 4 <= WS_END, "ws map");
constexpr int CW_BAR = 4096, CW_Q = 8192;
constexpr int SC_LS = 4160;
constexpr int MK_LS = 72;
constexpr size_t DSA_SCR = 1105920;
constexpr size_t DSA_MASK_OFF = (size_t)64 * SC_LS * 4;
static_assert(DSA_MASK_OFF + 64 * MK_LS * 8 <= DSA_SCR && 256 * DSA_SCR <= REGA_BYTES, "dsa scratch");

constexpr int RING_BYTES = 135168, LDSCTL_OFF = RING_BYTES, MISC_OFF = LDSCTL_OFF + 320, LDS_BYTES = 147456;
constexpr int NWAVES = 8;

typedef unsigned short bf16;
typedef unsigned v4u __attribute__((ext_vector_type(4)));
typedef unsigned v2u __attribute__((ext_vector_type(2)));
typedef float f32x4 __attribute__((ext_vector_type(4)));
typedef float f32x16 __attribute__((ext_vector_type(16)));
typedef short bf16x8 __attribute__((ext_vector_type(8)));
typedef short s16x4 __attribute__((ext_vector_type(4)));
typedef GAS unsigned gu32;
#define RLX_AGENT __ATOMIC_RELAXED, __HIP_MEMORY_SCOPE_AGENT
#define LDS_WAIT() asm volatile("s_waitcnt lgkmcnt(0)" ::: "memory")
#define VM_WAIT() asm volatile("s_waitcnt vmcnt(0)" ::: "memory")

__device__ __forceinline__ unsigned f2bf(float f) { unsigned u = __builtin_bit_cast(unsigned, f); return (u + 0x7fffu + ((u >> 16) & 1u)) >> 16; }
__device__ __forceinline__ unsigned pk2(float lo, float hi) { return f2bf(lo) | (f2bf(hi) << 16); }
__device__ __forceinline__ float bf2f(bf16 b) { return __builtin_bit_cast(float, ((unsigned)b) << 16); }
typedef float f32x2_t __attribute__((ext_vector_type(2))); typedef __bf16 bf16x2_t __attribute__((ext_vector_type(2)));
__device__ __forceinline__ unsigned cvtpk(float lo, float hi) { f32x2_t v = {lo, hi}; bf16x2_t b = __builtin_convertvector(v, bf16x2_t); return __builtin_bit_cast(unsigned, b); }
__device__ __forceinline__ int opaque_s(int x) { asm volatile("" : "+s"(x)); return x; }
__device__ __forceinline__ int fresh_lane() { int l; asm volatile("v_mbcnt_lo_u32_b32 %0, -1, 0\n\tv_mbcnt_hi_u32_b32 %0, -1, %0" : "=&v"(l)); return l; }
__device__ __forceinline__ float opaque_vf(float x) { asm volatile("" : "+v"(x)); return x; }
__device__ __forceinline__ float wave_sum(float v) {
#pragma unroll
    for (int o = 1; o < 64; o <<= 1) v += __shfl_xor(v, o);
    return v;
}

__device__ __forceinline__ float ssq_sum16(const float* p, int row) { const f32x4* q = (const f32x4*)(p + (size_t)row * 16); const f32x4 a = q[0], b = q[1], c = q[2], d = q[3];
    return (((a[0] + a[1]) + (a[2] + a[3])) + ((b[0] + b[1]) + (b[2] + b[3]))) + (((c[0] + c[1]) + (c[2] + c[3])) + ((d[0] + d[1]) + (d[2] + d[3]))); }
__device__ __forceinline__ float ssq_sum4(const float* p, int row) { const f32x4 a = *(const f32x4*)(p + (size_t)row * 4); return (a[0] + a[1]) + (a[2] + a[3]); }
namespace pg8 {
#define PG8_LAS __attribute__((address_space(3)))
typedef unsigned short bf16_t;
typedef unsigned u32x4 __attribute__((ext_vector_type(4)));
constexpr int BM = 256, BK = 64, HALF = 128, HTB = HALF * BK * 2, STAGE_BYTES = 8 * HTB, NXCD = 8, WGM = 8;
__host__ __device__ __forceinline__ int lds_byte(int r, int c) { const int st = (r >> 4) * 2 + (c >> 5), rr = r & 15, cc = c & 31, ob = rr * 64 + cc * 2; return st * 1024 + (ob ^ (((ob >> 9) & 1) << 5)); }
__host__ __device__ __forceinline__ void stage_rc(int b, int& R, int& C) { const int st = b / 1024, sb = b % 1024, swz = sb ^ (((sb >> 9) & 1) << 5); R = (st >> 1) * 16 + swz / 64; C = (st & 1) * 32 + (swz % 64) / 2; }
__host__ __device__ __forceinline__ int perm32(int rho) { const int n = rho >> 4, i = rho & 15; return 8 * (i >> 2) + 4 * n + (i & 3); }
struct Unit { int pm, pn; };
struct Gemm { const bf16_t* A; const bf16_t* Bt; int M, N, K, lda, ldb; };
struct StaticOrder {
    int nM, nN, nwg, G, c;
    __host__ __device__ void init(int M_, int N_, int G_, int c_) { nM = M_ / BM; nN = N_ / BM; nwg = nM * nN; G = G_; c = c_; }
    __host__ __device__ bool next(int i, Unit& u) const {
        const long L = (long)i * G + c; if (L >= nwg) return false;
        int wgid = (int)L; { const int q = nwg / NXCD, r = nwg % NXCD, xcd = wgid % NXCD, off = wgid / NXCD; wgid = (xcd < r ? xcd * (q + 1) : r * (q + 1) + (xcd - r) * q) + off; }
        const int nig = WGM * nN, gid = wgid / nig, fm = gid * WGM, gsz = (nM - fm) < WGM ? (nM - fm) : WGM;
        u.pm = fm + ((wgid % nig) % gsz); u.pn = (wgid % nig) / gsz; return true;
    }
    __device__ __forceinline__ void a_ready(const Unit&) const {}
    __device__ __forceinline__ void done(const Unit&) const {}
};

struct EpiSwiGLU {
    static constexpr bool PERM = true, AFTER_DRAIN = false;
    bf16_t* act; const float* ssq;
    __device__ __forceinline__ void operator()(const f32x4 (&acc)[2][2][4][2], const Unit& u, int wr, int wc, int fr, int fq) const {
        const int row0 = u.pm * BM + wr * 64 + fr, col0 = u.pn * 128 + wc * 32 + 8 * fq;
#pragma unroll
        for (int ai = 0; ai < 2; ++ai)
#pragma unroll
            for (int m = 0; m < 4; ++m) {
                const int row = row0 + ai * HALF + m * 16;
                const float rs = 1.0f / sqrtf(ssq_sum16(ssq, row) * (1.0f / 1024.0f) + EPS);
                float o[8];
#pragma unroll
                for (int n = 0; n < 2; ++n)
#pragma unroll
                    for (int j = 0; j < 4; ++j) {
                        const float g = acc[ai][0][m][n][j] * rs, up = acc[ai][1][m][n][j] * rs;
                        const float sg = g * __builtin_amdgcn_rcpf(1.0f + __builtin_amdgcn_exp2f(-g * LOG2E));
                        o[n * 4 + j] = sg * up;
                    }
                u32x4 w; w.x = cvtpk(o[0], o[1]); w.y = cvtpk(o[2], o[3]); w.z = cvtpk(o[4], o[5]); w.w = cvtpk(o[6], o[7]);
                *(u32x4*)(act + (size_t)row * DFF + col0) = w;
            }
    }
};
template <bool BASE_F32> struct EpiResid {
    static constexpr bool PERM = true, AFTER_DRAIN = false;
    const float* baseP; const float* baseS; bf16_t* xb; float* ssq_out; float alpha;
    __device__ __forceinline__ void operator()(const f32x4 (&acc)[2][2][4][2], const Unit& u, int wr, int wc, int fr, int fq) const {
        const int row0 = u.pm * BM + wr * 64 + fr, col0 = u.pn * BM + wc * 32 + 8 * fq;
        const float* base = (u.pm < MP / BM) ? baseP : baseS;
        u32x4 bw[2][4][2];
        if (!BASE_F32) {
#pragma unroll
            for (int ai = 0; ai < 2; ++ai)
#pragma unroll
                for (int m = 0; m < 4; ++m)
#pragma unroll
                    for (int bj = 0; bj < 2; ++bj) bw[ai][m][bj] = *(const u32x4*)(xb + (size_t)(row0 + ai * HALF + m * 16) * DM + col0 + bj * HALF);
            __builtin_amdgcn_sched_barrier(0);
        }
#pragma unroll
        for (int ai = 0; ai < 2; ++ai) {
        f32x4 bf[4][2][2];
        if (BASE_F32) {
#pragma unroll
            for (int m = 0; m < 4; ++m)
#pragma unroll
                for (int bj = 0; bj < 2; ++bj) { const float* bp = base + (size_t)(row0 + ai * HALF + m * 16) * DM + col0 + bj * HALF; bf[m][bj][0] = *(const f32x4*)bp; bf[m][bj][1] = *(const f32x4*)(bp + 4); }
            __builtin_amdgcn_sched_barrier(0);
        }
#pragma unroll
            for (int m = 0; m < 4; ++m) {
                const int row = row0 + ai * HALF + m * 16; const size_t off = (size_t)row * DM + col0; float ss = 0.f;
#pragma unroll
                for (int bj = 0; bj < 2; ++bj) {
                    f32x4 b0, b1;
                    if (BASE_F32) { b0 = bf[m][bj][0]; b1 = bf[m][bj][1]; }
                    else { const u32x4 w = bw[ai][m][bj];
                        b0 = (f32x4){__uint_as_float(w.x << 16), __uint_as_float(w.x & 0xffff0000u), __uint_as_float(w.y << 16), __uint_as_float(w.y & 0xffff0000u)};
                        b1 = (f32x4){__uint_as_float(w.z << 16), __uint_as_float(w.z & 0xffff0000u), __uint_as_float(w.w << 16), __uint_as_float(w.w & 0xffff0000u)}; }
                    const f32x4 o0 = b0 + acc[ai][bj][m][0] * alpha, o1 = b1 + acc[ai][bj][m][1] * alpha;
                    u32x4 w2; w2.x = cvtpk(o0[0], o0[1]); w2.y = cvtpk(o0[2], o0[3]); w2.z = cvtpk(o1[0], o1[1]); w2.w = cvtpk(o1[2], o1[3]);
                    *(u32x4*)(xb + off + bj * HALF) = w2;
                    ss += (o0[0] * o0[0] + o0[1] * o0[1]) + (o0[2] * o0[2] + o0[3] * o0[3]) + (o1[0] * o1[0] + o1[1] * o1[1]) + (o1[2] * o1[2] + o1[3] * o1[3]);
                }
                ss += __shfl_xor(ss, 16); ss += __shfl_xor(ss, 32);
                if (fq == 0) ssq_out[(size_t)row * 16 + u.pn * 4 + wc] = ss;
                asm volatile("" ::: "memory");
            }
        }
    }
};
struct OneUnit {
    __device__ __forceinline__ bool next(int i, Unit& u) const { if (i > 0) return false; u.pm = 0; u.pn = 0; return true; }
    __device__ __forceinline__ void a_ready(const Unit&) const {}
    __device__ __forceinline__ void done(const Unit&) const {}
};
struct EpiPartial {
    static constexpr bool PERM = true, AFTER_DRAIN = false;
    float* P;
    __device__ __forceinline__ void operator()(const f32x4 (&acc)[2][2][4][2], const Unit&, int wr, int wc, int fr, int fq) const {
        const int tid = (wr * 4 + wc) * 64 + fq * 16 + fr;
#pragma unroll
        for (int ai = 0; ai < 2; ++ai)
#pragma unroll
            for (int bj = 0; bj < 2; ++bj)
#pragma unroll
                for (int m = 0; m < 4; ++m)
#pragma unroll
                    for (int n = 0; n < 2; ++n) { const f32x4 a = acc[ai][bj][m][n]; typedef unsigned u32x2_t __attribute__((ext_vector_type(2)));
                        *(u32x2_t*)((unsigned*)P + ((size_t)((((ai * 2 + bj) * 4 + m) * 2 + n) * 512 + tid)) * 2) = (u32x2_t){cvtpk(a[0], a[1]), cvtpk(a[2], a[3])}; }
    }
};
template <bool BASE_F32> __device__ __forceinline__ void resid_fixup(const float* Pu  , int pm, int pn, int ai, int m, const float* base, bf16_t* xb, float* ssq_out, float alpha, int tid) {
    const int wid = tid >> 6, lane = tid & 63, wr = wid >> 2, wc = wid & 3, fr = lane & 15, fq = lane >> 4;
    typedef unsigned u32x2_t __attribute__((ext_vector_type(2))); f32x4 S[2][2]; u32x2_t L[8][2][2];
#pragma unroll
    for (int sl = 0; sl < 8; ++sl)
#pragma unroll
        for (int bj = 0; bj < 2; ++bj)
#pragma unroll
            for (int n = 0; n < 2; ++n) L[sl][bj][n] = *(const u32x2_t*)((const unsigned*)Pu + (size_t)sl * (32 * 512 * 4) + ((size_t)((((ai * 2 + bj) * 4 + m) * 2 + n) * 512 + tid)) * 2);
    __builtin_amdgcn_sched_barrier(0);
#pragma unroll
    for (int bj = 0; bj < 2; ++bj)
#pragma unroll
        for (int n = 0; n < 2; ++n) { S[bj][n] = (f32x4){0.f, 0.f, 0.f, 0.f};
#pragma unroll
            for (int sl = 0; sl < 8; ++sl) { const u32x2_t w = L[sl][bj][n]; S[bj][n] += (f32x4){__uint_as_float(w.x << 16), __uint_as_float(w.x & 0xffff0000u), __uint_as_float(w.y << 16), __uint_as_float(w.y & 0xffff0000u)}; } }
    const int row = pm * BM + wr * 64 + fr + ai * HALF + m * 16, col0 = pn * BM + wc * 32 + 8 * fq; const size_t off = (size_t)row * DM + col0; float ss = 0.f;
#pragma unroll
    for (int bj = 0; bj < 2; ++bj) {
        f32x4 b0, b1;
        if (BASE_F32) { b0 = *(const f32x4*)(base + off + bj * HALF); b1 = *(const f32x4*)(base + off + bj * HALF + 4); }
        else { const u32x4 w = *(const u32x4*)(xb + off + bj * HALF);
            b0 = (f32x4){__uint_as_float(w.x << 16), __uint_as_float(w.x & 0xffff0000u), __uint_as_float(w.y << 16), __uint_as_float(w.y & 0xffff0000u)};
            b1 = (f32x4){__uint_as_float(w.z << 16), __uint_as_float(w.z & 0xffff0000u), __uint_as_float(w.w << 16), __uint_as_float(w.w & 0xffff0000u)}; }
        const f32x4 o0 = b0 + S[bj][0] * alpha, o1 = b1 + S[bj][1] * alpha;
        u32x4 w2; w2.x = cvtpk(o0[0], o0[1]); w2.y = cvtpk(o0[2], o0[3]); w2.z = cvtpk(o1[0], o1[1]); w2.w = cvtpk(o1[2], o1[3]);
        *(u32x4*)(xb + off + bj * HALF) = w2;
        ss += (o0[0] * o0[0] + o0[1] * o0[1]) + (o0[2] * o0[2] + o0[3] * o0[3]) + (o1[0] * o1[0] + o1[1] * o1[1]) + (o1[2] * o1[2] + o1[3] * o1[3]);
    }
    ss += __shfl_xor(ss, 16); ss += __shfl_xor(ss, 32);
    if (fq == 0) ssq_out[(size_t)row * 16 + pn * 4 + wc] = ss;
}
struct EpiScaleBf16 {
    static constexpr bool PERM = true, AFTER_DRAIN = false;
    bf16_t* O; int ldc; const float* ssq_in; int np_in; float inv_dim; float* ssq_out;
    __device__ __forceinline__ void operator()(const f32x4 (&acc)[2][2][4][2], const Unit& u, int wr, int wc, int fr, int fq) const {
        const int row0 = u.pm * BM + wr * 64 + fr, col0 = u.pn * BM + wc * 32 + 8 * fq;
        const bool do_ssq = (ssq_out != nullptr) && (u.pn == 0);
#pragma unroll
        for (int ai = 0; ai < 2; ++ai)
#pragma unroll
            for (int m = 0; m < 4; ++m) {
                const int row = row0 + ai * HALF + m * 16;
                const float rs = 1.0f / sqrtf((np_in == 16 ? ssq_sum16(ssq_in, row) : ssq_sum4(ssq_in, row)) * inv_dim + EPS); float ss = 0.f;
                bf16_t* rowp = O + (size_t)row * ldc + col0;
#pragma unroll
                for (int bj = 0; bj < 2; ++bj) {
                    const f32x4 v0 = acc[ai][bj][m][0] * rs, v1 = acc[ai][bj][m][1] * rs;
                    u32x4 w; w.x = cvtpk(v0[0], v0[1]); w.y = cvtpk(v0[2], v0[3]); w.z = cvtpk(v1[0], v1[1]); w.w = cvtpk(v1[2], v1[3]);
                    *(u32x4*)(rowp + bj * HALF) = w;
                    ss += (v0[0] * v0[0] + v0[1] * v0[1]) + (v0[2] * v0[2] + v0[3] * v0[3]) + (v1[0] * v1[0] + v1[1] * v1[1]) + (v1[2] * v1[2] + v1[3] * v1[3]);
                }
                if (do_ssq) { ss += __shfl_xor(ss, 16); ss += __shfl_xor(ss, 32); if (fq == 0) ssq_out[(size_t)row * 4 + wc] = ss; }
            }
    }
};


struct EpiInFused {
    static constexpr bool PERM = true, AFTER_DRAIN = false;
    unsigned char* ws; float* out; int layer;
    __device__ __forceinline__ void operator()(const f32x4 (&acc)[2][2][4][2], const Unit& u, int wr, int wc, int fr_, int fq_) const {
        int fr = fr_, fq = fq_; asm volatile("" : "+v"(fr), "+v"(fq));
        const int row0 = u.pm * BM + wr * 64 + fr, c0 = wc * 32 + 8 * fq, pn = u.pn;
        float* const SSQP_ = (float*)(ws + WS_SSQP);
        const float* ssq_in = SSQP_ + (size_t)(3 + layer) * M * 16; float* ssq_cq = SSQP_ + (size_t)7 * M * 16 + (size_t)layer * M * 4; float* ssq_kv = SSQP_ + (size_t)7 * M * 16 + (size_t)(2 + layer) * M * 4;
        bf16_t* const CQ = (bf16_t*)(ws + WS_REGA + (size_t)300 * MiB); bf16_t* const CKV = (bf16_t*)(ws + WS_REGA + (size_t)340 * MiB);
        bf16_t* const QB = (bf16_t*)(ws + WS_QB); bf16_t* const QI = (bf16_t*)(ws + WS_QI); bf16_t* const QC = (bf16_t*)(ws + WS_QC); bf16_t* const QD = (bf16_t*)(ws + WS_QD);
        bf16_t* const RA = (bf16_t*)(ws + WS_RA); bf16_t* const RB = (bf16_t*)(ws + WS_RB); bf16_t* const RC = (bf16_t*)(ws + WS_RC); bf16_t* const RD = (bf16_t*)(ws + WS_RD);
        float* const WI = (float*)(ws + WS_WI); const float2* const R64 = (const float2*)(ws + WS_MISC + MISC_ROPE64); const float2* const R32 = (const float2*)(ws + WS_MISC + MISC_ROPE32);
        bf16_t* const HBdbg = SELFCHECK ? (bf16_t*)(ws + WS_REGA) : nullptr;
        const float scaleB = 0.125f * LOG2E, scaleD = 0.17677669529663687f * LOG2E, scaleC = 0.125f * LOG2E;
#define EPK8(f) ((u32x4){cvtpk(f[0], f[1]), cvtpk(f[2], f[3]), cvtpk(f[4], f[5]), cvtpk(f[6], f[7])})
#define EST8F(p, f) do { *(f32x4*)(p) = (f32x4){f[0], f[1], f[2], f[3]}; *(f32x4*)((p) + 4) = (f32x4){f[4], f[5], f[6], f[7]}; } while (0)
#pragma unroll
        for (int ai = 0; ai < 2; ++ai)
#pragma unroll
            for (int m = 0; m < 4; ++m) {
                const int row = row0 + ai * HALF + m * 16;
                const float rs = 1.0f / sqrtf(ssq_sum16(ssq_in, row) * (1.0f / 1024.0f) + EPS);
                float v0[8], v1[8];
#pragma unroll
                for (int e = 0; e < 4; ++e) { v0[e] = acc[ai][0][m][0][e] * rs; v0[4 + e] = acc[ai][0][m][1][e] * rs; v1[e] = acc[ai][1][m][0][e] * rs; v1[4 + e] = acc[ai][1][m][1][e] * rs; }
                if (HBdbg) { *(u32x4*)(HBdbg + (size_t)row * NINP + pn * 256 + c0) = EPK8(v0); *(u32x4*)(HBdbg + (size_t)row * NINP + pn * 256 + 128 + c0) = EPK8(v1); }
                const bool smp = row >= MP; const int rr = smp ? row - MP : row; const int pidx = smp ? 2048 + (rr & 63) : (rr & 2047);
                if (pn == 0) {
                    *(u32x4*)(CQ + (size_t)row * 256 + c0) = EPK8(v0); *(u32x4*)(CQ + (size_t)row * 256 + 128 + c0) = EPK8(v1);
                    float ss = 0.f;
#pragma unroll
                    for (int e = 0; e < 8; ++e) ss += v0[e] * v0[e] + v1[e] * v1[e];
                    ss += __shfl_xor(ss, 16); ss += __shfl_xor(ss, 32); if (fq == 0) ssq_cq[(size_t)row * 4 + wc] = ss;
                } else if (pn <= 6 && pn != 4) {
                    const bool d32 = pn >= 5; const int i0 = d32 ? 8 * (fq & 1) : 8 * fq;
                    const f32x4* cp = (const f32x4*)(d32 ? R32 + pidx * 16 + i0 : R64 + pidx * 32 + i0);
                    float a[8], b[8];
#pragma unroll
                    for (int e2 = 0; e2 < 4; ++e2) { const f32x4 cs = cp[e2];
                        a[2 * e2] = v0[2 * e2] * cs[0] - v1[2 * e2] * cs[1]; b[2 * e2] = v1[2 * e2] * cs[0] + v0[2 * e2] * cs[1];
                        a[2 * e2 + 1] = v0[2 * e2 + 1] * cs[2] - v1[2 * e2 + 1] * cs[3]; b[2 * e2 + 1] = v1[2 * e2 + 1] * cs[2] + v0[2 * e2 + 1] * cs[3]; }
                    if (pn == 1) {
#pragma unroll
                        for (int e = 0; e < 8; ++e) { a[e] *= scaleB; b[e] *= scaleB; }
                        bf16_t* d = QB + (size_t)row * 256 + wc * 64 + 8 * fq; *(u32x4*)d = EPK8(a); *(u32x4*)(d + 32) = EPK8(b);
                    } else if (pn <= 3) { bf16_t* d = QI + (size_t)row * 512 + (4 * (pn - 2) + wc) * 64 + 8 * fq; *(u32x4*)d = EPK8(a); *(u32x4*)(d + 32) = EPK8(b);
                    } else { const int blk = 2 * wc + (fq >> 1);
                        if (pn == 5) {
#pragma unroll
                            for (int e = 0; e < 8; ++e) { a[e] *= scaleD; b[e] *= scaleD; }
                            bf16_t* d = QD + (size_t)row * 256 + blk * 32 + i0; *(u32x4*)d = EPK8(a); *(u32x4*)(d + 16) = EPK8(b);
                        } else { const int oc = (blk >> 1) * 128 + (blk & 1) * 32 + i0;
                            float* od = out + (smp ? O_DIFF_S + ((size_t)layer * MS + rr) * 512 : O_DIFF_P + ((size_t)layer * MP + rr) * 512) + oc;
                            EST8F(od, a); EST8F(od + 16, b); bf16_t* d = RD + (size_t)row * 512 + oc; *(u32x4*)d = EPK8(a); *(u32x4*)(d + 16) = EPK8(b); } }
                } else if (pn == 4) {
                    if (wc < 2 || (wc == 2 && fq < 2)) {
                        const bool d32 = wc == 2; const f32x4* cp = (const f32x4*)(d32 ? R32 + pidx * 16 + 8 * fq : R64 + pidx * 32 + 8 * fq);
                        float a[8], b[8];
#pragma unroll
                        for (int e2 = 0; e2 < 4; ++e2) { const f32x4 cs = cp[e2];
                            a[2 * e2] = v0[2 * e2] * cs[0] - v1[2 * e2] * cs[1]; b[2 * e2] = v1[2 * e2] * cs[0] + v0[2 * e2] * cs[1];
                            a[2 * e2 + 1] = v0[2 * e2 + 1] * cs[2] - v1[2 * e2 + 1] * cs[3]; b[2 * e2 + 1] = v1[2 * e2 + 1] * cs[2] + v0[2 * e2 + 1] * cs[3]; }
                        if (!d32) { const int oc = (wc == 0 ? 0 : 128) + 8 * fq;
                            float* od = out + (smp ? O_DSA_S + ((size_t)layer * MS + rr) * 192 : O_DSA_P + ((size_t)layer * MP + rr) * 192) + oc;
                            EST8F(od, a); EST8F(od + 32, b); bf16_t* d = RB + (size_t)row * 192 + oc; *(u32x4*)d = EPK8(a); *(u32x4*)(d + 32) = EPK8(b);
                        } else { const int oc = 128 + 8 * fq;
                            float* od = out + (smp ? O_MLA_S + ((size_t)layer * MS + rr) * 160 : O_MLA_P + ((size_t)layer * MP + rr) * 160) + oc;
                            EST8F(od, a); EST8F(od + 16, b); bf16_t* d = RA + (size_t)row * 160 + oc; *(u32x4*)d = EPK8(a); *(u32x4*)(d + 16) = EPK8(b); } }
                } else if (pn == 7) {
                    *(u32x4*)(CKV + (size_t)row * 128 + c0) = EPK8(v0);
                    float ss = 0.f;
#pragma unroll
                    for (int e = 0; e < 8; ++e) ss += v0[e] * v0[e];
                    ss += __shfl_xor(ss, 16); ss += __shfl_xor(ss, 32); if (fq == 0) ssq_kv[(size_t)row * 4 + wc] = ss;
                    if (wc < 2) { const int oc = 64 + c0; float* od = out + (smp ? O_DSA_S + ((size_t)layer * MS + rr) * 192 : O_DSA_P + ((size_t)layer * MP + rr) * 192) + oc;
                        EST8F(od, v1); *(u32x4*)(RB + (size_t)row * 192 + oc) = EPK8(v1); }
                    else if (wc == 2 && fq == 0) { float w8[8];
#pragma unroll
                        for (int e = 0; e < 8; ++e) w8[e] = v1[e] * 0.35355339059327373f;
                        EST8F(WI + (size_t)row * 8, w8); }
                } else if (pn == 8) {
                    float a[8], b[8];
#pragma unroll
                    for (int e = 0; e < 8; ++e) { a[e] = v0[e] * scaleC; b[e] = v1[e] * scaleC; }
                    *(u32x4*)(QC + (size_t)row * 256 + c0) = EPK8(a); *(u32x4*)(QC + (size_t)row * 256 + 128 + c0) = EPK8(b);
                } else {
                    const int h0 = wc >> 1, d0 = 32 * (wc & 1) + 8 * fq;
                    const int voff = (pn == 9) ? 0 : 64;
                    if (pn == 11) { float* od = out + (smp ? O_DIFF_S + ((size_t)layer * MS + rr) * 512 : O_DIFF_P + ((size_t)layer * MP + rr) * 512);
                        EST8F(od + h0 * 128 + voff + d0, v0); EST8F(od + (h0 + 2) * 128 + voff + d0, v1);
                        *(u32x4*)(RD + (size_t)row * 512 + h0 * 128 + voff + d0) = EPK8(v0); *(u32x4*)(RD + (size_t)row * 512 + (h0 + 2) * 128 + voff + d0) = EPK8(v1);
                    } else { float* od = out + (smp ? O_SB_S + ((size_t)layer * MS + rr) * 512 : O_SB_P + ((size_t)layer * MP + rr) * 512);
                        EST8F(od + h0 * 128 + voff + d0, v0); EST8F(od + (h0 + 2) * 128 + voff + d0, v1);
                        *(u32x4*)(RC + (size_t)row * 512 + h0 * 128 + voff + d0) = EPK8(v0); *(u32x4*)(RC + (size_t)row * 512 + (h0 + 2) * 128 + voff + d0) = EPK8(v1); }
                }
                asm volatile("" ::: "memory");
            }
#undef EPK8
#undef EST8F
    }
};

template <class Epi, class Sched, bool ALIGN_EPI = false, bool SP2 = false>
__device__ __forceinline__ void gemm_phase(PG8_LAS unsigned char* lds, const Gemm g, const Sched& S, const Epi& E, const int wave0) {
    const int tid_ = wave0 * 64 + fresh_lane();
    const int tid = tid_, wid = __builtin_amdgcn_readfirstlane(tid >> 6), lane = tid & 63, wr = wid >> 2, wc = wid & 3, fr = lane & 15, fq = lane >> 4;
    const int K = g.K, nt = K / BK, lda = g.lda, ldb = g.ldb ? g.ldb : g.K;
    unsigned voffA[2], voffB[2];
#pragma unroll
    for (int i = 0; i < 2; ++i) { int R, C; stage_rc(tid * 16 + i * 8192, R, C); const int Rb = Epi::PERM ? ((R & ~31) + perm32(R & 31)) : R;
        voffA[i] = (unsigned)(R * lda + C) * 2u; voffB[i] = (unsigned)(Rb * ldb + C) * 2u; }
    const size_t kstep = (size_t)(BK * 2);
    const size_t hstepA = (size_t)HALF * lda * 2, hstepB = (size_t)HALF * ldb * 2;
    const size_t tstepA = 2 * hstepA, tstepB = 2 * hstepB;
    const unsigned ldsw = (unsigned)wid * 1024u;
    const int aoff = lds_byte(wr * 64 + fr, fq * 8), boff = lds_byte(wc * 32 + fr, fq * 8);
#define PG8_SA(b, h) (((b) * 2 + (h)) * HTB)
#define PG8_SB(b, h) ((4 + (b) * 2 + (h)) * HTB)
#define PG8_STAGE(bufoff, gbase, voff) do { _Pragma("unroll") for (int _i = 0; _i < 2; ++_i) \
        __builtin_amdgcn_global_load_lds((const unsigned*)((const char*)(gbase) + (voff)[_i]), (PG8_LAS unsigned*)(lds + (bufoff) + ldsw + _i * 8192), 16, 0, 0); } while (0)
#define PG8_LDA(dst, b, h) do { _Pragma("unroll") for (int m = 0; m < 4; ++m) _Pragma("unroll") for (int k = 0; k < 2; ++k) dst[m][k] = *(const PG8_LAS bf16x8*)(lds + PG8_SA(b, h) + aoff + m * 2048 + k * 1024); } while (0)
#define PG8_LDB(dst, b, h) do { _Pragma("unroll") for (int n = 0; n < 2; ++n) _Pragma("unroll") for (int k = 0; k < 2; ++k) dst[n][k] = *(const PG8_LAS bf16x8*)(lds + PG8_SB(b, h) + boff + n * 2048 + k * 1024); } while (0)
#define PG8_MMA(ai, bj, At, Bt) do { __builtin_amdgcn_s_setprio(1); _Pragma("unroll") for (int m = 0; m < 4; ++m) _Pragma("unroll") for (int n = 0; n < 2; ++n) _Pragma("unroll") for (int k = 0; k < 2; ++k) \
        acc[ai][bj][m][n] = __builtin_amdgcn_mfma_f32_16x16x32_bf16(Bt[n][k], At[m][k], acc[ai][bj][m][n], 0, 0, 0); __builtin_amdgcn_s_setprio(0); } while (0)
#define PG8_WAIT_V(n) asm volatile("s_waitcnt vmcnt(" #n ")" ::: "memory")
#define PG8_WAIT_L(n) asm volatile("s_waitcnt lgkmcnt(" #n ")" ::: "memory")
#define PG8_BAR __builtin_amdgcn_s_barrier()
#define PG8_SCHED __builtin_amdgcn_sched_barrier(0)
    Unit cur, nxt; int ui = 0;
    if (!S.next(0, cur)) return;
    f32x4 acc[2][2][4][2];
#pragma unroll
    for (int a = 0; a < 2; ++a)
#pragma unroll
        for (int b = 0; b < 2; ++b)
#pragma unroll
            for (int m = 0; m < 4; ++m)
#pragma unroll
                for (int n = 0; n < 2; ++n) acc[a][b][m][n] = (f32x4){0.f, 0.f, 0.f, 0.f};
    bf16x8 At[4][2], B0[2][2], B1[2][2];
    const char* cA = (const char*)g.A + (size_t)cur.pm * tstepA; const char* cB = (const char*)g.Bt + (size_t)cur.pn * tstepB;
    S.a_ready(cur);
    if constexpr (SP2) {
        PG8_STAGE(PG8_SB(0, 0), cB, voffB); PG8_STAGE(PG8_SB(0, 1), cB + hstepB, voffB); PG8_STAGE(PG8_SA(0, 0), cA, voffA); PG8_STAGE(PG8_SA(0, 1), cA + hstepA, voffA);
        if (wr == 1) PG8_BAR;
        PG8_WAIT_V(2); PG8_BAR;
        PG8_STAGE(PG8_SB(1, 0), cB + kstep, voffB); PG8_STAGE(PG8_SA(1, 0), cA + kstep, voffA); PG8_STAGE(PG8_SB(1, 1), cB + hstepB + kstep, voffB);
        PG8_WAIT_V(6); PG8_BAR;
    } else {
        PG8_STAGE(PG8_SB(0, 0), cB, voffB); PG8_STAGE(PG8_SA(0, 0), cA, voffA); PG8_STAGE(PG8_SB(0, 1), cB + hstepB, voffB); PG8_STAGE(PG8_SA(0, 1), cA + hstepA, voffA);
        if (wr == 1) PG8_BAR;
        PG8_WAIT_V(4); PG8_BAR;
        PG8_STAGE(PG8_SB(1, 0), cB + kstep, voffB); PG8_STAGE(PG8_SA(1, 0), cA + kstep, voffA); PG8_STAGE(PG8_SB(1, 1), cB + hstepB + kstep, voffB);
        PG8_WAIT_V(6); PG8_BAR;
    }
    for (;;) {
        const bool has_next = S.next(ui + 1, nxt);
        const char* nA = has_next ? (const char*)g.A + (size_t)nxt.pm * tstepA : cA; const char* nB = has_next ? (const char*)g.Bt + (size_t)nxt.pn * tstepB : cB;
        for (int t = 0; t < nt; t += 2) {
            const bool last = (t == nt - 2);
            const char* a1 = cA + (size_t)(t + 1) * kstep;
            const char* a2 = last ? nA : cA + (size_t)(t + 2) * kstep; const char* b2 = last ? nB : cB + (size_t)(t + 2) * kstep;
            const char* a3 = a2 + kstep; const char* b3 = b2 + kstep;
            if (last && has_next) S.a_ready(nxt);
            if constexpr (SP2) {
            PG8_LDB(B0, 0, 0); PG8_LDB(B1, 0, 1); PG8_SCHED; PG8_LDA(At, 0, 0); PG8_STAGE(PG8_SA(1, 1), a1 + hstepA, voffA);
            PG8_WAIT_V(8); PG8_WAIT_L(0); PG8_BAR; PG8_MMA(0, 0, At, B0); PG8_MMA(0, 1, At, B1); PG8_BAR; PG8_SCHED;
            PG8_LDA(At, 0, 1); PG8_STAGE(PG8_SB(0, 0), b2, voffB); PG8_STAGE(PG8_SB(0, 1), b2 + hstepB, voffB); PG8_STAGE(PG8_SA(0, 0), a2, voffA);
            PG8_WAIT_V(8); PG8_WAIT_L(0); PG8_BAR; PG8_MMA(1, 0, At, B0); PG8_MMA(1, 1, At, B1); PG8_BAR; PG8_SCHED;
            PG8_LDB(B0, 1, 0); PG8_LDB(B1, 1, 1); PG8_SCHED; PG8_LDA(At, 1, 0); PG8_STAGE(PG8_SA(0, 1), a2 + hstepA, voffA);
            PG8_WAIT_V(8); PG8_WAIT_L(0); PG8_BAR; PG8_MMA(0, 0, At, B0); PG8_MMA(0, 1, At, B1); PG8_BAR; PG8_SCHED;
            PG8_LDA(At, 1, 1); PG8_STAGE(PG8_SB(1, 0), b3, voffB); PG8_STAGE(PG8_SB(1, 1), b3 + hstepB, voffB); PG8_STAGE(PG8_SA(1, 0), a3, voffA);
            PG8_WAIT_V(8); PG8_WAIT_L(0); PG8_BAR; PG8_MMA(1, 0, At, B0); PG8_MMA(1, 1, At, B1); PG8_BAR; PG8_SCHED;
            } else {
            PG8_LDB(B0, 0, 0); PG8_SCHED; PG8_LDA(At, 0, 0); PG8_STAGE(PG8_SA(1, 1), a1 + hstepA, voffA);
            PG8_WAIT_L(8); PG8_BAR; PG8_WAIT_L(0); PG8_MMA(0, 0, At, B0); PG8_BAR; PG8_SCHED;
            PG8_LDB(B1, 0, 1); PG8_STAGE(PG8_SB(0, 0), b2, voffB);
            PG8_BAR; PG8_WAIT_L(0); PG8_MMA(0, 1, At, B1); PG8_BAR;
            PG8_LDA(At, 0, 1); PG8_STAGE(PG8_SA(0, 0), a2, voffA);
            PG8_BAR; PG8_WAIT_L(0); PG8_MMA(1, 0, At, B0); PG8_BAR; PG8_SCHED;
            PG8_STAGE(PG8_SB(0, 1), b2 + hstepB, voffB);
            PG8_WAIT_V(6); PG8_BAR; PG8_MMA(1, 1, At, B1); PG8_BAR;
            PG8_LDB(B0, 1, 0); PG8_SCHED; PG8_LDA(At, 1, 0); PG8_STAGE(PG8_SA(0, 1), a2 + hstepA, voffA);
            PG8_WAIT_L(8); PG8_BAR; PG8_WAIT_L(0); PG8_MMA(0, 0, At, B0); PG8_BAR; PG8_SCHED;
            PG8_LDB(B1, 1, 1); PG8_STAGE(PG8_SB(1, 0), b3, voffB);
            PG8_BAR; PG8_WAIT_L(0); PG8_MMA(0, 1, At, B1); PG8_BAR;
            PG8_LDA(At, 1, 1); PG8_STAGE(PG8_SA(1, 0), a3, voffA);
            PG8_BAR; PG8_WAIT_L(0); PG8_MMA(1, 0, At, B0); PG8_BAR; PG8_SCHED;
            PG8_STAGE(PG8_SB(1, 1), b3 + hstepB, voffB);
            PG8_WAIT_V(6); PG8_BAR; PG8_MMA(1, 1, At, B1); PG8_BAR;
            }
        }
        if constexpr (ALIGN_EPI) { if (wr == 0) PG8_BAR; }
        if constexpr (!Epi::AFTER_DRAIN) { E(acc, cur, wr, wc, fr, fq); S.done(cur); }
        if (!has_next) break;
#pragma unroll
        for (int a = 0; a < 2; ++a)
#pragma unroll
            for (int b = 0; b < 2; ++b)
#pragma unroll
                for (int m = 0; m < 4; ++m)
#pragma unroll
                    for (int n = 0; n < 2; ++n) acc[a][b][m][n] = (f32x4){0.f, 0.f, 0.f, 0.f};
        cur = nxt; cA = nA; cB = nB; ++ui;
        if constexpr (ALIGN_EPI) { if (wr == 1) PG8_BAR; }
    }
    PG8_WAIT_V(0);
    if constexpr (!ALIGN_EPI) { if (wr == 0) PG8_BAR; }
    PG8_BAR;
#undef PG8_SA
#undef PG8_SB
#undef PG8_STAGE
#undef PG8_LDA
#undef PG8_LDB
#undef PG8_MMA
#undef PG8_WAIT_V
#undef PG8_WAIT_L
#undef PG8_BAR
#undef PG8_SCHED
}
}

#define XB_TMO      128
#define XB_XCNT(j)  (256  + 64 * (j))
#define XB_XSUB(j)  (1280 + 64 * (j))
#define XB_XGEN(j)  (2304 + 64 * (j))
#define XB_TOP      3328
#define XB_TOPGEN   3392
#define XCD_BAR_WORDS 3456
#define XB_SPIN_CAP (1u << 18)
__device__ __forceinline__ unsigned xb_ld(unsigned* p)              { return __hip_atomic_load(p, __ATOMIC_RELAXED, __HIP_MEMORY_SCOPE_AGENT); }
__device__ __forceinline__ unsigned xb_add(unsigned* p, unsigned v) { return __hip_atomic_fetch_add(p, v, __ATOMIC_RELAXED, __HIP_MEMORY_SCOPE_AGENT); }
__device__ __forceinline__ unsigned xb_xcc_id() { return (unsigned)__builtin_amdgcn_s_getreg((3 << 11) | 20) & 0xFu; }
#define XB_SPIN(cond, bar) do { unsigned _sp = 0; while (cond) { __builtin_amdgcn_s_sleep(1); \
    if ((++_sp & 255u) == 0u) { if (xb_ld(&(bar)[XB_TMO])) break; if (_sp > XB_SPIN_CAP) { atomicAdd(&(bar)[XB_TMO], 1u); break; } } } } while (0)
struct XcdBarrier { unsigned* bar; unsigned x; volatile LAS unsigned* st; int wave0; };
__device__ __forceinline__ XcdBarrier xcd_barrier_post(unsigned* bar, volatile LAS unsigned* st, int wave0) {
    XcdBarrier b; b.bar = bar; b.x = xb_xcc_id(); b.st = st; b.wave0 = wave0;
    if (wave0 == 0 && fresh_lane() == 0) (void)xb_add(&bar[XB_XCNT(b.x)], 1u);
    return b;
}
__device__ __forceinline__ void xcd_barrier_complete(unsigned* bar, unsigned x, unsigned& nloc, unsigned& nx) {
    const unsigned G = gridDim.x * gridDim.y * gridDim.z;
    unsigned sum, cnt, mine, sp = 0u;
    for (;;) {
        sum = 0u; cnt = 0u; mine = 0u;
#pragma unroll
        for (unsigned j = 0; j < 16; ++j) { const unsigned c = xb_ld(&bar[XB_XCNT(j)]); sum += c; cnt += (c > 0u) ? 1u : 0u; mine = (j == x) ? c : mine; }
        if (sum == G) break;
        __builtin_amdgcn_s_sleep(1);
        if ((++sp & 255u) == 0u) { if (xb_ld(&bar[XB_TMO])) break; if (sp > XB_SPIN_CAP) { atomicAdd(&bar[XB_TMO], 1u); break; } }
    }
    nloc = mine > 0u ? mine : 1u; nx = cnt > 0u ? cnt : 1u;
}
__device__ __forceinline__ void xcd_barrier(const XcdBarrier& b) {
    asm volatile("s_waitcnt vmcnt(0)" ::: "memory");
    __syncthreads();
    if (b.wave0 == 0 && fresh_lane() == 0) {
        unsigned* bar = b.bar;
        __builtin_amdgcn_s_waitcnt(0);
        unsigned nloc = b.st[0], nx = b.st[1];
        if (nloc == 0u) { xcd_barrier_complete(bar, b.x, nloc, nx); b.st[0] = nloc; b.st[1] = nx; }
        const unsigned old = xb_add(&bar[XB_XSUB(b.x)], 1u);
        const unsigned gen = old / nloc;
        if (old + 1u == (gen + 1u) * nloc) {
            __builtin_amdgcn_fence(__ATOMIC_RELEASE, "agent");
            asm volatile("s_waitcnt vmcnt(0)" ::: "memory");
            const unsigned og = xb_add(&bar[XB_TOP], 1u);
            const unsigned tg = og / nx;
            if (og + 1u == (tg + 1u) * nx) xb_add(&bar[XB_TOPGEN], 1u);
            else XB_SPIN(xb_ld(&bar[XB_TOPGEN]) == tg, bar);
            __builtin_amdgcn_fence(__ATOMIC_ACQUIRE, "agent");
            xb_add(&bar[XB_XGEN(b.x)], 1u);
            asm volatile("s_waitcnt vmcnt(0)" ::: "memory");
        } else {
            XB_SPIN(xb_ld(&bar[XB_XGEN(b.x)]) == gen, bar);
            __builtin_amdgcn_fence(__ATOMIC_ACQUIRE, "agent");
            asm volatile("s_waitcnt vmcnt(0)" ::: "memory");
        }
    }
    __syncthreads();
}

struct Args { const float* in[24]; float* out; unsigned char* ws; float freq64[32]; float freq32[16]; int ph_lo, ph_hi; };
enum { I_XP = 0, I_XS, I_CMLA, I_CDSA, I_CSB, I_CDIFF, I_N1, I_G1, I_U1, I_D1, I_NM, I_WIN, I_QN, I_WQB, I_KVN, I_WKVB, I_LAM, I_DN, I_WO, I_N2, I_G2, I_U2, I_D2, I_FN };

__host__ __device__ __forceinline__ int mycol(int j) {
    if (j < 256) return j;
    if (j < 384) return 7 * 256 + (j - 256);
    if (j < 416) { const int t = j - 384; return 4 * 256 + (t >> 4) * 128 + 64 + (t & 15); }
    if (j < 672) { const int t = j - 416; return 1 * 256 + ((t >> 5) & 1) * 128 + (t >> 6) * 32 + (t & 31); }
    if (j < 736) { const int t = j - 672; return 4 * 256 + (t >> 5) * 128 + (t & 31); }
    if (j < 800) return 7 * 256 + 128 + (j - 736);
    if (j < 1312) { const int t = j - 800, h8 = t >> 6; return (2 + (h8 >> 2)) * 256 + ((t >> 5) & 1) * 128 + (h8 & 3) * 32 + (t & 31); }
    if (j < 1376) { const int t = j - 1312; return 4 * 256 + (t >> 5) * 128 + 32 + (t & 31); }
    if (j < 1384) return 7 * 256 + 128 + 64 + (j - 1376);
    if (j < 1640) return 8 * 256 + (j - 1384);
    if (j < 1896) return 9 * 256 + (j - 1640);
    if (j < 2152) return 10 * 256 + (j - 1896);
    if (j < 2408) { const int t = j - 2152; return 5 * 256 + ((t >> 4) & 1) * 128 + (t >> 5) * 16 + (t & 15); }
    if (j < 2664) { const int t = j - 2408; return 6 * 256 + ((t >> 4) & 1) * 128 + (t >> 5) * 16 + (t & 15); }
    return 11 * 256 + (j - 2664);
}
__host__ __device__ __forceinline__ bool mycol_is_pad(int np) { const int t = np >> 8, c = np & 127, hf = (np >> 7) & 1; return (t == 4 && c >= 80) || (t == 7 && hf == 1 && c >= 72); }
typedef __attribute__((address_space(4))) const char* kaptr_t;
__device__ __forceinline__ kaptr_t kargs() { kaptr_t p = (kaptr_t)__builtin_amdgcn_kernarg_segment_ptr(); asm volatile("" : "+s"(p)); return p; }
typedef const float* cfp_t; typedef float* fp_t; typedef unsigned char* ucp_t;
typedef __attribute__((address_space(4))) const cfp_t* ka_cfp_t; typedef __attribute__((address_space(4))) const fp_t* ka_fp_t; typedef __attribute__((address_space(4))) const ucp_t* ka_ucp_t;
typedef __attribute__((address_space(4))) const float* ka_f_t; typedef __attribute__((address_space(4))) const int* ka_i_t;
#define GLB __attribute__((address_space(1)))
#define ARG_IN(i) ((const float*)(GLB const float*)(*(ka_cfp_t)(kargs() + 8 * (i))))
#define ARG_OUT (*(ka_fp_t)(kargs() + 192))
#define ARG_WS (*(ka_ucp_t)(kargs() + 200))
#define ARG_FREQ64(j) (((ka_f_t)(kargs() + 208))[j])
#define ARG_FREQ32(j) (((ka_f_t)(kargs() + 336))[j])
#define ARG_PH_LO (*(ka_i_t)(kargs() + 400))
#define ARG_PH_HI (*(ka_i_t)(kargs() + 404))
static_assert(sizeof(Args) == 408, "kernarg offsets above follow struct Args");
template <int MAP> __device__ __forceinline__ int rowmap(int n) {
    if (MAP == 1) return (n >> 7) * 256 + (n & 127);
    if (MAP == 2) return (n >> 7) * 256 + 128 + (n & 127);
    if (MAP == 3) return FUSE_POST ? mycol(n) : (n < 1376 ? n : (n < 1384 ? H_WI + (n - 1376) : n - 8));
    return n;
}
template <int MAP> __device__ __forceinline__ void transpose_item(const float* W, int K, int N, const float* g, bf16* dst, int ldd, int koff, LAS float* scr, int item, int lane) {
    const int nblk = (N + 31) / 32, kb = item / nblk, nb = item % nblk, k0 = 64 * kb, n0 = 32 * nb;
    const int nn = n0 + (lane & 31); const bool nok = nn < N;
    float tv[32];
#pragma unroll
    for (int i = 0; i < 32; ++i) { const int kk = 2 * i + (lane >> 5); tv[i] = nok ? W[(size_t)(k0 + kk) * N + nn] : 0.f; }
#pragma unroll
    for (int i = 0; i < 32; ++i) { const int kk = 2 * i + (lane >> 5); float v = tv[i]; if (g) v *= g[k0 + kk]; scr[kk * 33 + (lane & 31)] = v; }
    LDS_WAIT(); asm volatile("" ::: "memory");
    const int c = lane & 7;
#pragma unroll
    for (int j = 0; j < 4; ++j) { const int n = (lane >> 3) + 8 * j; const LAS float* s = scr + (8 * c) * 33 + n;
        v4u o; o.x = pk2(s[0 * 33], s[1 * 33]); o.y = pk2(s[2 * 33], s[3 * 33]); o.z = pk2(s[4 * 33], s[5 * 33]); o.w = pk2(s[6 * 33], s[7 * 33]);
        if (n0 + n < N) *(v4u*)(dst + (size_t)rowmap<MAP>(n0 + n) * ldd + koff + k0 + 8 * c) = o; }
    LDS_WAIT(); asm volatile("" ::: "memory");
}
__device__ __forceinline__ void sincos_acc(float ang, float& sn, float& cs) {
    const double a = (double)ang; const double k = rint(a * 0.15915494309189533577); const double x = fma(-k, 6.283185307179586476925, a); const double x2 = x * x;
    double s = 1.0, c = 1.0;
#pragma unroll
    for (int n = 14; n >= 1; --n) { s = 1.0 - x2 * (1.0 / (double)((2 * n) * (2 * n + 1))) * s; c = 1.0 - x2 * (1.0 / (double)((2 * n - 1) * (2 * n))) * c; }
    sn = (float)(x * s); cs = (float)c;
}

#define MFMA32(a, b, c) __builtin_amdgcn_mfma_f32_32x32x16_bf16((a), (b), (c), 0, 0, 0)
__device__ __forceinline__ f32x16 zero16() { f32x16 z;
#pragma unroll
    for (int i = 0; i < 16; ++i) z[i] = 0.f; return z; }
__device__ __forceinline__ s16x4 vtr(const LAS char* p) { return __builtin_bit_cast(s16x4, __builtin_amdgcn_ds_read_tr16_b64_v4i16((LAS s16x4*)p)); }
template <int BASE> __device__ __forceinline__ bf16x8 pack8(const f32x16& p) {
    v4u w; w.x = cvtpk(p[BASE], p[BASE + 1]); w.y = cvtpk(p[BASE + 2], p[BASE + 3]); w.z = cvtpk(p[BASE + 4], p[BASE + 5]); w.w = cvtpk(p[BASE + 6], p[BASE + 7]);
    return __builtin_bit_cast(bf16x8, w);
}
template <int NS> __device__ __forceinline__ void qk(f32x16& p0, f32x16& p1, const LAS char* kb, int strideB, const bf16x8 (&q)[NS]) {
    p0 = zero16(); p1 = zero16();
#pragma unroll
    for (int s = 0; s < NS; ++s) {
        const bf16x8 a0 = *(const LAS bf16x8*)(kb + s * 32);
        const bf16x8 a1 = *(const LAS bf16x8*)(kb + 32 * strideB + s * 32);
        p0 = MFMA32(a0, q[s], p0); p1 = MFMA32(a1, q[s], p1);
    }
}
template <int NDB> __device__ __forceinline__ void pv(f32x16 (&o)[NDB], const f32x16& p0, const f32x16& p1, const LAS char* vb, int strideB) {
    const bf16x8 pb0 = pack8<0>(p0), pb1 = pack8<8>(p0), pb2 = pack8<0>(p1), pb3 = pack8<8>(p1);
#pragma unroll
    for (int kk = 0; kk < 4; ++kk) {
        const bf16x8 pb = kk == 0 ? pb0 : (kk == 1 ? pb1 : (kk == 2 ? pb2 : pb3));
#pragma unroll
        for (int db = 0; db < NDB; ++db) {
            const s16x4 lo = vtr(vb + (16 * kk) * strideB + db * 64);
            const s16x4 hh = vtr(vb + (16 * kk + 8) * strideB + db * 64);
            const bf16x8 a = __builtin_shufflevector(lo, hh, 0, 1, 2, 3, 4, 5, 6, 7);
            o[db] = MFMA32(a, pb, o[db]);
        }
    }
}
template <int NS> __device__ __forceinline__ void k_ld(bf16x8 (&k)[2 * NS], const LAS char* kb, int strideB) {
#pragma unroll
    for (int s = 0; s < NS; ++s) { k[2 * s] = *(const LAS bf16x8*)(kb + s * 32); k[2 * s + 1] = *(const LAS bf16x8*)(kb + 32 * strideB + s * 32); }
}
template <int NS> __device__ __forceinline__ void qk_r(f32x16& p0, f32x16& p1, const bf16x8 (&k)[2 * NS], const bf16x8 (&q)[NS]) {
    p0 = zero16(); p1 = zero16();
#pragma unroll
    for (int s = 0; s < NS; ++s) { p0 = MFMA32(k[2 * s], q[s], p0); p1 = MFMA32(k[2 * s + 1], q[s], p1); }
}
template <int NDB> __device__ __forceinline__ void v_ld(bf16x8 (&v)[4 * NDB], const LAS char* vb, int strideB) {
#pragma unroll
    for (int kk = 0; kk < 4; ++kk)
#pragma unroll
        for (int db = 0; db < NDB; ++db) {
            const s16x4 lo = vtr(vb + (16 * kk) * strideB + db * 64);
            const s16x4 hh = vtr(vb + (16 * kk + 8) * strideB + db * 64);
            v[kk * NDB + db] = __builtin_shufflevector(lo, hh, 0, 1, 2, 3, 4, 5, 6, 7);
        }
}
template <int NDB> __device__ __forceinline__ void pv_r(f32x16 (&o)[NDB], const f32x16& p0, const f32x16& p1, const bf16x8 (&v)[4 * NDB]) {
    const bf16x8 pb0 = pack8<0>(p0), pb1 = pack8<8>(p0), pb2 = pack8<0>(p1), pb3 = pack8<8>(p1);
#pragma unroll
    for (int kk = 0; kk < 4; ++kk) {
        const bf16x8 pb = kk == 0 ? pb0 : (kk == 1 ? pb1 : (kk == 2 ? pb2 : pb3));
#pragma unroll
        for (int db = 0; db < NDB; ++db) o[db] = MFMA32(v[kk * NDB + db], pb, o[db]);
    }
}
template <int NS> __device__ __forceinline__ void qk_h2(f32x16& p0, f32x16& p1, const LAS char* kb, int strideB, const bf16x8 (&q)[NS]) {
    constexpr int H = NS / 2; p0 = zero16(); p1 = zero16();
#pragma unroll
    for (int h = 0; h < 2; ++h) {
        bf16x8 ka[2 * H];
#pragma unroll
        for (int s = 0; s < H; ++s) { ka[2 * s] = *(const LAS bf16x8*)(kb + (h * H + s) * 32); ka[2 * s + 1] = *(const LAS bf16x8*)(kb + 32 * strideB + (h * H + s) * 32); }
        __builtin_amdgcn_sched_barrier(0);
#pragma unroll
        for (int s = 0; s < H; ++s) { p0 = MFMA32(ka[2 * s], q[h * H + s], p0); p1 = MFMA32(ka[2 * s + 1], q[h * H + s], p1); }
    }
}
template <int NDB> __device__ __forceinline__ void v_ld2(bf16x8 (&v)[2 * NDB], const LAS char* vb, int strideB, int kk0) {
#pragma unroll
    for (int k2 = 0; k2 < 2; ++k2)
#pragma unroll
        for (int db = 0; db < NDB; ++db) {
            const s16x4 lo = vtr(vb + (16 * (kk0 + k2)) * strideB + db * 64);
            const s16x4 hh = vtr(vb + (16 * (kk0 + k2) + 8) * strideB + db * 64);
            v[k2 * NDB + db] = __builtin_shufflevector(lo, hh, 0, 1, 2, 3, 4, 5, 6, 7);
        }
}
template <int NDB> __device__ __forceinline__ void pv_h2(f32x16 (&o)[NDB], const f32x16& p0, const f32x16& p1, const LAS char* vb, int strideB, const bf16x8 (&v01)[2 * NDB]) {
    const bf16x8 pb0 = pack8<0>(p0), pb1 = pack8<8>(p0), pb2 = pack8<0>(p1), pb3 = pack8<8>(p1);
    bf16x8 v23[2 * NDB]; v_ld2<NDB>(v23, vb, strideB, 2);
    __builtin_amdgcn_sched_barrier(0);
#pragma unroll
    for (int db = 0; db < NDB; ++db) o[db] = MFMA32(v01[db], pb0, o[db]);
#pragma unroll
    for (int db = 0; db < NDB; ++db) o[db] = MFMA32(v01[NDB + db], pb1, o[db]);
#pragma unroll
    for (int db = 0; db < NDB; ++db) o[db] = MFMA32(v23[db], pb2, o[db]);
#pragma unroll
    for (int db = 0; db < NDB; ++db) o[db] = MFMA32(v23[NDB + db], pb3, o[db]);
}
template <int NDB> __device__ __forceinline__ void softmax_step(f32x16& p0, f32x16& p1, float& m, float& l, f32x16 (&o)[NDB]) {
    float mx = p0[0];
#pragma unroll
    for (int r = 1; r < 16; ++r) mx = fmaxf(mx, p0[r]);
#pragma unroll
    for (int r = 0; r < 16; ++r) mx = fmaxf(mx, p1[r]);
    { const unsigned ux_ = __float_as_uint(mx); const auto sw_ = __builtin_amdgcn_permlane32_swap(ux_, ux_, false, false);
      mx = fmaxf(__uint_as_float(sw_[0]), __uint_as_float(sw_[1])); }
    const float mn = fmaxf(m, mx);
    if (__any(mn > m)) {
        const float alpha = __builtin_amdgcn_exp2f(m - mn);
        l *= alpha;
#pragma unroll
        for (int db = 0; db < NDB; ++db)
#pragma unroll
            for (int r = 0; r < 16; ++r) o[db][r] *= alpha;
    }
    m = mn;
    typedef float f32x2_t __attribute__((ext_vector_type(2)));
    const f32x2_t mn2 = {mn, mn}; f32x2_t s2 = {0.f, 0.f};
#pragma unroll
    for (int r = 0; r < 8; ++r) { f32x2_t d = {p0[2 * r], p0[2 * r + 1]}; d -= mn2; d.x = __builtin_amdgcn_exp2f(d.x); d.y = __builtin_amdgcn_exp2f(d.y); p0[2 * r] = d.x; p0[2 * r + 1] = d.y; s2 += d; }
#pragma unroll
    for (int r = 0; r < 8; ++r) { f32x2_t d = {p1[2 * r], p1[2 * r + 1]}; d -= mn2; d.x = __builtin_amdgcn_exp2f(d.x); d.y = __builtin_amdgcn_exp2f(d.y); p1[2 * r] = d.x; p1[2 * r + 1] = d.y; s2 += d; }
    l += s2.x + s2.y;
}
__device__ __forceinline__ v4u cvt8f(const v4u a, const v4u b) {
    const unsigned a0 = a[0], a1 = a[1], a2 = a[2], a3 = a[3], b0 = b[0], b1 = b[1], b2 = b[2], b3 = b[3]; v4u v;
    v[0] = cvtpk(__uint_as_float(a0), __uint_as_float(a1)); v[1] = cvtpk(__uint_as_float(a2), __uint_as_float(a3));
    v[2] = cvtpk(__uint_as_float(b0), __uint_as_float(b1)); v[3] = cvtpk(__uint_as_float(b2), __uint_as_float(b3)); return v; }
template <int W, int STRIDE, bool F32PF = true, int ROWS = 64> struct TileLd {
    static constexpr int CH = W / 8, RPP = 512 / CH, PER = (ROWS + RPP - 1) / RPP, STRB = (W + 8) * 2;
    int nrows_ = ROWS;
    v4u raw[PER][F32PF ? 2 : 1];
    const char* src_;
    __device__ __forceinline__ void init() { src_ = nullptr;
#pragma unroll
        for (int i = 0; i < PER; ++i) { raw[i][0] = (v4u){0u, 0u, 0u, 0u}; raw[i][F32PF ? 1 : 0] = (v4u){0u, 0u, 0u, 0u}; } }
    __device__ __forceinline__ void issue(const void* src, bool f32, int tid) {
        src_ = (const char*)src;
        if (!F32PF && f32) return;
        const int row0 = tid / CH, cc = tid % CH; const bool act = tid < RPP * CH;
        const unsigned loff = (unsigned)(row0 * STRIDE + cc * 8);
#pragma unroll
        for (int i = 0; i < PER; ++i) {
            if (act && (row0 + i * RPP < nrows_)) {
                if (F32PF && f32) { const GLB v4u* p = (const GLB v4u*)(src_ + (size_t)i * RPP * STRIDE * 4 + (size_t)loff * 4); raw[i][0] = p[0]; raw[i][F32PF ? 1 : 0] = p[1]; }
                else { raw[i][0] = *(const GLB v4u*)(src_ + (size_t)i * RPP * STRIDE * 2 + (size_t)loff * 2); } } }
    }
    __device__ __forceinline__ static v4u cvt8(const v4u a, const v4u b) { return cvt8f(a, b); }
    __device__ __forceinline__ void store(LAS char* tile, bool f32, int tid) {
        const int row0 = tid / CH, cc = tid % CH; const bool act = tid < RPP * CH;
        const unsigned loff = (unsigned)(row0 * STRIDE + cc * 8);
        LAS char* dst = tile + row0 * STRB + cc * 16;
#pragma unroll
        for (int i = 0; i < PER; ++i) {
            if (act && (row0 + i * RPP < nrows_)) { v4u v = raw[i][0];
                if (f32) {
                    if (F32PF) v = cvt8(raw[i][0], raw[i][F32PF ? 1 : 0]);
                    else { const GLB v4u* p = (const GLB v4u*)(src_ + (size_t)i * RPP * STRIDE * 4 + (size_t)loff * 4); v = cvt8(p[0], p[1]); } }
                *(LAS v4u*)(dst + i * RPP * STRB) = v; } }
    }
};
constexpr int T512_STRB = 1040, T512_BYTES = 64 * T512_STRB;
__device__ __forceinline__ void t512_dma(const void* src, LAS char* buf, int wave, int lane) {
#pragma unroll
    for (int j = 0; j < 8; ++j) { const int row = wave * 8 + j;
        __builtin_amdgcn_global_load_lds((const unsigned*)((const char*)src + (size_t)row * 1024 + lane * 16), (LAS unsigned*)(buf + row * T512_STRB), 16, 0, 0); }
}
__device__ __forceinline__ void t512_cvt(const void* src, LAS char* buf, int tid) {
    const int row0 = tid >> 6, cc = tid & 63; const char* p0 = (const char*)src + (size_t)row0 * 2048 + cc * 32; LAS char* d0 = buf + row0 * T512_STRB + cc * 16;
    v4u a[8], b[8];
#pragma unroll
    for (int i = 0; i < 8; ++i) { const GLB v4u* p = (const GLB v4u*)(p0 + (size_t)i * 8 * 2048); a[i] = p[0]; b[i] = p[1]; }
    __builtin_amdgcn_sched_barrier(0);
#pragma unroll
    for (int i = 0; i < 8; ++i) *(LAS v4u*)(d0 + i * 8 * T512_STRB) = cvt8f(a[i], b[i]);
}
__device__ __forceinline__ int crow(int r, int hi) { return (r & 3) + 8 * (r >> 2) + 4 * hi; }

struct UnitId { int sample, b, c, nt, qrow0, krow0; };
constexpr int QLIST = 4 + 4 * 32;
__device__ __forceinline__ UnitId decode_unit(int x, int idx) {
    UnitId u;
    if (idx < 4) { u.sample = 1; u.b = x + 8 * idx; u.c = 0; u.nt = PAST / 64 + 1; u.qrow0 = MP + u.b * DSEQ; u.krow0 = MP + u.b * DSEQ; }
    else { const int j = idx - 4; u.sample = 0; u.c = 31 - (j & 31); u.b = x + 8 * (j >> 5); u.nt = u.c + 1; u.qrow0 = u.b * SEQ + u.c * 64; u.krow0 = u.b * SEQ; }
    return u;
}
constexpr int N_UNITS = NB + NB * (SEQ / 64);

__device__ __forceinline__ const void* tile_src(const UnitId& u, int t, const float* cache_lb  , const bf16* rows, int W, int coloff, bool& f32) {
    if (u.sample && t < PAST / 64) { f32 = true; return cache_lb + (size_t)t * 64 * W + coloff; }
    f32 = false; const int tt = u.sample ? 0 : t;
    return rows + (size_t)(u.krow0 + tt * 64) * W + coloff;
}

template <int NQ> __device__ __forceinline__ void hist_pick(LAS unsigned* hist, int lane, int (&kk)[NQ], int (&bin_out)[NQ], unsigned (&cnt_out)[NQ], const bool (&act)[NQ]) {
    unsigned sl[NQ], incl[NQ];
#pragma unroll
    for (int a = 0; a < NQ; ++a) { sl[a] = 0u;
#pragma unroll
        for (int j = 0; j < 8; ++j) { const v4u c4 = ((LAS v4u*)(hist + a * 2048))[lane * 8 + j]; sl[a] += (c4[0] + c4[1]) + (c4[2] + c4[3]); }
        incl[a] = sl[a]; }
#pragma unroll
    for (int o = 1; o < 64; o <<= 1) {
        unsigned t2[NQ];
#pragma unroll
        for (int a = 0; a < NQ; ++a) t2[a] = (unsigned)__shfl_down((int)incl[a], o);
#pragma unroll
        for (int a = 0; a < NQ; ++a) incl[a] += (lane + o < 64) ? t2[a] : 0u; }
    int hl[NQ]; unsigned above_h[NQ], v[NQ], inc2[NQ];
#pragma unroll
    for (int a = 0; a < NQ; ++a) { const unsigned above_l = incl[a] - sl[a]; const bool hit = (above_l < (unsigned)kk[a]) && ((unsigned)kk[a] <= incl[a]);
        const unsigned long long hb = __ballot(hit); hl[a] = hb ? (int)__builtin_ctzll(hb) : 0; above_h[a] = (unsigned)__builtin_amdgcn_readlane((int)above_l, hl[a]);
        v[a] = (lane < 32) ? hist[a * 2048 + hl[a] * 32 + lane] : 0u; inc2[a] = v[a]; }
#pragma unroll
    for (int o = 1; o < 32; o <<= 1) {
        unsigned t2[NQ];
#pragma unroll
        for (int a = 0; a < NQ; ++a) t2[a] = (unsigned)__shfl_down((int)inc2[a], o);
#pragma unroll
        for (int a = 0; a < NQ; ++a) inc2[a] += (lane + o < 32) ? t2[a] : 0u; }
#pragma unroll
    for (int a = 0; a < NQ; ++a) { const unsigned above2 = above_h[a] + inc2[a] - v[a];
        const bool hit2 = (lane < 32) && (above2 < (unsigned)kk[a]) && ((unsigned)kk[a] <= above2 + v[a]);
        const unsigned long long hb2 = __ballot(hit2); const int l2 = hb2 ? (int)__builtin_ctzll(hb2) : 0;
        if (act[a]) { bin_out[a] = hl[a] * 32 + l2; kk[a] -= __builtin_amdgcn_readlane((int)above2, l2); cnt_out[a] = (unsigned)__builtin_amdgcn_readlane((int)v[a], l2); } }
}
template <int NI, int NQ, int ES = 1> __device__ __forceinline__ void dsa_select(const float* srow, int nt, LAS unsigned* hist, unsigned long long* mrow, int lane) {
    float xv[NQ][NI]; float lo[NQ], hi[NQ];
#pragma unroll
    for (int a = 0; a < NQ; ++a) { lo[a] = 3e38f; hi[a] = -3e38f; }
    { const int nt_ = opaque_s(nt);
#pragma unroll
    for (int i = 0; i < NI; ++i) {
#pragma unroll
        for (int a = 0; a < NQ; ++a) xv[a][i] = 0.f;
        if (i < nt_) {
#pragma unroll
            for (int a = 0; a < NQ; ++a) { xv[a][i] = srow[(size_t)a * SC_LS + (size_t)(i * 64 + lane) * ES]; lo[a] = fminf(lo[a], xv[a][i]); hi[a] = fmaxf(hi[a], xv[a][i]); } } } }
#pragma unroll
    for (int o = 1; o < 64; o <<= 1)
#pragma unroll
        for (int a = 0; a < NQ; ++a) { lo[a] = fminf(lo[a], __shfl_xor(lo[a], o)); hi[a] = fmaxf(hi[a], __shfl_xor(hi[a], o)); }
    float scale[NQ]; int kk[NQ], b0[NQ]; unsigned c0n[NQ];
#pragma unroll
    for (int a = 0; a < NQ; ++a) { const float range = hi[a] - lo[a]; scale[a] = (range > 1e-30f) ? 2047.0f / range : 0.f; kk[a] = 256; b0[a] = 0; c0n[a] = 0u; }
#pragma unroll
    for (int j = 0; j < 8 * NQ; ++j) ((LAS v4u*)hist)[lane + 64 * j] = (v4u){0u, 0u, 0u, 0u};
    LDS_WAIT();
    { const int nt_ = opaque_s(nt); float sc_[NQ];
#pragma unroll
    for (int a = 0; a < NQ; ++a) sc_[a] = opaque_vf(scale[a]);
#pragma unroll
    for (int i = 0; i < NI; ++i) if (i < nt_) {
#pragma unroll
        for (int a = 0; a < NQ; ++a) { const int b = min(2047, (int)((xv[a][i] - lo[a]) * sc_[a])); __hip_atomic_fetch_add(hist + a * 2048 + b, 1u, __ATOMIC_RELAXED, __HIP_MEMORY_SCOPE_WORKGROUP); } } }
    LDS_WAIT();
    { bool all_[NQ];
#pragma unroll
      for (int a = 0; a < NQ; ++a) all_[a] = true;
      hist_pick<NQ>(hist, lane, kk, b0, c0n, all_); }
    unsigned prefix[NQ], pmask[NQ]; bool whole[NQ], live[NQ]; bool any_live = false;
#pragma unroll
    for (int a = 0; a < NQ; ++a) { prefix[a] = 0u; pmask[a] = 0u; whole[a] = ((unsigned)kk[a] == c0n[a]); live[a] = !whole[a]; any_live = any_live || live[a]; }
    if (any_live) {
#pragma unroll
        for (int pass = 0; pass < 3; ++pass) {
            const int SH = pass == 0 ? 21 : (pass == 1 ? 10 : 0); const unsigned BM_ = pass == 2 ? 1023u : 2047u;
#pragma unroll
            for (int j = 0; j < 8 * NQ; ++j) ((LAS v4u*)hist)[lane + 64 * j] = (v4u){0u, 0u, 0u, 0u};
            LDS_WAIT();
            const int nt_ = opaque_s(nt); float sc_[NQ];
#pragma unroll
            for (int a = 0; a < NQ; ++a) sc_[a] = opaque_vf(scale[a]);
#pragma unroll
            for (int i = 0; i < NI; ++i) if (i < nt_) {
#pragma unroll
                for (int a = 0; a < NQ; ++a) { const int b = min(2047, (int)((xv[a][i] - lo[a]) * sc_[a])); const unsigned bts = __float_as_uint(xv[a][i]); const unsigned x = bts ^ ((bts >> 31) ? 0xFFFFFFFFu : 0x80000000u);
                    if (live[a] && b == b0[a] && (x & pmask[a]) == prefix[a]) __hip_atomic_fetch_add(hist + a * 2048 + ((x >> SH) & BM_), 1u, __ATOMIC_RELAXED, __HIP_MEMORY_SCOPE_WORKGROUP); } }
            LDS_WAIT();
            bool more = false; int bin[NQ]; unsigned c_u[NQ];
#pragma unroll
            for (int a = 0; a < NQ; ++a) { bin[a] = 0; c_u[a] = 0u; }
            hist_pick<NQ>(hist, lane, kk, bin, c_u, live);
#pragma unroll
            for (int a = 0; a < NQ; ++a) if (live[a]) {
                prefix[a] |= ((unsigned)bin[a] & BM_) << SH; pmask[a] |= BM_ << SH;
                if ((unsigned)kk[a] == c_u[a]) live[a] = false;
                more = more || live[a]; }
            if (!more) break;
        }
    }
    const int nt2_ = opaque_s(nt); float sc2_[NQ];
#pragma unroll
    for (int a = 0; a < NQ; ++a) sc2_[a] = opaque_vf(scale[a]);
#pragma unroll
    for (int i = 0; i < NI; ++i) if (i < nt2_) {
#pragma unroll
        for (int a = 0; a < NQ; ++a) { const int b = min(2047, (int)((xv[a][i] - lo[a]) * sc2_[a])); const unsigned bts = __float_as_uint(xv[a][i]); const unsigned x = bts ^ ((bts >> 31) ? 0xFFFFFFFFu : 0x80000000u);
            const bool selq = b > b0[a] || (b == b0[a] && (whole[a] || x >= prefix[a]));
            const unsigned long long mw = __ballot(selq); if (lane == 0) mrow[(size_t)a * MK_LS + i] = mw; } }
}
#define FRESH_TID() const int tid_o = wave0 * 64 + fresh_lane(); const int tid = tid_o, lane = tid & 63, wave = __builtin_amdgcn_readfirstlane(tid >> 6); (void)lane; (void)wave
__global__ void __launch_bounds__(NWAVES * 64, 2) fwd_kernel(Args args) {
    extern __shared__ __attribute__((aligned(16))) unsigned char lds_raw[];
    LAS unsigned char* lds = (LAS unsigned char*)lds_raw;
    volatile LAS unsigned* MISC = (volatile LAS unsigned*)(lds + MISC_OFF);
    const int wave0 = __builtin_amdgcn_readfirstlane((int)threadIdx.x >> 6);
    const int tid = wave0 * 64 + fresh_lane();
    const int G = gridDim.x;
    unsigned char* ws = args.ws;
    gu32* ctl = (gu32*)(ws + WS_CTL);
    float* const out = args.out;
#define X (out + O_Y)
#define XB ((bf16*)(ws + WS_XB))
#define HB ((bf16*)(ws + WS_REGA))
#define ACT ((bf16*)(ws + WS_REGA))
#define QA ((bf16*)(ws + WS_QA))
#define QB ((bf16*)(ws + WS_QB))
#define QI ((bf16*)(ws + WS_QI))
#define QC ((bf16*)(ws + WS_QC))
#define QD ((bf16*)(ws + WS_QD))
#define WI ((float*)(ws + WS_WI))
#define RA ((bf16*)(ws + WS_RA))
#define RB ((bf16*)(ws + WS_RB))
#define RC ((bf16*)(ws + WS_RC))
#define RD ((bf16*)(ws + WS_RD))
#define CC ((bf16*)(ws + WS_CC))
#define CQ ((bf16*)(ws + WS_REGA + (size_t)300 * MiB))
#define CKV ((bf16*)(ws + WS_REGA + (size_t)340 * MiB))
#define SSQP ((float*)(ws + WS_SSQP))
#define LAMF ((float*)(ws + WS_MISC))
#define ROPE64 ((float2*)(ws + WS_MISC + MISC_ROPE64))
#define ROPE32 ((float2*)(ws + WS_MISC + MISC_ROPE32))
    for (int u = tid; u < (LDS_BYTES - LDSCTL_OFF) / 4; u += NWAVES * 64) ((LAS unsigned*)(lds + LDSCTL_OFF))[u] = 0u;
    __syncthreads();
    XcdBarrier bar; bar.bar = (unsigned*)(ctl + CW_BAR); bar.x = 0; bar.st = nullptr; bar.wave0 = wave0;
    const int lo = args.ph_lo, hi_ph = args.ph_hi;
    if (hi_ph - lo > 1) bar = xcd_barrier_post((unsigned*)(ctl + CW_BAR), MISC + 8, wave0);
#define IN(k) (opaque_s(lo) <= (k) && (k) < opaque_s(hi_ph))
#define BOTH(k) (IN(k) && IN((k) + 1))
#define GRID_BAR() xcd_barrier(bar)

    if (EN_PH(0) && IN(0)) {
        FRESH_TID();
        for (int p0rep = 0; p0rep < P0_REPS; ++p0rep) {
        LAS float* scr = (LAS float*)(lds + wave * 16384);
        const int gw = blockIdx.x * NWAVES + wave, NGW = G * NWAVES;
        for (int l = 0; l < DEPTH; ++l) {
            unsigned char* wl = ws + WS_W + (size_t)l * W_LAYER;
            const int I_GU = (DM / 64) * (DFF / 32), I_D = (DFF / 64) * (DM / 32), I_INN = (DM / 64) * ((NIN + 31) / 32), I_O = (768 / 64) * (DM / 32);
            const int NIT = 4 * I_GU + 2 * I_D + I_INN + I_O;
            for (int it = gw; it < NIT; it += NGW) {
                int r = it;
                if (r < I_GU) { transpose_item<1>(ARG_IN(I_G1) + (size_t)l * DM * DFF, DM, DFF, ARG_IN(I_N1) + l * DM, (bf16*)(wl + W_GU1), DM, 0, scr, r, lane); continue; } r -= I_GU;
                if (r < I_GU) { transpose_item<2>(ARG_IN(I_U1) + (size_t)l * DM * DFF, DM, DFF, ARG_IN(I_N1) + l * DM, (bf16*)(wl + W_GU1), DM, 0, scr, r, lane); continue; } r -= I_GU;
                if (r < I_GU) { transpose_item<1>(ARG_IN(I_G2) + (size_t)l * DM * DFF, DM, DFF, ARG_IN(I_N2) + l * DM, (bf16*)(wl + W_GU2), DM, 0, scr, r, lane); continue; } r -= I_GU;
                if (r < I_GU) { transpose_item<2>(ARG_IN(I_U2) + (size_t)l * DM * DFF, DM, DFF, ARG_IN(I_N2) + l * DM, (bf16*)(wl + W_GU2), DM, 0, scr, r, lane); continue; } r -= I_GU;
                if (r < I_D) { transpose_item<0>(ARG_IN(I_D1) + (size_t)l * DFF * DM, DFF, DM, nullptr, (bf16*)(wl + W_D1), DFF, 0, scr, r, lane); continue; } r -= I_D;
                if (r < I_D) { transpose_item<0>(ARG_IN(I_D2) + (size_t)l * DFF * DM, DFF, DM, nullptr, (bf16*)(wl + W_D2), DFF, 0, scr, r, lane); continue; } r -= I_D;
                if (r < I_INN) { transpose_item<3>(ARG_IN(I_WIN) + (size_t)l * DM * NIN, DM, NIN, ARG_IN(I_NM) + l * DM, (bf16*)(wl + W_IN), DM, 0, scr, r, lane); continue; } r -= I_INN;
                transpose_item<0>(ARG_IN(I_WO) + (size_t)l * DM * DM + (size_t)256 * DM, 768, DM, nullptr, (bf16*)(wl + W_OUT), KOUT, 512, scr, r, lane);
            }
            const int gt = blockIdx.x * 512 + tid, NGT = G * 512;
            if (FUSE_POST) { for (int i = gt; i < NINP * (DM / 8); i += NGT) { const int np = i / (DM / 8); if (mycol_is_pad(np)) *(v4u*)((bf16*)(wl + W_IN) + (size_t)np * DM + 8 * (i % (DM / 8))) = (v4u){0u, 0u, 0u, 0u}; } }
            else for (int i = gt; i < (NINP - NIN) * DM; i += NGT) ((bf16*)(wl + W_IN))[(size_t)NIN * DM + i] = 0;
            for (int i = gt; i < (NQP - NQ) * 256; i += NGT) ((bf16*)(wl + W_Q))[(size_t)NQ * 256 + i] = 0;
            const float* wqb = ARG_IN(I_WQB) + (size_t)l * 256 * 384; const float* wkvb = ARG_IN(I_WKVB) + (size_t)l * 128 * 512; const float* qn = ARG_IN(I_QN) + l * 256;
            const float scaleA = 0.10206207261596575f * LOG2E;
            for (int i = gt; i < NQ * 256; i += NGT) {
                const int np = i >> 8, k = i & 255, hh = np / 160, c = np % 160; float v;
                if (c < 128) { float s = 0.f; for (int e = 0; e < 64; ++e) s += wqb[(size_t)k * 384 + hh * 96 + e] * wkvb[(size_t)c * 512 + hh * 128 + e]; v = s; }
                else v = wqb[(size_t)k * 384 + hh * 96 + 64 + (c - 128)];
                ((bf16*)(wl + W_Q))[(size_t)np * 256 + k] = (bf16)f2bf(v * qn[k] * scaleA);
            }
            const float* wo = ARG_IN(I_WO) + (size_t)l * DM * DM;
            for (int i = gt; i < 512 * DM; i += NGT) {
                const int n = i & 1023, kc = i >> 10, hh = kc >> 7, c = kc & 127; float s = 0.f;
                for (int e = 0; e < 64; ++e) s += wkvb[(size_t)c * 512 + hh * 128 + 64 + e] * wo[(size_t)(hh * 64 + e) * DM + n];
                ((bf16*)(wl + W_OUT))[(size_t)n * KOUT + kc] = (bf16)f2bf(s);
            }
            if (blockIdx.x == 0 && wave == 0) {
                const float* lf = ARG_IN(I_LAM) + l * 128;
                float a = lane < 32 ? lf[lane] * lf[32 + lane] : 0.f, b = lane < 32 ? lf[64 + lane] * lf[96 + lane] : 0.f;
                a = wave_sum(a); b = wave_sum(b);
                const float lam_init = 0.8f - 0.6f * expf(-0.3f * (float)l);
                if (lane == 0) LAMF[l] = expf(a) - expf(b) + lam_init;
            }
        }
        {
            const int gt = blockIdx.x * 512 + tid, NGT = G * 512;
            for (int i = gt; i < 2112 * 48; i += NGT) {
                const int pidx = i / 48, j = i % 48; const float pos = (float)(pidx < 2048 ? pidx : 4096 + (pidx - 2048));
                const float fr = j < 32 ? ARG_FREQ64(j) : ARG_FREQ32(j - 32);
                float sn, cs; sincos_acc(pos * fr, sn, cs);
                if (j < 32) ROPE64[pidx * 32 + j] = make_float2(cs, sn); else ROPE32[pidx * 16 + (j - 32)] = make_float2(cs, sn);
            }
        }
        for (int m = 2 * gw; m < M; m += 2 * NGW) {
            f32x4 v[2][4]; float sq[2];
#pragma unroll
            for (int r2 = 0; r2 < 2; ++r2) { const int mr = m + r2; const float* xr = (mr < MP) ? ARG_IN(I_XP) + (size_t)mr * DM : ARG_IN(I_XS) + (size_t)(mr - MP) * DM; const f32x4* x4 = (const f32x4*)xr + lane;
#pragma unroll
                for (int j = 0; j < 4; ++j) v[r2][j] = x4[64 * j]; }
#pragma unroll
            for (int r2 = 0; r2 < 2; ++r2) { const int mr = m + r2; float s2 = 0.f; unsigned long long* o8 = (unsigned long long*)(XB + (size_t)mr * DM) + lane;
#pragma unroll
                for (int j = 0; j < 4; ++j) { const f32x4 w = v[r2][j]; s2 += (w.x * w.x + w.y * w.y) + (w.z * w.z + w.w * w.w);
                    o8[64 * j] = (unsigned long long)cvtpk(w.x, w.y) | ((unsigned long long)cvtpk(w.z, w.w) << 32); }
                sq[r2] = wave_sum(s2); }
#pragma unroll
            for (int r2 = 0; r2 < 2; ++r2) if (lane < 16) SSQP[(size_t)(m + r2) * 16 + lane] = lane == 0 ? sq[r2] : 0.f;
        }
        }
        if (BOTH(0)) GRID_BAR();
    }

#pragma unroll 1
    for (int l = 0; l < DEPTH; ++l) {
        const int pb = 1 + 8 * l;
        unsigned char* wl = ws + WS_W + (size_t)l * W_LAYER;
        float* ssqA = SSQP + (size_t)l * M * 16; float* ssqAn = SSQP + (size_t)(l + 1) * M * 16; float* ssqB = SSQP + (size_t)(3 + l) * M * 16; float* ssqC = SSQP + (size_t)(5 + l) * M * 16; float* ssqQ = SSQP + (size_t)7 * M * 16 + (size_t)l * M * 4; float* ssqK = SSQP + (size_t)7 * M * 16 + (size_t)(2 + l) * M * 4; (void)ssqK;
        if (EN_PH(1) && IN(pb + 0)) {
            pg8::Gemm g{XB, (const bf16*)(wl + W_GU1), M, NGU, DM, DM}; pg8::StaticOrder S; S.init(M, NGU, G, (int)blockIdx.x);
            pg8::EpiSwiGLU E{ACT, ssqA};
            for (int grep = 0; grep < GU_REPS; ++grep)
            pg8::gemm_phase<pg8::EpiSwiGLU, pg8::StaticOrder, true, true>(lds, g, S, E, wave0);
            if (BOTH(pb + 0)) GRID_BAR();
        }
#define SPLITK_SAMPLE(WOFF) do { const int sl_ = (int)blockIdx.x & 7, un_ = (int)blockIdx.x >> 3; const int kb_ = sl_ < 6 ? 3 * sl_ : 18 + 2 * (sl_ - 6), kl_ = sl_ < 6 ? 3 : 2; \
        pg8::Gemm g2{ACT + (size_t)(MP + 256 * (un_ >> 2)) * DFF + kb_ * 128, (const bf16*)(wl + WOFF) + (size_t)(256 * (un_ & 3)) * DFF + kb_ * 128, 256, 256, kl_ * 128, DFF, DFF}; \
        pg8::OneUnit S2; pg8::EpiPartial E2{(float*)(ws + WS_QA) + (size_t)(un_ * 8 + sl_) * 32 * 512 * 4}; \
        pg8::gemm_phase<pg8::EpiPartial, pg8::OneUnit, true, true>(lds, g2, S2, E2, wave0); } while (0)
        if (EN_PH(2) && IN(pb + 1)) {
            pg8::Gemm g{ACT, (const bf16*)(wl + W_D1), M, DM, DFF, DFF}; pg8::StaticOrder S; S.init(MP, DM, G, (int)blockIdx.x);
            if (l == 0) { pg8::EpiResid<true> E{ARG_IN(I_XP), ARG_IN(I_XS) - (size_t)MP * DM, XB, ssqB, 0.5f};
                pg8::gemm_phase<pg8::EpiResid<true>, pg8::StaticOrder, true, true>(lds, g, S, E, wave0); }
            else { pg8::EpiResid<false> E{nullptr, nullptr, XB, ssqB, 0.5f};
                pg8::gemm_phase<pg8::EpiResid<false>, pg8::StaticOrder, true, true>(lds, g, S, E, wave0); }
            SPLITK_SAMPLE(W_D1);
            GRID_BAR();
            { FRESH_TID(); const int un_ = (int)blockIdx.x >> 3, j_ = (int)blockIdx.x & 7; const float* Pu = (const float*)(ws + WS_QA) + (size_t)un_ * 8 * 32 * 512 * 4;
              if (l == 0) pg8::resid_fixup<true>(Pu, MP / 256 + (un_ >> 2), un_ & 3, j_ >> 2, j_ & 3, ARG_IN(I_XS) - (size_t)MP * DM, XB, ssqB, 0.5f, tid);
              else pg8::resid_fixup<false>(Pu, MP / 256 + (un_ >> 2), un_ & 3, j_ >> 2, j_ & 3, nullptr, XB, ssqB, 0.5f, tid); }
            if (BOTH(pb + 1)) GRID_BAR();
        }
        if (EN_PH(3) && IN(pb + 2)) {
            pg8::Gemm g{XB, (const bf16*)(wl + W_IN), M, NINP, DM, DM}; pg8::StaticOrder S; S.init(M, NINP, G, (int)blockIdx.x);
#if FUSE_POST
#if IN_STAGGER_TICKS > 0
            if (blockIdx.x & 1) { const unsigned long long t0 = __builtin_amdgcn_s_memrealtime(); while (__builtin_amdgcn_s_memrealtime() - t0 < (unsigned long long)IN_STAGGER_TICKS) __builtin_amdgcn_s_sleep(8); }
#endif
            pg8::EpiInFused E{ws, out, l};
            pg8::gemm_phase<pg8::EpiInFused, pg8::StaticOrder, true, true>(lds, g, S, E, wave0);
#else
            pg8::EpiScaleBf16 E{HB, NINP, ssqB, 16, 1.0f / 1024.0f, ssqQ};
            pg8::gemm_phase<pg8::EpiScaleBf16, pg8::StaticOrder, true, true>(lds, g, S, E, wave0);
#endif
            if (BOTH(pb + 2)) GRID_BAR();
        }
        if (EN_PH(4) && IN(pb + 3)) {
#if FUSE_POST
            {
                pg8::Gemm g{CQ, (const bf16*)(wl + W_Q), M, NQP, 256, 256}; pg8::StaticOrder S; S.init(M, NQP, G, (int)blockIdx.x);
                pg8::EpiScaleBf16 E{QA, NQP, ssqQ, 4, 1.0f / 256.0f, nullptr};
                pg8::gemm_phase<pg8::EpiScaleBf16, pg8::StaticOrder, true, true>(lds, g, S, E, wave0);
            }
            {
                FRESH_TID();
                const float* kvn = ARG_IN(I_KVN) + l * 128; const int gw = blockIdx.x * NWAVES + wave, NGW = G * NWAVES; const int c16 = lane & 15, sub = lane >> 4;
                for (int row4 = gw * 4; row4 < M; row4 += NGW * 4) { const int row = row4 + sub;
                    const bool smp = row >= MP; const int rr = smp ? row - MP : row;
                    const v4u w = *(const v4u*)(CKV + (size_t)row * 128 + 8 * c16); float x[8];
                    x[0] = __uint_as_float(w[0] << 16); x[1] = __uint_as_float(w[0] & 0xffff0000u); x[2] = __uint_as_float(w[1] << 16); x[3] = __uint_as_float(w[1] & 0xffff0000u);
                    x[4] = __uint_as_float(w[2] << 16); x[5] = __uint_as_float(w[2] & 0xffff0000u); x[6] = __uint_as_float(w[3] << 16); x[7] = __uint_as_float(w[3] & 0xffff0000u);
                    const float rs = 1.0f / sqrtf(ssq_sum4(ssqK, row) * (1.0f / 128.0f) + EPS); const f32x4 g0 = *(const f32x4*)(kvn + 8 * c16), g1 = *(const f32x4*)(kvn + 8 * c16 + 4);
#pragma unroll
                    for (int e = 0; e < 4; ++e) { x[e] = x[e] * rs * g0[e]; x[4 + e] = x[4 + e] * rs * g1[e]; }
                    float* od = out + (smp ? O_MLA_S + ((size_t)l * MS + rr) * 160 : O_MLA_P + ((size_t)l * MP + rr) * 160) + 8 * c16;
                    *(f32x4*)od = (f32x4){x[0], x[1], x[2], x[3]}; *(f32x4*)(od + 4) = (f32x4){x[4], x[5], x[6], x[7]};
                    *(v4u*)(RA + (size_t)row * 160 + 8 * c16) = (v4u){cvtpk(x[0], x[1]), cvtpk(x[2], x[3]), cvtpk(x[4], x[5]), cvtpk(x[6], x[7])}; }
            }
            if (BOTH(pb + 3)) GRID_BAR();
#else
            for (int prep = 0; prep < POST_REPS; ++prep) {
            {
                pg8::Gemm g{HB, (const bf16*)(wl + W_Q), M, NQP, 256, NINP}; pg8::StaticOrder S; S.init(M, NQP, G, (int)blockIdx.x);
                pg8::EpiScaleBf16 E{QA, NQP, ssqQ, 4, 1.0f / 256.0f, nullptr};
                pg8::gemm_phase<pg8::EpiScaleBf16, pg8::StaticOrder, true, true>(lds, g, S, E, wave0);
            }
            FRESH_TID();
            const float* kvn = ARG_IN(I_KVN) + l * 128;
            const float scaleB = 0.125f * LOG2E, scaleD = 0.17677669529663687f * LOG2E, scaleC = 0.125f * LOG2E;
            const int gw = blockIdx.x * NWAVES + wave, NGW = G * NWAVES;
#define UP8(w, f) do { f[0] = __uint_as_float((w)[0] << 16); f[1] = __uint_as_float((w)[0] & 0xffff0000u); f[2] = __uint_as_float((w)[1] << 16); f[3] = __uint_as_float((w)[1] & 0xffff0000u); \
                       f[4] = __uint_as_float((w)[2] << 16); f[5] = __uint_as_float((w)[2] & 0xffff0000u); f[6] = __uint_as_float((w)[3] << 16); f[7] = __uint_as_float((w)[3] & 0xffff0000u); } while (0)
#define PK8(f) ((v4u){cvtpk(f[0], f[1]), cvtpk(f[2], f[3]), cvtpk(f[4], f[5]), cvtpk(f[6], f[7])})
#define ST8F(p, f) do { *(f32x4*)(p) = (f32x4){f[0], f[1], f[2], f[3]}; *(f32x4*)((p) + 4) = (f32x4){f[4], f[5], f[6], f[7]}; } while (0)
            for (int row = gw; row < M; row += NGW) {
                const bf16* h = HB + (size_t)row * NINP;
                const bool smp = row >= MP; const int rr = smp ? row - MP : row;
                const int pidx = smp ? 2048 + (rr & 63) : (rr & 2047);
                float* o_mla = out + (smp ? O_MLA_S + ((size_t)l * MS + rr) * 160 : O_MLA_P + ((size_t)l * MP + rr) * 160);
                float* o_dsa = out + (smp ? O_DSA_S + ((size_t)l * MS + rr) * 192 : O_DSA_P + ((size_t)l * MP + rr) * 192);
                float* o_sb = out + (smp ? O_SB_S + ((size_t)l * MS + rr) * 512 : O_SB_P + ((size_t)l * MP + rr) * 512);
                float* o_df = out + (smp ? O_DIFF_S + ((size_t)l * MS + rr) * 512 : O_DIFF_P + ((size_t)l * MP + rr) * 512);
                bf16* ra = RA + (size_t)row * 160; bf16* rb = RB + (size_t)row * 192; bf16* rc = RC + (size_t)row * 512; bf16* rd = RD + (size_t)row * 512;
                if (lane < 56) { const int blk = lane >> 2, j = lane & 3;
                    const int base = blk < 4 ? H_QB + 64 * blk : (blk == 4 ? H_KB : (blk < 13 ? H_QI + 64 * (blk - 5) : H_KI));
                    const v4u w1 = *(const v4u*)(h + base + 8 * j), w2 = *(const v4u*)(h + base + 32 + 8 * j); float x1[8], x2[8], a[8], b[8]; UP8(w1, x1); UP8(w2, x2);
                    const f32x4* cp = (const f32x4*)(ROPE64 + pidx * 32 + 8 * j);
#pragma unroll
                    for (int e2 = 0; e2 < 4; ++e2) { const f32x4 cs = cp[e2];
                        a[2 * e2] = x1[2 * e2] * cs[0] - x2[2 * e2] * cs[1]; b[2 * e2] = x2[2 * e2] * cs[0] + x1[2 * e2] * cs[1];
                        a[2 * e2 + 1] = x1[2 * e2 + 1] * cs[2] - x2[2 * e2 + 1] * cs[3]; b[2 * e2 + 1] = x2[2 * e2 + 1] * cs[2] + x1[2 * e2 + 1] * cs[3]; }
                    if (blk < 4) {
#pragma unroll
                        for (int e = 0; e < 8; ++e) { a[e] *= scaleB; b[e] *= scaleB; }
                        bf16* d = QB + (size_t)row * 256 + 64 * blk + 8 * j; *(v4u*)d = PK8(a); *(v4u*)(d + 32) = PK8(b); }
                    else if (blk == 4) { ST8F(o_dsa + 8 * j, a); ST8F(o_dsa + 32 + 8 * j, b); *(v4u*)(rb + 8 * j) = PK8(a); *(v4u*)(rb + 32 + 8 * j) = PK8(b); }
                    else if (blk < 13) { bf16* d = QI + (size_t)row * 512 + 64 * (blk - 5) + 8 * j; *(v4u*)d = PK8(a); *(v4u*)(d + 32) = PK8(b); }
                    else { ST8F(o_dsa + 128 + 8 * j, a); ST8F(o_dsa + 160 + 8 * j, b); *(v4u*)(rb + 128 + 8 * j) = PK8(a); *(v4u*)(rb + 160 + 8 * j) = PK8(b); }
                }
                if (lane < 34) { const int blk = lane >> 1, j = lane & 1;
                    const int base = blk == 0 ? H_KR : (blk < 9 ? H_QD + 32 * (blk - 1) : H_KD + 32 * (blk - 9));
                    const v4u w1 = *(const v4u*)(h + base + 8 * j), w2 = *(const v4u*)(h + base + 16 + 8 * j); float x1[8], x2[8], a[8], b[8]; UP8(w1, x1); UP8(w2, x2);
                    const f32x4* cp = (const f32x4*)(ROPE32 + pidx * 16 + 8 * j);
#pragma unroll
                    for (int e2 = 0; e2 < 4; ++e2) { const f32x4 cs = cp[e2];
                        a[2 * e2] = x1[2 * e2] * cs[0] - x2[2 * e2] * cs[1]; b[2 * e2] = x2[2 * e2] * cs[0] + x1[2 * e2] * cs[1];
                        a[2 * e2 + 1] = x1[2 * e2 + 1] * cs[2] - x2[2 * e2 + 1] * cs[3]; b[2 * e2 + 1] = x2[2 * e2 + 1] * cs[2] + x1[2 * e2 + 1] * cs[3]; }
                    if (blk == 0) { ST8F(o_mla + 128 + 8 * j, a); ST8F(o_mla + 144 + 8 * j, b); *(v4u*)(ra + 128 + 8 * j) = PK8(a); *(v4u*)(ra + 144 + 8 * j) = PK8(b); }
                    else if (blk < 9) {
#pragma unroll
                        for (int e = 0; e < 8; ++e) { a[e] *= scaleD; b[e] *= scaleD; }
                        bf16* d = QD + (size_t)row * 256 + 32 * (blk - 1) + 8 * j; *(v4u*)d = PK8(a); *(v4u*)(d + 16) = PK8(b); }
                    else { const int bb = blk - 9, oc = (bb >> 1) * 128 + (bb & 1) * 32 + 8 * j; ST8F(o_df + oc, a); ST8F(o_df + oc + 16, b); *(v4u*)(rd + oc) = PK8(a); *(v4u*)(rd + oc + 16) = PK8(b); }
                }
                { const int c16 = lane & 15; float x[8] = {0.f, 0.f, 0.f, 0.f, 0.f, 0.f, 0.f, 0.f}; float ss = 0.f;
                  if (lane >= 48) { const v4u w = *(const v4u*)(h + H_CKV + 8 * c16); UP8(w, x);
#pragma unroll
                      for (int e = 0; e < 8; ++e) ss += x[e] * x[e]; }
                  ss += __shfl_xor(ss, 1); ss += __shfl_xor(ss, 2); ss += __shfl_xor(ss, 4); ss += __shfl_xor(ss, 8);
                  if (lane >= 48) { const float rs = 1.0f / sqrtf(ss * (1.0f / 128.0f) + EPS); const f32x4 g0 = *(const f32x4*)(kvn + 8 * c16), g1 = *(const f32x4*)(kvn + 8 * c16 + 4);
#pragma unroll
                      for (int e = 0; e < 4; ++e) { x[e] = x[e] * rs * g0[e]; x[4 + e] = x[4 + e] * rs * g1[e]; }
                      ST8F(o_mla + 8 * c16, x); *(v4u*)(ra + 8 * c16) = PK8(x); } }
#pragma unroll
                for (int r3 = 0; r3 < 3; ++r3) { const int t = lane + 64 * r3;
                    if (t < 137) { float x[8];
                        if (t < 8) { const v4u w = *(const v4u*)(h + H_VB + 8 * t); UP8(w, x); ST8F(o_dsa + 64 + 8 * t, x); *(v4u*)(rb + 64 + 8 * t) = w; }
                        else if (t < 40) { const int k = t - 8; const v4u w = *(const v4u*)(h + H_QC + 8 * k); UP8(w, x);
#pragma unroll
                            for (int e = 0; e < 8; ++e) x[e] *= scaleC;
                            *(v4u*)(QC + (size_t)row * 256 + 8 * k) = PK8(x); }
                        else if (t < 72) { const int k = t - 40, oc = (k >> 3) * 128 + 8 * (k & 7); const v4u w = *(const v4u*)(h + H_KC + 8 * k); UP8(w, x); ST8F(o_sb + oc, x); *(v4u*)(rc + oc) = w; }
                        else if (t < 104) { const int k = t - 72, oc = (k >> 3) * 128 + 64 + 8 * (k & 7); const v4u w = *(const v4u*)(h + H_VC + 8 * k); UP8(w, x); ST8F(o_sb + oc, x); *(v4u*)(rc + oc) = w; }
                        else if (t < 136) { const int k = t - 104, oc = (k >> 3) * 128 + 64 + 8 * (k & 7); const v4u w = *(const v4u*)(h + H_VD + 8 * k); UP8(w, x); ST8F(o_df + oc, x); *(v4u*)(rd + oc) = w; }
                        else { const v4u w = *(const v4u*)(h + H_WI); UP8(w, x);
#pragma unroll
                            for (int e = 0; e < 8; ++e) x[e] *= 0.35355339059327373f;
                            ST8F(WI + (size_t)row * 8, x); }
                    } }
            }
            }
#undef UP8
#undef PK8
#undef ST8F
            if (BOTH(pb + 3)) GRID_BAR();
#endif
        }
        if (EN_PH(5) && IN(pb + 4)) {
            GLB unsigned char* wsg_ = (GLB unsigned char*)args.ws; asm volatile("" : "+s"(wsg_)); unsigned char* ws = (unsigned char*)wsg_;
            LAS char* tile = (LAS char*)lds;
            volatile LAS unsigned* qslot = MISC + 16;
            const int myx = (int)(xb_xcc_id() & 7u);
            for (int rep = 0; rep < ATTN_REPS; ++rep) {
#define MIXER_IDS() FRESH_TID(); const int r32 = lane & 31, hi = lane >> 5, hd = wave & 3, qh = wave >> 2, q4 = (lane & 15) >> 2; (void)q4; int qx = myx
#define NEXT_UNIT(kind, out) do { __syncthreads(); if (tid == 0) { int res_ = -1, q_ = qx; gu32* heads_ = ctl + CW_Q + (((rep * 2 + l) * 4 + (kind)) * 8) * 64; \
        for (;;) { const unsigned got_ = __hip_atomic_fetch_add((unsigned*)(heads_ + q_ * 64), 1u, RLX_AGENT); if (got_ < (unsigned)QLIST) { res_ = (int)got_ + 256 * q_; break; } \
            unsigned hv_[8]; _Pragma("unroll") for (int s_ = 0; s_ < 8; ++s_) hv_[s_] = __hip_atomic_load((unsigned*)(heads_ + ((myx + s_) & 7) * 64), RLX_AGENT); \
            int pick_ = -1; _Pragma("unroll") for (int s_ = 7; s_ >= 0; --s_) if (hv_[s_] < (unsigned)QLIST) pick_ = s_; \
            if (pick_ < 0) break; q_ = (myx + pick_) & 7; } \
        qslot[0] = (unsigned)res_; } \
    __syncthreads(); { const int r_ = (int)qslot[0]; out = r_ < 0 ? -1 : (r_ & 255); qx = r_ < 0 ? qx : ((r_ >> 8) & 7); } } while (0)
#if EN_DSA
            if (rep == 0 || ((REP_MASK >> 1) & 1)) { MIXER_IDS();
            for (;;) {
                int uidx; NEXT_UNIT(1, uidx); if (uidx < 0) break;
                const UnitId u = decode_unit(qx, uidx);
                const float* cache_lb = ARG_IN(I_CDSA) + ((size_t)(l * NB + u.b) * PAST) * 192;
                const int myq = u.qrow0 + 32 * qh + r32;
                float* sc = (float*)(ws + WS_REGA + (size_t)blockIdx.x * DSA_SCR);
                unsigned long long* mk = (unsigned long long*)(ws + WS_REGA + (size_t)blockIdx.x * DSA_SCR + DSA_MASK_OFF);
                const bool sel = u.nt > 4;
                if (sel) {
                    {
                    float wq[8]; float smin = 3e38f, smax = -3e38f;
                    LAS unsigned* mmq = (LAS unsigned*)(lds + 110592);
                    if (tid < 64) { mmq[tid] = 0xFFFFFFFFu; mmq[64 + tid] = 0u; }
#pragma unroll
                    for (int hh = 0; hh < 8; ++hh) wq[hh] = WI[(size_t)myq * 8 + hh];
                    LAS char* ql_ = (LAS char*)lds + 20480;
                    { const int row0 = tid >> 6, cc = tid & 63;
#pragma unroll
                      for (int i = 0; i < 8; ++i) { const int row = row0 + 8 * i; *(LAS v4u*)(ql_ + row * T512_STRB + cc * 16) = *(const v4u*)(QI + (size_t)(u.qrow0 + row) * 512 + cc * 8); } }
                    const LAS char* qb_ = ql_ + (32 * qh + r32) * T512_STRB + 8 * hi * 2;
                    TileLd<64, 192, true, 128> ld; ld.init(); constexpr int STRB = TileLd<64, 192, true, 128>::STRB;
                    const int nt2 = (u.nt + 1) >> 1;
                    bool f32; const void* src = tile_src(u, 0, cache_lb, RB, 192, 128, f32);
                    ld.nrows_ = (u.nt >= 2) ? 128 : 64; ld.issue(src, f32, tid); ld.store(tile, f32, tid); __syncthreads();
                    const int kboffA = (32 * hd + r32) * STRB + 8 * hi * 2;
                    int cbA = 0;
                    for (int t2 = 0; t2 < nt2; ++t2) {
                        LAS char* curA = tile + cbA * 90112; LAS char* nxbA = tile + (cbA ^ 1) * 90112; cbA ^= 1;
                        const LAS char* kb = curA + kboffA;
                        const int rows_cur = (2 * t2 + 2 <= u.nt) ? 128 : 64;
                        bool f32n; { const int tn2 = (t2 + 1 < nt2) ? t2 + 1 : t2; const void* sn = tile_src(u, 2 * tn2, cache_lb, RB, 192, 128, f32n); ld.nrows_ = (2 * tn2 + 2 <= u.nt) ? 128 : 64; ld.issue(sn, f32n, tid); }
                        if (32 * hd < rows_cur) {
                            bf16x8 ka[4];
#pragma unroll
                            for (int s = 0; s < 4; ++s) ka[s] = *(const LAS bf16x8*)(kb + s * 32);
                            typedef float f32x2_t __attribute__((ext_vector_type(2)));
                            f32x2_t I2[8];
#pragma unroll
                            for (int r = 0; r < 8; ++r) I2[r] = (f32x2_t){0.f, 0.f};
                            bf16x8 qf[2][4];
#pragma unroll
                            for (int s = 0; s < 4; ++s) qf[0][s] = *(const LAS bf16x8*)(qb_ + s * 32);
#pragma unroll
                            for (int hh = 0; hh < 8; ++hh) { f32x16 p = zero16(); const f32x2_t w2 = {wq[hh], wq[hh]};
                                if (hh < 7) {
#pragma unroll
                                    for (int s = 0; s < 4; ++s) qf[(hh + 1) & 1][s] = *(const LAS bf16x8*)(qb_ + (hh + 1) * 128 + s * 32); }
                                __builtin_amdgcn_sched_barrier(0);
#pragma unroll
                                for (int s = 0; s < 4; ++s) p = MFMA32(ka[s], qf[hh & 1][s], p);
#pragma unroll
                                for (int r = 0; r < 8; ++r) { const f32x2_t rl = {__int_as_float(max(__float_as_int(p[2 * r]), 0)), __int_as_float(max(__float_as_int(p[2 * r + 1]), 0))};        I2[r] = w2 * rl + I2[r]; } }
                            f32x16 I;
#pragma unroll
                            for (int r = 0; r < 8; ++r) { I[2 * r] = I2[r].x; I[2 * r + 1] = I2[r].y; }
                            GLB float* scol = (GLB float*)sc + (size_t)(t2 * 128 + 32 * hd + 4 * hi) * 64 + 32 * qh + r32;
#pragma unroll
                            for (int r = 0; r < 16; ++r) { scol[(size_t)((r & 3) + 8 * (r >> 2)) * 64] = I[r]; smin = fminf(smin, I[r]); smax = fmaxf(smax, I[r]); }
                        }
                        ld.store(nxbA, f32n, tid);
                        __syncthreads();
                    }
                    { const unsigned bmn = __float_as_uint(smin), bmx = __float_as_uint(smax);
                      __hip_atomic_fetch_min(mmq + 32 * qh + r32, bmn ^ ((bmn >> 31) ? 0xFFFFFFFFu : 0x80000000u), __ATOMIC_RELAXED, __HIP_MEMORY_SCOPE_WORKGROUP);
                      __hip_atomic_fetch_max(mmq + 64 + 32 * qh + r32, bmx ^ ((bmx >> 31) ? 0xFFFFFFFFu : 0x80000000u), __ATOMIC_RELAXED, __HIP_MEMORY_SCOPE_WORKGROUP); }
                    }
                    VM_WAIT(); __syncthreads();
                    {
                    LAS unsigned* hist = (LAS unsigned*)lds;
                    LAS unsigned* part = (LAS unsigned*)(lds + 65536);
                    LAS float* qlo = (LAS float*)(lds + 67584); LAS float* qsc = qlo + 64; LAS int* qkk = (LAS int*)(qsc + 64); LAS unsigned* qT = (LAS unsigned*)(qkk + 64); LAS int* qwhole = (LAS int*)(qT + 64);
                    LAS int* qcn = qwhole + 64;
                    LAS unsigned long long* mkl = (LAS unsigned long long*)(lds + 69632);
                    LAS unsigned* cval = (LAS unsigned*)(lds + 106496);
                    LAS unsigned short* ckey = (LAS unsigned short*)(lds + 122880);
                    constexpr int CMAX = 64;
                    const int pq = tid & 63, ps = tid >> 6;
                    LAS unsigned* mmq = (LAS unsigned*)(lds + 110592);
                    if (tid < 64) { const unsigned a = mmq[tid], b = mmq[64 + tid];
                        const float lo_ = __uint_as_float((a & 0x80000000u) ? (a ^ 0x80000000u) : ~a), hi_ = __uint_as_float((b & 0x80000000u) ? (b ^ 0x80000000u) : ~b);
                        const float range = hi_ - lo_; qlo[tid] = lo_; qsc[tid] = (range > 1e-30f) ? 255.99f / range : 0.f; qcn[tid] = 0; }
#pragma unroll
                    for (int j = 0; j < 8; ++j) ((LAS v4u*)hist)[tid + 512 * j] = (v4u){0u, 0u, 0u, 0u};
                    __syncthreads();
                    const float lo_q = qlo[pq], sc_q = qsc[pq];
                    const GLB float* scq = (const GLB float*)sc + pq;
                    for (int t = ps; t < u.nt; t += 8) { const GLB float* sp = scq + (size_t)t * 4096;
                        { float xs[64];
#pragma unroll
                            for (int j = 0; j < 64; ++j) xs[j] = sp[j * 64];
#pragma unroll
                            for (int j = 0; j < 64; ++j) { const int b0 = min(255, (int)((xs[j] - lo_q) * sc_q)); __hip_atomic_fetch_add(hist + b0 * 64 + pq, 1u, __ATOMIC_RELAXED, __HIP_MEMORY_SCOPE_WORKGROUP); } } }
                    __syncthreads();
                    { unsigned sm = 0u;
#pragma unroll 8
                      for (int j = 0; j < 32; ++j) sm += hist[(32 * ps + j) * 64 + pq];
                      part[ps * 64 + pq] = sm; }
                    __syncthreads();
                    if (tid < 64) { const unsigned kk_ = 256u; unsigned acc = 0u; int sl_ = -1; unsigned abv = 0u;
#pragma unroll
                        for (int s2 = 7; s2 >= 0; --s2) { const unsigned c = part[s2 * 64 + tid]; const bool take = (sl_ < 0) && (acc + c >= kk_); if (take) { sl_ = s2; abv = acc; } acc += c; }
                        sl_ = sl_ < 0 ? 0 : sl_; unsigned acc2 = abv; int bsel = -1; unsigned abv2 = 0u, csel = 0u;
#pragma unroll 8
                        for (int j = 31; j >= 0; --j) { const unsigned c = hist[(32 * sl_ + j) * 64 + tid]; const bool take = (bsel < 0) && (acc2 + c >= kk_); if (take) { bsel = j; abv2 = acc2; csel = c; } acc2 += c; }
                        bsel = bsel < 0 ? 0 : bsel;
                        qT[tid] = (unsigned)(32 * sl_ + bsel); qkk[tid] = (int)(kk_ - abv2); qwhole[tid] = ((kk_ - abv2) == csel) ? 1 : 0; }
                    __syncthreads();
                    { const int T0 = (int)qT[pq]; const bool whole = qwhole[pq] != 0;
                      for (int t = ps; t < u.nt; t += 8) { const GLB float* sp = scq + (size_t)t * 4096; unsigned long long w = 0ull;
#pragma unroll 1
                        for (int k0 = 0; k0 < 64; k0 += 32) { float xs[32];
#pragma unroll
                            for (int j = 0; j < 32; ++j) xs[j] = sp[(k0 + j) * 64];
#pragma unroll
                            for (int j = 0; j < 32; ++j) { const int b0 = min(255, (int)((xs[j] - lo_q) * sc_q));
                                const bool selq = b0 > T0 || (whole && b0 == T0); w |= (unsigned long long)(selq ? 1u : 0u) << (k0 + j);
                                if (!whole && b0 == T0) { const int ix = __hip_atomic_fetch_add(qcn + pq, 1, __ATOMIC_RELAXED, __HIP_MEMORY_SCOPE_WORKGROUP);
                                    if (ix < CMAX) { const unsigned bts = __float_as_uint(xs[j]); cval[pq * CMAX + ix] = bts ^ ((bts >> 31) ? 0xFFFFFFFFu : 0x80000000u); ckey[pq * CMAX + ix] = (unsigned short)(t * 64 + k0 + j); } } } }
                        mkl[pq * 72 + t] = w; } }
                    __syncthreads();
                    if (!qwhole[pq]) { const int n = qcn[pq], kk_ = qkk[pq];
                        if (n <= CMAX) { for (int i = ps; i < n; i += 8) { const unsigned vi = cval[pq * CMAX + i]; const unsigned ki = ckey[pq * CMAX + i]; int rank = 0;
                                for (int j = 0; j < n; ++j) { const unsigned vj = cval[pq * CMAX + j]; const unsigned kj = ckey[pq * CMAX + j]; rank += (vj > vi || (vj == vi && kj < ki)) ? 1 : 0; }
                                if (rank < kk_) __hip_atomic_fetch_or((LAS unsigned*)mkl + (pq * 72 + (int)(ki >> 6)) * 2 + (int)((ki >> 5) & 1u), 1u << (ki & 31u), __ATOMIC_RELAXED, __HIP_MEMORY_SCOPE_WORKGROUP); } } }
                    __syncthreads();
                    if (wave == 0) { unsigned long long und = __ballot(!qwhole[lane] && qcn[lane] > CMAX);
                        while (und) { const int qf = (int)__builtin_ctzll(und); und &= und - 1ull;
                            if (u.sample) dsa_select<65, 1, 64>(sc + qf, u.nt, hist, (unsigned long long*)(mkl + qf * 72), lane); else dsa_select<32, 1, 64>(sc + qf, u.nt, hist, (unsigned long long*)(mkl + qf * 72), lane); } }
                    }
                    VM_WAIT(); __syncthreads();
                }
                bf16x8 q[4];
#pragma unroll
                for (int s = 0; s < 4; ++s) q[s] = *(const bf16x8*)(QB + (size_t)myq * 256 + hd * 64 + 16 * s + 8 * hi);
                f32x16 o[2]; o[0] = zero16(); o[1] = zero16(); float m_ = -1e30f, l_ = 0.f;
                TileLd<128, 192> ld; ld.init(); constexpr int STRB = TileLd<128, 192>::STRB;
                bool f32; const void* src = tile_src(u, 0, cache_lb, RB, 192, 0, f32);
                ld.issue(src, f32, tid); ld.store(tile, f32, tid); __syncthreads();
                const int kboff = r32 * STRB + 8 * hi * 2;
                const int vboff = (4 * hi + q4) * STRB + (64 + 16 * ((lane >> 4) & 1) + 4 * (lane & 3)) * 2;
                int cb = 0;
                for (int t = 0; t < u.nt; ++t) {
                    LAS char* cur = tile + cb * 24576; LAS char* nxb = tile + (cb ^ 1) * 24576; cb ^= 1;
                    const LAS char* kb = cur + kboff; const LAS char* vb = cur + vboff;
                    bool f32n; { const int tn = (t + 1 < u.nt) ? t + 1 : t; const void* sn = tile_src(u, tn, cache_lb, RB, 192, 0, f32n); ld.issue(sn, f32n, tid); }
                    unsigned long long mw = ~0ull; if (sel) mw = ((const LAS unsigned long long*)(lds + 69632))[(32 * qh + r32) * 72 + t];
                    const unsigned mlo = (unsigned)mw >> (4 * hi), mhi = (unsigned)(mw >> 32) >> (4 * hi);
                    f32x16 p0, p1; bf16x8 kf[8], vf[8];
                    k_ld<4>(kf, kb, STRB); __builtin_amdgcn_sched_barrier(0); qk_r<4>(p0, p1, kf, q); v_ld<2>(vf, vb, STRB); __builtin_amdgcn_sched_barrier(0);
#pragma unroll
                    for (int r = 0; r < 16; ++r) { const int bpos = (r & 3) + 8 * (r >> 2);
                        const unsigned s0 = (unsigned)__builtin_amdgcn_sbfe((int)mlo, bpos, 1), s1 = (unsigned)__builtin_amdgcn_sbfe((int)mhi, bpos, 1);
                        p0[r] = __uint_as_float((__float_as_uint(p0[r]) & s0) | (0xff61b1e6u & ~s0)); p1[r] = __uint_as_float((__float_as_uint(p1[r]) & s1) | (0xff61b1e6u & ~s1)); }
                    softmax_step<2>(p0, p1, m_, l_, o);
                    pv_r<2>(o, p0, p1, vf);
                    ld.store(nxb, f32n, tid);
                    __syncthreads();
                }
                l_ += __shfl_xor(l_, 32); const float inv = 1.0f / l_;
                bf16* orow = CC + (size_t)myq * KOUT + 512 + hd * 64;
#pragma unroll
                for (int db = 0; db < 2; ++db)
#pragma unroll
                    for (int gq = 0; gq < 4; ++gq) { v2u w; w.x = cvtpk(o[db][4 * gq] * inv, o[db][4 * gq + 1] * inv); w.y = cvtpk(o[db][4 * gq + 2] * inv, o[db][4 * gq + 3] * inv);
                        *(v2u*)(orow + 32 * db + 8 * gq + 4 * hi) = w; }
            }
            }
#endif
#if EN_DIFF
            if (rep == 0 || ((REP_MASK >> 3) & 1)) { MIXER_IDS();
            for (;;) {
                int uidx; NEXT_UNIT(3, uidx); if (uidx < 0) break;
                const UnitId u = decode_unit(qx, uidx);
                const float* cache_lb = ARG_IN(I_CDIFF) + ((size_t)(l * NB + u.b) * PAST) * 512;
                const int myq = u.qrow0 + 32 * qh + r32;
                bf16x8 qa[2], qb2[2];
#pragma unroll
                for (int s = 0; s < 2; ++s) { qa[s] = *(const bf16x8*)(QD + (size_t)myq * 256 + hd * 64 + 16 * s + 8 * hi); qb2[s] = *(const bf16x8*)(QD + (size_t)myq * 256 + hd * 64 + 32 + 16 * s + 8 * hi); }
                f32x16 o1[2], o2[2]; o1[0] = zero16(); o1[1] = zero16(); o2[0] = zero16(); o2[1] = zero16(); float m1 = -1e30f, l1 = 0.f, m2 = -1e30f, l2 = 0.f;
                constexpr int STRB = T512_STRB;
                { bool f32; const void* src = tile_src(u, 0, cache_lb, RD, 512, 0, f32);
                  if (f32) t512_cvt(src, tile, tid); else t512_dma(src, tile, wave, lane); VM_WAIT(); __syncthreads(); }
                const int kboff = r32 * STRB + (hd * 128 + 8 * hi) * 2;
                const int vboff = (4 * hi + q4) * STRB + (hd * 128 + 64 + 16 * ((lane >> 4) & 1) + 4 * (lane & 3)) * 2;
                int cb = 0;
                for (int t = 0; t < u.nt; ++t) {
                    LAS char* cur = tile + cb * T512_BYTES; LAS char* nxb = tile + (cb ^ 1) * T512_BYTES; cb ^= 1;
                    const LAS char* kb1 = cur + kboff; const LAS char* kb2 = kb1 + 64; const LAS char* vb = cur + vboff;
                    bool f32n = false; const void* sn = nullptr; if (t + 1 < u.nt) sn = tile_src(u, t + 1, cache_lb, RD, 512, 0, f32n);
#if DBG_VARIANTS
                    { f32x16 p0, p1; qk<2>(p0, p1, kb1, STRB, qa); float sx = 0.f; for (int r = 0; r < 16; ++r) { p0[r] = __builtin_amdgcn_exp2f(p0[r] - 8.f); p1[r] = __builtin_amdgcn_exp2f(p1[r] - 8.f); sx += p0[r] + p1[r]; } l1 += sx; pv<2>(o1, p0, p1, vb, STRB); }
                    { f32x16 p0, p1; qk<2>(p0, p1, kb2, STRB, qb2); float sx = 0.f; for (int r = 0; r < 16; ++r) { p0[r] = __builtin_amdgcn_exp2f(p0[r] - 8.f); p1[r] = __builtin_amdgcn_exp2f(p1[r] - 8.f); sx += p0[r] + p1[r]; } l2 += sx; pv<2>(o2, p0, p1, vb, STRB); }
#else
                    { bf16x8 kA[4], kB[4], vf[8]; f32x16 pa0, pa1, pb0, pb1;
                      k_ld<2>(kA, kb1, STRB); k_ld<2>(kB, kb2, STRB); __builtin_amdgcn_sched_barrier(0);
                      qk_r<2>(pa0, pa1, kA, qa); qk_r<2>(pb0, pb1, kB, qb2); v_ld<2>(vf, vb, STRB); __builtin_amdgcn_sched_barrier(0);
                      if (t + 1 < u.nt && !f32n) t512_dma(sn, nxb, wave, lane);
                      __builtin_amdgcn_sched_barrier(0);
                      softmax_step<2>(pa0, pa1, m1, l1, o1); pv_r<2>(o1, pa0, pa1, vf);
                      softmax_step<2>(pb0, pb1, m2, l2, o2); pv_r<2>(o2, pb0, pb1, vf); }
#endif
                    if (t + 1 < u.nt && f32n) t512_cvt(sn, nxb, tid);
                    VM_WAIT(); __syncthreads();
                }
                l1 += __shfl_xor(l1, 32); l2 += __shfl_xor(l2, 32);
                const float i1 = 1.0f / l1, i2 = LAMF[l] / l2; float ss = 0.f;
#pragma unroll
                for (int db = 0; db < 2; ++db)
#pragma unroll
                    for (int r = 0; r < 16; ++r) { const float v = o1[db][r] * i1 - o2[db][r] * i2; o1[db][r] = v; ss += v * v; }
                ss += __shfl_xor(ss, 32);
                const float lam_init = 0.8f - 0.6f * expf(-0.3f * (float)l);
                const float rs = (1.0f - lam_init) / sqrtf(ss * (1.0f / 64.0f) + EPS);
                const float* dn = ARG_IN(I_DN) + l * 64;
                bf16* orow = CC + (size_t)myq * KOUT + 1024 + hd * 64;
#pragma unroll
                for (int db = 0; db < 2; ++db)
#pragma unroll
                    for (int gq = 0; gq < 4; ++gq) { const f32x4 dv = *(const f32x4*)(dn + 32 * db + 8 * gq + 4 * hi);
                        v2u w; w.x = cvtpk(o1[db][4 * gq] * rs * dv[0], o1[db][4 * gq + 1] * rs * dv[1]); w.y = cvtpk(o1[db][4 * gq + 2] * rs * dv[2], o1[db][4 * gq + 3] * rs * dv[3]);
                        *(v2u*)(orow + 32 * db + 8 * gq + 4 * hi) = w; }
            }
            }
#endif
#if EN_MLA
            if (rep == 0 || ((REP_MASK >> 0) & 1)) { MIXER_IDS();
            for (;;) {
                int uidx; NEXT_UNIT(0, uidx); if (uidx < 0) break;
                const UnitId u = decode_unit(qx, uidx);
                const float* cache_lb = ARG_IN(I_CMLA) + ((size_t)(l * NB + u.b) * PAST) * 160;
                const int myq = u.qrow0 + 32 * qh + r32;
                bf16x8 q[10];
#pragma unroll
                for (int s = 0; s < 10; ++s) q[s] = *(const bf16x8*)(QA + (size_t)myq * NQP + hd * 160 + 16 * s + 8 * hi);
                {
                    const int pidx = u.sample ? 2048 + 32 * qh + r32 : u.c * 64 + 32 * qh + r32;
                    bf16x8 a = q[8], b = q[9];
#pragma unroll
                    for (int j = 0; j < 8; ++j) { const float2 cs = ROPE32[pidx * 16 + 8 * hi + j]; const float x1 = bf2f((bf16)a[j]), x2 = bf2f((bf16)b[j]);
                        a[j] = (short)f2bf(x1 * cs.x - x2 * cs.y); b[j] = (short)f2bf(x2 * cs.x + x1 * cs.y); }
                    q[8] = a; q[9] = b;
                }
                f32x16 o[4]; o[0] = zero16(); o[1] = zero16(); o[2] = zero16(); o[3] = zero16(); float m_ = -1e30f, l_ = 0.f;
                TileLd<160, 160> ld; ld.init(); constexpr int STRB = TileLd<160, 160>::STRB;
                bool f32; const void* src = tile_src(u, 0, cache_lb, RA, 160, 0, f32);
                ld.issue(src, f32, tid); ld.store(tile, f32, tid); __syncthreads();
                const int kboff = r32 * STRB + 8 * hi * 2;
                const int vboff = (4 * hi + q4) * STRB + (16 * ((lane >> 4) & 1) + 4 * (lane & 3)) * 2;
                int cb = 0;
                for (int t = 0; t < u.nt; ++t) {
                    LAS char* cur = tile + cb * 24576; LAS char* nxb = tile + (cb ^ 1) * 24576; cb ^= 1;
                    const LAS char* kb = cur + kboff; const LAS char* vb = cur + vboff;
                    bool f32n; { const int tn = (t + 1 < u.nt) ? t + 1 : t; const void* sn = tile_src(u, tn, cache_lb, RA, 160, 0, f32n); ld.issue(sn, f32n, tid); }
                    f32x16 p0, p1; qk_h2<10>(p0, p1, kb, STRB, q);
#if DBG_VARIANTS
                    { for (int r = 0; r < 16; ++r) { p0[r] = p0[r] * 0.f + 1.f; p1[r] = p1[r] * 0.f + 1.f; } l_ += 32.f; }
#else
                    softmax_step<4>(p0, p1, m_, l_, o);
#endif
                    pv<4>(o, p0, p1, vb, STRB);
                    ld.store(nxb, f32n, tid);
                    __syncthreads();
                }
                l_ += __shfl_xor(l_, 32); const float inv = 1.0f / l_;
                bf16* orow = CC + (size_t)myq * KOUT + hd * 128;
#pragma unroll
                for (int db = 0; db < 4; ++db)
#pragma unroll
                    for (int gq = 0; gq < 4; ++gq) { v2u w; w.x = cvtpk(o[db][4 * gq] * inv, o[db][4 * gq + 1] * inv); w.y = cvtpk(o[db][4 * gq + 2] * inv, o[db][4 * gq + 3] * inv);
                        *(v2u*)(orow + 32 * db + 8 * gq + 4 * hi) = w; }
            }
            }
#endif
#if EN_SB
            if (rep == 0 || ((REP_MASK >> 2) & 1)) { MIXER_IDS();
            for (;;) {
                int uidx; NEXT_UNIT(2, uidx); if (uidx < 0) break;
                const UnitId u = decode_unit(qx, uidx);
                const float* cache_lb = ARG_IN(I_CSB) + ((size_t)(l * NB + u.b) * PAST) * 512;
                const int myq = u.qrow0 + 32 * qh + r32, qloc = 32 * qh + r32;
                bf16x8 q[4];
#pragma unroll
                for (int s = 0; s < 4; ++s) q[s] = *(const bf16x8*)(QC + (size_t)myq * 256 + hd * 64 + 16 * s + 8 * hi);
                f32x16 o[2]; o[0] = zero16(); o[1] = zero16(); float carry = 1.0f; int it3 = 0;
                constexpr int STRB = T512_STRB;
                { bool f32; const void* src = tile_src(u, u.nt - 1, cache_lb, RC, 512, 0, f32);
                  if (f32) t512_cvt(src, tile, tid); else t512_dma(src, tile, wave, lane); VM_WAIT(); __syncthreads(); }
                const int kboff = r32 * STRB + (hd * 128 + 8 * hi) * 2;
                const int vboff = (4 * hi + q4) * STRB + (hd * 128 + 64 + 16 * ((lane >> 4) & 1) + 4 * (lane & 3)) * 2;
                volatile LAS unsigned* sbflag = MISC + 20;
                if (tid == 0) { sbflag[0] = 0u; sbflag[1] = 0u; sbflag[2] = 0u; }
                __syncthreads();
                int cb = 0;
                for (int t = u.nt - 1; t >= 0; --t) {
                    LAS char* cur = tile + cb * T512_BYTES; LAS char* nxb = tile + (cb ^ 1) * T512_BYTES; cb ^= 1;
                    const LAS char* kb = cur + kboff; const LAS char* vb = cur + vboff;
                    bool f32n = false; const void* sn = nullptr; if (t > 0) { sn = tile_src(u, t - 1, cache_lb, RC, 512, 0, f32n); if (!f32n) t512_dma(sn, nxb, wave, lane); }
                    const bool diag = (t == u.nt - 1);
                    f32x16 z0, z1; qk<4>(z0, z1, kb, STRB, q);
                    f32x16 u0, u1; float gs[8];
#pragma unroll
                    for (int r = 0; r < 16; ++r) {
                        const int key = crow(r, hi);
                        { const float e = __builtin_amdgcn_exp2f(fminf(z0[r], 80.f)); const float uu = __builtin_amdgcn_rcpf(1.0f + e); const bool ok = !diag || (key < qloc); u0[r] = ok ? uu : 1.0f; z0[r] = ok ? e * uu : 0.f; }
                        { const float e = __builtin_amdgcn_exp2f(fminf(z1[r], 80.f)); const float uu = __builtin_amdgcn_rcpf(1.0f + e); const bool ok = !diag || (key + 32 < qloc); u1[r] = ok ? uu : 1.0f; z1[r] = ok ? e * uu : 0.f; }
                    }
#pragma unroll
                    for (int g4 = 0; g4 < 4; ++g4) { gs[g4] = (u0[4 * g4] * u0[4 * g4 + 1]) * (u0[4 * g4 + 2] * u0[4 * g4 + 3]); gs[4 + g4] = (u1[4 * g4] * u1[4 * g4 + 1]) * (u1[4 * g4 + 2] * u1[4 * g4 + 3]); }
                    float pg[8];
#pragma unroll
                    for (int g8 = 0; g8 < 8; ++g8) pg[g8] = __shfl_xor(gs[g8], 32);
                    float run = carry;
#pragma unroll
                    for (int g8 = 7; g8 >= 0; --g8) {
                        float P = run * (hi == 0 ? pg[g8] : 1.0f);
                        if (g8 >= 4) { const int b4 = 4 * (g8 - 4);
                            z1[b4 + 3] *= P; P *= u1[b4 + 3]; z1[b4 + 2] *= P; P *= u1[b4 + 2]; z1[b4 + 1] *= P; P *= u1[b4 + 1]; z1[b4] *= P;
                        } else { const int b4 = 4 * g8;
                            z0[b4 + 3] *= P; P *= u0[b4 + 3]; z0[b4 + 2] *= P; P *= u0[b4 + 2]; z0[b4 + 1] *= P; P *= u0[b4 + 1]; z0[b4] *= P;
                        }
                        run *= gs[g8] * pg[g8];
                    }
                    carry = run;
                    pv<2>(o, z0, z1, vb, STRB);
                    if (t > 0 && f32n) t512_cvt(sn, nxb, tid);
                    if (tid == 0) sbflag[(it3 + 1) % 3] = 0u;
                    if (__any(carry != 0.f) && lane == 0) sbflag[it3] = 1u;
                    VM_WAIT(); __syncthreads();
                    const bool alive = sbflag[it3] != 0u; it3 = (it3 + 1) % 3;
                    if (!alive) break;
                }
                bf16* orow = CC + (size_t)myq * KOUT + 768 + hd * 64;
#pragma unroll
                for (int db = 0; db < 2; ++db)
#pragma unroll
                    for (int gq = 0; gq < 4; ++gq) { v2u w; w.x = cvtpk(o[db][4 * gq], o[db][4 * gq + 1]); w.y = cvtpk(o[db][4 * gq + 2], o[db][4 * gq + 3]);
                        *(v2u*)(orow + 32 * db + 8 * gq + 4 * hi) = w; }
            }
            }
#endif
            }
            if (BOTH(pb + 4)) GRID_BAR();
        }
        if (EN_PH(6) && IN(pb + 5)) {
            pg8::Gemm g{CC, (const bf16*)(wl + W_OUT), M, DM, KOUT, KOUT}; pg8::StaticOrder S; S.init(M, DM, G, (int)blockIdx.x);
            pg8::EpiResid<false> E{nullptr, nullptr, XB, ssqC, 1.0f};
            pg8::gemm_phase<pg8::EpiResid<false>, pg8::StaticOrder, true, true>(lds, g, S, E, wave0);
            if (BOTH(pb + 5)) GRID_BAR();
        }
        if (EN_PH(7) && IN(pb + 6)) {
            pg8::Gemm g{XB, (const bf16*)(wl + W_GU2), M, NGU, DM, DM}; pg8::StaticOrder S; S.init(M, NGU, G, (int)blockIdx.x);
            pg8::EpiSwiGLU E{ACT, ssqC};
            for (int grep = 0; grep < GU_REPS; ++grep)
            pg8::gemm_phase<pg8::EpiSwiGLU, pg8::StaticOrder, true, true>(lds, g, S, E, wave0);
            if (BOTH(pb + 6)) GRID_BAR();
        }
        if (EN_PH(8) && IN(pb + 7)) {
            pg8::Gemm g{ACT, (const bf16*)(wl + W_D2), M, DM, DFF, DFF}; pg8::StaticOrder S; S.init(MP, DM, G, (int)blockIdx.x);
            pg8::EpiResid<false> E{nullptr, nullptr, XB, ssqAn, 0.5f};
            pg8::gemm_phase<pg8::EpiResid<false>, pg8::StaticOrder, true, true>(lds, g, S, E, wave0);
            SPLITK_SAMPLE(W_D2);
            GRID_BAR();
            { FRESH_TID(); const int un_ = (int)blockIdx.x >> 3, j_ = (int)blockIdx.x & 7; const float* Pu = (const float*)(ws + WS_QA) + (size_t)un_ * 8 * 32 * 512 * 4;
              pg8::resid_fixup<false>(Pu, MP / 256 + (un_ >> 2), un_ & 3, j_ >> 2, j_ & 3, nullptr, XB, ssqAn, 0.5f, tid); }
            if (BOTH(pb + 7)) GRID_BAR();
        }
    }
    if (EN_PH(9) && IN(17)) {
        FRESH_TID();
        const float* fn = ARG_IN(I_FN); const float* ssqF = SSQP + (size_t)2 * M * 16;
        const int gw = blockIdx.x * NWAVES + wave, NGW = G * NWAVES;
        for (int m = gw; m < M; m += NGW) {
            const float rs = 1.0f / sqrtf(ssq_sum16(ssqF, m) * (1.0f / 1024.0f) + EPS);
            const v2u* x2 = (const v2u*)(XB + (size_t)m * DM) + lane; f32x4* y4 = (f32x4*)(X + (size_t)m * DM) + lane; const f32x4* g4 = (const f32x4*)fn + lane;
#pragma unroll
            for (int j = 0; j < 4; ++j) { const v2u w = x2[64 * j]; const f32x4 gg = g4[64 * j];
                const f32x4 v = (f32x4){__uint_as_float(w.x << 16), __uint_as_float(w.x & 0xffff0000u), __uint_as_float(w.y << 16), __uint_as_float(w.y & 0xffff0000u)};
                y4[64 * j] = v * rs * gg; }
        }
    }
#undef IN
#undef BOTH
#undef GRID_BAR
#undef X
#undef XB
#undef HB
#undef ACT
#undef QA
#undef QB
#undef QI
#undef QC
#undef QD
#undef WI
#undef RA
#undef RB
#undef RC
#undef RD
#undef CC
#undef CQ
#undef CKV
#undef SSQP
#undef LAMF
#undef ROPE64
#undef ROPE32
}


#if SELFCHECK
constexpr size_t WS_CHK = 3 * MiB + 768 * 1024;
__device__ __forceinline__ unsigned hsh(unsigned x) { x ^= x >> 16; x *= 0x7feb352du; x ^= x >> 15; x *= 0x846ca68bu; x ^= x >> 16; return x; }
__device__ __forceinline__ void chk_rep(unsigned* slot, float got, float ex, float atol, float rtol) {
    float e = fabsf(got - ex) / (atol + rtol * fabsf(ex)); if (!(e == e)) e = 1e30f; atomicMax(slot, __float_as_uint(e)); }
__device__ __forceinline__ float bfr(float x) { return bf2f((bf16)f2bf(x)); }
__device__ __forceinline__ int nat_col(int np) { return np < 1376 ? np : (np < 2912 ? np + 8 : (np < 2920 ? 1376 + (np - 2912) : -1)); }
struct Ptrs { float* X; bf16 *XB, *HB, *ACT, *QA, *QB, *QI, *QC, *QD, *RA, *RB, *RC, *RD, *CC; float* WI; float* SSQ; float* LAMF; float2 *R64, *R32; unsigned* chk; float* save; unsigned char* wl; };
__device__ __forceinline__ Ptrs mkptrs(const Args& a, int l) { Ptrs p; unsigned char* ws = a.ws;
    p.X = a.out; p.XB = (bf16*)(ws + WS_XB); p.HB = (bf16*)(ws + WS_REGA); p.ACT = p.HB; p.QA = (bf16*)(ws + WS_QA); p.QB = (bf16*)(ws + WS_QB); p.QI = (bf16*)(ws + WS_QI); p.QC = (bf16*)(ws + WS_QC); p.QD = (bf16*)(ws + WS_QD);
    p.RA = (bf16*)(ws + WS_RA); p.RB = (bf16*)(ws + WS_RB); p.RC = (bf16*)(ws + WS_RC); p.RD = (bf16*)(ws + WS_RD); p.CC = (bf16*)(ws + WS_CC); p.WI = (float*)(ws + WS_WI); p.SSQ = (float*)(ws + WS_SSQ);
    p.LAMF = (float*)(ws + WS_MISC); p.R64 = (float2*)(ws + WS_MISC + MISC_ROPE64); p.R32 = (float2*)(ws + WS_MISC + MISC_ROPE32); p.chk = (unsigned*)(ws + WS_CHK); p.save = (float*)(ws + WS_CHK + 256); p.wl = ws + WS_W + (size_t)l * W_LAYER; return p; }
__device__ __forceinline__ int samp_row(unsigned h) { const unsigned r = h % 4096u; return r < 3584u ? (int)(hsh(h) % (unsigned)MP) : MP + (int)(hsh(h) % (unsigned)MS); }

__global__ void __launch_bounds__(256) check_kernel(Args a, int l, int which) {
    const Ptrs p = mkptrs(a, l); const int gt = blockIdx.x * 256 + threadIdx.x, NT = gridDim.x * 256; const int lane = threadIdx.x & 63; const int gwv = gt >> 6, NW = NT >> 6;
    const float* ssqA = p.SSQ + (size_t)l * M; const float* ssqB = p.SSQ + (size_t)(3 + l) * M; const float* ssqC = p.SSQ + (size_t)(5 + l) * M; const float* ssqQ = p.SSQ + (size_t)(7 + l) * M;
    if (which == 0) {
        for (int i = gt; i < 16384; i += NT) { const unsigned h = hsh(i * 3 + 1);
            { const int np = h % NGU, k = hsh(h) % DM, pn = np >> 8, c = np & 255, f = pn * 128 + (c & 127); const float* src = (c < 128 ? a.in[I_G1] : a.in[I_U1]) + (size_t)l * DM * DFF;
              chk_rep(p.chk + 0, bf2f(((bf16*)(p.wl + W_GU1))[(size_t)np * DM + k]), bfr(src[(size_t)k * DFF + f] * a.in[I_N1][l * DM + k]), 1e-6f, 1e-3f); }
            { const int n = h % DM, k = hsh(h + 7) % DFF; chk_rep(p.chk + 1, bf2f(((bf16*)(p.wl + W_D1))[(size_t)n * DFF + k]), bfr(a.in[I_D1][(size_t)l * DFF * DM + (size_t)k * DM + n]), 1e-6f, 1e-3f); }
            { const int np = h % NINP, k = hsh(h + 9) % DM, j = nat_col(np); const float ex = j < 0 ? 0.f : bfr(a.in[I_WIN][(size_t)l * DM * NIN + (size_t)k * NIN + j] * a.in[I_NM][l * DM + k]);
              chk_rep(p.chk + 2, bf2f(((bf16*)(p.wl + W_IN))[(size_t)np * DM + k]), ex, 1e-6f, 1e-3f); }
            if (l == 0) { const int row = samp_row(h), c = hsh(h + 11) % DM; const float xv = row < MP ? a.in[I_XP][(size_t)row * DM + c] : a.in[I_XS][(size_t)(row - MP) * DM + c];
              chk_rep(p.chk + 3, bf2f(p.XB[(size_t)row * DM + c]), bfr(xv), 1e-6f, 1e-3f); }
        }
        if (l == 0) for (int i = gwv; i < 256; i += NW) { const int row = samp_row(hsh(i + 77)); const float* xr = row < MP ? a.in[I_XP] + (size_t)row * DM : a.in[I_XS] + (size_t)(row - MP) * DM;
            float s = 0.f; for (int c = lane; c < DM; c += 64) s += xr[c] * xr[c]; s = wave_sum(s); if (lane == 0) chk_rep(p.chk + 3, ssqA[row], s, 1e-3f, 1e-3f); }
    }
    if (which == 1) {
        for (int i = gt; i < 8192; i += NT) { const unsigned h = hsh(i * 5 + 2); const int row = samp_row(h), f = hsh(h + 1) % DFF; const bf16* wg = (bf16*)(p.wl + W_GU1) + (size_t)((f >> 7) * 256 + (f & 127)) * DM; const bf16* wu = wg + (size_t)128 * DM;
            const float* ssq = ssqA; float g = 0.f, u = 0.f; for (int k = 0; k < DM; ++k) { const float xv = bf2f(p.XB[(size_t)row * DM + k]); g += xv * bf2f(wg[k]); u += xv * bf2f(wu[k]); }
            const float rs = 1.0f / sqrtf(ssq[row] / 1024.f + EPS); g *= rs; u *= rs; const float ex = g / (1.f + expf(-g)) * u;
            chk_rep(p.chk + 4, bf2f(p.ACT[(size_t)row * DFF + f]), ex, 0.01f, 0.02f); }
    }
    if (which == 2) {
        for (int i = gt; i < 8192; i += NT) { const unsigned h = hsh(i * 7 + 3); const int row = samp_row(h), c = hsh(h + 1) % DM; const bf16* wd = (bf16*)(p.wl + W_D1) + (size_t)c * DFF;
            float s = 0.f; for (int k = 0; k < DFF; ++k) s += bf2f(p.ACT[(size_t)row * DFF + k]) * bf2f(wd[k]);
            const float xin = l == 0 ? (row < MP ? a.in[I_XP][(size_t)row * DM + c] : a.in[I_XS][(size_t)(row - MP) * DM + c]) : 0.f;
            if (l == 0) chk_rep(p.chk + 5, p.X[(size_t)row * DM + c], xin + 0.5f * s, 0.01f, 0.005f);
            chk_rep(p.chk + 5, bf2f(p.XB[(size_t)row * DM + c]), bfr(p.X[(size_t)row * DM + c]), 1e-6f, 1e-3f); }
        for (int i = gwv; i < 256; i += NW) { const int row = samp_row(hsh(i + 177)); float s = 0.f; for (int c = lane; c < DM; c += 64) { const float v = p.X[(size_t)row * DM + c]; s += v * v; } s = wave_sum(s);
            if (lane == 0) chk_rep(p.chk + 5, ssqB[row], s, 1e-3f, 1e-3f); }
    }
    if (which == 3) {
        for (int i = gt; i < 8192; i += NT) { const unsigned h = hsh(i * 11 + 4); const int row = samp_row(h), np = hsh(h + 1) % NINP; const bf16* w = (bf16*)(p.wl + W_IN) + (size_t)np * DM;
            float s = 0.f; for (int k = 0; k < DM; ++k) s += bf2f(p.XB[(size_t)row * DM + k]) * bf2f(w[k]); s *= 1.0f / sqrtf(ssqB[row] / 1024.f + EPS);
            chk_rep(p.chk + 6, bf2f(p.HB[(size_t)row * NINP + np]), s, 0.01f, 0.01f); }
        for (int i = gwv; i < 256; i += NW) { const int row = samp_row(hsh(i + 277)); float s = 0.f; for (int c = lane; c < 256; c += 64) { const float v = bf2f(p.HB[(size_t)row * NINP + c]); s += v * v; } s = wave_sum(s);
            if (lane == 0) chk_rep(p.chk + 6, ssqQ[row], s, 0.05f, 0.01f); }
    }
    if (which == 4) {
        const float* wqb = a.in[I_WQB] + (size_t)l * 256 * 384; const float* wkvb = a.in[I_WKVB] + (size_t)l * 128 * 512; const float* qn = a.in[I_QN] + l * 256;
        for (int i = gt; i < 2048; i += NT) { const unsigned h = hsh(i * 13 + 5); const int row = samp_row(h), hh = (hsh(h + 1) >> 3) & 3, c = hsh(h + 2) % 160; const bf16* hr = p.HB + (size_t)row * NINP;
            const float rs = 1.0f / sqrtf(ssqQ[row] / 256.f + EPS); float ex;
            if (c < 128) { float acc = 0.f; for (int e = 0; e < 64; ++e) { float qe = 0.f; for (int k = 0; k < 256; ++k) qe += bf2f(hr[k]) * rs * qn[k] * wqb[(size_t)k * 384 + hh * 96 + e]; acc += qe * wkvb[(size_t)c * 512 + hh * 128 + e]; } ex = acc; }
            else { float qe = 0.f; for (int k = 0; k < 256; ++k) qe += bf2f(hr[k]) * rs * qn[k] * wqb[(size_t)k * 384 + hh * 96 + 64 + (c - 128)]; ex = qe; }
            ex *= 0.10206207261596575f * LOG2E;
            chk_rep(p.chk + 7, bf2f(p.QA[(size_t)row * NQP + hh * 160 + c]), ex, 0.01f, 0.02f); }
        for (int i = gt; i < 16384; i += NT) { const unsigned h = hsh(i * 17 + 6); const int row = samp_row(h); const bool smp = row >= MP; const int rr = smp ? row - MP : row; const float pos = smp ? 4096.f + (rr & 63) : (float)(rr & 2047);
            const bf16* hr = p.HB + (size_t)row * NINP;
            const float* o_mla = a.out + (smp ? O_MLA_S + ((size_t)l * MS + rr) * 160 : O_MLA_P + ((size_t)l * MP + rr) * 160);
            const float* o_dsa = a.out + (smp ? O_DSA_S + ((size_t)l * MS + rr) * 192 : O_DSA_P + ((size_t)l * MP + rr) * 192);
            const float* o_sb = a.out + (smp ? O_SB_S + ((size_t)l * MS + rr) * 512 : O_SB_P + ((size_t)l * MP + rr) * 512);
            const float* o_df = a.out + (smp ? O_DIFF_S + ((size_t)l * MS + rr) * 512 : O_DIFF_P + ((size_t)l * MP + rr) * 512);
#define HN(j) bf2f(hr[(j) < 1376 ? (j) : ((j) < 1384 ? H_WI + ((j) - 1376) : (j) - 8)])
#define ROPE(base, d, idx, res) do { const int hf = (d) / 2, ii = (idx) % hf; const float fr = (d) == 64 ? a.freq64[ii] : a.freq32[ii]; float sn, cs; sincos_acc(pos * fr, sn, cs); \
            const float x1 = HN((base) + ii), x2 = HN((base) + hf + ii); res = (idx) < hf ? x1 * cs - x2 * sn : x2 * cs + x1 * sn; } while (0)
            const int sel = hsh(h + 3) % 12; const unsigned e = hsh(h + 4);
            if (sel == 0) { const int c = e % 128; float ss = 0.f; for (int k = 0; k < 128; ++k) { const float v = HN(256 + k); ss += v * v; } const float ex = HN(256 + c) / sqrtf(ss / 128.f + EPS) * a.in[I_KVN][l * 128 + c];
                chk_rep(p.chk + 8, o_mla[c], ex, 0.01f, 0.01f); chk_rep(p.chk + 8, bf2f(p.RA[(size_t)row * 160 + c]), ex, 0.01f, 0.01f); }
            if (sel == 1) { const int c = e % 32; float ex; ROPE(384, 32, c, ex); chk_rep(p.chk + 8, o_mla[128 + c], ex, 0.01f, 0.01f); chk_rep(p.chk + 8, bf2f(p.RA[(size_t)row * 160 + 128 + c]), ex, 0.01f, 0.01f); }
            if (sel == 2) { const int c = e % 256, hd = c >> 6; float ex; ROPE(416 + hd * 64, 64, c & 63, ex); chk_rep(p.chk + 8, bf2f(p.QB[(size_t)row * 256 + c]), ex * 0.125f * LOG2E, 0.01f, 0.01f); }
            if (sel == 3) { const int c = e % 64; float ex; ROPE(672, 64, c, ex); chk_rep(p.chk + 8, o_dsa[c], ex, 0.01f, 0.01f); chk_rep(p.chk + 8, bf2f(p.RB[(size_t)row * 192 + c]), ex, 0.01f, 0.01f);
                            const float v = HN(736 + c); chk_rep(p.chk + 8, o_dsa[64 + c], v, 0.01f, 0.01f); chk_rep(p.chk + 8, bf2f(p.RB[(size_t)row * 192 + 64 + c]), v, 0.01f, 0.01f); }
            if (sel == 4) { const int c = e % 512, hd = c >> 6; float ex; ROPE(800 + hd * 64, 64, c & 63, ex); chk_rep(p.chk + 8, bf2f(p.QI[(size_t)row * 512 + c]), ex, 0.01f, 0.01f); }
            if (sel == 5) { const int c = e % 64; float ex; ROPE(1312, 64, c, ex); chk_rep(p.chk + 8, o_dsa[128 + c], ex, 0.01f, 0.01f); chk_rep(p.chk + 8, bf2f(p.RB[(size_t)row * 192 + 128 + c]), ex, 0.01f, 0.01f);
                            const int w8 = e % 8; chk_rep(p.chk + 8, p.WI[(size_t)row * 8 + w8], HN(1376 + w8) * 0.35355339f, 0.005f, 0.01f); }
            if (sel == 6) { const int c = e % 256, hd = c >> 6, d = c & 63; chk_rep(p.chk + 8, bf2f(p.QC[(size_t)row * 256 + c]), HN(1384 + c) * 0.125f, 0.005f, 0.01f);
                            chk_rep(p.chk + 8, o_sb[hd * 128 + d], HN(1640 + c), 0.01f, 0.01f); chk_rep(p.chk + 8, o_sb[hd * 128 + 64 + d], HN(1896 + c), 0.01f, 0.01f);
                            chk_rep(p.chk + 8, bf2f(p.RC[(size_t)row * 512 + hd * 128 + d]), HN(1640 + c), 0.01f, 0.01f); chk_rep(p.chk + 8, bf2f(p.RC[(size_t)row * 512 + hd * 128 + 64 + d]), HN(1896 + c), 0.01f, 0.01f); }
            if (sel == 7) { const int c = e % 256, blk = c >> 5; float ex; ROPE(2152 + blk * 32, 32, c & 31, ex); chk_rep(p.chk + 8, bf2f(p.QD[(size_t)row * 256 + c]), ex * 0.17677669529663687f * LOG2E, 0.01f, 0.01f); }
            if (sel == 8) { const int c = e % 256, blk = c >> 5, hd = c >> 6; float ex; ROPE(2408 + blk * 32, 32, c & 31, ex); chk_rep(p.chk + 8, o_df[hd * 128 + (c & 63)], ex, 0.01f, 0.01f); chk_rep(p.chk + 8, bf2f(p.RD[(size_t)row * 512 + hd * 128 + (c & 63)]), ex, 0.01f, 0.01f); }
            if (sel == 9) { const int c = e % 256, hd = c >> 6, d = c & 63; chk_rep(p.chk + 8, o_df[hd * 128 + 64 + d], HN(2664 + c), 0.01f, 0.01f); chk_rep(p.chk + 8, bf2f(p.RD[(size_t)row * 512 + hd * 128 + 64 + d]), HN(2664 + c), 0.01f, 0.01f); }
        }
    }
    if (which == 5) {
        for (int i = gwv; i < 4 * 96; i += NW) {
            int kind = i / 96; const int slot = kind; const unsigned h = hsh(i * 19 + 7); int row = samp_row(h);
            if (CHK_FILTER == 6) { row = MP + (int)(hsh(h + 5) % (unsigned)MS); if (slot == 1) { kind = 2; row = (row & ~63) | (int)(hsh(h + 9) % 3u); } if (slot == 2) row = (row & ~63) | (48 + (int)(hsh(h + 9) % 16u)); }
            if (CHK_FILTER == 1) row = (int)(hsh(h + 5) % NB) * SEQ + (int)(hsh(h + 6) % 64u);
            if (CHK_FILTER == 2) row = (int)(hsh(h + 5) % (unsigned)MP);
            if (CHK_FILTER == 3) row = MP + (int)(hsh(h + 5) % (unsigned)MS);
            if (CHK_FILTER == 5) { if (kind == 0 || kind == 2) row = MP + (int)(hsh(h + 5) % (unsigned)MS); else if (kind == 1) row = (int)(hsh(h + 5) % NB) * SEQ + 128 + (int)(hsh(h + 6) % 128u); else row = (int)(hsh(h + 5) % NB) * SEQ + 128 + (int)(hsh(h + 6) % 384u); }
            if (CHK_FILTER == 4) row = (int)(hsh(h + 5) % NB) * SEQ + 64 + (int)(hsh(h + 6) % 64u); const int hd = (hsh(h + 1) >> 5) & 3; const bool smp = row >= MP; const int rr = smp ? row - MP : row;
            const int b = smp ? rr >> 6 : rr >> 11, t = smp ? rr & 63 : rr & 2047; const int L = smp ? PAST + 64 : ((t >> 6) + 1) * 64;
            const int W = kind == 0 ? 160 : (kind == 1 ? 192 : 512);
            const float* cache = (kind == 0 ? a.in[I_CMLA] : kind == 1 ? a.in[I_CDSA] : kind == 2 ? a.in[I_CSB] : a.in[I_CDIFF]) + (size_t)(l * NB + b) * PAST * W;
            const bf16* rows = kind == 0 ? p.RA : kind == 1 ? p.RB : kind == 2 ? p.RC : p.RD;
#define SLD(ptr) __hip_atomic_load((ptr), __ATOMIC_RELAXED, __HIP_MEMORY_SCOPE_AGENT)
#define KEL(k, c) (smp ? ((k) < PAST ? bfr(cache[(size_t)(k) * W + (c)]) : bf2f(rows[(size_t)(MP + b * 64 + (k) - PAST) * W + (c)])) : bf2f(rows[(size_t)(b * SEQ + (k)) * W + (c)]))
            float* sbuf = (float*)(a.ws + WS_REGA + (size_t)300 * MiB) + (size_t)i * 8448;
            if (kind == 0) {
                const int pidx = smp ? 2048 + t : t; float mx = -1e30f;
                for (int k = lane; k < L; k += 64) { float s = 0.f; for (int c = 0; c < 128; ++c) s += bf2f(p.QA[(size_t)row * NQP + hd * 160 + c]) * KEL(k, c);
                    for (int c = 0; c < 16; ++c) { const float2 cs = p.R32[pidx * 16 + c]; const float x1 = bf2f(p.QA[(size_t)row * NQP + hd * 160 + 128 + c]), x2 = bf2f(p.QA[(size_t)row * NQP + hd * 160 + 144 + c]);
                        s += bfr(x1 * cs.x - x2 * cs.y) * KEL(k, 128 + c) + bfr(x2 * cs.x + x1 * cs.y) * KEL(k, 144 + c); }
                    sbuf[k] = s; mx = fmaxf(mx, s); }
                for (int o = 1; o < 64; o <<= 1) mx = fmaxf(mx, __shfl_xor(mx, o));
                float den = 0.f; for (int k = lane; k < L; k += 64) { float pp = exp2f(sbuf[k] - mx); if (DBG_VARIANTS) pp = 1.f; sbuf[k] = pp; den += pp; } den = wave_sum(den);
                __builtin_amdgcn_s_waitcnt(0);
                for (int d = 0; d < 128; d += 16) { const int dd = d + (lane & 15); float acc = 0.f; for (int k = lane >> 4; k < L; k += 4) acc += SLD(sbuf + k) * KEL(k, dd); acc += __shfl_xor(acc, 16); acc += __shfl_xor(acc, 32);
                    if (lane < 16) chk_rep(p.chk + 9, bf2f(p.CC[(size_t)row * KOUT + hd * 128 + dd]), acc / den, 0.004f, 0.03f); }
            }
            if (kind == 1) {
                const int nsel = 256;
                for (int k = lane; k < L; k += 64) { float sc = 0.f; for (int ih = 0; ih < 8; ++ih) { float s = 0.f; for (int c = 0; c < 64; ++c) s += bf2f(p.QI[(size_t)row * 512 + ih * 64 + c]) * KEL(k, 128 + c); sc += fmaxf(s, 0.f) * p.WI[(size_t)row * 8 + ih]; } sbuf[k] = sc; }
                __builtin_amdgcn_s_waitcnt(0);
                float mx = -1e30f; float* pb = sbuf + 4224;
                for (int k = lane; k < L; k += 64) { const float me = sbuf[k]; int rank = 0; if (L > nsel) for (int j = 0; j < L; ++j) { const float o = SLD(sbuf + j); rank += (o > me) || (o == me && j < k); }
                    float s = -1e30f; if (rank < nsel) { s = 0.f; for (int c = 0; c < 64; ++c) s += bf2f(p.QB[(size_t)row * 256 + hd * 64 + c]) * KEL(k, c); } pb[k] = s; mx = fmaxf(mx, s); }
                for (int o = 1; o < 64; o <<= 1) mx = fmaxf(mx, __shfl_xor(mx, o));
                float den = 0.f; for (int k = lane; k < L; k += 64) { const float pp = pb[k] > -1e29f ? exp2f(pb[k] - mx) : 0.f; pb[k] = pp; den += pp; } den = wave_sum(den);
                __builtin_amdgcn_s_waitcnt(0);
                for (int d = 0; d < 64; d += 16) { const int dd = d + (lane & 15); float acc = 0.f; for (int k = lane >> 4; k < L; k += 4) acc += SLD(pb + k) * KEL(k, 64 + dd); acc += __shfl_xor(acc, 16); acc += __shfl_xor(acc, 32);
                    if (lane < 16) chk_rep(p.chk + 10, bf2f(p.CC[(size_t)row * KOUT + 512 + hd * 64 + dd]), acc / den, 0.02f, 0.10f); }
            }
            if (kind == 2) {
                const int qpos = smp ? PAST + t : t; float accv[1]; (void)accv;
                for (int k = lane; k < qpos; k += 64) { float z = 0.f; for (int c = 0; c < 64; ++c) z += bf2f(p.QC[(size_t)row * 256 + hd * 64 + c]) * KEL(k, hd * 128 + c); sbuf[k] = z; }
                __builtin_amdgcn_s_waitcnt(0);
                float logafter = 0.f, acc = 0.f;
                for (int k = qpos - 1; k >= 0; --k) { const float z = SLD(sbuf + k); const float sp = fmaxf(z, 0.f) + logf(1.f + expf(-fabsf(z))); const float aw = expf(z - sp + logafter); acc += bfr(aw) * KEL(k, hd * 128 + 64 + lane); logafter -= sp; if (logafter < -60.f) break; }
                chk_rep(p.chk + 9 + slot, bf2f(p.CC[(size_t)row * KOUT + 768 + hd * 64 + lane]), acc, 0.02f, 0.05f);
            }
            if (kind == 3) {
                float outv = 0.f; float o2[2];
                for (int m2 = 0; m2 < 2; ++m2) { float mx = -1e30f;
                    for (int k = lane; k < L; k += 64) { float s = 0.f; for (int c = 0; c < 32; ++c) s += bf2f(p.QD[(size_t)row * 256 + hd * 64 + m2 * 32 + c]) * KEL(k, hd * 128 + m2 * 32 + c); sbuf[k] = s; mx = fmaxf(mx, s); }
                    for (int o = 1; o < 64; o <<= 1) mx = fmaxf(mx, __shfl_xor(mx, o));
                    float den = 0.f; for (int k = lane; k < L; k += 64) { const float pp = exp2f(sbuf[k] - (DBG_VARIANTS ? 8.f : mx)); sbuf[k] = pp; den += pp; } den = wave_sum(den);
                    __builtin_amdgcn_s_waitcnt(0);
                    float acc = 0.f; for (int k = 0; k < L; ++k) acc += SLD(sbuf + k) * KEL(k, hd * 128 + 64 + lane); o2[m2] = acc / den; __builtin_amdgcn_s_waitcnt(0); }
                outv = o2[0] - p.LAMF[l] * o2[1]; const float ss = wave_sum(outv * outv); const float lam_init = 0.8f - 0.6f * expf(-0.3f * (float)l);
                const float ex = outv / sqrtf(ss / 64.f + EPS) * a.in[I_DN][l * 64 + lane] * (1.f - lam_init);
                chk_rep(p.chk + 12, bf2f(p.CC[(size_t)row * KOUT + 1024 + hd * 64 + lane]), ex, 0.02f, 0.05f);
            }
        }
    }
    if (which == 6) { for (int i = gt; i < 4096; i += NT) { const unsigned h = hsh(i * 23 + 8); const int row = samp_row(h), c = hsh(h + 1) % DM; p.save[i] = p.X[(size_t)row * DM + c]; } }
    if (which == 7) {
        const float* wkvb = a.in[I_WKVB] + (size_t)l * 128 * 512; const float* wo = a.in[I_WO] + (size_t)l * DM * DM;
        for (int i = gt; i < 4096; i += NT) { const unsigned h = hsh(i * 23 + 8); const int row = samp_row(h), c = hsh(h + 1) % DM; const bf16* w = (bf16*)(p.wl + W_OUT) + (size_t)c * KOUT;
            float s = 0.f; for (int k = 0; k < KOUT; ++k) s += bf2f(p.CC[(size_t)row * KOUT + k]) * bf2f(w[k]);
            chk_rep(p.chk + 13, p.X[(size_t)row * DM + c], p.save[i] + s, 0.01f, 0.005f);
            float s1 = 0.f, s2 = 0.f; for (int k = 0; k < 512; ++k) s1 += bf2f(p.CC[(size_t)row * KOUT + k]) * bf2f(w[k]);
            for (int hh = 0; hh < 4; ++hh) for (int e = 0; e < 64; ++e) { float v = 0.f; for (int cc = 0; cc < 128; ++cc) v += bf2f(p.CC[(size_t)row * KOUT + hh * 128 + cc]) * wkvb[(size_t)cc * 512 + hh * 128 + 64 + e]; s2 += v * wo[(size_t)(hh * 64 + e) * DM + c]; }
            chk_rep(p.chk + 14, s1, s2, 0.01f, 0.02f);
            for (int k = 512; k < KOUT; k += 97) chk_rep(p.chk + 14, bf2f(w[k]), bfr(wo[(size_t)(256 + k - 512) * DM + c]), 1e-6f, 1e-3f); }
    }
}
#ifndef CHK_SHOW
#define CHK_SHOW -1
#endif
#ifndef CHK_MAXLI
#define CHK_MAXLI 6
#endif
__global__ void __launch_bounds__(256) report_kernel(Args a) {
    const unsigned* chk = (const unsigned*)(a.ws + WS_CHK); float A = 0.f;
    if (CHK_SHOW >= 0) { A = sqrtf(fminf(__uint_as_float(chk[CHK_SHOW >= 0 ? CHK_SHOW : 0]), 400.f)); if (A < 0.3f) A = 0.f; }
    else if (CHK_SHOW == -2) { int bits = 0; for (int f = 9; f <= 12; ++f) if (__uint_as_float(chk[f]) > 1.0f) bits |= 1 << (f - 9); A = (float)(1 + bits); }
    else for (int f = 0; f < 15; ++f) if (__uint_as_float(chk[f]) > 1.0f) { A = (float)(f + 1); break; }
    if (A == 0.f) return;
    for (size_t i = (size_t)blockIdx.x * 256 + threadIdx.x; i < (size_t)M * DM; i += (size_t)gridDim.x * 256) a.out[i] = A;
}
#endif

extern "C" void kernel_launch(void* const* d_in, const int* in_sizes, int n_in, void* d_out, int out_size, void* d_ws, size_t ws_size, hipStream_t stream) {
    static int grid = 0;
    if (grid == 0) {
        if (n_in != 24 || (size_t)out_size != O_END || ws_size < WS_END) { fprintf(stderr, "kernel_launch: unexpected shapes: n_in %d out %d ws %zu (need %zu)\n", n_in, out_size, ws_size, (size_t)WS_END); grid = -1; return; }
        int dev = 0, cus = 0, per_cu = 0;
        if (hipGetDevice(&dev) != hipSuccess || hipDeviceGetAttribute(&cus, hipDeviceAttributeMultiprocessorCount, dev) != hipSuccess) { grid = -1; return; }
        if (hipFuncSetAttribute((const void*)fwd_kernel, hipFuncAttributeMaxDynamicSharedMemorySize, LDS_BYTES) != hipSuccess) { fprintf(stderr, "kernel_launch: hipFuncSetAttribute failed\n"); grid = -1; return; }
        if (hipOccupancyMaxActiveBlocksPerMultiprocessor(&per_cu, (const void*)fwd_kernel, NWAVES * 64, LDS_BYTES) != hipSuccess || per_cu < 1) fprintf(stderr, "kernel_launch: occupancy query reports %d\n", per_cu);
        (void)hipGetLastError();
        grid = cus < 256 ? cus : 256;
    }
    if (grid < 0) return;
    (void)hipMemsetAsync((char*)d_ws + WS_CTL, 0, CTL_ZERO_BYTES, stream);
    Args a{};
    for (int i = 0; i < 24; ++i) a.in[i] = (const float*)d_in[i];
    a.out = (float*)d_out; a.ws = (unsigned char*)d_ws;
    for (int i = 0; i < 32; ++i) a.freq64[i] = (float)pow(10000.0, -(double)i * 2.0 / 64.0);
    for (int i = 0; i < 16; ++i) a.freq32[i] = (float)pow(10000.0, -(double)i * 2.0 / 32.0);
    constexpr int NPH = 18;
    for (int li = 0; li < MK_N_LAUNCHES; ++li) {
        a.ph_lo = (MK_N_LAUNCHES == 1) ? 0 : li; a.ph_hi = (MK_N_LAUNCHES == 1) ? NPH : li + 1;
#if SELFCHECK
        if (MK_N_LAUNCHES == 18 && li == 6 && CHK_MAXLI >= 6) hipLaunchKernelGGL(check_kernel, dim3(256), dim3(256), 0, stream, a, 0, 6);
#endif
        hipLaunchKernelGGL(fwd_kernel, dim3(grid), dim3(NWAVES * 64), LDS_BYTES, stream, a);
        const hipError_t le = hipPeekAtLastError();
        if (le != hipSuccess) { fprintf(stderr, "kernel_launch: launch %d failed: %s\n", li, hipGetErrorName(le)); break; }
#if SELFCHECK
        if (MK_N_LAUNCHES == 18) { const int wmap[7] = {0, 1, 2, 3, 4, 5, 7}; if (li <= CHK_MAXLI) hipLaunchKernelGGL(check_kernel, dim3(512), dim3(256), 0, stream, a, 0, wmap[li]); }
#endif
    }
#if SELFCHECK
    hipLaunchKernelGGL(report_kernel, dim3(1024), dim3(256), 0, stream, a);
#endif
}
```
